# Optimizing an MI355X kernel written in HIP

```python
import math
import jax, jax.numpy as jnp
from jax import lax
import numpy as np

D_MODEL = 2048
BATCH = 8
SEQ = 2048
DEPTH = 2

GRID_W = 64
CTX_LEN = 256
Q_BLOCK = 128
ROPE_THETA = 10000.0
EPS = 1e-6
NEG_INF = -1e30

NA_HEADS = 4
NA_HEAD_DIM = 128
NA_KH_MAX = 8
NA_KW = 16
NA_QCB = 16
NA_KCB = 2 * NA_KW
MLA_HEADS = 4
MLA_NOPE = 128
MLA_ROPE = 64
MLA_V = 128
MLA_Q_RANK = 384
MLA_KV_RANK = 128
GQA_HEADS = 4
GQA_KV_HEADS = 2
GQA_HEAD_DIM = 128
DIFF_HEADS = 4
DIFF_QK_DIM = 64
DIFF_V_DIM = 128

NA_SCALE = NA_HEAD_DIM ** -0.5
MLA_SCALE = (MLA_NOPE + MLA_ROPE) ** -0.5
GQA_SCALE = GQA_HEAD_DIM ** -0.5
DIFF_SCALE = DIFF_QK_DIM ** -0.5

MIX_WIDTH = NA_HEADS * NA_HEAD_DIM + MLA_HEADS * MLA_V + GQA_HEADS * GQA_HEAD_DIM + DIFF_HEADS * DIFF_V_DIM
IN_SIZES = (NA_HEADS * NA_HEAD_DIM, NA_HEADS * NA_HEAD_DIM, NA_HEADS * NA_HEAD_DIM,
            MLA_Q_RANK, MLA_KV_RANK, MLA_ROPE,
            GQA_HEADS * GQA_HEAD_DIM, GQA_KV_HEADS * GQA_HEAD_DIM, GQA_KV_HEADS * GQA_HEAD_DIM,
            DIFF_HEADS * 2 * DIFF_QK_DIM, DIFF_HEADS * 2 * DIFF_QK_DIM, DIFF_HEADS * DIFF_V_DIM)
IN_COLS = sum(IN_SIZES)
IN_SPLIT_POINTS = tuple(int(v) for v in np.cumsum(IN_SIZES)[:-1])

D_FF = 5632
N_EXPERTS = 8
TOP_K = 2
D_FF_EXPERT = 7168

kernel_name = 'hybrid_parallel_heads_dit_block'


def rmsnorm(x, g):
    xf = x.astype(jnp.float32)
    y = xf * lax.rsqrt(jnp.mean(xf * xf, axis=-1, keepdims=True) + EPS)
    return y.astype(x.dtype) * g


def modulate(x, shift, scale):
    return x * (1.0 + scale) + shift


def split_heads(t, n_heads):
    return t.reshape(t.shape[:2] + (n_heads, t.shape[-1] // n_heads))


def axial_angles(n_tokens, dim):
    half = dim // 2
    freqs = ROPE_THETA ** (-jnp.arange(0, half, 2, dtype=jnp.float32) / half)
    t = jnp.arange(n_tokens, dtype=jnp.int32)
    row = (t // GRID_W).astype(jnp.float32)
    col = (t % GRID_W).astype(jnp.float32)
    ang = jnp.stack([row[:, None] * freqs, col[:, None] * freqs], axis=1)
    return jnp.cos(ang), jnp.sin(ang)


def rope_2d(x, cos, sin):
    q = x.shape[-1] // 4
    xr = x.reshape(x.shape[:-1] + (2, 2, q))
    shape = (1, x.shape[1]) + (1,) * (x.ndim - 3) + (2, q)
    c = cos.reshape(shape).astype(x.dtype)
    s = sin.reshape(shape).astype(x.dtype)
    x1, x2 = xr[..., 0, :], xr[..., 1, :]
    out = jnp.stack([x1 * c - x2 * s, x2 * c + x1 * s], axis=-2)
    return out.reshape(x.shape)


def over_query_blocks(fn, *qs):
    b, n = qs[0].shape[:2]
    nb = n // Q_BLOCK
    blocks = tuple(jnp.moveaxis(q.reshape((b, nb, Q_BLOCK) + q.shape[2:]), 1, 0) for q in qs)
    out = lax.map(lambda qb: fn(*qb), blocks)
    out = jnp.moveaxis(out, 0, 1)
    return out.reshape((b, n) + out.shape[3:])


def softmax_attend(q, k, v, scale):
    b, nq, h, dk = q.shape
    g = k.shape[2]
    qg = q.reshape(b, nq, g, h // g, dk)
    s = jnp.einsum('bqgrd,bkgd->bgrqk', qg, k) * scale
    p = jax.nn.softmax(s.astype(jnp.float32), axis=-1).astype(v.dtype)
    o = jnp.einsum('bgrqk,bkgv->bqgrv', p, v)
    return o.reshape(b, nq, h, v.shape[-1])


def diff_attend(q1, q2, k1, k2, v, lam, scale):
    s1 = jnp.einsum('bqhd,bkhd->bhqk', q1, k1) * scale
    s2 = jnp.einsum('bqhd,bkhd->bhqk', q2, k2) * scale
    p = jax.nn.softmax(s1.astype(jnp.float32), axis=-1) - lam * jax.nn.softmax(s2.astype(jnp.float32), axis=-1)
    return jnp.einsum('bhqk,bkhv->bqhv', p.astype(v.dtype), v)


def natten_attend(q, k, v, k_ctx, v_ctx, rel_bias):
    b, n, h, d = q.shape
    rows = n // GRID_W
    kh = min(NA_KH_MAX, rows)
    ncb = GRID_W // NA_QCB
    qc = np.arange(GRID_W).reshape(ncb, NA_QCB)
    kb = np.clip(np.arange(ncb) * NA_QCB - NA_KW // 2, 0, GRID_W - NA_KCB)
    kc = kb[:, None] + np.arange(NA_KCB)
    cs = np.clip(qc - NA_KW // 2, 0, GRID_W - NA_KW)
    col_ok = (kc[:, None, :] >= cs[:, :, None]) & (kc[:, None, :] < cs[:, :, None] + NA_KW)
    col_off = np.clip(kc[:, None, :] - qc[:, :, None] + NA_KW - 1, 0, 2 * NA_KW - 2)
    col_bias = rel_bias[:, :, col_off]
    mask = jnp.asarray(np.broadcast_to(col_ok[:, :, None, :], (ncb, NA_QCB, kh, NA_KCB)).reshape(ncb, NA_QCB, kh * NA_KCB))
    nk = kh * NA_KCB

    def one_row(r):
        rs = jnp.clip(r - kh // 2, 0, rows - kh)
        qr = lax.dynamic_slice_in_dim(q, r * GRID_W, GRID_W, axis=1).reshape(b, ncb, NA_QCB, h, d)

        def band(t):
            t = lax.dynamic_slice_in_dim(t, rs * GRID_W, kh * GRID_W, axis=1).reshape(b, kh, GRID_W, h, d)
            t = t[:, :, kc]
            return jnp.moveaxis(t, 2, 1).reshape(b, ncb, nk, h, d)

        kr, vr = band(k), band(v)
        row_idx = rs - r + jnp.arange(kh) + NA_KH_MAX - 1
        bias = jnp.take(col_bias, row_idx, axis=1)
        bias = jnp.transpose(bias, (0, 2, 3, 1, 4)).reshape(h, ncb, NA_QCB, nk).astype(jnp.float32)
        s_lat = jnp.einsum('bnqhd,bnkhd->bhnqk', qr, kr).astype(jnp.float32) * NA_SCALE + bias
        s_lat = jnp.where(mask, s_lat, NEG_INF)
        s_ctx = jnp.einsum('bnqhd,bkhd->bhnqk', qr, k_ctx).astype(jnp.float32) * NA_SCALE
        p = jax.nn.softmax(jnp.concatenate([s_lat, s_ctx], axis=-1), axis=-1).astype(v.dtype)
        o = (jnp.einsum('bhnqk,bnkhd->bnqhd', p[..., :nk], vr)
             + jnp.einsum('bhnqk,bkhd->bnqhd', p[..., nk:], v_ctx))
        return o.reshape(b, GRID_W, h, d)

    out = lax.map(one_row, jnp.arange(rows, dtype=jnp.int32))
    return jnp.moveaxis(out, 0, 1).reshape(b, n, h, d)


def mla_queries(cq, g_q, w_qup, rope):
    q = split_heads(rmsnorm(cq, g_q) @ w_qup, MLA_HEADS)
    q_nope, q_pe = q[..., :MLA_NOPE], q[..., MLA_NOPE:]
    if rope is not None:
        q_pe = rope_2d(q_pe, *rope)
    return jnp.concatenate([q_nope, q_pe], axis=-1)


def mla_keys_values(ckv, k_pe, g_kv, w_kvup, rope):
    kv = split_heads(rmsnorm(ckv, g_kv) @ w_kvup, MLA_HEADS)
    k_nope, v = kv[..., :MLA_NOPE], kv[..., MLA_NOPE:]
    k_pe = k_pe[:, :, None, :]
    if rope is not None:
        k_pe = rope_2d(k_pe, *rope)
    k_pe = jnp.broadcast_to(k_pe, k_nope.shape[:-1] + (MLA_ROPE,))
    return jnp.concatenate([k_nope, k_pe], axis=-1), v


def gqa_qk(t, n_heads, g, rope):
    z = rmsnorm(split_heads(t, n_heads), g)
    if rope is not None:
        z = rope_2d(z, *rope)
    return z


def diff_qk(t, rope):
    z = t.reshape(t.shape[:2] + (DIFF_HEADS, 2, DIFF_QK_DIM))
    if rope is not None:
        z = rope_2d(z, *rope)
    return z[..., 0, :], z[..., 1, :]


def diff_lambda(lq1, lk1, lq2, lk2, lam_init):
    e = lambda a, b: jnp.exp(jnp.sum(a.astype(jnp.float32) * b.astype(jnp.float32)))
    return e(lq1, lk1) - e(lq2, lk2) + lam_init


def merge_heads(o_na, o_mla, o_gqa, o_diff, g_sub, lam_init, w_out):
    o_diff = rmsnorm(o_diff, g_sub) * (1.0 - lam_init)
    b, n = o_na.shape[:2]
    o = jnp.concatenate([o_na.reshape(b, n, -1), o_mla.reshape(b, n, -1),
                         o_gqa.reshape(b, n, -1), o_diff.reshape(b, n, -1)], axis=-1)
    return o @ w_out


def token_mixer(u, uc, lp, lam_init, rope64, rope128, need_ctx):
    (na_q, na_k, na_v, mla_cq, mla_ckv, mla_kpe, gqa_q, gqa_k, gqa_v,
     diff_q, diff_k, diff_v) = jnp.split(u @ lp['w_in'], IN_SPLIT_POINTS, axis=-1)
    (na_q_ctx, na_k_ctx, na_v_ctx, mla_cq_ctx, mla_ckv_ctx, mla_kpe_ctx, gqa_q_ctx, gqa_k_ctx, gqa_v_ctx,
     diff_q_ctx, diff_k_ctx, diff_v_ctx) = jnp.split(uc @ lp['w_in'], IN_SPLIT_POINTS, axis=-1)
    cat = lambda a, b: jnp.concatenate([a, b], axis=1)

    k_na_ctx, v_na_ctx = split_heads(na_k_ctx, NA_HEADS), split_heads(na_v_ctx, NA_HEADS)
    o_na = natten_attend(split_heads(na_q, NA_HEADS), split_heads(na_k, NA_HEADS), split_heads(na_v, NA_HEADS),
                         k_na_ctx, v_na_ctx, lp['na_rel_bias'])
    k_mla_ctx, v_mla_ctx = mla_keys_values(mla_ckv_ctx, mla_kpe_ctx, lp['mla_g_kv'], lp['mla_w_kvup'], None)
    k_mla, v_mla = mla_keys_values(mla_ckv, mla_kpe, lp['mla_g_kv'], lp['mla_w_kvup'], rope64)
    k_mla, v_mla = cat(k_mla_ctx, k_mla), cat(v_mla_ctx, v_mla)
    q_mla = mla_queries(mla_cq, lp['mla_g_q'], lp['mla_w_qup'], rope64)
    o_mla = over_query_blocks(lambda q: softmax_attend(q, k_mla, v_mla, MLA_SCALE), q_mla)
    k_gqa_ctx = gqa_qk(gqa_k_ctx, GQA_KV_HEADS, lp['gqa_g_k'], None)
    v_gqa_ctx = split_heads(gqa_v_ctx, GQA_KV_HEADS)
    k_gqa = cat(k_gqa_ctx, gqa_qk(gqa_k, GQA_KV_HEADS, lp['gqa_g_k'], rope128))
    v_gqa = cat(v_gqa_ctx, split_heads(gqa_v, GQA_KV_HEADS))
    q_gqa = gqa_qk(gqa_q, GQA_HEADS, lp['gqa_g_q'], rope128)
    o_gqa = over_query_blocks(lambda q: softmax_attend(q, k_gqa, v_gqa, GQA_SCALE), q_gqa)
    lam = diff_lambda(lp['diff_lq1'], lp['diff_lk1'], lp['diff_lq2'], lp['diff_lk2'], lam_init)
    k1_ctx, k2_ctx = diff_qk(diff_k_ctx, None)
    v_diff_ctx = split_heads(diff_v_ctx, DIFF_HEADS)
    k1, k2 = diff_qk(diff_k, rope64)
    k1, k2 = cat(k1_ctx, k1), cat(k2_ctx, k2)
    v_diff = cat(v_diff_ctx, split_heads(diff_v, DIFF_HEADS))
    q1, q2 = diff_qk(diff_q, rope64)
    o_diff = over_query_blocks(lambda a, b: diff_attend(a, b, k1, k2, v_diff, lam, DIFF_SCALE), q1, q2)
    out = merge_heads(o_na, o_mla, o_gqa, o_diff, lp['diff_g_sub'], lam_init, lp['w_out'])
    if not need_ctx:
        return out, None

    o_na_ctx = over_query_blocks(lambda q: softmax_attend(q, k_na_ctx, v_na_ctx, NA_SCALE), split_heads(na_q_ctx, NA_HEADS))
    q_mla_ctx = mla_queries(mla_cq_ctx, lp['mla_g_q'], lp['mla_w_qup'], None)
    o_mla_ctx = over_query_blocks(lambda q: softmax_attend(q, k_mla_ctx, v_mla_ctx, MLA_SCALE), q_mla_ctx)
    q_gqa_ctx = gqa_qk(gqa_q_ctx, GQA_HEADS, lp['gqa_g_q'], None)
    o_gqa_ctx = over_query_blocks(lambda q: softmax_attend(q, k_gqa_ctx, v_gqa_ctx, GQA_SCALE), q_gqa_ctx)
    q1_ctx, q2_ctx = diff_qk(diff_q_ctx, None)
    o_diff_ctx = over_query_blocks(lambda a, b: diff_attend(a, b, k1_ctx, k2_ctx, v_diff_ctx, lam, DIFF_SCALE), q1_ctx, q2_ctx)
    out_ctx = merge_heads(o_na_ctx, o_mla_ctx, o_gqa_ctx, o_diff_ctx, lp['diff_g_sub'], lam_init, lp['w_out'])
    return out, out_ctx


def swiglu(u, w_gate, w_up, w_down):
    return (jax.nn.silu(u @ w_gate) * (u @ w_up)) @ w_down


def moe_swiglu(u, w_router, b_router, w_gate, w_up, w_down):
    b, n, d = u.shape
    t = u.reshape(b * n, d)
    logits = (t @ w_router).astype(jnp.float32) + b_router.astype(jnp.float32)
    top_val, top_idx = lax.top_k(logits, TOP_K)
    gates = jax.nn.softmax(top_val, axis=-1)
    comb = jnp.sum(jax.nn.one_hot(top_idx, N_EXPERTS, dtype=jnp.float32) * gates[..., None], axis=1).astype(u.dtype)
    y = jnp.zeros_like(t)
    for e in range(N_EXPERTS):
        y = y + comb[:, e:e + 1] * swiglu(t, w_gate[e], w_up[e], w_down[e])
    return y.reshape(b, n, d)


def setup_inputs(seed: int = 0) -> dict:
    key = jax.random.key(seed)
    keys = jax.random.split(key, 32)
    n_dense = (DEPTH + 1) // 2
    n_moe = DEPTH // 2
    D = D_MODEL

    def nrm(i, shape, scale):
        return scale * jax.random.normal(keys[i], shape, jnp.float32)

    def gain(i, shape):
        return 1.0 + nrm(i, shape, 0.1)

    return {
        'x': nrm(0, (BATCH, SEQ, D), 1.0),
        'c': nrm(1, (BATCH, D), 1.0),
        'ctx': nrm(2, (BATCH, CTX_LEN, D), 1.0),
        'c_ctx': nrm(3, (D,), 1.0),
        'w_mod': nrm(4, (DEPTH, D, 6 * D), 0.3 * D ** -0.5),
        'b_mod': nrm(5, (DEPTH, 6 * D), 0.02),
        'g_mix': gain(6, (DEPTH, D)),
        'w_in': nrm(7, (DEPTH, D, IN_COLS), D ** -0.5),
        'na_rel_bias': nrm(8, (DEPTH, NA_HEADS, 2 * NA_KH_MAX - 1, 2 * NA_KW - 1), 0.3),
        'mla_g_q': gain(9, (DEPTH, MLA_Q_RANK)),
        'mla_w_qup': nrm(10, (DEPTH, MLA_Q_RANK, MLA_HEADS * (MLA_NOPE + MLA_ROPE)), MLA_Q_RANK ** -0.5),
        'mla_g_kv': gain(11, (DEPTH, MLA_KV_RANK)),
        'mla_w_kvup': nrm(12, (DEPTH, MLA_KV_RANK, MLA_HEADS * (MLA_NOPE + MLA_V)), MLA_KV_RANK ** -0.5),
        'gqa_g_q': gain(13, (DEPTH, GQA_HEAD_DIM)),
        'gqa_g_k': gain(14, (DEPTH, GQA_HEAD_DIM)),
        'diff_lq1': nrm(15, (DEPTH, DIFF_QK_DIM), 0.1),
        'diff_lk1': nrm(16, (DEPTH, DIFF_QK_DIM), 0.1),
        'diff_lq2': nrm(17, (DEPTH, DIFF_QK_DIM), 0.1),
        'diff_lk2': nrm(18, (DEPTH, DIFF_QK_DIM), 0.1),
        'diff_g_sub': gain(19, (DEPTH, DIFF_V_DIM)),
        'w_out': nrm(20, (DEPTH, MIX_WIDTH, D), MIX_WIDTH ** -0.5),
        'g_ffn': gain(21, (DEPTH, D)),
        'ffn_w_gate': nrm(22, (n_dense, D, D_FF), D ** -0.5),
        'ffn_w_up': nrm(23, (n_dense, D, D_FF), D ** -0.5),
        'ffn_w_down': nrm(24, (n_dense, D_FF, D), D_FF ** -0.5),
        'moe_w_router': nrm(25, (n_moe, D, N_EXPERTS), D ** -0.5),
        'moe_b_router': nrm(26, (n_moe, N_EXPERTS), 0.01),
        'moe_w_gate': nrm(27, (n_moe, N_EXPERTS, D, D_FF_EXPERT), D ** -0.5),
        'moe_w_up': nrm(28, (n_moe, N_EXPERTS, D, D_FF_EXPERT), D ** -0.5),
        'moe_w_down': nrm(29, (n_moe, N_EXPERTS, D_FF_EXPERT, D), D_FF_EXPERT ** -0.5),
        'g_final': gain(30, (D,)),
    }


def reference(x, c, ctx, c_ctx, w_mod, b_mod, g_mix, w_in, na_rel_bias, mla_g_q, mla_w_qup, mla_g_kv, mla_w_kvup,
              gqa_g_q, gqa_g_k, diff_lq1, diff_lk1, diff_lq2, diff_lk2, diff_g_sub, w_out, g_ffn,
              ffn_w_gate, ffn_w_up, ffn_w_down, moe_w_router, moe_b_router, moe_w_gate, moe_w_up, moe_w_down,
              g_final):
    n = x.shape[1]
    rope64 = axial_angles(n, MLA_ROPE)
    rope128 = axial_angles(n, GQA_HEAD_DIM)
    s_c = jax.nn.silu(c)
    s_cc = jax.nn.silu(c_ctx)
    h, hc = x, ctx
    for l in range(DEPTH):
        last = l == DEPTH - 1
        mod = (s_c @ w_mod[l] + b_mod[l])[:, None, :]
        sh_a, sc_a, gt_a, sh_f, sc_f, gt_f = jnp.split(mod, 6, axis=-1)
        csh_a, csc_a, cgt_a, csh_f, csc_f, cgt_f = jnp.split(s_cc @ w_mod[l] + b_mod[l], 6, axis=-1)
        lp = {'w_in': w_in[l], 'w_out': w_out[l], 'na_rel_bias': na_rel_bias[l],
              'mla_g_q': mla_g_q[l], 'mla_w_qup': mla_w_qup[l], 'mla_g_kv': mla_g_kv[l], 'mla_w_kvup': mla_w_kvup[l],
              'gqa_g_q': gqa_g_q[l], 'gqa_g_k': gqa_g_k[l],
              'diff_lq1': diff_lq1[l], 'diff_lk1': diff_lk1[l], 'diff_lq2': diff_lq2[l], 'diff_lk2': diff_lk2[l],
              'diff_g_sub': diff_g_sub[l]}
        lam_init = 0.8 - 0.6 * math.exp(-0.3 * l)
        u = modulate(rmsnorm(h, g_mix[l]), sh_a, sc_a)
        uc = modulate(rmsnorm(hc, g_mix[l]), csh_a, csc_a)
        a, a_ctx = token_mixer(u, uc, lp, lam_init, rope64, rope128, not last)
        h = h + gt_a * a
        u = modulate(rmsnorm(h, g_ffn[l]), sh_f, sc_f)
        if l % 2 == 0:
            ffn = lambda z: swiglu(z, ffn_w_gate[l // 2], ffn_w_up[l // 2], ffn_w_down[l // 2])
        else:
            ffn = lambda z: moe_swiglu(z, moe_w_router[l // 2], moe_b_router[l // 2], moe_w_gate[l // 2],
                                       moe_w_up[l // 2], moe_w_down[l // 2])
        h = h + gt_f * ffn(u)
        if not last:
            hc = hc + cgt_a * a_ctx
            uc = modulate(rmsnorm(hc, g_ffn[l]), csh_f, csc_f)
            hc = hc + cgt_f * ffn(uc)
    return rmsnorm(h, g_final)
```

```cpp
#include <hip/hip_runtime.h>
#include <cstdio>
#include <cstdint>
namespace pg8 {
#define PG8_LAS __attribute__((address_space(3)))
typedef unsigned short bf16_t;
typedef short bf16x8 __attribute__((ext_vector_type(8)));
typedef float f32x4 __attribute__((ext_vector_type(4)));
typedef unsigned u32x4 __attribute__((ext_vector_type(4)));
typedef int v8i32 __attribute__((ext_vector_type(8)));
constexpr int BM = 256, BK = 64, HALF = 128, HTB = HALF * BK * 2  , STAGE_BYTES = 8 * HTB, NXCD = 8, WGM = 8;

__host__ __device__ __forceinline__ int lds_byte(int r, int c) { const int st = (r >> 4) * 2 + (c >> 5), rr = r & 15, cc = c & 31, ob = rr * 64 + cc * 2; return st * 1024 + (ob ^ (((ob >> 9) & 1) << 5)); }
__host__ __device__ __forceinline__ void stage_rc(int b, int& R, int& C) { const int st = b / 1024, sb = b % 1024, swz = sb ^ (((sb >> 9) & 1) << 5); R = (st >> 1) * 16 + swz / 64; C = (st & 1) * 32 + (swz % 64) / 2; }
__host__ __device__ __forceinline__ int perm32(int rho) { const int n = rho >> 4, i = rho & 15; return 8 * (i >> 2) + 4 * n + (i & 3); }

struct Unit { int pm, pn, ko = 0, aux = 0; };
struct Gemm { const bf16_t* A; const bf16_t* Bt; int M, N, K, lda, ldb; int ktA = 0, ktB = 0, rev = 0; };

struct StaticOrder {
    static constexpr bool NTB = false;
    int nM, nN, nwg, G, c, wgm;
    __host__ __device__ void init(int M, int N, int G_, int c_, int wgm_ = WGM) { nM = M / BM; nN = N / BM; nwg = nM * nN; G = G_; c = c_; wgm = wgm_; }
    __host__ __device__ bool next(int i, Unit& u) const {
        const long L = (long)i * G + c; if (L >= nwg) return false;
        int wgid = (int)L; { const int q = nwg / NXCD, r = nwg % NXCD, xcd = wgid % NXCD, off = wgid / NXCD; wgid = (xcd < r ? xcd * (q + 1) : r * (q + 1) + (xcd - r) * q) + off; }
        const int nig = wgm * nN, gid = wgid / nig, fm = gid * wgm, gsz = (nM - fm) < wgm ? (nM - fm) : wgm;
        u.pm = fm + ((wgid % nig) % gsz); u.pn = (wgid % nig) / gsz; return true;
    }
    __device__ __forceinline__ void a_ready(const Unit&) const {}
    __device__ __forceinline__ void done(const Unit&) const {}
};

__device__ __forceinline__ unsigned cvt_pk_bf16(float lo, float hi) { unsigned r; asm volatile("v_cvt_pk_bf16_f32 %0, %1, %2" : "=v"(r) : "v"(lo), "v"(hi)); return r; }
typedef float f32x2 __attribute__((ext_vector_type(2)));
__device__ __forceinline__ void mfma_e4m3(f32x4& acc, const v8i32& a, const v8i32& b, int one) {
    asm volatile("v_mfma_scale_f32_16x16x128_f8f6f4 %0, %1, %2, %0, %3, %3 op_sel_hi:[0,0,0]" : "+v"(acc) : "v"(a), "v"(b), "v"(one));
}
template <class Epi, class Sched, bool ALIGN_EPI = false, bool SP2 = false, bool FP8 = false>
__device__ __forceinline__ void gemm_phase(PG8_LAS unsigned char* lds, const Gemm g, const Sched& S, const Epi& E) {
    int tid_ = threadIdx.x; asm volatile("" : "+v"(tid_));
    const int tid = tid_, wid = __builtin_amdgcn_readfirstlane(tid >> 6), lane = tid & 63, wr = wid >> 2, wc = wid & 3, fr = lane & 15, fq = lane >> 4;
    constexpr int ES = FP8 ? 1 : 2, KE = FP8 ? 128 : 64;
    const int K = g.K, nt = K / KE;
    unsigned voffA[2], voffB[2];
#pragma unroll
    for (int i = 0; i < 2; ++i) { int R, C; stage_rc(tid * 16 + i * 8192, R, C); const int Rb = Epi::PERM ? ((R & ~31) + perm32(R & 31)) : R;
        voffA[i] = (unsigned)(R * (g.ktA ? 128 : g.lda * ES) + C * 2); voffB[i] = (unsigned)(Rb * (g.ktB ? 128 : g.ldb * ES) + C * 2); }
    const long kabsA = g.ktA ? 32768 : (BK * 2), kabsB = g.ktB ? 32768 : (BK * 2);
    const long kstepA = g.rev ? -kabsA : kabsA, kstepB = g.rev ? -kabsB : kabsB;
    const long kfirstA = g.rev ? (long)(nt - 1) * kabsA : 0, kfirstB = g.rev ? (long)(nt - 1) * kabsB : 0;
    const size_t hstepA = g.ktA ? (size_t)16384 : (size_t)HALF * g.lda * ES, hstepB = g.ktB ? (size_t)16384 : (size_t)HALF * g.ldb * ES;
    const size_t tstepA = (size_t)BM * g.lda * ES, tstepB = (size_t)BM * g.ldb * ES;
    const unsigned ldsw = (unsigned)wid * 1024u;
    const int fcol = FP8 ? ((fq >> 1) * 32 + (fq & 1) * 16) : fq * 8;
    const int aoff = lds_byte(wr * 64 + fr, fcol), boff = lds_byte(wc * 32 + fr, fcol);
#define PG8_SA(b, h) (((b) * 2 + (h)) * HTB)
#define PG8_SB(b, h) ((4 + (b) * 2 + (h)) * HTB)
#define PG8_STAGE(bufoff, gbase, voff) do { _Pragma("unroll") for (int _i = 0; _i < 2; ++_i) { \
        if constexpr (FP8) { unsigned vo_ = (voff)[_i]; asm volatile("" : "+v"(vo_));   \
            __builtin_amdgcn_global_load_lds((const unsigned*)((const char*)(gbase) + vo_), (PG8_LAS unsigned*)(lds + (bufoff) + ldsw + _i * 8192), 16, 0, 0); } else \
        if constexpr (Sched::NTB && (bufoff) >= 4 * HTB) __builtin_amdgcn_global_load_lds((const unsigned*)((const char*)(gbase) + (voff)[_i]), (PG8_LAS unsigned*)(lds + (bufoff) + ldsw + _i * 8192), 16, 0, 2); \
        else __builtin_amdgcn_global_load_lds((const unsigned*)((const char*)(gbase) + (voff)[_i]), (PG8_LAS unsigned*)(lds + (bufoff) + ldsw + _i * 8192), 16, 0, 0); } } while (0)
#define PG8_LDA(dst, b, h) do { if constexpr (FP8) { _Pragma("unroll") for (int m = 0; m < 4; ++m) { const PG8_LAS unsigned char* p_ = lds + PG8_SA(b, h) + aoff + m * 2048; \
        const u32x4 lo_ = *(const PG8_LAS u32x4*)p_, hi_ = *(const PG8_LAS u32x4*)(p_ + 16); dst##8[m] = (v8i32){(int)lo_.x, (int)lo_.y, (int)lo_.z, (int)lo_.w, (int)hi_.x, (int)hi_.y, (int)hi_.z, (int)hi_.w}; } } \
    else { _Pragma("unroll") for (int m = 0; m < 4; ++m) _Pragma("unroll") for (int k = 0; k < 2; ++k) dst[m][k] = *(const PG8_LAS bf16x8*)(lds + PG8_SA(b, h) + aoff + m * 2048 + k * 1024); } } while (0)
#define PG8_LDB(dst, b, h) do { if constexpr (FP8) { _Pragma("unroll") for (int n = 0; n < 2; ++n) { const PG8_LAS unsigned char* p_ = lds + PG8_SB(b, h) + boff + n * 2048; \
        const u32x4 lo_ = *(const PG8_LAS u32x4*)p_, hi_ = *(const PG8_LAS u32x4*)(p_ + 16); dst##8[n] = (v8i32){(int)lo_.x, (int)lo_.y, (int)lo_.z, (int)lo_.w, (int)hi_.x, (int)hi_.y, (int)hi_.z, (int)hi_.w}; } } \
    else { _Pragma("unroll") for (int n = 0; n < 2; ++n) _Pragma("unroll") for (int k = 0; k < 2; ++k) dst[n][k] = *(const PG8_LAS bf16x8*)(lds + PG8_SB(b, h) + boff + n * 2048 + k * 1024); } } while (0)
#define PG8_MMA(ai, bj, At, Bt) do { __builtin_amdgcn_s_setprio(1); if constexpr (FP8) { _Pragma("unroll") for (int m = 0; m < 4; ++m) _Pragma("unroll") for (int n = 0; n < 2; ++n) \
        mfma_e4m3(acc[ai][bj][m][n], Bt##8[n], At##8[m], one8); } \
    else { _Pragma("unroll") for (int m = 0; m < 4; ++m) _Pragma("unroll") for (int n = 0; n < 2; ++n) _Pragma("unroll") for (int k = 0; k < 2; ++k) \
        acc[ai][bj][m][n] = __builtin_amdgcn_mfma_f32_16x16x32_bf16(Bt[n][k], At[m][k], acc[ai][bj][m][n], 0, 0, 0); } __builtin_amdgcn_s_setprio(0); } while (0)
#define PG8_WAIT_V(n) asm volatile("s_waitcnt vmcnt(" #n ")" ::: "memory")
#define PG8_WAIT_L(n) asm volatile("s_waitcnt lgkmcnt(" #n ")" ::: "memory")
#define PG8_BAR __builtin_amdgcn_s_barrier()
#define PG8_SCHED __builtin_amdgcn_sched_barrier(0)
    Unit cur, nxt; int ui = 0;
    if (!S.next(0, cur)) return;
    f32x4 acc[2][2][4][2];
#pragma unroll
    for (int a = 0; a < 2; ++a)
#pragma unroll
        for (int b = 0; b < 2; ++b)
#pragma unroll
            for (int m = 0; m < 4; ++m)
#pragma unroll
                for (int n = 0; n < 2; ++n) acc[a][b][m][n] = (f32x4){0.f, 0.f, 0.f, 0.f};
    int one8 = 0x7F7F7F7F; asm volatile("" : "+v"(one8));
    bf16x8 At[4][2], B0[2][2], B1[2][2]; v8i32 At8[4], B08[2], B18[2];
    const char* cA = (const char*)g.A + (size_t)cur.pm * tstepA + (g.ktA ? (size_t)(cur.ko / KE) * 32768 : (size_t)cur.ko * ES) + kfirstA; const char* cB = (const char*)g.Bt + (size_t)cur.pn * tstepB + (g.ktB ? (size_t)(cur.ko / KE) * 32768 : (size_t)cur.ko * ES) + kfirstB;
    S.a_ready(cur);
    if constexpr (SP2) {
        PG8_STAGE(PG8_SB(0, 0), cB, voffB); PG8_STAGE(PG8_SB(0, 1), cB + hstepB, voffB); PG8_STAGE(PG8_SA(0, 0), cA, voffA); PG8_STAGE(PG8_SA(0, 1), cA + hstepA, voffA);
        if (wr == 1) PG8_BAR;
        PG8_WAIT_V(2); PG8_BAR;
        PG8_STAGE(PG8_SB(1, 0), cB + kstepB, voffB); PG8_STAGE(PG8_SA(1, 0), cA + kstepA, voffA); PG8_STAGE(PG8_SB(1, 1), cB + hstepB + kstepB, voffB);
        PG8_WAIT_V(6); PG8_BAR;
    } else {
        PG8_STAGE(PG8_SB(0, 0), cB, voffB); PG8_STAGE(PG8_SA(0, 0), cA, voffA); PG8_STAGE(PG8_SB(0, 1), cB + hstepB, voffB); PG8_STAGE(PG8_SA(0, 1), cA + hstepA, voffA);
        if (wr == 1) PG8_BAR;
        PG8_WAIT_V(4); PG8_BAR;
        PG8_STAGE(PG8_SB(1, 0), cB + kstepB, voffB); PG8_STAGE(PG8_SA(1, 0), cA + kstepA, voffA); PG8_STAGE(PG8_SB(1, 1), cB + hstepB + kstepB, voffB);
        PG8_WAIT_V(6); PG8_BAR;
    }
    for (;;) {
        const bool has_next = S.next(ui + 1, nxt);
        const char* nA = has_next ? (const char*)g.A + (size_t)nxt.pm * tstepA + (g.ktA ? (size_t)(nxt.ko / KE) * 32768 : (size_t)nxt.ko * ES) + kfirstA : cA; const char* nB = has_next ? (const char*)g.Bt + (size_t)nxt.pn * tstepB + (g.ktB ? (size_t)(nxt.ko / KE) * 32768 : (size_t)nxt.ko * ES) + kfirstB : cB;
        for (int t = 0; t < nt; t += 2) {
            const bool last = (t == nt - 2);
            const char* a1 = cA + (long)(t + 1) * kstepA;
            const char* a2 = last ? nA : cA + (long)(t + 2) * kstepA; const char* b2 = last ? nB : cB + (long)(t + 2) * kstepB;
            const char* a3 = a2 + kstepA; const char* b3 = b2 + kstepB;
            if (last && has_next) S.a_ready(nxt);
            if constexpr (SP2) {
            PG8_LDB(B0, 0, 0); PG8_LDB(B1, 0, 1); PG8_SCHED; PG8_LDA(At, 0, 0); PG8_STAGE(PG8_SA(1, 1), a1 + hstepA, voffA);
            PG8_WAIT_V(8); PG8_WAIT_L(0); PG8_BAR; PG8_MMA(0, 0, At, B0); PG8_MMA(0, 1, At, B1); PG8_BAR; PG8_SCHED;
            PG8_LDA(At, 0, 1); PG8_STAGE(PG8_SB(0, 0), b2, voffB); PG8_STAGE(PG8_SB(0, 1), b2 + hstepB, voffB); PG8_STAGE(PG8_SA(0, 0), a2, voffA);
            PG8_WAIT_V(8); PG8_WAIT_L(0); PG8_BAR; PG8_MMA(1, 0, At, B0); PG8_MMA(1, 1, At, B1); PG8_BAR; PG8_SCHED;
            PG8_LDB(B0, 1, 0); PG8_LDB(B1, 1, 1); PG8_SCHED; PG8_LDA(At, 1, 0); PG8_STAGE(PG8_SA(0, 1), a2 + hstepA, voffA);
            PG8_WAIT_V(8); PG8_WAIT_L(0); PG8_BAR; PG8_MMA(0, 0, At, B0); PG8_MMA(0, 1, At, B1); PG8_BAR; PG8_SCHED;
            PG8_LDA(At, 1, 1); PG8_STAGE(PG8_SB(1, 0), b3, voffB); PG8_STAGE(PG8_SB(1, 1), b3 + hstepB, voffB); PG8_STAGE(PG8_SA(1, 0), a3, voffA);
            PG8_WAIT_V(8); PG8_WAIT_L(0); PG8_BAR; PG8_MMA(1, 0, At, B0); PG8_MMA(1, 1, At, B1); PG8_BAR; PG8_SCHED;
            } else {
            PG8_LDB(B0, 0, 0); PG8_SCHED; PG8_LDA(At, 0, 0); PG8_STAGE(PG8_SA(1, 1), a1 + hstepA, voffA);
            PG8_WAIT_L(8); PG8_BAR; PG8_WAIT_L(0); PG8_MMA(0, 0, At, B0); PG8_BAR; PG8_SCHED;
            PG8_LDB(B1, 0, 1); PG8_STAGE(PG8_SB(0, 0), b2, voffB);
            PG8_BAR; PG8_WAIT_L(0); PG8_MMA(0, 1, At, B1); PG8_BAR;
            PG8_LDA(At, 0, 1); PG8_STAGE(PG8_SA(0, 0), a2, voffA);
            PG8_BAR; PG8_WAIT_L(0); PG8_MMA(1, 0, At, B0); PG8_BAR; PG8_SCHED;
            PG8_STAGE(PG8_SB(0, 1), b2 + hstepB, voffB);
            PG8_WAIT_V(6); PG8_BAR; PG8_MMA(1, 1, At, B1); PG8_BAR;
            PG8_LDB(B0, 1, 0); PG8_SCHED; PG8_LDA(At, 1, 0); PG8_STAGE(PG8_SA(0, 1), a2 + hstepA, voffA);
            PG8_WAIT_L(8); PG8_BAR; PG8_WAIT_L(0); PG8_MMA(0, 0, At, B0); PG8_BAR; PG8_SCHED;
            PG8_LDB(B1, 1, 1); PG8_STAGE(PG8_SB(1, 0), b3, voffB);
            PG8_BAR; PG8_WAIT_L(0); PG8_MMA(0, 1, At, B1); PG8_BAR;
            PG8_LDA(At, 1, 1); PG8_STAGE(PG8_SA(1, 0), a3, voffA);
            PG8_BAR; PG8_WAIT_L(0); PG8_MMA(1, 0, At, B0); PG8_BAR; PG8_SCHED;
            PG8_STAGE(PG8_SB(1, 1), b3 + hstepB, voffB);
            PG8_WAIT_V(6); PG8_BAR; PG8_MMA(1, 1, At, B1); PG8_BAR;
            }
        }
        if constexpr (FP8) {
#define PG8_ACC16(a) "+v"(acc[a][0][0][0]), "+v"(acc[a][0][0][1]), "+v"(acc[a][0][1][0]), "+v"(acc[a][0][1][1]), "+v"(acc[a][0][2][0]), "+v"(acc[a][0][2][1]), "+v"(acc[a][0][3][0]), "+v"(acc[a][0][3][1]), \
                     "+v"(acc[a][1][0][0]), "+v"(acc[a][1][0][1]), "+v"(acc[a][1][1][0]), "+v"(acc[a][1][1][1]), "+v"(acc[a][1][2][0]), "+v"(acc[a][1][2][1]), "+v"(acc[a][1][3][0]), "+v"(acc[a][1][3][1])
            asm volatile("s_nop 15\n\ts_nop 15" : PG8_ACC16(0));
            asm volatile("s_nop 0" : PG8_ACC16(1));
#undef PG8_ACC16
        }
        if constexpr (ALIGN_EPI) { if (wr == 0) PG8_BAR; }
        if constexpr (!Epi::AFTER_DRAIN) { E(acc, cur, wr, wc, fr, fq); S.done(cur); }
        if (!has_next) break;
#pragma unroll
        for (int a = 0; a < 2; ++a)
#pragma unroll
            for (int b = 0; b < 2; ++b)
#pragma unroll
                for (int m = 0; m < 4; ++m)
#pragma unroll
                    for (int n = 0; n < 2; ++n) acc[a][b][m][n] = (f32x4){0.f, 0.f, 0.f, 0.f};
        cur = nxt; cA = nA; cB = nB; ++ui;
        if constexpr (ALIGN_EPI) { if (wr == 1) PG8_BAR; }
    }
    PG8_WAIT_V(0);
    if constexpr (!ALIGN_EPI) { if (wr == 0) PG8_BAR; }
    PG8_BAR;
    if constexpr (Epi::AFTER_DRAIN) { E.fused(acc, cur, wr, wc, fr, fq, lds, wid, lane); S.done(cur); }
#undef PG8_SA
#undef PG8_SB
#undef PG8_STAGE
#undef PG8_LDA
#undef PG8_LDB
#undef PG8_MMA
#undef PG8_WAIT_V
#undef PG8_WAIT_L
#undef PG8_BAR
#undef PG8_SCHED
}
}

#define GAS __attribute__((address_space(1)))
#define LAS __attribute__((address_space(3)))
typedef unsigned short bf16;
typedef unsigned v4u __attribute__((ext_vector_type(4)));
typedef unsigned v2u __attribute__((ext_vector_type(2)));
typedef float f32x4 __attribute__((ext_vector_type(4)));
typedef __bf16 bf2_t __attribute__((ext_vector_type(2)));
typedef GAS unsigned gu32;
#define RLX_AGENT __ATOMIC_RELAXED, __HIP_MEMORY_SCOPE_AGENT
#define LDS_WAIT() asm volatile("s_waitcnt lgkmcnt(0)" ::: "memory")
#define VM_WAIT() asm volatile("s_waitcnt vmcnt(0)" ::: "memory")
__device__ __forceinline__ unsigned f2bf(float f) { unsigned u = __builtin_bit_cast(unsigned, f); return (u + 0x7fffu + ((u >> 16) & 1u)) >> 16; }
__device__ __forceinline__ unsigned pk2(float lo, float hi) { return f2bf(lo) | (f2bf(hi) << 16); }
__device__ __forceinline__ float bflo(unsigned u) { return __builtin_bit_cast(float, u << 16); }
__device__ __forceinline__ float bfhi(unsigned u) { return __builtin_bit_cast(float, u & 0xffff0000u); }
__device__ __forceinline__ float bf1(bf16 h) { return __builtin_bit_cast(float, ((unsigned)h) << 16); }
__device__ __forceinline__ float dot2bf(unsigned a, unsigned b, float c) { return __builtin_amdgcn_fdot2_f32_bf16(__builtin_bit_cast(bf2_t, a), __builtin_bit_cast(bf2_t, b), c, false); }
__device__ __forceinline__ float wave_sum(float v) {
#pragma unroll
    for (int o = 1; o < 64; o <<= 1) v += __shfl_xor(v, o);
    return v;
}

#define XB_TMO      128
#define XB_XCNT(j)  (256  + 64 * (j))
#define XB_XSUB(j)  (1280 + 64 * (j))
#define XB_XGEN(j)  (2304 + 64 * (j))
#define XB_TOP      3328
#define XB_TOPGEN   3392
#define XCD_BAR_WORDS 3456
#define XB_SPIN_CAP (1u << 18)

__device__ __forceinline__ unsigned xb_ld(unsigned* p)              { return __hip_atomic_load(p, __ATOMIC_RELAXED, __HIP_MEMORY_SCOPE_AGENT); }
__device__ __forceinline__ unsigned xb_add(unsigned* p, unsigned v) { return __hip_atomic_fetch_add(p, v, __ATOMIC_RELAXED, __HIP_MEMORY_SCOPE_AGENT); }
__device__ __forceinline__ unsigned xb_xcc_id() { return (unsigned)__builtin_amdgcn_s_getreg((3 << 11) | 20) & 0xFu; }
#define XB_SPIN(cond, bar) do { unsigned _sp = 0; while (cond) { __builtin_amdgcn_s_sleep(1); \
    if ((++_sp & 255u) == 0u) { if (xb_ld(&(bar)[XB_TMO])) break; if (_sp > XB_SPIN_CAP) { atomicAdd(&(bar)[XB_TMO], 1u); break; } } } } while (0)

struct XcdBarrier {
    unsigned* bar; unsigned x;
    volatile LAS unsigned* st;
};

__device__ __forceinline__ XcdBarrier xcd_barrier_post(unsigned* bar, volatile LAS unsigned* st) {
    XcdBarrier b; b.bar = bar; b.x = xb_xcc_id(); b.st = st;
    if (threadIdx.x == 0) (void)xb_add(&bar[XB_XCNT(b.x)], 1u);
    return b;
}
__device__ __forceinline__ void xcd_barrier_complete(unsigned* bar, unsigned x, unsigned& nloc, unsigned& nx) {
    const unsigned G = gridDim.x * gridDim.y * gridDim.z;
    unsigned sum, cnt, mine, sp = 0u;
    for (;;) {
        sum = 0u; cnt = 0u; mine = 0u;
#pragma unroll
        for (unsigned j = 0; j < 16; ++j) { const unsigned c = xb_ld(&bar[XB_XCNT(j)]); sum += c; cnt += (c > 0u) ? 1u : 0u; mine = (j == x) ? c : mine; }
        if (sum == G) break;
        __builtin_amdgcn_s_sleep(1);
        if ((++sp & 255u) == 0u) { if (xb_ld(&bar[XB_TMO])) break; if (sp > XB_SPIN_CAP) { atomicAdd(&bar[XB_TMO], 1u); break; } }
    }
    nloc = mine > 0u ? mine : 1u; nx = cnt > 0u ? cnt : 1u;
}

__device__ __forceinline__ void xcd_barrier(const XcdBarrier& b) {
    asm volatile("s_waitcnt vmcnt(0)" ::: "memory");
    __syncthreads();
    if (threadIdx.x == 0) {
        unsigned* bar = b.bar;
        __builtin_amdgcn_s_waitcnt(0);
        unsigned nloc = b.st[0], nx = b.st[1];
        if (nloc == 0u) { xcd_barrier_complete(bar, b.x, nloc, nx); b.st[0] = nloc; b.st[1] = nx; }
        const unsigned old = xb_add(&bar[XB_XSUB(b.x)], 1u);
        const unsigned gen = old / nloc;
        if (old + 1u == (gen + 1u) * nloc) {
            __builtin_amdgcn_fence(__ATOMIC_RELEASE, "agent");
            asm volatile("s_waitcnt vmcnt(0)" ::: "memory");
            const unsigned og = xb_add(&bar[XB_TOP], 1u);
            const unsigned tg = og / nx;
            if (og + 1u == (tg + 1u) * nx) xb_add(&bar[XB_TOPGEN], 1u);
            else XB_SPIN(xb_ld(&bar[XB_TOPGEN]) == tg, bar);
            __builtin_amdgcn_fence(__ATOMIC_ACQUIRE, "agent");
            xb_add(&bar[XB_XGEN(b.x)], 1u);
            asm volatile("s_waitcnt vmcnt(0)" ::: "memory");
        } else {
            XB_SPIN(xb_ld(&bar[XB_XGEN(b.x)]) == gen, bar);
            __builtin_amdgcn_fence(__ATOMIC_ACQUIRE, "agent");
            asm volatile("s_waitcnt vmcnt(0)" ::: "memory");
        }
    }
    __syncthreads();
}

constexpr int NWAVES = 8;
constexpr int DM = 2048, NBATCH = 8, SEQ = 2048, CTXL = 256, TPB = 2304  , MT = 18432, NPAN = 72;
constexpr int INC = 4672, INCP = 4864;
constexpr int C_NAQ = 0, C_NAK = 512, C_NAV = 1024, C_CQ = 1536, C_CKV = 1920, C_KPE = 2048, C_GQ = 2112, C_GK = 2624, C_GV = 2880, C_DQ = 3136, C_DK = 3648, C_DV = 4160;
constexpr int QMW = 768, KVW = 1280;
constexpr int DFF = 5632, DFE = 7168, NEXP = 8;
constexpr int MODW = 12288;
constexpr int MOE_ROWS = 34816, MOE_PAN = 136;
constexpr float EPSN = 1e-6f;
constexpr float SC_NA = 0.08838834764831845f, SC_MLA = 0.07216878364870322f, SC_DIFF = 0.125f;

constexpr size_t MiB = 1u << 20;
constexpr size_t WS_CTL = 0, CTL_ZERO_BYTES = 1 * MiB;
constexpr size_t WS_MOD = 1 * MiB;
constexpr size_t WS_ROPE = 1 * MiB + 900 * 1024;
constexpr size_t WS_ROUTE = 2 * MiB;
constexpr size_t WS_WIN = 3 * MiB;
constexpr size_t WS_WOUT = WS_WIN + 38 * MiB;
constexpr size_t WS_WQUP = WS_WOUT + 16 * MiB;
constexpr size_t WS_WKVUP = WS_WQUP + 2 * MiB;
constexpr size_t WS_WGU = WS_WKVUP + 2 * MiB;
constexpr size_t WS_WD = WS_WGU + 44 * MiB;
constexpr size_t WS_MGU = WS_WD + 22 * MiB;
constexpr size_t WS_MD = WS_MGU + 448 * MiB;
constexpr size_t WS_H = WS_MD + 224 * MiB;
constexpr size_t WS_U = WS_H + 144 * MiB;
constexpr size_t WS_R1 = WS_U + 72 * MiB;
constexpr size_t WS_QKV = WS_R1;
constexpr size_t WS_QM = WS_QKV + 171 * MiB;
constexpr size_t WS_KVM = WS_QM + 27 * MiB;
constexpr size_t WS_O = WS_KVM + 45 * MiB;
constexpr size_t WS_HM2 = WS_R1;
constexpr size_t WS_R2 = WS_R1 + 476 * MiB;
constexpr size_t WS_AS = WS_R2;
constexpr size_t WS_Y = WS_R2 + 136 * MiB;
constexpr size_t WS_HM = WS_R2;
constexpr size_t WS_END = WS_R2 + 272 * MiB;
static_assert(WS_O + 72 * MiB <= WS_R2, "region 1");
static_assert(WS_END <= (size_t)1792 * MiB, "workspace map must fit 4 x the largest input");
constexpr int RT_E = 0;
constexpr int RT_G = 16384;
constexpr int RT_RANK = 16384 * 3;
constexpr int RT_POS = 16384 * 5;
constexpr int RT_CNT = 16384 * 7;
static_assert((RT_CNT + 256 * 8) * 4 <= (int)MiB, "route info");
constexpr int CW_BAR = 4096;

constexpr int RING_OFF = 0, RING_BYTES = 131072;
constexpr int LDSCTL_OFF = RING_BYTES, MISC_OFF = LDSCTL_OFF + 320;
constexpr int LDS_BYTES = 147456;

namespace pg8 {
#define PG8_GAS __attribute__((address_space(1)))
struct LatentOrder : StaticOrder {
    __device__ bool next(int i, Unit& u) const { if (!StaticOrder::next(i, u)) return false; u.pm = u.pm + (u.pm >> 3) + 1; return true; }
};
#ifndef MOE_WGM
#define MOE_WGM 16
#endif
#ifndef MOE_NTB
#define MOE_NTB 0
#endif
struct MoeOrder : StaticOrder {
    static constexpr bool NTB = MOE_NTB;
    const PG8_LAS int* tab;
    __device__ bool next(int i, Unit& u) const {
        {
            const long L = (long)i * G + c; if (L >= nwg) return false;
            int wgid = (int)L; { const int q = nwg / NXCD, r = nwg % NXCD, xcd = wgid % NXCD, off = wgid / NXCD; wgid = (xcd < r ? xcd * (q + 1) : r * (q + 1) + (xcd - r) * q) + off; }
            const int nig = MOE_WGM * nN, gid = wgid / nig, fm = gid * MOE_WGM, gsz = (nM - fm) < MOE_WGM ? (nM - fm) : MOE_WGM;
            u.pm = fm + ((wgid % nig) % gsz); u.pn = (wgid % nig) / gsz;
        }
        int e = 0;
#pragma unroll
        for (int q = 0; q < 7; ++q) e += (u.pm >= __builtin_amdgcn_readfirstlane(tab[32 + q])) ? 1 : 0;
        u.pn += e * nN; return true;
    }
};
#ifndef MOED_WGM
#define MOED_WGM 4
#endif
struct MoeFullOrder : StaticOrder {
    const PG8_LAS int* tab;
    __device__ bool next(int i, Unit& u) const {
        {
            const long L = (long)i * G + c; if (L >= nwg) return false;
            int wgid = (int)L; { const int q = nwg / NXCD, r = nwg % NXCD, xcd = wgid % NXCD, off = wgid / NXCD; wgid = (xcd < r ? xcd * (q + 1) : r * (q + 1) + (xcd - r) * q) + off; }
            const int nig = MOED_WGM * nN, gid = wgid / nig, fm = gid * MOED_WGM, gsz = (nM - fm) < MOED_WGM ? (nM - fm) : MOED_WGM;
            u.pm = fm + ((wgid % nig) % gsz); u.pn = (wgid % nig) / gsz;
        }
        const int f = u.pm; int e = 0;
#pragma unroll
        for (int q = 0; q < 7; ++q) e += (f >= __builtin_amdgcn_readfirstlane(tab[40 + q])) ? 1 : 0;
        u.pm = f + __builtin_amdgcn_readfirstlane(tab[48 + e]); u.pn += e * nN; return true;
    }
    __device__ __forceinline__ void a_ready(const Unit&) const {}
    __device__ __forceinline__ void done(const Unit&) const {}
};
struct MoeRemOrder {
    static constexpr bool NTB = false;
    int nsub, G, c; const PG8_LAS int* tab;
    __device__ bool next(int i, Unit& u) const {
        const int L = i * G + c; if (L >= nsub) return false;
        const int r = L >> 5, pn = (L >> 2) & 7, ks = L & 3, e = tab[64 + r];
        u.pm = tab[32 + e] - 1; u.pn = e * 8 + pn; u.ko = ks * 1792; u.aux = r; return true;
    }
    __device__ __forceinline__ void a_ready(const Unit&) const {}
    __device__ __forceinline__ void done(const Unit&) const {}
};
struct EpiSlab {
    static constexpr bool PERM = false, AFTER_DRAIN = false;
    float* S; float sc = 1.0f;
    __device__ __forceinline__ void operator()(const f32x4 (&acc)[2][2][4][2], const Unit& u, int wr, int wc, int fr_in, int fq_in) const {
        (void)fr_in; (void)fq_in; int t_ = threadIdx.x; asm volatile("" : "+v"(t_)); const int fr = t_ & 15, fq = (t_ >> 4) & 3;
        const int ks = u.ko / 1792, pn = u.pn & 7;
        float* base = S + ((size_t)(ks * 8 + u.aux) * 256 + wr * 64 + fr) * 2048 + pn * BM + wc * 32 + 4 * fq;
#pragma unroll
        for (int ai = 0; ai < 2; ++ai)
#pragma unroll
            for (int m = 0; m < 4; ++m)
#pragma unroll
                for (int bj = 0; bj < 2; ++bj)
#pragma unroll
                    for (int n = 0; n < 2; ++n) *(PG8_GAS f32x4*)(base + (size_t)(ai * HALF + m * 16) * 2048 + bj * HALF + n * 16) = acc[ai][bj][m][n] * sc;
    }
};
struct EpiBf16P {
    static constexpr bool PERM = true, AFTER_DRAIN = false;
    bf16_t* O; int ldc; int pn_mod; float sc = 1.0f;
    __device__ __forceinline__ void operator()(const f32x4 (&acc)[2][2][4][2], const Unit& u, int wr, int wc, int fr_in, int fq_in) const {
        (void)fr_in; (void)fq_in; int t_ = threadIdx.x; asm volatile("" : "+v"(t_)); const int fr = t_ & 15, fq = (t_ >> 4) & 3;
        const int pn = pn_mod ? (u.pn % pn_mod) : u.pn;
        const int row0 = u.pm * BM + wr * 64 + fr, col0 = pn * BM + wc * 32 + 8 * fq;
#pragma unroll
        for (int ai = 0; ai < 2; ++ai)
#pragma unroll
            for (int m = 0; m < 4; ++m) { bf16_t* rowp = O + (size_t)(row0 + ai * HALF + m * 16) * ldc + col0;
#pragma unroll
                for (int bj = 0; bj < 2; ++bj) { const f32x4 v0 = acc[ai][bj][m][0] * sc, v1 = acc[ai][bj][m][1] * sc;
                    u32x4 w; w.x = cvt_pk_bf16(v0[0], v0[1]); w.y = cvt_pk_bf16(v0[2], v0[3]); w.z = cvt_pk_bf16(v1[0], v1[1]); w.w = cvt_pk_bf16(v1[2], v1[3]);
                    *(PG8_GAS u32x4*)(rowp + bj * HALF) = w; } }
    }
};
#ifndef KT_MOE
#define KT_MOE 1
#endif
#ifndef MOE_FP8
#define MOE_FP8 1
#endif
constexpr float MOE_WSCALE = 64.0f;
#ifndef EMU_FP8
#define EMU_FP8 0
#endif
#ifndef EMU_DGU
#define EMU_DGU 0
#endif
__device__ __forceinline__ unsigned pk4_fp8(float a, float b, float c, float d) { int p = __builtin_amdgcn_cvt_pk_fp8_f32(a, b, 0, false); p = __builtin_amdgcn_cvt_pk_fp8_f32(c, d, p, true); return (unsigned)p; }
__device__ __forceinline__ float fp8r(float x) { const int p = __builtin_amdgcn_cvt_pk_fp8_f32(x, x, 0, false); return __builtin_amdgcn_cvt_f32_fp8(p, 0); }
#ifndef NT_HM2
#define NT_HM2 1
#endif
__device__ __forceinline__ float silu_f(float x) { return x * __builtin_amdgcn_rcpf(1.0f + __expf(-x)); }
__device__ __forceinline__ float swiglu_f(float g, float u, float c1, float kk) { const float e = __builtin_amdgcn_exp2f(g * c1); return (g * u) * __builtin_amdgcn_rcpf(fmaf(e, kk, kk)); }
struct EpiSwiGLU {
    static constexpr bool PERM = true, AFTER_DRAIN = false;
    bf16_t* O; int ldc; int pn_mod; float isc = 1.0f;
    __device__ __forceinline__ void operator()(const f32x4 (&acc)[2][2][4][2], const Unit& u, int wr, int wc, int fr_in, int fq_in) const {
        (void)fr_in; (void)fq_in; int t_ = threadIdx.x; asm volatile("" : "+v"(t_)); const int fr = t_ & 15, fq = (t_ >> 4) & 3;
        const int pn = pn_mod ? (u.pn % pn_mod) : u.pn;
        const int row0 = u.pm * BM + wr * 64 + fr, col0 = pn * HALF + wc * 32 + 8 * fq;
        const float c1 = -1.4426950408889634f * isc, kk = 1.0f / (isc * isc);
#pragma unroll
        for (int ai = 0; ai < 2; ++ai)
#pragma unroll
            for (int m = 0; m < 4; ++m) { bf16_t* rowp = O + (size_t)(row0 + ai * HALF + m * 16) * ldc + col0;
                if (KT_MOE && pn_mod) rowp = O + ((size_t)(u.pm * (ldc >> 6) + (col0 >> 6)) * 256 + (wr * 64 + fr + ai * HALF + m * 16)) * 64 + (col0 & 63);
                f32x4 r0, r1;
#pragma unroll
                for (int j = 0; j < 4; ++j) { r0[j] = swiglu_f(acc[ai][0][m][0][j], acc[ai][1][m][0][j], c1, kk); r1[j] = swiglu_f(acc[ai][0][m][1][j], acc[ai][1][m][1][j], c1, kk); }
                if (MOE_FP8 && pn_mod) {
                    typedef unsigned u32x2 __attribute__((ext_vector_type(2)));
                    unsigned char* p8 = (unsigned char*)O + ((size_t)(u.pm * (ldc >> 7) + (col0 >> 7)) * 256 + (wr * 64 + fr + ai * HALF + m * 16)) * 128 + (col0 & 127);
                    u32x2 w8; w8.x = pk4_fp8(r0[0], r0[1], r0[2], r0[3]); w8.y = pk4_fp8(r1[0], r1[1], r1[2], r1[3]);
                    __builtin_nontemporal_store(w8, (PG8_GAS u32x2*)p8); continue; }
                if (EMU_FP8 && pn_mod) {
#pragma unroll
                    for (int j = 0; j < 4; ++j) { r0[j] = fp8r(r0[j]); r1[j] = fp8r(r1[j]); } }
                u32x4 w; w.x = cvt_pk_bf16(r0[0], r0[1]); w.y = cvt_pk_bf16(r0[2], r0[3]); w.z = cvt_pk_bf16(r1[0], r1[1]); w.w = cvt_pk_bf16(r1[2], r1[3]);
                if (NT_HM2 && pn_mod) __builtin_nontemporal_store(w, (PG8_GAS u32x4*)rowp); else *(PG8_GAS u32x4*)rowp = w; }
    }
};
struct EpiResGate {
    static constexpr bool PERM = false, AFTER_DRAIN = false;
    float* H; const float* gate;
    const float* xin; const float* cin;
    __device__ __forceinline__ void operator()(const f32x4 (&acc)[2][2][4][2], const Unit& u, int wr, int wc, int fr, int fq) const {
        const int b = u.pm / 9, j = u.pm - 9 * b, mr = (j == 0) ? 8 : b;
        const int rloc = wr * 64 + fr, col0 = u.pn * BM + wc * 32 + 4 * fq;
        const float* gp = gate + (size_t)mr * 12288 + col0;
        float* outp = H + (size_t)(u.pm * BM + rloc) * 2048 + col0;
        const float* inp = xin ? ((j == 0) ? cin + ((size_t)b * 256 + rloc) * 2048 + col0 : xin + ((size_t)b * 2048 + (size_t)(j - 1) * 256 + rloc) * 2048 + col0) : outp;
        f32x4 gv[2][2];
#pragma unroll
        for (int bj = 0; bj < 2; ++bj)
#pragma unroll
            for (int n = 0; n < 2; ++n) gv[bj][n] = *(const PG8_GAS f32x4*)(gp + bj * HALF + n * 16);
#pragma unroll
        for (int ai = 0; ai < 2; ++ai)
#pragma unroll
            for (int m = 0; m < 4; ++m) {
                const size_t ro = (size_t)(ai * HALF + m * 16) * 2048;
#pragma unroll
                for (int bj = 0; bj < 2; ++bj)
#pragma unroll
                    for (int n = 0; n < 2; ++n) { const f32x4 h = *(const PG8_GAS f32x4*)(inp + ro + bj * HALF + n * 16); *(PG8_GAS f32x4*)(outp + ro + bj * HALF + n * 16) = h + gv[bj][n] * acc[ai][bj][m][n]; }
                asm volatile("" ::: "memory"); }
    }
};
struct EpiQupRope {
    static constexpr bool PERM = false, AFTER_DRAIN = false;
    bf16_t* O; const float* tab;
    __device__ __forceinline__ void operator()(const f32x4 (&acc)[2][2][4][2], const Unit& u, int wr, int wc, int fr, int fq) const {
        const int b = u.pm / 9, j = u.pm - 9 * b; const bool lat = j != 0;
        const int rloc = wr * 64 + fr, col0 = u.pn * BM + wc * 32 + 4 * fq;
        typedef unsigned u32x2 __attribute__((ext_vector_type(2)));
#pragma unroll
        for (int bj = 0; bj < 2; ++bj) {
            const int dblk = (8 * u.pn + 4 * bj + wc) % 6; const bool rope = lat && dblk >= 4; const int axis = dblk - 4;
#pragma unroll
            for (int ai = 0; ai < 2; ++ai)
#pragma unroll
                for (int m = 0; m < 4; ++m) {
                    const int r = ai * HALF + m * 16 + rloc;
                    f32x4 x1 = acc[ai][bj][m][0], x2 = acc[ai][bj][m][1];
                    if (rope) { const int t = (j - 1) * 256 + r, pos = axis ? (t & 63) : (t >> 6);
                        const f32x4 c = *(const PG8_GAS f32x4*)(tab + pos * 16 + 4 * fq), sn = *(const PG8_GAS f32x4*)(tab + 1024 + pos * 16 + 4 * fq);
                        const f32x4 a = x1, bb = x2; x1 = a * c - bb * sn; x2 = bb * c + a * sn; }
                    bf16_t* rowp = O + (size_t)(u.pm * BM + r) * 768 + col0 + bj * HALF;
                    u32x2 w0, w1; w0.x = cvt_pk_bf16(x1[0], x1[1]); w0.y = cvt_pk_bf16(x1[2], x1[3]); w1.x = cvt_pk_bf16(x2[0], x2[1]); w1.y = cvt_pk_bf16(x2[2], x2[3]);
                    *(PG8_GAS u32x2*)rowp = w0; *(PG8_GAS u32x2*)(rowp + 16) = w1;
                    asm volatile("" ::: "memory");
                }
        }
    }
};
}
#define PG8_SP2 true
#define PG8_ALIGN true

struct Frame {
    LAS unsigned char* lds;
    volatile LAS unsigned* MISC;
    gu32* ctl;
    int wave, G, gw, NGW;
    float* out;
    unsigned char* ws;
};
__device__ __forceinline__ int opq_v(int v) { asm volatile("" : "+v"(v)); return v; }
#define TIDX opq_v((int)threadIdx.x)
typedef const float* cfptr;
__device__ __forceinline__ const float* inptr(int i) {
    const __attribute__((address_space(4))) cfptr* p = (const __attribute__((address_space(4))) cfptr*)__builtin_amdgcn_kernarg_segment_ptr();
    asm volatile("" : "+s"(p));
    return p[i];
}
enum { I_X = 0, I_C, I_CTX, I_CCTX, I_WMOD, I_BMOD, I_GMIX, I_WIN, I_NABIAS, I_MLAGQ, I_WQUP, I_MLAGKV, I_WKVUP, I_GQAGQ, I_GQAGK, I_LQ1, I_LK1, I_LQ2, I_LK2, I_GSUB, I_WOUT, I_GFFN,
       I_FG, I_FU, I_FD, I_MR, I_MB, I_MG, I_MU, I_MDN, I_GFIN };

struct TrJob { const float* W; bf16* WT; int N, ldk, k0, n0, drow0, tiled, emu; };
__device__ __forceinline__ void tr_load(const TrJob& j, f32x4 (&v)[16], int lane) {
#pragma unroll
    for (int i = 0; i < 16; ++i) { const int k = 4 * i + (lane >> 4), n4 = (lane & 15) * 4;
        v[i] = __builtin_nontemporal_load((const GAS f32x4*)(j.W + (size_t)(j.k0 + k) * j.N + j.n0 + n4)); }
}
__device__ __forceinline__ void tr_finish8(const TrJob& j, const f32x4 (&v)[16], LAS unsigned char* scr, int lane) {
    constexpr int ROWB = 68;
#pragma unroll
    for (int i = 0; i < 16; ++i) { const int k = 4 * i + (lane >> 4), n4 = (lane & 15) * 4; const f32x4 t = v[i] * pg8::MOE_WSCALE;
        *(LAS unsigned*)(scr + k * ROWB + n4) = pg8::pk4_fp8(t.x, t.y, t.z, t.w); }
    LDS_WAIT();
    const int c = lane & 3;
#pragma unroll 2
    for (int jj = 0; jj < 4; ++jj) {
        const int n = 16 * jj + (lane >> 2);
        const LAS unsigned char* s = scr + (16 * c) * ROWB + n;
        unsigned e[16];
#pragma unroll
        for (int i = 0; i < 16; ++i) e[i] = s[i * ROWB];
        v4u o; o.x = e[0] | (e[1] << 8) | (e[2] << 16) | (e[3] << 24); o.y = e[4] | (e[5] << 8) | (e[6] << 16) | (e[7] << 24);
        o.z = e[8] | (e[9] << 8) | (e[10] << 16) | (e[11] << 24); o.w = e[12] | (e[13] << 8) | (e[14] << 16) | (e[15] << 24);
        const int dr = j.drow0 + n;
        unsigned char* dst = (unsigned char*)j.WT + ((size_t)((dr >> 8) * (j.ldk >> 7) + (j.k0 >> 7)) * 256 + (dr & 255)) * 128 + (j.k0 & 127) + 16 * c;
        __builtin_nontemporal_store(o, (GAS v4u*)dst);
    }
    LDS_WAIT();
}
__device__ __forceinline__ void tr_finish(const TrJob& j, const f32x4 (&v)[16], LAS unsigned char* scr, int lane) {
    constexpr int ROWB = 136;
#pragma unroll
    for (int i = 0; i < 16; ++i) { const int k = 4 * i + (lane >> 4), n4 = (lane & 15) * 4;
        f32x4 t = v[i]; if ((EMU_FP8 && j.tiled) || (EMU_DGU && j.emu)) { t.x = pg8::fp8r(t.x * 64.f) * (1.f / 64.f); t.y = pg8::fp8r(t.y * 64.f) * (1.f / 64.f); t.z = pg8::fp8r(t.z * 64.f) * (1.f / 64.f); t.w = pg8::fp8r(t.w * 64.f) * (1.f / 64.f); }
        v2u w; w.x = pg8::cvt_pk_bf16(t.x, t.y); w.y = pg8::cvt_pk_bf16(t.z, t.w);
        *(LAS v2u*)(scr + k * ROWB + n4 * 2) = w; }
    LDS_WAIT();
    const int c = lane & 7;
#pragma unroll 2
    for (int jj = 0; jj < 8; ++jj) {
        const int n = 8 * jj + (lane >> 3);
        const LAS unsigned short* s = (const LAS unsigned short*)(scr + (8 * c) * ROWB + n * 2);
        unsigned e[8];
#pragma unroll
        for (int i = 0; i < 8; ++i) e[i] = s[i * (ROWB / 2)];
        v4u o; o.x = e[0] | (e[1] << 16); o.y = e[2] | (e[3] << 16); o.z = e[4] | (e[5] << 16); o.w = e[6] | (e[7] << 16);
        const int dr = j.drow0 + n;
        bf16* dst = j.tiled ? j.WT + ((size_t)((dr >> 8) * (j.ldk >> 6) + (j.k0 >> 6)) * 256 + (dr & 255)) * 64 + 8 * c : j.WT + (size_t)dr * j.ldk + j.k0 + 8 * c;
        __builtin_nontemporal_store(o, (GAS v4u*)dst);
    }
    LDS_WAIT();
}
constexpr int IT_WIN = 32 * 73, IT_WOUT = 32 * 32, IT_FGU = 32 * 88, IT_FD = 88 * 32, IT_MGU = 32 * 112, IT_MD = 112 * 32;
constexpr int CV_N0 = 2 * IT_WIN, CV_N1 = CV_N0 + 2 * IT_WOUT, CV_N2 = CV_N1 + 2 * IT_FGU, CV_N3 = CV_N2 + IT_FD, CV_N4 = CV_N3 + 16 * IT_MGU, CV_N5 = CV_N4 + 8 * IT_MD;
constexpr int CVQ_L1 = IT_WIN + IT_WOUT, CVQ_N = CVQ_L1 + (CV_N5 - CV_N1), CVQ_FFN_END = CVQ_L1 + (CV_N3 - CV_N1);
__device__ __forceinline__ int cvq_item(int q) { return q < IT_WIN ? IT_WIN + q : (q < CVQ_L1 ? CV_N0 + IT_WOUT + (q - IT_WIN) : CV_N1 + (q - CVQ_L1)); }
__device__ __forceinline__ TrJob conv_job(int it, unsigned char* ws) {
    const float* W; bf16* WT; int N, ldk, k0, n0, drow0, tiled = 0, emu = 0;
    if (it < CV_N0) { const int l = it / IT_WIN, r = it % IT_WIN, kb = r / 73, nb = r % 73;
        W = inptr(I_WIN) + (size_t)l * 2048 * INC; N = INC; WT = (bf16*)(ws + WS_WIN) + (size_t)l * INCP * 2048; ldk = 2048; k0 = kb * 64; n0 = nb * 64; drow0 = n0; }
    else if (it < CV_N1) { const int q = it - CV_N0, l = q / IT_WOUT, r = q % IT_WOUT, kb = r / 32, nb = r % 32;
        W = inptr(I_WOUT) + (size_t)l * 2048 * 2048; N = 2048; WT = (bf16*)(ws + WS_WOUT) + (size_t)l * 2048 * 2048; ldk = 2048; k0 = kb * 64; n0 = nb * 64; drow0 = n0; }
    else if (it < CV_N2) { const int q = it - CV_N1, which = q / IT_FGU, r = q % IT_FGU, kb = r / 88, nb = r % 88;
        W = which ? inptr(I_FU) : inptr(I_FG); N = DFF; WT = (bf16*)(ws + WS_WGU); ldk = 2048; k0 = kb * 64; n0 = nb * 64; drow0 = (n0 >> 7) * 256 + (n0 & 127) + which * 128; emu = 1; }
    else if (it < CV_N3) { const int r = it - CV_N2, kb = r / 32, nb = r % 32;
        W = inptr(I_FD); N = 2048; WT = (bf16*)(ws + WS_WD); ldk = DFF; k0 = kb * 64; n0 = nb * 64; drow0 = n0; }
    else if (it < CV_N4) { const int q = it - CV_N3, mat = q / IT_MGU, e = mat >> 1, which = mat & 1, r = q % IT_MGU, kb = r / 112, nb = r % 112;
        W = (which ? inptr(I_MU) : inptr(I_MG)) + (size_t)e * 2048 * DFE; N = DFE; WT = MOE_FP8 ? (bf16*)(ws + WS_MGU + (size_t)e * 14336 * 2048) : (bf16*)(ws + WS_MGU) + (size_t)e * 14336 * 2048; ldk = 2048; k0 = kb * 64; n0 = nb * 64; drow0 = (n0 >> 7) * 256 + (n0 & 127) + which * 128; tiled = MOE_FP8 ? 2 : KT_MOE; }
    else { const int q = it - CV_N4, e = q / IT_MD, r = q % IT_MD, kb = r / 32, nb = r % 32;
        W = inptr(I_MDN) + (size_t)e * DFE * 2048; N = 2048; WT = MOE_FP8 ? (bf16*)(ws + WS_MD + (size_t)e * 2048 * DFE) : (bf16*)(ws + WS_MD) + (size_t)e * 2048 * DFE; ldk = DFE; k0 = kb * 64; n0 = nb * 64; drow0 = n0; tiled = MOE_FP8 ? 2 : KT_MOE; }
    TrJob j; j.W = W; j.WT = WT; j.N = N; j.ldk = ldk; j.k0 = k0; j.n0 = n0; j.drow0 = drow0; j.tiled = tiled; j.emu = emu; return j;
}
template <bool QUEUE>
__device__ __forceinline__ void conv_pair(int it0, int it1, int nlim, unsigned char* ws, LAS unsigned char* scr, int lane) {
    if (it0 >= nlim) return;
    const bool two = it1 < nlim;
    const TrJob j0 = conv_job(QUEUE ? cvq_item(it0) : it0, ws), j1 = conv_job(QUEUE ? cvq_item(two ? it1 : it0) : (two ? it1 : it0), ws);
    f32x4 v0[16], v1[16];
#ifdef PROBE_CONV2
    if (QUEUE) { tr_load(j0, v0, lane); if (two) tr_load(j1, v1, lane); if (j0.tiled == 2) tr_finish8(j0, v0, scr, lane); else tr_finish(j0, v0, scr, lane); if (two) { if (j1.tiled == 2) tr_finish8(j1, v1, scr, lane); else tr_finish(j1, v1, scr, lane); } }
#endif
    tr_load(j0, v0, lane); if (two) tr_load(j1, v1, lane);
    if (j0.tiled == 2) tr_finish8(j0, v0, scr, lane); else tr_finish(j0, v0, scr, lane);
    if (two) { if (j1.tiled == 2) tr_finish8(j1, v1, scr, lane); else tr_finish(j1, v1, scr, lane); }
}
#ifndef CV_CHUNK_N
#define CV_CHUNK_N 16
#endif
constexpr int CW_QHEAD = 64, CW_DONE0 = 128, CV_CHUNK = CV_CHUNK_N;
#ifndef NO_TAIL_FILL
#define NO_TAIL_FILL 0
#endif
__device__ __forceinline__ void filler(Frame& F, int slot, int drain_to) {
    if (NO_TAIL_FILL && drain_to < 0) return;
    __syncthreads();
    LAS int* bc = (LAS int*)(F.lds + LDSCTL_OFF + 2048);
    LAS unsigned char* scr = F.lds + F.wave * 8704;
    gu32* qhead = F.ctl + CW_QHEAD; gu32* done = F.ctl + CW_DONE0 + 64 * slot;
    if (TIDX == 0 && drain_to < 0) __hip_atomic_fetch_add(done, 1u, RLX_AGENT);
    const int nq = CVQ_N, lim = drain_to < 0 ? nq : drain_to;
    for (;;) {
        if (TIDX == 0) {
            int h = -1; bool stop = false;
            if (drain_to < 0) stop = __hip_atomic_load(done, RLX_AGENT) >= (unsigned)F.G;
            else stop = __hip_atomic_load(qhead, RLX_AGENT) >= (unsigned)lim;
            if (!stop) { h = (int)__hip_atomic_fetch_add(qhead, (unsigned)CV_CHUNK, RLX_AGENT); if (h >= nq) h = -1; }
            *bc = h;
        }
        __syncthreads();
        const int h = *bc;
        __syncthreads();
        if (h < 0) break;
#pragma unroll 1
        for (int k = F.wave; k < CV_CHUNK; k += 2 * NWAVES) conv_pair<true>(h + k, h + k + NWAVES, CVQ_N, F.ws, scr, (TIDX & 63));
    }
    __syncthreads();
}

__device__ __forceinline__ void rope_cs(int pos, int i, float inv_nfreq, float& c, float& s) {
    const float freq = exp2f(-(float)i * inv_nfreq * 13.287712379549449f);
    const float ang = (float)pos * freq;
    c = __cosf(ang); s = __sinf(ang);
}

__device__ __forceinline__ void filler_quota(Frame& F, int nchunks) {
    __syncthreads();
    LAS int* bc = (LAS int*)(F.lds + LDSCTL_OFF + 2048);
    LAS unsigned char* scr = F.lds + F.wave * 8704;
    gu32* qhead = F.ctl + CW_QHEAD;
    const int nq = CVQ_N;
#pragma unroll 1
    for (int cidx = 0; cidx < nchunks; ++cidx) {
        if (TIDX == 0) { int h = -1;
            if (__hip_atomic_load(qhead, RLX_AGENT) < (unsigned)nq) { h = (int)__hip_atomic_fetch_add(qhead, (unsigned)CV_CHUNK, RLX_AGENT); if (h >= nq) h = -1; }
            *bc = h; }
        __syncthreads();
        const int h = *bc;
        __syncthreads();
        if (h < 0) break;
#pragma unroll 1
        for (int k = F.wave; k < CV_CHUNK; k += 2 * NWAVES) conv_pair<true>(h + k, h + k + NWAVES, CVQ_N, F.ws, scr, (TIDX & 63));
    }
    __syncthreads();
}

__device__ __forceinline__ float silu_g(float x) { return x / (1.0f + __expf(-x)); }

__device__ __forceinline__ void p0_prologue(Frame& F) {
    unsigned char* ws = F.ws;
    __syncthreads();
    {
        LAS float* sv = (LAS float*)(F.lds);
        LAS float* red = (LAS float*)(F.lds + 73728);
        for (int i = TIDX; i < 9 * 2048; i += 512) { const int r = i >> 11, d = i & 2047; const float v = (r < 8) ? inptr(I_C)[r * 2048 + d] : inptr(I_CCTX)[d]; sv[i] = silu_g(v); }
        __syncthreads();
        for (int cb = blockIdx.x; cb < 256; cb += F.G) {
            const int cg = cb * 96, layer = cg / MODW, col0 = cg - layer * MODW;
            const float* W = inptr(I_WMOD) + (size_t)layer * 2048 * MODW;
            if (TIDX < 384) {
                const int cq = TIDX % 24, ks = TIDX / 24;
                f32x4 acc[9];
#pragma unroll
                for (int r = 0; r < 9; ++r) acc[r] = (f32x4){0.f, 0.f, 0.f, 0.f};
                const float* wp = W + (size_t)(ks * 128) * MODW + col0 + cq * 4;
#pragma unroll 2
                for (int k = 0; k < 128; k += 4) {
                    f32x4 w[4];
#pragma unroll
                    for (int q = 0; q < 4; ++q) w[q] = __builtin_nontemporal_load((const GAS f32x4*)(wp + (size_t)(k + q) * MODW));
#pragma unroll
                    for (int r = 0; r < 9; ++r) { const f32x4 s4 = *(const LAS f32x4*)(sv + r * 2048 + ks * 128 + k);
                        acc[r] += w[0] * s4.x; acc[r] += w[1] * s4.y; acc[r] += w[2] * s4.z; acc[r] += w[3] * s4.w; }
                }
#pragma unroll
                for (int r = 0; r < 9; ++r) *(LAS f32x4*)(red + (ks * 9 + r) * 96 + cq * 4) = acc[r];
            }
            __syncthreads();
            for (int i = TIDX; i < 9 * 96; i += 512) {
                const int r = i / 96, c = i - r * 96; float s = inptr(I_BMOD)[layer * MODW + col0 + c];
#pragma unroll
                for (int ks = 0; ks < 16; ++ks) s += red[(ks * 9 + r) * 96 + c];
                ((float*)(ws + WS_MOD))[((size_t)layer * 9 + r) * MODW + col0 + c] = s;
            }
            __syncthreads();
        }
    }
    {
        const size_t gt = (size_t)blockIdx.x * 512 + TIDX, GT = (size_t)F.G * 512;
        for (size_t i = gt; i < (size_t)2 * 768 * 384; i += GT) { const int l = (int)(i / (768 * 384)), r = (int)(i % (768 * 384)), n = r / 384, k = r % 384;
            ((bf16*)(ws + WS_WQUP))[i] = (bf16)f2bf(inptr(I_WQUP)[((size_t)l * 384 + k) * 768 + n]); }
        for (size_t i = gt; i < (size_t)2 * 1280 * 256; i += GT) { const int l = (int)(i / (1280 * 256)), r = (int)(i % (1280 * 256)), row = r >> 8, k = r & 255, h = row / 320, j = row - 320 * h;
            float v = 0.f;
            if (j < 128) { if (k < 128) v = inptr(I_WKVUP)[((size_t)l * 128 + k) * 1024 + h * 256 + j]; }
            else if (j < 192) { if (k == j) v = 1.0f; }
            else { if (k < 128) v = inptr(I_WKVUP)[((size_t)l * 128 + k) * 1024 + h * 256 + 128 + (j - 192)]; }
            ((bf16*)(ws + WS_WKVUP))[i] = (bf16)f2bf(v); }
        for (size_t i = gt; i < 64 * 16 + 64 * 32; i += GT) { float* tb = (float*)(ws + WS_ROPE);
            if (i < 1024) { const int pos = (int)i >> 4, f = (int)i & 15; float c, sn; rope_cs(pos, f, 1.0f / 16.0f, c, sn); tb[i] = c; tb[1024 + i] = sn; }
            else { const int q = (int)i - 1024, pos = q >> 5, f = q & 31; float c, sn; rope_cs(pos, f, 1.0f / 32.0f, c, sn); tb[2048 + q] = c; tb[4096 + q] = sn; } }
        for (size_t i = gt; i < (size_t)2 * 192 * 2048 / 8; i += GT) { const int l = (int)(i / (192 * 256)), r = (int)(i % (192 * 256));
            *(GAS v4u*)((bf16*)(ws + WS_WIN) + ((size_t)l * INCP + INC) * 2048 + (size_t)r * 8) = (v4u){0u, 0u, 0u, 0u}; }
    }
    {
        LAS unsigned char* scr = F.lds + F.wave * 8704;
        for (int it = F.gw; it < IT_WIN + IT_WOUT; it += 2 * F.NGW) {
            const int i1 = it + F.NGW, a0 = it < IT_WIN ? it : CV_N0 + (it - IT_WIN), a1 = i1 < IT_WIN ? i1 : CV_N0 + (i1 - IT_WIN);
            conv_pair<false>(a0, i1 < IT_WIN + IT_WOUT ? a1 : CV_N5, CV_N5, ws, scr, (TIDX & 63)); }
    }
}

struct RowInfo { int b, w, t, mr; bool ctx; };
__device__ __forceinline__ RowInfo row_info(int r) { RowInfo q; q.b = r / TPB; q.w = r - q.b * TPB; q.ctx = q.w < CTXL; q.t = q.w - CTXL; q.mr = q.ctx ? 8 : q.b; return q; }

__device__ __forceinline__ void norm_pass(Frame& F, int layer, bool first  , bool from_input) {
    unsigned char* ws = F.ws;
    const float* modl = (const float*)(ws + WS_MOD) + (size_t)layer * 9 * MODW;
    const float* g = (first ? inptr(I_GMIX) : inptr(I_GFFN)) + layer * DM;
    const int sh_off = first ? 0 : 3 * DM, sc_off = first ? DM : 4 * DM;
    const float* H = (const float*)(ws + WS_H); bf16* U = (bf16*)(ws + WS_U);
    const int tid_ = TIDX, lane_ = tid_ & 63;
    LAS float* ca = (LAS float*)F.lds; LAS float* cb = ca + 4096;
    for (int blk = blockIdx.x; blk < 256; blk += F.G) {
        const int r0 = blk * 72, bb = r0 / TPB;
        __syncthreads();
        for (int i = tid_; i < 2 * 2048; i += 512) { const int slot = i >> 11, col = i & 2047, mr = slot ? bb : 8;
            ca[i] = g[col] * (1.0f + modl[(size_t)mr * MODW + sc_off + col]); cb[i] = modl[(size_t)mr * MODW + sh_off + col]; }
        __syncthreads();
#pragma unroll 1
        for (int k = 0; k < 3; ++k) {
            f32x4 v[3][8];
#pragma unroll
            for (int q = 0; q < 3; ++q) { const int r = r0 + 9 * F.wave + 3 * k + q, w = r - bb * TPB;
                const float* src = from_input ? ((w < CTXL) ? inptr(I_CTX) + ((size_t)bb * CTXL + w) * DM : inptr(I_X) + ((size_t)bb * SEQ + (w - CTXL)) * DM) : H + (size_t)r * DM;
                const GAS f32x4* xr = (const GAS f32x4*)src + lane_;
#pragma unroll
                for (int j = 0; j < 8; ++j) v[q][j] = xr[64 * j]; }
#pragma unroll
            for (int q = 0; q < 3; ++q) { const int r = r0 + 9 * F.wave + 3 * k + q, w = r - bb * TPB, slot = (w < CTXL) ? 0 : 1;
                float ss = 0.f;
#pragma unroll
                for (int j = 0; j < 8; ++j) ss += (v[q][j].x * v[q][j].x + v[q][j].y * v[q][j].y) + (v[q][j].z * v[q][j].z + v[q][j].w * v[q][j].w);
                const float rstd = 1.0f / sqrtf(wave_sum(ss) * (1.0f / DM) + EPSN);
                GAS v2u* o8 = (GAS v2u*)(U + (size_t)r * DM) + lane_;
                const LAS f32x4* ap = (const LAS f32x4*)(ca + slot * 2048) + lane_; const LAS f32x4* bp = (const LAS f32x4*)(cb + slot * 2048) + lane_;
#pragma unroll
                for (int j = 0; j < 8; ++j) { f32x4 y = v[q][j] * rstd * ap[64 * j] + bp[64 * j]; if (EMU_DGU && !first) { y.x = pg8::fp8r(y.x); y.y = pg8::fp8r(y.y); y.z = pg8::fp8r(y.z); y.w = pg8::fp8r(y.w); } v2u wv; wv.x = pg8::cvt_pk_bf16(y.x, y.y); wv.y = pg8::cvt_pk_bf16(y.z, y.w); o8[64 * j] = wv; } }
        }
    }
    __syncthreads();
}

struct PostRow { unsigned cq[3], ckv; float kpe[2], gq[6][2], df[8][2]; };
__device__ __forceinline__ void post_load(const bf16* q, bool lat, int lane, PostRow& R) {
    const GAS unsigned* pc = (const GAS unsigned*)(q + C_CQ);
#pragma unroll
    for (int j = 0; j < 3; ++j) R.cq[j] = pc[lane + 64 * j];
    R.ckv = ((const GAS unsigned*)(q + C_CKV))[lane];
    { const int axis = (lane >> 4) & 1, i = lane & 15; const GAS bf16* pk = (const GAS bf16*)(q + C_KPE + axis * 32); R.kpe[0] = bf1(pk[i]); R.kpe[1] = bf1(pk[16 + i]); }
#pragma unroll
    for (int hh = 0; hh < 6; ++hh) { const int base = (hh < 4) ? (C_GQ + 128 * hh) : (C_GK + 128 * (hh - 4)); const int axis = lane >> 5, i = lane & 31;
        const GAS bf16* pg = (const GAS bf16*)(q + base + axis * 64); R.gq[hh][0] = bf1(pg[i]); R.gq[hh][1] = bf1(pg[32 + i]); }
    if (lat) {
#pragma unroll
        for (int pp = 0; pp < 8; ++pp) { const int blk = 2 * pp + (lane >> 5), axis = (lane >> 4) & 1, i = lane & 15; const int base = (blk < 8) ? (C_DQ + 64 * blk) : (C_DK + 64 * (blk - 8));
            const GAS bf16* pd = (const GAS bf16*)(q + base + axis * 32); R.df[pp][0] = bf1(pd[i]); R.df[pp][1] = bf1(pd[16 + i]); }
    }
}
__device__ __forceinline__ void post_finish(bf16* q, bool lat, int prow, int pcol, int lane, const PostRow& R, const float* g_mq, const float* g_mkv, const float* g_gq, const float* g_gk, const float* rt) {
    { float ss = 0.f;
#pragma unroll
      for (int j = 0; j < 3; ++j) { const float a = bflo(R.cq[j]), b = bfhi(R.cq[j]); ss += a * a + b * b; }
      const float rs = 1.0f / sqrtf(wave_sum(ss) * (1.0f / 384.0f) + EPSN); GAS unsigned* pc = (GAS unsigned*)(q + C_CQ);
#pragma unroll
      for (int j = 0; j < 3; ++j) { const int c = 2 * (lane + 64 * j); pc[lane + 64 * j] = pk2(bflo(R.cq[j]) * rs * g_mq[c], bfhi(R.cq[j]) * rs * g_mq[c + 1]); } }
    { const float a = bflo(R.ckv), b = bfhi(R.ckv); const float rs = 1.0f / sqrtf(wave_sum(a * a + b * b) * (1.0f / 128.0f) + EPSN);
      ((GAS unsigned*)(q + C_CKV))[lane] = pk2(a * rs * g_mkv[2 * lane], b * rs * g_mkv[2 * lane + 1]); }
    if (lat && lane < 32) { const int axis = lane >> 4, i = lane & 15, pos = axis ? pcol : prow; const float c = rt[pos * 16 + i], s = rt[1024 + pos * 16 + i];
      GAS bf16* pk = (GAS bf16*)(q + C_KPE + axis * 32); pk[i] = (bf16)f2bf(R.kpe[0] * c - R.kpe[1] * s); pk[16 + i] = (bf16)f2bf(R.kpe[1] * c + R.kpe[0] * s); }
    { const int axis = lane >> 5, i = lane & 31, pos = axis ? pcol : prow; const float c = rt[2048 + pos * 32 + i], s = rt[4096 + pos * 32 + i];
#pragma unroll
      for (int hh = 0; hh < 6; ++hh) { const int base = (hh < 4) ? (C_GQ + 128 * hh) : (C_GK + 128 * (hh - 4)); const float* gg = (hh < 4) ? g_gq : g_gk;
        const float x1 = R.gq[hh][0], x2 = R.gq[hh][1];
        const float rs = 1.0f / sqrtf(wave_sum(x1 * x1 + x2 * x2) * (1.0f / 128.0f) + EPSN);
        float y1 = x1 * rs * gg[axis * 64 + i], y2 = x2 * rs * gg[axis * 64 + 32 + i];
        if (lat) { const float o1 = y1 * c - y2 * s, o2 = y2 * c + y1 * s; y1 = o1; y2 = o2; }
        GAS bf16* pg = (GAS bf16*)(q + base + axis * 64); pg[i] = (bf16)f2bf(y1); pg[32 + i] = (bf16)f2bf(y2); } }
    if (lat) { const int axis = (lane >> 4) & 1, i = lane & 15, pos = axis ? pcol : prow; const float c = rt[pos * 16 + i], s = rt[1024 + pos * 16 + i];
#pragma unroll
      for (int pp = 0; pp < 8; ++pp) { const int blk = 2 * pp + (lane >> 5); const int base = (blk < 8) ? (C_DQ + 64 * blk) : (C_DK + 64 * (blk - 8));
        GAS bf16* pd = (GAS bf16*)(q + base + axis * 32); pd[i] = (bf16)f2bf(R.df[pp][0] * c - R.df[pp][1] * s); pd[16 + i] = (bf16)f2bf(R.df[pp][1] * c + R.df[pp][0] * s); } }
}
__device__ __forceinline__ void post_pass(Frame& F, int layer) {
    bf16* QKV = (bf16*)(F.ws + WS_QKV); const float* rt = (const float*)(F.ws + WS_ROPE);
    const float* g_mq = inptr(I_MLAGQ) + layer * 384; const float* g_mkv = inptr(I_MLAGKV) + layer * 128;
    const float* g_gq = inptr(I_GQAGQ) + layer * 128; const float* g_gk = inptr(I_GQAGK) + layer * 128;
    const int lane = opq_v((TIDX & 63));
    for (int r = F.gw; r < MT; r += 2 * F.NGW) {
        const int r2 = r + F.NGW; const bool two = r2 < MT;
        const RowInfo ra = row_info(r), rb = row_info(two ? r2 : r);
        bf16* qa = QKV + (size_t)r * INCP; bf16* qb = QKV + (size_t)(two ? r2 : r) * INCP;
        PostRow A, B;
        post_load(qa, !ra.ctx, lane, A); if (two) post_load(qb, !rb.ctx, lane, B);
        post_finish(qa, !ra.ctx, ra.ctx ? 0 : (ra.t >> 6), ra.ctx ? 0 : (ra.t & 63), lane, A, g_mq, g_mkv, g_gq, g_gk, rt);
        if (two) post_finish(qb, !rb.ctx, rb.ctx ? 0 : (rb.t >> 6), rb.ctx ? 0 : (rb.t & 63), lane, B, g_mq, g_mkv, g_gq, g_gk, rt);
    }
}
__device__ __forceinline__ void qm_rope_pass(Frame& F) {
    bf16* QM = (bf16*)(F.ws + WS_QM); const int lane = opq_v((TIDX & 63));
    for (int r = F.gw; r < MT; r += F.NGW) {
        const RowInfo ri = row_info(r); if (ri.ctx) continue;
        const int prow = ri.t >> 6, pcol = ri.t & 63;
#pragma unroll
        for (int pp = 0; pp < 2; ++pp) {
            const int h = 2 * pp + (lane >> 5), axis = (lane >> 4) & 1, i = lane & 15;
            GAS bf16* p = (GAS bf16*)(QM + (size_t)r * QMW + 192 * h + 128 + axis * 32);
            const float x1 = bf1(p[i]), x2 = bf1(p[16 + i]); float c, s; rope_cs(axis ? pcol : prow, i, 1.0f / 16.0f, c, s);
            p[i] = (bf16)f2bf(x1 * c - x2 * s); p[16 + i] = (bf16)f2bf(x2 * c + x1 * s);
        }
    }
}

__device__ __forceinline__ void ffn_tables(Frame& F, int layer, int b, LAS float* ca, LAS float* cb) {
    const float* modl = (const float*)(F.ws + WS_MOD) + (size_t)layer * 9 * MODW + (size_t)b * MODW; const float* g = inptr(I_GFFN) + layer * DM;
    for (int i = TIDX; i < 2048; i += 512) { ca[i] = g[i] * (1.0f + modl[4 * DM + i]); cb[i] = modl[3 * DM + i]; }
}
__device__ __forceinline__ void ffn_u_pair(Frame& F, int r0, int r1, const LAS float* ca, const LAS float* cb, int lane_, f32x4 (&v0)[8], f32x4 (&v1)[8]) {
    const float* H = (const float*)(F.ws + WS_H);
    const GAS f32x4* x0 = (const GAS f32x4*)(H + (size_t)r0 * DM) + lane_; const GAS f32x4* x1 = (const GAS f32x4*)(H + (size_t)r1 * DM) + lane_;
#pragma unroll
    for (int j = 0; j < 8; ++j) { v0[j] = x0[64 * j]; v1[j] = x1[64 * j]; }
    float s0 = 0.f, s1 = 0.f;
#pragma unroll
    for (int j = 0; j < 8; ++j) { s0 += (v0[j].x * v0[j].x + v0[j].y * v0[j].y) + (v0[j].z * v0[j].z + v0[j].w * v0[j].w); s1 += (v1[j].x * v1[j].x + v1[j].y * v1[j].y) + (v1[j].z * v1[j].z + v1[j].w * v1[j].w); }
    const float q0 = 1.0f / sqrtf(wave_sum(s0) * (1.0f / DM) + EPSN), q1 = 1.0f / sqrtf(wave_sum(s1) * (1.0f / DM) + EPSN);
    const LAS f32x4* ap = (const LAS f32x4*)ca + lane_; const LAS f32x4* bp = (const LAS f32x4*)cb + lane_;
#pragma unroll
    for (int j = 0; j < 8; ++j) { const f32x4 a4 = ap[64 * j], b4 = bp[64 * j]; v0[j] = v0[j] * q0 * a4 + b4; v1[j] = v1[j] * q1 * a4 + b4; }
}
__device__ __forceinline__ int moe_tok(int blk, int tl) { return (blk >> 5) * 2048 + (blk & 31) + 32 * tl; }
__device__ __forceinline__ void route_one(const f32x4 (&v)[8], const LAS float* wl, const float* br, int lane_, int& e1o, int& e2o, float& g1o, float& g2o) {
    float lg[8];
#pragma unroll
    for (int e = 0; e < 8; ++e) lg[e] = 0.f;
#pragma unroll
    for (int j = 0; j < 8; ++j) {
        const LAS f32x4* wp = (const LAS f32x4*)(wl + (size_t)(4 * (lane_ + 64 * j)) * 8);
#pragma unroll
        for (int c = 0; c < 4; ++c) { const f32x4 w0 = wp[2 * c], w1 = wp[2 * c + 1]; const float x = v[j][c];
            lg[0] += x * w0.x; lg[1] += x * w0.y; lg[2] += x * w0.z; lg[3] += x * w0.w; lg[4] += x * w1.x; lg[5] += x * w1.y; lg[6] += x * w1.z; lg[7] += x * w1.w; }
    }
#pragma unroll
    for (int e = 0; e < 8; ++e) lg[e] = wave_sum(lg[e]) + br[e];
    int e1 = 0; float v1 = lg[0];
#pragma unroll
    for (int e = 1; e < 8; ++e) if (lg[e] > v1) { v1 = lg[e]; e1 = e; }
    int e2 = -1; float v2 = -3.0e38f;
#pragma unroll
    for (int e = 0; e < 8; ++e) if (e != e1 && lg[e] > v2) { v2 = lg[e]; e2 = e; }
    g2o = 1.0f / (1.0f + expf(v1 - v2)); g1o = 1.0f - g2o; e1o = e1; e2o = e2;
}
__device__ __forceinline__ void moe_route_pass(Frame& F, int layer) {
    const int lane_ = opq_v((TIDX & 63));
    int* rt = (int*)(F.ws + WS_ROUTE); float* rtf = (float*)(F.ws + WS_ROUTE);
    LAS float* ca = (LAS float*)F.lds; LAS float* cb = ca + 2048; LAS float* wl = ca + 4096;
    LAS int* le = (LAS int*)(F.lds + 16384 + 65536);
    const float* wr = inptr(I_MR); const float* br = inptr(I_MB);
    __syncthreads();
    for (int i = TIDX; i < 2048 * 8 / 4; i += 512) ((LAS f32x4*)wl)[i] = ((const GAS f32x4*)wr)[i];
    for (int blk = blockIdx.x; blk < 256; blk += F.G) {
        const int b = blk >> 5;
        __syncthreads();
        ffn_tables(F, layer, b, ca, cb);
        __syncthreads();
#pragma unroll 1
        for (int i = 0; i < 4; ++i) {
            const int tl = F.wave + 16 * i, tl1 = tl + 8, tok = moe_tok(blk, tl), tok1 = moe_tok(blk, tl1);
            f32x4 v0[8], v1[8]; ffn_u_pair(F, b * TPB + CTXL + (tok & 2047), b * TPB + CTXL + (tok1 & 2047), ca, cb, lane_, v0, v1);
            int e1, e2; float g1, g2;
            route_one(v0, wl, br, lane_, e1, e2, g1, g2);
            if (lane_ == 0) { le[tl] = e1 | (e2 << 8); rt[RT_E + tok] = e1 | (e2 << 8); rtf[RT_G + 2 * tok] = g1; rtf[RT_G + 2 * tok + 1] = g2; }
            route_one(v1, wl, br, lane_, e1, e2, g1, g2);
            if (lane_ == 0) { le[tl1] = e1 | (e2 << 8); rt[RT_E + tok1] = e1 | (e2 << 8); rtf[RT_G + 2 * tok1] = g1; rtf[RT_G + 2 * tok1 + 1] = g2; }
        }
        __syncthreads();
        if (TIDX < 8) { const int e = TIDX; int cnt = 0;
            for (int tl = 0; tl < 64; ++tl) { const int w = le[tl], a = w & 255, c = w >> 8;
                if (a == e) rt[RT_RANK + 2 * moe_tok(blk, tl)] = cnt++;
                if (c == e) rt[RT_RANK + 2 * moe_tok(blk, tl) + 1] = cnt++; }
            rt[RT_CNT + blk * 8 + e] = cnt; }
    }
    __syncthreads();
}
__device__ __forceinline__ void moe_tables(Frame& F, LAS int* tab, int blk) {
    const int* rt = (const int*)(F.ws + WS_ROUTE);
    __syncthreads();
    if (TIDX < 8) { const int e = TIDX; int tot = 0, before = 0;
        for (int k = 0; k < 256; ++k) { const int c = rt[RT_CNT + k * 8 + e]; tot += c; before += (k < blk) ? c : 0; }
        tab[e] = tot; tab[16 + e] = before; }
    __syncthreads();
    if (TIDX == 0) { int base = 0, pan = 0, nf = 0, nr = 0;
        for (int e = 0; e < 8; ++e) { tab[8 + e] = base; const int np = (tab[e] + 255) >> 8, fu = tab[e] >> 8; base += np * 256; pan += np; tab[32 + e] = pan;
            tab[48 + e] = nr; nf += fu; tab[40 + e] = nf; if (np != fu) { tab[64 + nr] = e; ++nr; } }
        tab[24] = pan; tab[56] = nf; tab[57] = nr; }
    __syncthreads();
}
__device__ __forceinline__ void moe_scatter_pass(Frame& F, int layer) {
    const int lane_ = opq_v((TIDX & 63));
    int* rt = (int*)(F.ws + WS_ROUTE); bf16* AS = (bf16*)(F.ws + WS_AS);
    LAS int* tab = (LAS int*)(F.lds + 16384); LAS float* ca = (LAS float*)F.lds; LAS float* cb = ca + 2048;
    for (int blk = blockIdx.x; blk < 256; blk += F.G) {
        const int b = blk >> 5;
        moe_tables(F, tab, blk);
        ffn_tables(F, layer, b, ca, cb);
        __syncthreads();
#pragma unroll 1
        for (int i = 0; i < 4; ++i) {
            const int tl = F.wave + 16 * i, tok = moe_tok(blk, tl), tok1 = moe_tok(blk, tl + 8);
            f32x4 v0[8], v1[8]; ffn_u_pair(F, b * TPB + CTXL + (tok & 2047), b * TPB + CTXL + (tok1 & 2047), ca, cb, lane_, v0, v1);
#pragma unroll
            for (int s = 0; s < 2; ++s) {
                const int tk = s ? tok1 : tok; const int w = rt[RT_E + tk], e1 = w & 255, e2 = w >> 8;
                const int p1 = tab[8 + e1] + tab[16 + e1] + rt[RT_RANK + 2 * tk], p2 = tab[8 + e2] + tab[16 + e2] + rt[RT_RANK + 2 * tk + 1];
                if (lane_ == 0) { rt[RT_POS + 2 * tk] = p1; rt[RT_POS + 2 * tk + 1] = p2; }
                if (MOE_FP8) {
                    GAS unsigned* q1 = (GAS unsigned*)((unsigned char*)AS + (size_t)p1 * DM) + lane_; GAS unsigned* q2 = (GAS unsigned*)((unsigned char*)AS + (size_t)p2 * DM) + lane_;
#pragma unroll
                    for (int j = 0; j < 8; ++j) { const f32x4 y = s ? v1[j] : v0[j]; const unsigned x = pg8::pk4_fp8(y.x, y.y, y.z, y.w); q1[64 * j] = x; q2[64 * j] = x; }
                    continue; }
                GAS v2u* o1 = (GAS v2u*)(AS + (size_t)p1 * DM) + lane_; GAS v2u* o2 = (GAS v2u*)(AS + (size_t)p2 * DM) + lane_;
#pragma unroll
                for (int j = 0; j < 8; ++j) { f32x4 y = s ? v1[j] : v0[j]; if (EMU_FP8) { y.x = pg8::fp8r(y.x); y.y = pg8::fp8r(y.y); y.z = pg8::fp8r(y.z); y.w = pg8::fp8r(y.w); } v2u x; x.x = pg8::cvt_pk_bf16(y.x, y.y); x.y = pg8::cvt_pk_bf16(y.z, y.w); o1[64 * j] = x; o2[64 * j] = x; }
            }
        }
        for (int e = 0; e < 8; ++e) { const int tot = tab[e], end = (tot + 255) & ~255;
            for (int pr = tot + blk * 8 + F.wave; pr < end; pr += 2048) {
                if (MOE_FP8) { GAS unsigned* o = (GAS unsigned*)((unsigned char*)AS + (size_t)(tab[8 + e] + pr) * DM) + lane_;
#pragma unroll
                    for (int j = 0; j < 8; ++j) o[64 * j] = 0u; continue; }
                GAS v2u* o = (GAS v2u*)(AS + (size_t)(tab[8 + e] + pr) * DM) + lane_;
#pragma unroll
                for (int j = 0; j < 8; ++j) o[64 * j] = (v2u){0u, 0u}; } }
    }
    __syncthreads();
}
__device__ __forceinline__ void final_pass(Frame& F, int layer) {
    const int lane_ = opq_v((TIDX & 63));
    const int* rt = (const int*)(F.ws + WS_ROUTE); const float* rtf = (const float*)(F.ws + WS_ROUTE);
    const bf16* Y = (const bf16*)(F.ws + WS_Y); const float* H = (const float*)(F.ws + WS_H); const float* SL = (const float*)(F.ws + WS_U);
    const float* modl = (const float*)(F.ws + WS_MOD) + (size_t)layer * 9 * MODW;
    LAS int* tab = (LAS int*)(F.lds);
    moe_tables(F, tab, 0);
    for (int tok = F.gw; tok < NBATCH * SEQ; tok += F.NGW) {
        const int b = tok >> 11, t = tok & 2047, r = b * TPB + CTXL + t;
        const int ee = rt[RT_E + tok]; const float g1 = rtf[RT_G + 2 * tok], g2 = rtf[RT_G + 2 * tok + 1];
        const GAS f32x4* xr = (const GAS f32x4*)(H + (size_t)r * DM) + lane_;
        const GAS f32x4* gt = (const GAS f32x4*)(modl + (size_t)b * MODW + 5 * DM) + lane_;
        f32x4 y[8], v[8];
#pragma unroll
        for (int j = 0; j < 8; ++j) { y[j] = (f32x4){0.f, 0.f, 0.f, 0.f}; v[j] = xr[64 * j]; }
#pragma unroll 1
        for (int s = 0; s < 2; ++s) {
            const int e = s ? (ee >> 8) : (ee & 255), p = rt[RT_POS + 2 * tok + s]; const float g = s ? g2 : g1;
            const int loc = p - tab[8 + e], fu = tab[e] >> 8;
            if (loc < 256 * fu) {
                const GAS v2u* yp = (const GAS v2u*)(Y + (size_t)p * DM) + lane_;
#pragma unroll
                for (int j = 0; j < 8; ++j) { const v2u a = yp[64 * j]; y[j] += (f32x4){bflo(a.x), bfhi(a.x), bflo(a.y), bfhi(a.y)} * g; }
            } else {
                const int rr = tab[48 + e], row = loc - 256 * fu;
#pragma unroll
                for (int ks = 0; ks < 4; ++ks) { const GAS f32x4* sp = (const GAS f32x4*)(SL + ((size_t)(ks * 8 + rr) * 256 + row) * DM) + lane_;
#pragma unroll
                    for (int j = 0; j < 8; ++j) y[j] += sp[64 * j] * g; }
            }
        }
        float ss = 0.f;
#pragma unroll
        for (int j = 0; j < 8; ++j) { v[j] = v[j] + gt[64 * j] * y[j]; ss += (v[j].x * v[j].x + v[j].y * v[j].y) + (v[j].z * v[j].z + v[j].w * v[j].w); }
        const float rstd = 1.0f / sqrtf(wave_sum(ss) * (1.0f / DM) + EPSN);
        const GAS f32x4* gf = (const GAS f32x4*)inptr(I_GFIN) + lane_;
        GAS f32x4* op = (GAS f32x4*)(F.out + (size_t)tok * DM) + lane_;
#pragma unroll
        for (int j = 0; j < 8; ++j) op[64 * j] = v[j] * rstd * gf[64 * j];
    }
}

namespace fa {
using bf16x8 = __attribute__((ext_vector_type(8))) short;
using s16x4  = __attribute__((ext_vector_type(4))) short;
using f32x16 = __attribute__((ext_vector_type(16))) float;
using u32x4  = __attribute__((ext_vector_type(4))) unsigned;
constexpr int SHM_V = 64 * 128 * 2;
constexpr float THRN = 8.f;
#define FA_SBAR() __builtin_amdgcn_sched_barrier(0)
__device__ __forceinline__ int kswz(int row, int colB, int pitch) { return row * pitch + (colB ^ ((row & 7) << 4)); }
__device__ __forceinline__ int crow(int r, int hi) { return (r & 3) + 8 * (r >> 2) + 4 * hi; }
__device__ __forceinline__ unsigned cvtpk(float lo, float hi) { unsigned r; asm volatile("v_cvt_pk_bf16_f32 %0, %1, %2" : "=v"(r) : "v"(lo), "v"(hi)); return r; }

__device__ __forceinline__ void partialSM(f32x16& p0, f32x16& p1, float& m_reg, float& mn, float& alpha, const float C, const float thr_raw) {
  float pmax = p0[0];
#pragma unroll
  for (int r = 1; r < 16; ++r) pmax = fmaxf(pmax, p0[r]);
#pragma unroll
  for (int r = 0; r < 16; ++r) pmax = fmaxf(pmax, p1[r]);
  { auto rr = __builtin_amdgcn_permlane32_swap(__float_as_uint(pmax), __float_as_uint(pmax), false, false);
    pmax = fmaxf(__uint_as_float(rr[0]), __uint_as_float(rr[1])); }
  if (__builtin_expect(__all(pmax - m_reg <= thr_raw), 1)) { mn = m_reg; alpha = 1.f; }
  else { mn = fmaxf(m_reg, pmax); alpha = __builtin_amdgcn_exp2f((m_reg - mn) * C); m_reg = mn; }
  const float mnC = -mn * C;
#pragma unroll
  for (int r = 0; r < 16; ++r) p0[r] = fmaf(p0[r], C, mnC);
#pragma unroll
  for (int r = 0; r < 16; ++r) p1[r] = fmaf(p1[r], C, mnC);
#pragma unroll
  for (int r = 0; r < 16; ++r) p0[r] = __builtin_amdgcn_exp2f(p0[r]);
}
__device__ __forceinline__ void finishSM(f32x16& p0, f32x16& p1, float alpha, float& l_reg, bf16x8& pa0, bf16x8& pa1, bf16x8& pa2, bf16x8& pa3) {
#pragma unroll
  for (int r = 0; r < 16; ++r) p1[r] = __builtin_amdgcn_exp2f(p1[r]);
  float ps = 0;
#pragma unroll
  for (int r = 0; r < 16; ++r) ps += p0[r];
#pragma unroll
  for (int r = 0; r < 16; ++r) ps += p1[r];
  { auto rr = __builtin_amdgcn_permlane32_swap(__float_as_uint(ps), __float_as_uint(ps), false, false);
    ps = __uint_as_float(rr[0]) + __uint_as_float(rr[1]); }
  l_reg = l_reg * alpha + ps;
#define FA_PK4(P, BASE, OUT) do { unsigned a0 = cvtpk(P[BASE + 0], P[BASE + 1]), a1 = cvtpk(P[BASE + 2], P[BASE + 3]);   \
    unsigned b0 = cvtpk(P[BASE + 4], P[BASE + 5]), b1 = cvtpk(P[BASE + 6], P[BASE + 7]);                              \
    auto r0 = __builtin_amdgcn_permlane32_swap(a0, b0, false, false); auto r1 = __builtin_amdgcn_permlane32_swap(a1, b1, false, false); \
    u32x4 w = {r0[0], r1[0], r0[1], r1[1]}; OUT = __builtin_bit_cast(bf16x8, w); } while (0)
  FA_PK4(p0, 0, pa0); FA_PK4(p0, 8, pa1); FA_PK4(p1, 0, pa2); FA_PK4(p1, 8, pa3);
#undef FA_PK4
}
template <int DK>
__device__ __forceinline__ void qkt(f32x16& p0, f32x16& p1, const LAS unsigned char* Ks, const bf16x8 (&qr)[DK / 16], int r32, int hi) {
  p0 = f32x16{}; p1 = f32x16{};
#pragma unroll
  for (int d0 = 0; d0 < DK / 16; ++d0) { const int cb = (d0 * 16 + hi * 8) * 2;
    const bf16x8 b0 = *(const LAS bf16x8*)(Ks + kswz(r32, cb, DK * 2));
    const bf16x8 b1 = *(const LAS bf16x8*)(Ks + kswz(32 + r32, cb, DK * 2));
    p0 = __builtin_amdgcn_mfma_f32_32x32x16_bf16(b0, qr[d0], p0, 0, 0, 0);
    p1 = __builtin_amdgcn_mfma_f32_32x32x16_bf16(b1, qr[d0], p1, 0, 0, 0); }
}
__device__ __forceinline__ int v_st(int k, int c) { const int kk = (k & ~0xC) | ((k & 4) << 1) | ((k & 8) >> 1); return ((kk >> 3) * 4 + (c >> 5)) * 512 + ((kk & 7) * 32 + (c & 31)) * 2; }
__device__ __forceinline__ int v_rd_base(int lane) { return ((lane & 3) << 3) | (((lane >> 2) & 3) << 6) | (((lane >> 4) & 1) << 5) | (((lane >> 5) & 1) << 8); }
constexpr int v_rd_off(int d0, int ks, int half) { return d0 * 512 + ks * 4096 + half * 2048; }
template <int OFF> __device__ __forceinline__ s16x4 tr_read(int vb) {
  s16x4 r; asm volatile("ds_read_b64_tr_b16 %0, %1 offset:%2" : "=&v"(r) : "v"(vb), "i"(OFF) : "memory"); return r;
}
template <int D0> __device__ __forceinline__ void pv_one(f32x16& od, int vb, bf16x8 pa0, bf16x8 pa1, bf16x8 pa2, bf16x8 pa3) {
  const s16x4 l0 = tr_read<v_rd_off(D0, 0, 0)>(vb), h0 = tr_read<v_rd_off(D0, 0, 1)>(vb), l1 = tr_read<v_rd_off(D0, 1, 0)>(vb), h1 = tr_read<v_rd_off(D0, 1, 1)>(vb);
  const s16x4 l2 = tr_read<v_rd_off(D0, 2, 0)>(vb), h2 = tr_read<v_rd_off(D0, 2, 1)>(vb), l3 = tr_read<v_rd_off(D0, 3, 0)>(vb), h3 = tr_read<v_rd_off(D0, 3, 1)>(vb);
  asm volatile("s_waitcnt lgkmcnt(0)" ::: "memory"); FA_SBAR();
#define FA_PK(L, H) (bf16x8){L[0], L[1], L[2], L[3], H[0], H[1], H[2], H[3]}
  od = __builtin_amdgcn_mfma_f32_32x32x16_bf16(pa0, FA_PK(l0, h0), od, 0, 0, 0);
  od = __builtin_amdgcn_mfma_f32_32x32x16_bf16(pa1, FA_PK(l1, h1), od, 0, 0, 0);
  od = __builtin_amdgcn_mfma_f32_32x32x16_bf16(pa2, FA_PK(l2, h2), od, 0, 0, 0);
  od = __builtin_amdgcn_mfma_f32_32x32x16_bf16(pa3, FA_PK(l3, h3), od, 0, 0, 0);
#undef FA_PK
}
__device__ __forceinline__ void pv_d0(f32x16 (&o)[4], int vb, bf16x8 pa0, bf16x8 pa1, bf16x8 pa2, bf16x8 pa3) {
  pv_one<0>(o[0], vb, pa0, pa1, pa2, pa3); pv_one<1>(o[1], vb, pa0, pa1, pa2, pa3); pv_one<2>(o[2], vb, pa0, pa1, pa2, pa3); pv_one<3>(o[3], vb, pa0, pa1, pa2, pa3);
}

struct TileMap { int k0, lat0, r_lo; bool na;
  __device__ __forceinline__ int row(int j) const { if (!na || j < 4) return k0 + 64 * j; const int g = min(r_lo + j - 4, 31); return lat0 + 64 * g; } };
struct NaLane { int qr, qc, rs, cs; const LAS float* btab; };

__device__ __forceinline__ void na_mask(f32x16& p0, f32x16& p1, int j, const TileMap& tm, const NaLane& nl, int hi) {
  if (j < 4) return;
  const int kr = tm.r_lo + j - 4; const bool rowok = (kr >= nl.rs) && (kr < nl.rs + 8);
  const int b0 = (kr - nl.qr + 7) * 31 + 15 - nl.qc;
#pragma unroll
  for (int r = 0; r < 16; ++r) {
    const int kc0 = crow(r, hi), kc1 = 32 + kc0;
    const bool ok0 = rowok && (kc0 >= nl.cs) && (kc0 < nl.cs + 16), ok1 = rowok && (kc1 >= nl.cs) && (kc1 < nl.cs + 16);
    float bv0 = 0.f, bv1 = 0.f; if (ok0) bv0 = nl.btab[b0 + kc0]; if (ok1) bv1 = nl.btab[b0 + kc1];
    p0[r] = ok0 ? p0[r] + bv0 : -1e30f; p1[r] = ok1 ? p1[r] + bv1 : -1e30f;
  }
}

template <int DK, int SDEPTH, bool NA>
__device__ __forceinline__ void body(const bf16* Qb, int ldq, const bf16* Kp, int ldk, const bf16* Vp, int ldv, const TileMap tm, const int NT, const float scale,
                                     const NaLane nl, LAS unsigned char* lds, f32x16 (&o)[4]) {
  constexpr int KP = DK / 64, SHM_K = 64 * DK * 2, KCH = DK / 8;
  int tid = threadIdx.x; asm volatile("" : "+v"(tid));
  const int wid = tid >> 6, lane = tid & 63, r32 = lane & 31, hi = lane >> 5;
  LAS unsigned char* V_lds = lds; LAS unsigned char* K_lds = lds + 2 * SHM_V;
  LAS float* wsl = (LAS float*)(lds + 2 * SHM_V + 2 * SHM_K) + wid * 64; LAS float* li_l = wsl; LAS float* al_l = wsl + 32;
  const float C = scale * 1.4426950408889634f, thr_raw = THRN / scale;
  float m_reg = -1e30f, l_reg = 0;
#pragma unroll
  for (int d = 0; d < 4; ++d) o[d] = f32x16{};
  bf16x8 qr[DK / 16];
  { const bf16* Qw = Qb + (long)(wid * 32 + r32) * ldq + hi * 8;
#pragma unroll
    for (int d0 = 0; d0 < DK / 16; ++d0) qr[d0] = *(const GAS bf16x8*)(Qw + d0 * 16); }
  const int sr = tid >> 4, sc = (tid & 15) * 8, vst0 = v_st(sr, sc), vst1 = v_st(32 + sr, sc);
  int krow[KP], kcol[KP], kst[KP];
#pragma unroll
  for (int i = 0; i < KP; ++i) { const int c = tid + 512 * i; krow[i] = c / KCH; kcol[i] = (c % KCH) * 8; kst[i] = kswz(krow[i], kcol[i] * 2, DK * 2); }
  const int vb0 = (int)(unsigned)(unsigned long)(V_lds) + v_rd_base(lane);
  struct Slot { bf16x8 vs0, vs1, ks[KP]; } sl[SDEPTH];
#define FA_SLOAD(i, j) do { const int r0_ = tm.row(j); sl[i].vs0 = *(const GAS bf16x8*)(Vp + (long)(r0_ + sr) * ldv + sc); sl[i].vs1 = *(const GAS bf16x8*)(Vp + (long)(r0_ + 32 + sr) * ldv + sc); \
    _Pragma("unroll") for (int q_ = 0; q_ < KP; ++q_) sl[i].ks[q_] = *(const GAS bf16x8*)(Kp + (long)(r0_ + krow[q_]) * ldk + kcol[q_]); } while (0)
#define FA_SWRITE(b, i) do { *(LAS bf16x8*)(V_lds + (b) * SHM_V + vst0) = sl[i].vs0; *(LAS bf16x8*)(V_lds + (b) * SHM_V + vst1) = sl[i].vs1; \
    _Pragma("unroll") for (int q_ = 0; q_ < KP; ++q_) *(LAS bf16x8*)(K_lds + (b) * SHM_K + kst[q_]) = sl[i].ks[q_]; } while (0)
#define FA_SWAIT() do { if constexpr (SDEPTH == 2) asm volatile("s_waitcnt vmcnt(%0)" :: "n"(2 + KP) : "memory"); else asm volatile("s_waitcnt vmcnt(0)" ::: "memory"); } while (0)
#define FA_RESC(a) do { if (__any((a) < 1.f)) { if (hi == 0) al_l[r32] = (a); asm volatile("s_waitcnt lgkmcnt(0)" ::: "memory"); \
    _Pragma("unroll") for (int d = 0; d < 4; ++d) _Pragma("unroll") for (int r = 0; r < 16; ++r) o[d][r] *= al_l[crow(r, hi)]; } } while (0)
#define FA_QKT(P0, P1, buf, j) do { qkt<DK>(P0, P1, K_lds + (buf) * SHM_K, qr, r32, hi); if constexpr (NA) na_mask(P0, P1, j, tm, nl, hi); } while (0)
  f32x16 pA0, pA1, pB0, pB1; float mnA, mnB, alA, alB; bf16x8 pa0, pa1, pa2, pa3;
  constexpr int SE = 0, SO = SDEPTH - 1;
  FA_SLOAD(SE, 0); asm volatile("s_waitcnt vmcnt(0)" ::: "memory"); FA_SWRITE(0, SE); __syncthreads();
  FA_QKT(pA0, pA1, 0, 0); partialSM(pA0, pA1, m_reg, mnA, alA, C, thr_raw);
  FA_SLOAD(SO, 1); if constexpr (SDEPTH == 2) { if (2 < NT) FA_SLOAD(SE, 2); }
  FA_SWAIT(); FA_SWRITE(1, SO); __syncthreads();
  for (int j = 1; j + 1 < NT; j += 2) {
    FA_SBAR(); FA_QKT(pB0, pB1, 1, j);
    finishSM(pA0, pA1, alA, l_reg, pa0, pa1, pa2, pa3); FA_SBAR();
    FA_SLOAD(SO, j + SDEPTH); FA_SBAR();
    pv_d0(o, vb0, pa0, pa1, pa2, pa3); partialSM(pB0, pB1, m_reg, mnB, alB, C, thr_raw);
    __syncthreads(); FA_SWAIT(); FA_SWRITE(0, SE);
    FA_RESC(alB); __syncthreads();
    FA_SBAR(); FA_QKT(pA0, pA1, 0, j + 1);
    finishSM(pB0, pB1, alB, l_reg, pa0, pa1, pa2, pa3); FA_SBAR();
    if (SDEPTH == 1 || j + 3 < NT) FA_SLOAD(SE, j + 1 + SDEPTH); FA_SBAR();
    pv_d0(o, vb0 + SHM_V, pa0, pa1, pa2, pa3); partialSM(pA0, pA1, m_reg, mnA, alA, C, thr_raw);
    __syncthreads(); FA_SWAIT(); FA_SWRITE(1, SO);
    FA_RESC(alA); __syncthreads();
  }
  FA_SBAR(); FA_QKT(pB0, pB1, 1, NT - 1);
  finishSM(pA0, pA1, alA, l_reg, pa0, pa1, pa2, pa3); FA_SBAR();
  pv_d0(o, vb0, pa0, pa1, pa2, pa3); partialSM(pB0, pB1, m_reg, mnB, alB, C, thr_raw);
  __syncthreads(); FA_RESC(alB);
  finishSM(pB0, pB1, alB, l_reg, pa0, pa1, pa2, pa3); FA_SBAR();
  pv_d0(o, vb0 + SHM_V, pa0, pa1, pa2, pa3);
  if (hi == 0) li_l[r32] = l_reg; asm volatile("s_waitcnt lgkmcnt(0)" ::: "memory");
#pragma unroll
  for (int r = 0; r < 16; ++r) { const float rl = __builtin_amdgcn_rcpf(li_l[crow(r, hi)]);
#pragma unroll
    for (int d0 = 0; d0 < 4; ++d0) o[d0][r] *= rl; }
#undef FA_SLOAD
#undef FA_SWRITE
#undef FA_SWAIT
#undef FA_RESC
#undef FA_QKT
}

template <int DK, bool NA>
__device__ __forceinline__ void body_seq(const bf16* Qb, int ldq, const bf16* Kp, int ldk, const bf16* Vp, int ldv, const TileMap tm, const int NT, const float scale,
                                         const NaLane nl, LAS unsigned char* lds, f32x16 (&o)[4]) {
  constexpr int KP = DK / 64, SHM_K = 64 * DK * 2, KCH = DK / 8;
  int tid = threadIdx.x; asm volatile("" : "+v"(tid));
  const int wid = tid >> 6, lane = tid & 63, r32 = lane & 31, hi = lane >> 5;
  LAS unsigned char* V_lds = lds; LAS unsigned char* K_lds = lds + 2 * SHM_V;
  LAS float* wsl = (LAS float*)(lds + 2 * SHM_V + 2 * SHM_K) + wid * 64; LAS float* li_l = wsl; LAS float* al_l = wsl + 32;
  const float C = scale * 1.4426950408889634f, thr_raw = THRN / scale;
  float m_reg = -1e30f, l_reg = 0;
#pragma unroll
  for (int d = 0; d < 4; ++d) o[d] = f32x16{};
  bf16x8 qr[DK / 16];
  { const bf16* Qw = Qb + (long)(wid * 32 + r32) * ldq + hi * 8;
#pragma unroll
    for (int d0 = 0; d0 < DK / 16; ++d0) qr[d0] = *(const GAS bf16x8*)(Qw + d0 * 16); }
  const int sr = tid >> 4, sc = (tid & 15) * 8, vst0 = v_st(sr, sc), vst1 = v_st(32 + sr, sc);
  int krow[KP], kcol[KP], kst[KP];
#pragma unroll
  for (int i = 0; i < KP; ++i) { const int c = tid + 512 * i; krow[i] = c / KCH; kcol[i] = (c % KCH) * 8; kst[i] = kswz(krow[i], kcol[i] * 2, DK * 2); }
  const int vb0 = (int)(unsigned)(unsigned long)(V_lds) + v_rd_base(lane);
  bf16x8 vs0, vs1, ks[KP];
#define FS_SLOAD(j) do { const int r0_ = tm.row(j); vs0 = *(const GAS bf16x8*)(Vp + (long)(r0_ + sr) * ldv + sc); vs1 = *(const GAS bf16x8*)(Vp + (long)(r0_ + 32 + sr) * ldv + sc); \
    _Pragma("unroll") for (int q_ = 0; q_ < KP; ++q_) ks[q_] = *(const GAS bf16x8*)(Kp + (long)(r0_ + krow[q_]) * ldk + kcol[q_]); } while (0)
#define FS_SWRITE(b) do { *(LAS bf16x8*)(V_lds + (b) * SHM_V + vst0) = vs0; *(LAS bf16x8*)(V_lds + (b) * SHM_V + vst1) = vs1; \
    _Pragma("unroll") for (int q_ = 0; q_ < KP; ++q_) *(LAS bf16x8*)(K_lds + (b) * SHM_K + kst[q_]) = ks[q_]; } while (0)
  FS_SLOAD(0); FS_SWRITE(0); __syncthreads();
#pragma unroll 1
  for (int j = 0; j < NT; ++j) {
    const int b = j & 1;
    if (j + 1 < NT) FS_SLOAD(j + 1);
    f32x16 p0, p1; float mn, al; bf16x8 pa0, pa1, pa2, pa3;
    qkt<DK>(p0, p1, K_lds + b * SHM_K, qr, r32, hi);
    if constexpr (NA) na_mask(p0, p1, j, tm, nl, hi);
    partialSM(p0, p1, m_reg, mn, al, C, thr_raw);
    finishSM(p0, p1, al, l_reg, pa0, pa1, pa2, pa3);
    if (__any(al < 1.f)) { if (hi == 0) al_l[r32] = al; asm volatile("s_waitcnt lgkmcnt(0)" ::: "memory");
#pragma unroll
      for (int d = 0; d < 4; ++d)
#pragma unroll
        for (int r = 0; r < 16; ++r) o[d][r] *= al_l[crow(r, hi)]; }
    FA_SBAR();
    pv_d0(o, vb0 + b * SHM_V, pa0, pa1, pa2, pa3);
    if (j + 1 < NT) FS_SWRITE(b ^ 1);
    __syncthreads();
  }
  if (hi == 0) li_l[r32] = l_reg; asm volatile("s_waitcnt lgkmcnt(0)" ::: "memory");
#pragma unroll
  for (int r = 0; r < 16; ++r) { const float rl = __builtin_amdgcn_rcpf(li_l[crow(r, hi)]);
#pragma unroll
    for (int d0 = 0; d0 < 4; ++d0) o[d0][r] *= rl; }
#undef FS_SLOAD
#undef FS_SWRITE
}
}

__device__ __forceinline__ void fa_store(const fa::f32x16 (&o)[4], LAS unsigned char* lds, bf16* Orow0  , bool do_norm, const float* gsub, float post) {
    int tid = threadIdx.x; asm volatile("" : "+v"(tid));
    const int wid = tid >> 6, lane = tid & 63, r32 = lane & 31, hi = lane >> 5;
    LAS float* slab = (LAS float*)(lds + wid * 16384);
    __syncthreads();
#pragma unroll
    for (int r = 0; r < 16; ++r) { const int row = fa::crow(r, hi);
#pragma unroll
        for (int d0 = 0; d0 < 4; ++d0) slab[row * 128 + d0 * 32 + r32] = o[d0][r]; }
    LDS_WAIT();
    const int row = lane >> 1, half = lane & 1;
    const LAS f32x4* src = (const LAS f32x4*)(slab + row * 128 + half * 64);
    f32x4 v[16]; float ss = 0.f;
#pragma unroll
    for (int c = 0; c < 16; ++c) { v[c] = src[c]; ss += (v[c].x * v[c].x + v[c].y * v[c].y) + (v[c].z * v[c].z + v[c].w * v[c].w); }
    float sc = 1.0f;
    if (do_norm) { ss += __shfl_xor(ss, 1); sc = post / sqrtf(ss * (1.0f / 128.0f) + EPSN);
#pragma unroll
        for (int c = 0; c < 16; ++c) v[c] = v[c] * *(const GAS f32x4*)(gsub + half * 64 + 4 * c); }
    GAS v4u* dst = (GAS v4u*)(Orow0 + (size_t)(wid * 32 + row) * DM + half * 64);
#pragma unroll
    for (int c = 0; c < 8; ++c) { const f32x4 a = v[2 * c] * sc, b = v[2 * c + 1] * sc; v4u w; w.x = pk2(a.x, a.y); w.y = pk2(a.z, a.w); w.z = pk2(b.x, b.y); w.w = pk2(b.z, b.w); dst[c] = w; }
    __syncthreads();
}

__device__ __forceinline__ void attn_unit_fa(Frame& F, int layer, int b, bool latent, int qb, int type, int h) {
    unsigned char* ws = F.ws;
    const bf16* QKV = (const bf16*)(ws + WS_QKV); const bf16* QM = (const bf16*)(ws + WS_QM); const bf16* KVM = (const bf16*)(ws + WS_KVM); bf16* O = (bf16*)(ws + WS_O);
    const int q0 = b * TPB + (latent ? CTXL + qb * 256 : 0);
    const int kall0 = b * TPB, ntall = latent ? TPB / 64 : CTXL / 64;
    bf16* orow0 = O + (size_t)q0 * DM + type * 512 + h * 128;
    fa::TileMap tm; tm.k0 = kall0; tm.lat0 = kall0 + CTXL; tm.r_lo = 0; tm.na = false;
    fa::NaLane nl; nl.qr = 0; nl.qc = 0; nl.rs = 0; nl.cs = 0; nl.btab = nullptr;
    fa::f32x16 o[4];
#ifdef FA_ONLY
    type = FA_ONLY; if (FA_ONLY != 4) latent = FA_ONLY != 0 ? latent : false; else { type = 0; latent = true; }
#endif
    if (type == 0 && latent) {
        const int r_lo = min(max(4 * qb - 4, 0), 24), r_hi = min(max(4 * qb + 3 - 4, 0), 24) + 8;
        tm.na = true; tm.r_lo = r_lo; int nt = 4 + (r_hi - r_lo); nt += nt & 1;
        LAS float* bt = (LAS float*)(F.lds + 100 * 1024);
        const float* bsrc = inptr(I_NABIAS) + ((size_t)layer * 4 + h) * 465;
        __syncthreads();
        for (int i = TIDX; i < 465; i += 512) bt[i] = bsrc[i] * (1.0f / SC_NA);
        __syncthreads();
        const int t = qb * 256 + (TIDX >> 6) * 32 + (TIDX & 31);
        nl.qr = t >> 6; nl.qc = t & 63; nl.rs = min(max(nl.qr - 4, 0), 24); nl.cs = min(max(nl.qc - 8, 0), 48); nl.btab = bt;
        fa::body<128, 1, true>(QKV + (size_t)q0 * INCP + C_NAQ + 128 * h, INCP, QKV + C_NAK + 128 * h, INCP, QKV + C_NAV + 128 * h, INCP, tm, nt, SC_NA, nl, F.lds, o);
        fa_store(o, F.lds, orow0, false, nullptr, 1.0f);
    } else if (type == 0 || type == 2) {
        const int qc = (type == 0) ? C_NAQ + 128 * h : C_GQ + 128 * h, kc = (type == 0) ? C_NAK + 128 * h : C_GK + 128 * (h >> 1), vc = (type == 0) ? C_NAV + 128 * h : C_GV + 128 * (h >> 1);
        fa::body<128, 2, false>(QKV + (size_t)q0 * INCP + qc, INCP, QKV + kc, INCP, QKV + vc, INCP, tm, ntall, SC_NA, nl, F.lds, o);
        fa_store(o, F.lds, orow0, false, nullptr, 1.0f);
    } else if (type == 1) {
        fa::body_seq<192, false>(QM + (size_t)q0 * QMW + 192 * h, QMW, KVM + 320 * h, KVW, KVM + 320 * h + 192, KVW, tm, ntall, SC_MLA, nl, F.lds, o);
        fa_store(o, F.lds, orow0, false, nullptr, 1.0f);
    } else {
        const float lam_init = layer == 0 ? 0.2f : 0.35550906759096926f;
        LAS float* lm = (LAS float*)(F.lds + 100 * 1024);
        __syncthreads();
        if (TIDX < 64) { const float a = wave_sum(inptr(I_LQ1)[layer * 64 + TIDX] * inptr(I_LK1)[layer * 64 + TIDX]), c = wave_sum(inptr(I_LQ2)[layer * 64 + TIDX] * inptr(I_LK2)[layer * 64 + TIDX]);
            if (TIDX == 0) lm[0] = expf(a) - expf(c) + lam_init; }
        __syncthreads();
        const float lam = lm[0];
        GAS f32x4* stash = (GAS f32x4*)((float*)(ws + WS_U) + ((size_t)blockIdx.x * 512 + TIDX) * 64);
#pragma unroll 1
        for (int pass = 0; pass < 2; ++pass) {
            fa::body<64, 2, false>(QKV + (size_t)q0 * INCP + C_DQ + 128 * h + 64 * pass, INCP, QKV + C_DK + 128 * h + 64 * pass, INCP, QKV + C_DV + 128 * h, INCP, tm, ntall, SC_DIFF, nl, F.lds, o);
            if (pass == 0) {
#pragma unroll
                for (int d0 = 0; d0 < 4; ++d0)
#pragma unroll
                    for (int r4 = 0; r4 < 4; ++r4) stash[d0 * 4 + r4] = (f32x4){o[d0][4 * r4], o[d0][4 * r4 + 1], o[d0][4 * r4 + 2], o[d0][4 * r4 + 3]};
                __syncthreads();
            }
        }
#pragma unroll
        for (int d0 = 0; d0 < 4; ++d0)
#pragma unroll
            for (int r4 = 0; r4 < 4; ++r4) { const f32x4 s1 = stash[d0 * 4 + r4];
#pragma unroll
                for (int q = 0; q < 4; ++q) o[d0][4 * r4 + q] = s1[q] - lam * o[d0][4 * r4 + q]; }
        fa_store(o, F.lds, orow0, true, inptr(I_GSUB) + layer * 128, 1.0f - lam_init);
    }
}
#ifndef ATTN_Q0
#define ATTN_Q0 0
#endif
#ifndef ATTN_Q1
#define ATTN_Q1 0
#endif
__device__ __forceinline__ void attn_phase_fa(Frame& F, int layer) {
    const int total = 1024 + ((layer == 0) ? 128 : 0);
#pragma unroll 1
    for (int n = blockIdx.x; n < total; n += F.G) {
        int type, h, qb, b; bool latent = n < 1024;
        if (latent) { const int i = n >> 8, k = n & 255, idx = i * 64 + (k >> 2); type = (k + i) & 3; h = idx & 3; qb = (idx >> 2) & 7; b = idx >> 5; }
        else { const int v = n - 1024, hh = v & 15; type = hh >> 2; h = hh & 3; qb = 0; b = v >> 4; }
        attn_unit_fa(F, layer, b, latent, qb, type, h);
        if (ATTN_Q0 + ATTN_Q1 > 0) filler_quota(F, layer == 0 ? ATTN_Q0 : ATTN_Q1);
    }
    __syncthreads();
}

#ifndef REP_GEMM
#define REP_GEMM 1
#endif
#ifndef REP_WIN
#define REP_WIN REP_GEMM
#endif
#ifndef REP_FGU
#define REP_FGU REP_GEMM
#endif
#ifndef REP_PASS
#define REP_PASS 1
#endif
#ifndef WO_WGM
#define WO_WGM 4
#endif
#ifndef REV_DOWN
#define REV_DOWN 1
#endif
#ifndef FD_WGM
#define FD_WGM 4
#endif
#ifndef PROBE_HOTB
#define PROBE_HOTB 0
#endif
#ifndef PROBE_LATE_DENSE
#define PROBE_LATE_DENSE 0
#endif
#ifndef REP_FDN
#define REP_FDN REP_GEMM
#endif
#ifndef REP_MGU
#define REP_MGU REP_GEMM
#endif
#ifndef REP_MDN
#define REP_MDN REP_GEMM
#endif
#ifndef REP_ATTN
#define REP_ATTN 1
#endif
#ifndef REP_P0
#define REP_P0 1
#endif
#ifndef MK_MULTI
#define MK_MULTI 0
#endif
constexpr int PH_PER_LAYER = 11, N_PHASES = 1 + 2 * PH_PER_LAYER + 1;
struct Args { const float* in[31]; float* out; unsigned char* ws; int ph_lo, ph_hi; };
static_assert(sizeof(Args) == 31 * 8 + 8 + 8 + 8, "Args has no padding");

#define IN(k) (lo <= (k) && (k) < hi)
#if MK_MULTI
#define SEAM(k) do { } while (0)
#else
#define SEAM(k) do { if (IN(k) && IN((k) + 1)) xcd_barrier(bar); } while (0)
#endif
__device__ __forceinline__ int opq_s(int v) { asm volatile("" : "+s"(v)); return v; }
template <int layer>
__device__ __forceinline__ void layer_phases(Frame& F, const XcdBarrier& bar, const int lo, const int hi, LAS int* mtab) {
    unsigned char* ws = F.ws; asm volatile("" : "+s"(ws));
        const int pb = 1 + layer * PH_PER_LAYER;
        const float* modl = (const float*)(ws + WS_MOD) + (size_t)layer * 9 * MODW;
#ifndef SKIP_NORM
        if (IN(pb + 0)) for (int rp_ = 0; rp_ < REP_PASS; ++rp_) norm_pass(F, layer, true, layer == 0);
#endif
        SEAM(pb + 0);
        if (IN(pb + 1)) {
            pg8::Gemm g{(const bf16*)(ws + WS_U), (const bf16*)(ws + WS_WIN) + (size_t)layer * INCP * 2048, MT, INCP, 2048, 2048, 2048};
            pg8::StaticOrder S; S.init(MT, INCP, F.G, opq_s((int)blockIdx.x));
            pg8::EpiBf16P E{(bf16*)(ws + WS_QKV), INCP, 0};
            for (int rep_ = 0; rep_ < REP_WIN; ++rep_) { pg8::gemm_phase<pg8::EpiBf16P, pg8::StaticOrder, PG8_ALIGN, PG8_SP2>(F.lds + RING_OFF, g, S, E); if (rep_ + 1 < REP_WIN) __syncthreads(); }
            filler(F, layer * 8 + 0, -1);
        }
        SEAM(pb + 1);
#ifndef SKIP_POST
        if (IN(pb + 2)) post_pass(F, layer);
#endif
        SEAM(pb + 2);
#ifndef SKIP_UP
        if (IN(pb + 3)) {
            { pg8::Gemm g{(const bf16*)(ws + WS_QKV) + C_CQ, (const bf16*)(ws + WS_WQUP) + (size_t)layer * QMW * 384, MT, QMW, opq_s(384), INCP, 384};
              pg8::StaticOrder S; S.init(MT, QMW, F.G, opq_s((int)blockIdx.x));
              pg8::EpiQupRope E{(bf16*)(ws + WS_QM), (const float*)(ws + WS_ROPE)};
              for (int rep_ = 0; rep_ < REP_GEMM; ++rep_) { pg8::gemm_phase<pg8::EpiQupRope, pg8::StaticOrder, PG8_ALIGN, PG8_SP2>(F.lds + RING_OFF, g, S, E); if (rep_ + 1 < REP_GEMM) __syncthreads(); } }
            __syncthreads();
            { pg8::Gemm g{(const bf16*)(ws + WS_QKV) + C_CKV, (const bf16*)(ws + WS_WKVUP) + (size_t)layer * KVW * 256, MT, KVW, opq_s(256), INCP, 256};
              pg8::StaticOrder S; S.init(MT, KVW, F.G, opq_s((int)blockIdx.x));
              pg8::EpiBf16P E{(bf16*)(ws + WS_KVM), KVW, 0};
              for (int rep_ = 0; rep_ < REP_GEMM; ++rep_) { pg8::gemm_phase<pg8::EpiBf16P, pg8::StaticOrder, PG8_ALIGN, PG8_SP2>(F.lds + RING_OFF, g, S, E); if (rep_ + 1 < REP_GEMM) __syncthreads(); } }
            filler(F, layer * 8 + 1, -1);
        }
#endif
        SEAM(pb + 3);
        #ifndef SKIP_ATTN
        if (IN(pb + 5)) {
#pragma unroll
            for (int rep_ = 0; rep_ < REP_ATTN; ++rep_) attn_phase_fa(F, layer);
            filler(F, layer * 8 + 2, -1); }
#endif
        SEAM(pb + 5);
#ifndef SKIP_WOUT
        if (IN(pb + 6)) {
            pg8::Gemm g{(const bf16*)(ws + WS_O), (const bf16*)(ws + WS_WOUT) + (size_t)layer * 2048 * 2048, MT, 2048, 2048, 2048, 2048};
            pg8::EpiResGate E{(float*)(ws + WS_H), modl + 2 * DM, layer == 0 ? inptr(I_X) : nullptr, layer == 0 ? inptr(I_CTX) : nullptr};
            pg8::EpiResGate Ed{(float*)(ws + WS_R2), modl + 2 * DM, nullptr, nullptr}; (void)Ed;
            if constexpr (layer == 0) { pg8::StaticOrder S; S.init(MT, 2048, F.G, opq_s((int)blockIdx.x), WO_WGM); for (int rep_ = 1; rep_ < REP_GEMM; ++rep_) { pg8::gemm_phase<pg8::EpiResGate, pg8::StaticOrder, PG8_ALIGN, PG8_SP2>(F.lds + RING_OFF, g, S, Ed); __syncthreads(); } pg8::gemm_phase<pg8::EpiResGate, pg8::StaticOrder, PG8_ALIGN, PG8_SP2>(F.lds + RING_OFF, g, S, E); }
            else { pg8::LatentOrder S; S.init(NBATCH * SEQ, 2048, F.G, opq_s((int)blockIdx.x), WO_WGM); for (int rep_ = 1; rep_ < REP_GEMM; ++rep_) { pg8::gemm_phase<pg8::EpiResGate, pg8::LatentOrder, PG8_ALIGN, PG8_SP2>(F.lds + RING_OFF, g, S, Ed); __syncthreads(); } pg8::gemm_phase<pg8::EpiResGate, pg8::LatentOrder, PG8_ALIGN, PG8_SP2>(F.lds + RING_OFF, g, S, E); }            filler(F, layer * 8 + 3, -1);
        }
#endif
        SEAM(pb + 6);
        if constexpr (layer == 0) {
#ifndef SKIP_DENSE
            if (IN(pb + 7)) { for (int rp_ = 0; rp_ < REP_PASS; ++rp_) norm_pass(F, layer, false, false); filler(F, layer * 8 + 6, CVQ_FFN_END); }
            SEAM(pb + 7);
            if (IN(pb + 9)) {
                pg8::Gemm g{(const bf16*)(ws + WS_U), (const bf16*)(ws + WS_WGU), MT, 2 * DFF, 2048, 2048, 2048};
                pg8::StaticOrder S; S.init(MT, 2 * DFF, F.G, opq_s((int)blockIdx.x));
                pg8::EpiSwiGLU E{(bf16*)(ws + WS_HM), DFF, 0};
                for (int rep_ = 0; rep_ < REP_FGU; ++rep_) { pg8::gemm_phase<pg8::EpiSwiGLU, pg8::StaticOrder, PG8_ALIGN, PG8_SP2>(F.lds + RING_OFF, g, S, E); if (rep_ + 1 < REP_FGU) __syncthreads(); }                filler(F, layer * 8 + 4, -1);
            }
            SEAM(pb + 9);
            if (IN(pb + 10)) {
                pg8::Gemm g{(const bf16*)(ws + WS_HM), (const bf16*)(ws + WS_WD), MT, 2048, DFF, DFF, DFF, 0, 0, REV_DOWN};
                pg8::StaticOrder S; S.init(MT, 2048, F.G, opq_s((int)blockIdx.x), FD_WGM);
                pg8::EpiResGate E{(float*)(ws + WS_H), modl + 5 * DM, nullptr, nullptr};
                pg8::EpiResGate Ed{(float*)(ws + WS_R1), modl + 5 * DM, nullptr, nullptr}; (void)Ed;
                for (int rep_ = 1; rep_ < REP_FDN; ++rep_) { pg8::gemm_phase<pg8::EpiResGate, pg8::StaticOrder, PG8_ALIGN, PG8_SP2>(F.lds + RING_OFF, g, S, Ed); __syncthreads(); }
                pg8::gemm_phase<pg8::EpiResGate, pg8::StaticOrder, PG8_ALIGN, PG8_SP2>(F.lds + RING_OFF, g, S, E);                filler(F, layer * 8 + 5, -1);
            }
            SEAM(pb + 10);
#endif
        } else {
#ifndef SKIP_MOE
            if (IN(pb + 7)) for (int rp_ = 0; rp_ < REP_PASS; ++rp_) moe_route_pass(F, layer);
            SEAM(pb + 7);
            if (IN(pb + 8)) { for (int rp_ = 0; rp_ < REP_PASS; ++rp_) moe_scatter_pass(F, layer); filler(F, layer * 8 + 6, CVQ_N); }
            SEAM(pb + 8);
            if (IN(pb + 9)) {
#if PROBE_LATE_DENSE
                {
                    pg8::Gemm gd{(const bf16*)(ws + WS_U), (const bf16*)(ws + WS_WGU), MT, 2 * DFF, 2048, 2048, 2048};
                    pg8::StaticOrder Sd; Sd.init(MT, 2 * DFF, F.G, opq_s((int)blockIdx.x));
                    pg8::EpiSwiGLU Ed{(bf16*)(ws + WS_R1), DFF, 0};
                    pg8::gemm_phase<pg8::EpiSwiGLU, pg8::StaticOrder, PG8_ALIGN, PG8_SP2>(F.lds + RING_OFF, gd, Sd, Ed);
                    __syncthreads();
                }
#endif
                moe_tables(F, mtab, 0);
                pg8::Gemm g{(const bf16*)(ws + WS_AS), (const bf16*)(ws + WS_MGU), 0, 2 * DFE, 2048, 2048, 2048, 0, KT_MOE};
                pg8::MoeOrder S; S.init(__builtin_amdgcn_readfirstlane(mtab[24]) * 256, 2 * DFE, F.G, opq_s((int)blockIdx.x));
                S.tab = mtab;
                pg8::EpiSwiGLU E{(bf16*)(ws + WS_HM2), DFE, 2 * DFE / 256, MOE_FP8 ? 1.0f / pg8::MOE_WSCALE : 1.0f};
                for (int rep_ = 0; rep_ < REP_MGU; ++rep_) { pg8::gemm_phase<pg8::EpiSwiGLU, pg8::MoeOrder, PG8_ALIGN, PG8_SP2, (MOE_FP8 != 0)>(F.lds + RING_OFF, g, S, E); if (rep_ + 1 < REP_MGU) __syncthreads(); }
            }
            SEAM(pb + 9);
            if (IN(pb + 10)) {
                moe_tables(F, mtab, 0);
                pg8::Gemm g{(const bf16*)(ws + WS_HM2), (const bf16*)(ws + WS_MD), 0, 2048, DFE, DFE, DFE, KT_MOE, KT_MOE, REV_DOWN};
#define RFL(i) __builtin_amdgcn_readfirstlane(mtab[i])
                { pg8::MoeFullOrder S; S.init(RFL(56) * 256, 2048, F.G, opq_s((int)blockIdx.x));
                  S.tab = mtab;
                  pg8::EpiBf16P E{(bf16*)(ws + WS_Y), 2048, 8, MOE_FP8 ? 1.0f / pg8::MOE_WSCALE : 1.0f};
                  for (int rep_ = 0; rep_ < REP_MDN; ++rep_) { pg8::gemm_phase<pg8::EpiBf16P, pg8::MoeFullOrder, PG8_ALIGN, PG8_SP2, (MOE_FP8 != 0)>(F.lds + RING_OFF, g, S, E); if (rep_ + 1 < REP_MDN) __syncthreads(); } }
                __syncthreads();
                { pg8::Gemm g2{(const bf16*)(ws + WS_HM2), (const bf16*)(ws + WS_MD), 0, 2048, opq_s(1792), DFE, DFE, KT_MOE, KT_MOE, REV_DOWN};
                  pg8::MoeRemOrder S; S.nsub = RFL(57) * 32; S.G = F.G; S.c = opq_s((int)blockIdx.x); S.tab = mtab;
                  pg8::EpiSlab E{(float*)(ws + WS_U), MOE_FP8 ? 1.0f / pg8::MOE_WSCALE : 1.0f};
                  pg8::gemm_phase<pg8::EpiSlab, pg8::MoeRemOrder, PG8_ALIGN, PG8_SP2, (MOE_FP8 != 0)>(F.lds + RING_OFF, g2, S, E); }
#undef RFL
            }
            SEAM(pb + 10);
#endif
        }
}

__global__ void __launch_bounds__(NWAVES * 64, 2) fwd_kernel(Args args) {
    extern __shared__ __attribute__((aligned(16))) unsigned char lds[];
    Frame F;
    F.lds = (LAS unsigned char*)lds;
    F.MISC = (volatile LAS unsigned*)(F.lds + MISC_OFF);
    F.wave = __builtin_amdgcn_readfirstlane((int)threadIdx.x >> 6);
    F.G = gridDim.x; F.gw = blockIdx.x * NWAVES + F.wave; F.NGW = F.G * NWAVES;
    F.out = args.out; F.ws = args.ws; F.ctl = (gu32*)(args.ws + WS_CTL);
    unsigned char* ws = args.ws;
    for (int u = TIDX; u < (LDS_BYTES - LDSCTL_OFF) / 4; u += NWAVES * 64) ((LAS unsigned*)(F.lds + LDSCTL_OFF))[u] = 0u;
    __syncthreads();
    XcdBarrier bar; bar.bar = (unsigned*)(F.ctl + CW_BAR); bar.x = 0; bar.st = nullptr;
#if !MK_MULTI
    bar = xcd_barrier_post((unsigned*)(F.ctl + CW_BAR), F.MISC + 8);
#endif
    const int lo = args.ph_lo, hi = args.ph_hi;
    LAS int* mtab = (LAS int*)(F.lds + LDSCTL_OFF + 1024);

    #ifndef SKIP_P0
    if (IN(0)) {
#pragma unroll
        for (int rep_ = 0; rep_ < REP_P0; ++rep_) p0_prologue(F); }
#endif
    SEAM(0);

    layer_phases<0>(F, bar, lo, hi, mtab);
    layer_phases<1>(F, bar, lo, hi, mtab);
#ifndef SKIP_FINAL
    if (IN(N_PHASES - 1)) for (int rp_ = 0; rp_ < REP_PASS; ++rp_) final_pass(F, 1);
#endif
#undef IN
#undef SEAM
}

extern "C" void kernel_launch(void* const* d_in, const int* in_sizes, int n_in, void* d_out, int out_size, void* d_ws, size_t ws_size, hipStream_t stream) {
    static int grid = 0;
    if (grid == 0) {
        if (n_in != 31 || in_sizes[0] != NBATCH * SEQ * DM || out_size != NBATCH * SEQ * DM || ws_size < WS_END) {
            fprintf(stderr, "kernel_launch: unexpected shapes (n_in %d, in0 %d, out %d, ws %zu, need %zu); nothing launched\n", n_in, n_in > 0 ? in_sizes[0] : -1, out_size, ws_size, (size_t)WS_END); grid = -1; return; }
        int dev = 0, cus = 0, per_cu = 0;
        if (hipGetDevice(&dev) != hipSuccess || hipDeviceGetAttribute(&cus, hipDeviceAttributeMultiprocessorCount, dev) != hipSuccess) { fprintf(stderr, "kernel_launch: device query failed\n"); grid = -1; return; }
        if (hipFuncSetAttribute((const void*)fwd_kernel, hipFuncAttributeMaxDynamicSharedMemorySize, LDS_BYTES) != hipSuccess) { fprintf(stderr, "kernel_launch: hipFuncSetAttribute failed\n"); grid = -1; return; }
        if (hipOccupancyMaxActiveBlocksPerMultiprocessor(&per_cu, (const void*)fwd_kernel, NWAVES * 64, LDS_BYTES) != hipSuccess || per_cu < 1)
            fprintf(stderr, "kernel_launch: note: occupancy query reports %d workgroups per CU\n", per_cu);
        (void)hipGetLastError();
        grid = cus < 256 ? cus : 256;
    }
    if (grid < 0) return;
    if (hipMemsetAsync((char*)d_ws + WS_CTL, 0, CTL_ZERO_BYTES, stream) != hipSuccess) { fprintf(stderr, "kernel_launch: memset failed\n"); return; }
    Args a{};
    for (int i = 0; i < 31; ++i) a.in[i] = (const float*)d_in[i];
    a.out = (float*)d_out; a.ws = (unsigned char*)d_ws;
#if MK_MULTI
    for (int p = 0; p < N_PHASES; ++p) {
        if (p == 1 + 8) continue;
        a.ph_lo = p; a.ph_hi = p + 1;
        hipLaunchKernelGGL(fwd_kernel, dim3(grid), dim3(NWAVES * 64), LDS_BYTES, stream, a);
    }
#else
    a.ph_lo = 0; a.ph_hi = N_PHASES;
    hipLaunchKernelGGL(fwd_kernel, dim3(grid), dim3(NWAVES * 64), LDS_BYTES, stream, a);
#endif
    const hipError_t le = hipPeekAtLastError();
    if (le != hipSuccess) fprintf(stderr, "kernel_launch: launch failed: %s\n", hipGetErrorName(le));
}
```

```cpp
#include <hip/hip_runtime.h>
#include <cstdio>
#include <cstdint>
namespace pg8 {
#define PG8_LAS __attribute__((address_space(3)))
typedef unsigned short bf16_t;
typedef short bf16x8 __attribute__((ext_vector_type(8)));
typedef float f32x4 __attribute__((ext_vector_type(4)));
typedef unsigned u32x4 __attribute__((ext_vector_type(4)));
typedef int v8i32 __attribute__((ext_vector_type(8)));
constexpr int BM = 256, BK = 64, HALF = 128, HTB = HALF * BK * 2  , STAGE_BYTES = 8 * HTB, NXCD = 8, WGM = 8;

__host__ __device__ __forceinline__ int lds_byte(int r, int c) { const int st = (r >> 4) * 2 + (c >> 5), rr = r & 15, cc = c & 31, ob = rr * 64 + cc * 2; return st * 1024 + (ob ^ (((ob >> 9) & 1) << 5)); }
__host__ __device__ __forceinline__ void stage_rc(int b, int& R, int& C) { const int st = b / 1024, sb = b % 1024, swz = sb ^ (((sb >> 9) & 1) << 5); R = (st >> 1) * 16 + swz / 64; C = (st & 1) * 32 + (swz % 64) / 2; }
__host__ __device__ __forceinline__ int perm32(int rho) { const int n = rho >> 4, i = rho & 15; return 8 * (i >> 2) + 4 * n + (i & 3); }

struct Unit { int pm, pn, ko = 0, aux = 0; };
struct Gemm { const bf16_t* A; const bf16_t* Bt; int M, N, K, lda, ldb; int ktA = 0, ktB = 0, rev = 0; };

struct StaticOrder {
    static constexpr bool NTB = false;
    int nM, nN, nwg, G, c, wgm;
    __host__ __device__ void init(int M, int N, int G_, int c_, int wgm_ = WGM) { nM = M / BM; nN = N / BM; nwg = nM * nN; G = G_; c = c_; wgm = wgm_; }
    __host__ __device__ bool next(int i, Unit& u) const {
        const long L = (long)i * G + c; if (L >= nwg) return false;
        int wgid = (int)L; { const int q = nwg / NXCD, r = nwg % NXCD, xcd = wgid % NXCD, off = wgid / NXCD; wgid = (xcd < r ? xcd * (q + 1) : r * (q + 1) + (xcd - r) * q) + off; }
        const int nig = wgm * nN, gid = wgid / nig, fm = gid * wgm, gsz = (nM - fm) < wgm ? (nM - fm) : wgm;
        u.pm = fm + ((wgid % nig) % gsz); u.pn = (wgid % nig) / gsz; return true;
    }
    __device__ __forceinline__ void a_ready(const Unit&) const {}
    __device__ __forceinline__ void done(const Unit&) const {}
};

__device__ __forceinline__ unsigned cvt_pk_bf16(float lo, float hi) { unsigned r; asm volatile("v_cvt_pk_bf16_f32 %0, %1, %2" : "=v"(r) : "v"(lo), "v"(hi)); return r; }
typedef float f32x2 __attribute__((ext_vector_type(2)));
__device__ __forceinline__ void mfma_e4m3(f32x4& acc, const v8i32& a, const v8i32& b, int one) {
    asm volatile("v_mfma_scale_f32_16x16x128_f8f6f4 %0, %1, %2, %0, %3, %3 op_sel_hi:[0,0,0]" : "+v"(acc) : "v"(a), "v"(b), "v"(one));
}
template <class Epi, class Sched, bool ALIGN_EPI = false, bool SP2 = false, bool FP8 = false>
__device__ __forceinline__ void gemm_phase(PG8_LAS unsigned char* lds, const Gemm g, const Sched& S, const Epi& E) {
    int tid_ = threadIdx.x; asm volatile("" : "+v"(tid_));
    const int tid = tid_, wid = __builtin_amdgcn_readfirstlane(tid >> 6), lane = tid & 63, wr = wid >> 2, wc = wid & 3, fr = lane & 15, fq = lane >> 4;
    constexpr int ES = FP8 ? 1 : 2, KE = FP8 ? 128 : 64;
    const int K = g.K, nt = K / KE;
    unsigned voffA[2], voffB[2];
#pragma unroll
    for (int i = 0; i < 2; ++i) { int R, C; stage_rc(tid * 16 + i * 8192, R, C); const int Rb = Epi::PERM ? ((R & ~31) + perm32(R & 31)) : R;
        voffA[i] = (unsigned)(R * (g.ktA ? 128 : g.lda * ES) + C * 2); voffB[i] = (unsigned)(Rb * (g.ktB ? 128 : g.ldb * ES) + C * 2); }
    const long kabsA = g.ktA ? 32768 : (BK * 2), kabsB = g.ktB ? 32768 : (BK * 2);
    const long kstepA = g.rev ? -kabsA : kabsA, kstepB = g.rev ? -kabsB : kabsB;
    const long kfirstA = g.rev ? (long)(nt - 1) * kabsA : 0, kfirstB = g.rev ? (long)(nt - 1) * kabsB : 0;
    const size_t hstepA = g.ktA ? (size_t)16384 : (size_t)HALF * g.lda * ES, hstepB = g.ktB ? (size_t)16384 : (size_t)HALF * g.ldb * ES;
    const size_t tstepA = (size_t)BM * g.lda * ES, tstepB = (size_t)BM * g.ldb * ES;
    const unsigned ldsw = (unsigned)wid * 1024u;
    const int fcol = FP8 ? ((fq >> 1) * 32 + (fq & 1) * 16) : fq * 8;
    const int aoff = lds_byte(wr * 64 + fr, fcol), boff = lds_byte(wc * 32 + fr, fcol);
#define PG8_SA(b, h) (((b) * 2 + (h)) * HTB)
#define PG8_SB(b, h) ((4 + (b) * 2 + (h)) * HTB)
#define PG8_STAGE(bufoff, gbase, voff) do { _Pragma("unroll") for (int _i = 0; _i < 2; ++_i) { \
        if constexpr (FP8) { unsigned vo_ = (voff)[_i]; asm volatile("" : "+v"(vo_));   \
            __builtin_amdgcn_global_load_lds((const unsigned*)((const char*)(gbase) + vo_), (PG8_LAS unsigned*)(lds + (bufoff) + ldsw + _i * 8192), 16, 0, 0); } else \
        if constexpr (Sched::NTB && (bufoff) >= 4 * HTB) __builtin_amdgcn_global_load_lds((const unsigned*)((const char*)(gbase) + (voff)[_i]), (PG8_LAS unsigned*)(lds + (bufoff) + ldsw + _i * 8192), 16, 0, 2); \
        else __builtin_amdgcn_global_load_lds((const unsigned*)((const char*)(gbase) + (voff)[_i]), (PG8_LAS unsigned*)(lds + (bufoff) + ldsw + _i * 8192), 16, 0, 0); } } while (0)
#define PG8_LDA(dst, b, h) do { if constexpr (FP8) { _Pragma("unroll") for (int m = 0; m < 4; ++m) { const PG8_LAS unsigned char* p_ = lds + PG8_SA(b, h) + aoff + m * 2048; \
        const u32x4 lo_ = *(const PG8_LAS u32x4*)p_, hi_ = *(const PG8_LAS u32x4*)(p_ + 16); dst##8[m] = (v8i32){(int)lo_.x, (int)lo_.y, (int)lo_.z, (int)lo_.w, (int)hi_.x, (int)hi_.y, (int)hi_.z, (int)hi_.w}; } } \
    else { _Pragma("unroll") for (int m = 0; m < 4; ++m) _Pragma("unroll") for (int k = 0; k < 2; ++k) dst[m][k] = *(const PG8_LAS bf16x8*)(lds + PG8_SA(b, h) + aoff + m * 2048 + k * 1024); } } while (0)
#define PG8_LDB(dst, b, h) do { if constexpr (FP8) { _Pragma("unroll") for (int n = 0; n < 2; ++n) { const PG8_LAS unsigned char* p_ = lds + PG8_SB(b, h) + boff + n * 2048; \
        const u32x4 lo_ = *(const PG8_LAS u32x4*)p_, hi_ = *(const PG8_LAS u32x4*)(p_ + 16); dst##8[n] = (v8i32){(int)lo_.x, (int)lo_.y, (int)lo_.z, (int)lo_.w, (int)hi_.x, (int)hi_.y, (int)hi_.z, (int)hi_.w}; } } \
    else { _Pragma("unroll") for (int n = 0; n < 2; ++n) _Pragma("unroll") for (int k = 0; k < 2; ++k) dst[n][k] = *(const PG8_LAS bf16x8*)(lds + PG8_SB(b, h) + boff + n * 2048 + k * 1024); } } while (0)
#define PG8_MMA(ai, bj, At, Bt) do { __builtin_amdgcn_s_setprio(1); if constexpr (FP8) { _Pragma("unroll") for (int m = 0; m < 4; ++m) _Pragma("unroll") for (int n = 0; n < 2; ++n) \
        mfma_e4m3(acc[ai][bj][m][n], Bt##8[n], At##8[m], one8); } \
    else { _Pragma("unroll") for (int m = 0; m < 4; ++m) _Pragma("unroll") for (int n = 0; n < 2; ++n) _Pragma("unroll") for (int k = 0; k < 2; ++k) \
        acc[ai][bj][m][n] = __builtin_amdgcn_mfma_f32_16x16x32_bf16(Bt[n][k], At[m][k], acc[ai][bj][m][n], 0, 0, 0); } __builtin_amdgcn_s_setprio(0); } while (0)
#define PG8_WAIT_V(n) asm volatile("s_waitcnt vmcnt(" #n ")" ::: "memory")
#define PG8_WAIT_L(n) asm volatile("s_waitcnt lgkmcnt(" #n ")" ::: "memory")
#define PG8_BAR __builtin_amdgcn_s_barrier()
#define PG8_SCHED __builtin_amdgcn_sched_barrier(0)
    Unit cur, nxt; int ui = 0;
    if (!S.next(0, cur)) return;
    f32x4 acc[2][2][4][2];
#pragma unroll
    for (int a = 0; a < 2; ++a)
#pragma unroll
        for (int b = 0; b < 2; ++b)
#pragma unroll
            for (int m = 0; m < 4; ++m)
#pragma unroll
                for (int n = 0; n < 2; ++n) acc[a][b][m][n] = (f32x4){0.f, 0.f, 0.f, 0.f};
    int one8 = 0x7F7F7F7F; asm volatile("" : "+v"(one8));
    bf16x8 At[4][2], B0[2][2], B1[2][2]; v8i32 At8[4], B08[2], B18[2];
    const char* cA = (const char*)g.A + (size_t)cur.pm * tstepA + (g.ktA ? (size_t)(cur.ko / KE) * 32768 : (size_t)cur.ko * ES) + kfirstA; const char* cB = (const char*)g.Bt + (size_t)cur.pn * tstepB + (g.ktB ? (size_t)(cur.ko / KE) * 32768 : (size_t)cur.ko * ES) + kfirstB;
    S.a_ready(cur);
    if constexpr (SP2) {
        PG8_STAGE(PG8_SB(0, 0), cB, voffB); PG8_STAGE(PG8_SB(0, 1), cB + hstepB, voffB); PG8_STAGE(PG8_SA(0, 0), cA, voffA); PG8_STAGE(PG8_SA(0, 1), cA + hstepA, voffA);
        if (wr == 1) PG8_BAR;
        PG8_WAIT_V(2); PG8_BAR;
        PG8_STAGE(PG8_SB(1, 0), cB + kstepB, voffB); PG8_STAGE(PG8_SA(1, 0), cA + kstepA, voffA); PG8_STAGE(PG8_SB(1, 1), cB + hstepB + kstepB, voffB);
        PG8_WAIT_V(6); PG8_BAR;
    } else {
        PG8_STAGE(PG8_SB(0, 0), cB, voffB); PG8_STAGE(PG8_SA(0, 0), cA, voffA); PG8_STAGE(PG8_SB(0, 1), cB + hstepB, voffB); PG8_STAGE(PG8_SA(0, 1), cA + hstepA, voffA);
        if (wr == 1) PG8_BAR;
        PG8_WAIT_V(4); PG8_BAR;
        PG8_STAGE(PG8_SB(1, 0), cB + kstepB, voffB); PG8_STAGE(PG8_SA(1, 0), cA + kstepA, voffA); PG8_STAGE(PG8_SB(1, 1), cB + hstepB + kstepB, voffB);
        PG8_WAIT_V(6); PG8_BAR;
    }
    for (;;) {
        const bool has_next = S.next(ui + 1, nxt);
        const char* nA = has_next ? (const char*)g.A + (size_t)nxt.pm * tstepA + (g.ktA ? (size_t)(nxt.ko / KE) * 32768 : (size_t)nxt.ko * ES) + kfirstA : cA; const char* nB = has_next ? (const char*)g.Bt + (size_t)nxt.pn * tstepB + (g.ktB ? (size_t)(nxt.ko / KE) * 32768 : (size_t)nxt.ko * ES) + kfirstB : cB;
        for (int t = 0; t < nt; t += 2) {
            const bool last = (t == nt - 2);
            const char* a1 = cA + (long)(t + 1) * kstepA;
            const char* a2 = last ? nA : cA + (long)(t + 2) * kstepA; const char* b2 = last ? nB : cB + (long)(t + 2) * kstepB;
            const char* a3 = a2 + kstepA; const char* b3 = b2 + kstepB;
            if (last && has_next) S.a_ready(nxt);
            if constexpr (SP2) {
            PG8_LDB(B0, 0, 0); PG8_LDB(B1, 0, 1); PG8_SCHED; PG8_LDA(At, 0, 0); PG8_STAGE(PG8_SA(1, 1), a1 + hstepA, voffA);
            PG8_WAIT_V(8); PG8_WAIT_L(0); PG8_BAR; PG8_MMA(0, 0, At, B0); PG8_MMA(0, 1, At, B1); PG8_BAR; PG8_SCHED;
            PG8_LDA(At, 0, 1); PG8_STAGE(PG8_SB(0, 0), b2, voffB); PG8_STAGE(PG8_SB(0, 1), b2 + hstepB, voffB); PG8_STAGE(PG8_SA(0, 0), a2, voffA);
            PG8_WAIT_V(8); PG8_WAIT_L(0); PG8_BAR; PG8_MMA(1, 0, At, B0); PG8_MMA(1, 1, At, B1); PG8_BAR; PG8_SCHED;
            PG8_LDB(B0, 1, 0); PG8_LDB(B1, 1, 1); PG8_SCHED; PG8_LDA(At, 1, 0); PG8_STAGE(PG8_SA(0, 1), a2 + hstepA, voffA);
            PG8_WAIT_V(8); PG8_WAIT_L(0); PG8_BAR; PG8_MMA(0, 0, At, B0); PG8_MMA(0, 1, At, B1); PG8_BAR; PG8_SCHED;
            PG8_LDA(At, 1, 1); PG8_STAGE(PG8_SB(1, 0), b3, voffB); PG8_STAGE(PG8_SB(1, 1), b3 + hstepB, voffB); PG8_STAGE(PG8_SA(1, 0), a3, voffA);
            PG8_WAIT_V(8); PG8_WAIT_L(0); PG8_BAR; PG8_MMA(1, 0, At, B0); PG8_MMA(1, 1, At, B1); PG8_BAR; PG8_SCHED;
            } else {
            PG8_LDB(B0, 0, 0); PG8_SCHED; PG8_LDA(At, 0, 0); PG8_STAGE(PG8_SA(1, 1), a1 + hstepA, voffA);
            PG8_WAIT_L(8); PG8_BAR; PG8_WAIT_L(0); PG8_MMA(0, 0, At, B0); PG8_BAR; PG8_SCHED;
            PG8_LDB(B1, 0, 1); PG8_STAGE(PG8_SB(0, 0), b2, voffB);
            PG8_BAR; PG8_WAIT_L(0); PG8_MMA(0, 1, At, B1); PG8_BAR;
            PG8_LDA(At, 0, 1); PG8_STAGE(PG8_SA(0, 0), a2, voffA);
            PG8_BAR; PG8_WAIT_L(0); PG8_MMA(1, 0, At, B0); PG8_BAR; PG8_SCHED;
            PG8_STAGE(PG8_SB(0, 1), b2 + hstepB, voffB);
            PG8_WAIT_V(6); PG8_BAR; PG8_MMA(1, 1, At, B1); PG8_BAR;
            PG8_LDB(B0, 1, 0); PG8_SCHED; PG8_LDA(At, 1, 0); PG8_STAGE(PG8_SA(0, 1), a2 + hstepA, voffA);
            PG8_WAIT_L(8); PG8_BAR; PG8_WAIT_L(0); PG8_MMA(0, 0, At, B0); PG8_BAR; PG8_SCHED;
            PG8_LDB(B1, 1, 1); PG8_STAGE(PG8_SB(1, 0), b3, voffB);
            PG8_BAR; PG8_WAIT_L(0); PG8_MMA(0, 1, At, B1); PG8_BAR;
            PG8_LDA(At, 1, 1); PG8_STAGE(PG8_SA(1, 0), a3, voffA);
            PG8_BAR; PG8_WAIT_L(0); PG8_MMA(1, 0, At, B0); PG8_BAR; PG8_SCHED;
            PG8_STAGE(PG8_SB(1, 1), b3 + hstepB, voffB);
            PG8_WAIT_V(6); PG8_BAR; PG8_MMA(1, 1, At, B1); PG8_BAR;
            }
        }
        if constexpr (FP8) {
#define PG8_ACC16(a) "+v"(acc[a][0][0][0]), "+v"(acc[a][0][0][1]), "+v"(acc[a][0][1][0]), "+v"(acc[a][0][1][1]), "+v"(acc[a][0][2][0]), "+v"(acc[a][0][2][1]), "+v"(acc[a][0][3][0]), "+v"(acc[a][0][3][1]), \
                     "+v"(acc[a][1][0][0]), "+v"(acc[a][1][0][1]), "+v"(acc[a][1][1][0]), "+v"(acc[a][1][1][1]), "+v"(acc[a][1][2][0]), "+v"(acc[a][1][2][1]), "+v"(acc[a][1][3][0]), "+v"(acc[a][1][3][1])
            asm volatile("s_nop 15\n\ts_nop 15" : PG8_ACC16(0));
            asm volatile("s_nop 0" : PG8_ACC16(1));
#undef PG8_ACC16
        }
        if constexpr (ALIGN_EPI) { if (wr == 0) PG8_BAR; }
        if constexpr (!Epi::AFTER_DRAIN) { E(acc, cur, wr, wc, fr, fq); S.done(cur); }
        if (!has_next) break;
#pragma unroll
        for (int a = 0; a < 2; ++a)
#pragma unroll
            for (int b = 0; b < 2; ++b)
#pragma unroll
                for (int m = 0; m < 4; ++m)
#pragma unroll
                    for (int n = 0; n < 2; ++n) acc[a][b][m][n] = (f32x4){0.f, 0.f, 0.f, 0.f};
        cur = nxt; cA = nA; cB = nB; ++ui;
        if constexpr (ALIGN_EPI) { if (wr == 1) PG8_BAR; }
    }
    PG8_WAIT_V(0);
    if constexpr (!ALIGN_EPI) { if (wr == 0) PG8_BAR; }
    PG8_BAR;
    if constexpr (Epi::AFTER_DRAIN) { E.fused(acc, cur, wr, wc, fr, fq, lds, wid, lane); S.done(cur); }
#undef PG8_SA
#undef PG8_SB
#undef PG8_STAGE
#undef PG8_LDA
#undef PG8_LDB
#undef PG8_MMA
#undef PG8_WAIT_V
#undef PG8_WAIT_L
#undef PG8_BAR
#undef PG8_SCHED
}
}

#define GAS __attribute__((address_space(1)))
#define LAS __attribute__((address_space(3)))
typedef unsigned short bf16;
typedef unsigned v4u __attribute__((ext_vector_type(4)));
typedef unsigned v2u __attribute__((ext_vector_type(2)));
typedef float f32x4 __attribute__((ext_vector_type(4)));
typedef __bf16 bf2_t __attribute__((ext_vector_type(2)));
typedef GAS unsigned gu32;
#define RLX_AGENT __ATOMIC_RELAXED, __HIP_MEMORY_SCOPE_AGENT
#define LDS_WAIT() asm volatile("s_waitcnt lgkmcnt(0)" ::: "memory")
#define VM_WAIT() asm volatile("s_waitcnt vmcnt(0)" ::: "memory")
__device__ __forceinline__ unsigned f2bf(float f) { unsigned u = __builtin_bit_cast(unsigned, f); return (u + 0x7fffu + ((u >> 16) & 1u)) >> 16; }
__device__ __forceinline__ unsigned pk2(float lo, float hi) { return f2bf(lo) | (f2bf(hi) << 16); }
__device__ __forceinline__ float bflo(unsigned u) { return __builtin_bit_cast(float, u << 16); }
__device__ __forceinline__ float bfhi(unsigned u) { return __builtin_bit_cast(float, u & 0xffff0000u); }
__device__ __forceinline__ float bf1(bf16 h) { return __builtin_bit_cast(float, ((unsigned)h) << 16); }
__device__ __forceinline__ float dot2bf(unsigned a, unsigned b, float c) { return __builtin_amdgcn_fdot2_f32_bf16(__builtin_bit_cast(bf2_t, a), __builtin_bit_cast(bf2_t, b), c, false); }
__device__ __forceinline__ float wave_sum(float v) {
#pragma unroll
    for (int o = 1; o < 64; o <<= 1) v += __shfl_xor(v, o);
    return v;
}

#define XB_TMO      128
#define XB_XCNT(j)  (256  + 64 * (j))
#define XB_XSUB(j)  (1280 + 64 * (j))
#define XB_XGEN(j)  (2304 + 64 * (j))
#define XB_TOP      3328
#define XB_TOPGEN   3392
#define XCD_BAR_WORDS 3456
#define XB_SPIN_CAP (1u << 18)

__device__ __forceinline__ unsigned xb_ld(unsigned* p)              { return __hip_atomic_load(p, __ATOMIC_RELAXED, __HIP_MEMORY_SCOPE_AGENT); }
__device__ __forceinline__ unsigned xb_add(unsigned* p, unsigned v) { return __hip_atomic_fetch_add(p, v, __ATOMIC_RELAXED, __HIP_MEMORY_SCOPE_AGENT); }
__device__ __forceinline__ unsigned xb_xcc_id() { return (unsigned)__builtin_amdgcn_s_getreg((3 << 11) | 20) & 0xFu; }
#define XB_SPIN(cond, bar) do { unsigned _sp = 0; while (cond) { __builtin_amdgcn_s_sleep(1); \
    if ((++_sp & 255u) == 0u) { if (xb_ld(&(bar)[XB_TMO])) break; if (_sp > XB_SPIN_CAP) { atomicAdd(&(bar)[XB_TMO], 1u); break; } } } } while (0)

struct XcdBarrier {
    unsigned* bar; unsigned x;
    volatile LAS unsigned* st;
};

__device__ __forceinline__ XcdBarrier xcd_barrier_post(unsigned* bar, volatile LAS unsigned* st) {
    XcdBarrier b; b.bar = bar; b.x = xb_xcc_id(); b.st = st;
    if (threadIdx.x == 0) (void)xb_add(&bar[XB_XCNT(b.x)], 1u);
    return b;
}
__device__ __forceinline__ void xcd_barrier_complete(unsigned* bar, unsigned x, unsigned& nloc, unsigned& nx) {
    const unsigned G = gridDim.x * gridDim.y * gridDim.z;
    unsigned sum, cnt, mine, sp = 0u;
    for (;;) {
        sum = 0u; cnt = 0u; mine = 0u;
#pragma unroll
        for (unsigned j = 0; j < 16; ++j) { const unsigned c = xb_ld(&bar[XB_XCNT(j)]); sum += c; cnt += (c > 0u) ? 1u : 0u; mine = (j == x) ? c : mine; }
        if (sum == G) break;
        __builtin_amdgcn_s_sleep(1);
        if ((++sp & 255u) == 0u) { if (xb_ld(&bar[XB_TMO])) break; if (sp > XB_SPIN_CAP) { atomicAdd(&bar[XB_TMO], 1u); break; } }
    }
    nloc = mine > 0u ? mine : 1u; nx = cnt > 0u ? cnt : 1u;
}

__device__ __forceinline__ void xcd_barrier(const XcdBarrier& b) {
    asm volatile("s_waitcnt vmcnt(0)" ::: "memory");
    __syncthreads();
    if (threadIdx.x == 0) {
        unsigned* bar = b.bar;
        __builtin_amdgcn_s_waitcnt(0);
        unsigned nloc = b.st[0], nx = b.st[1];
        if (nloc == 0u) { xcd_barrier_complete(bar, b.x, nloc, nx); b.st[0] = nloc; b.st[1] = nx; }
        const unsigned old = xb_add(&bar[XB_XSUB(b.x)], 1u);
        const unsigned gen = old / nloc;
        if (old + 1u == (gen + 1u) * nloc) {
            __builtin_amdgcn_fence(__ATOMIC_RELEASE, "agent");
            asm volatile("s_waitcnt vmcnt(0)" ::: "memory");
            const unsigned og = xb_add(&bar[XB_TOP], 1u);
            const unsigned tg = og / nx;
            if (og + 1u == (tg + 1u) * nx) xb_add(&bar[XB_TOPGEN], 1u);
            else XB_SPIN(xb_ld(&bar[XB_TOPGEN]) == tg, bar);
            __builtin_amdgcn_fence(__ATOMIC_ACQUIRE, "agent");
            xb_add(&bar[XB_XGEN(b.x)], 1u);
            asm volatile("s_waitcnt vmcnt(0)" ::: "memory");
        } else {
            XB_SPIN(xb_ld(&bar[XB_XGEN(b.x)]) == gen, bar);
            __builtin_amdgcn_fence(__ATOMIC_ACQUIRE, "agent");
            asm volatile("s_waitcnt vmcnt(0)" ::: "memory");
        }
    }
    __syncthreads();
}

constexpr int NWAVES = 8;
constexpr int DM = 2048, NBATCH = 8, SEQ = 2048, CTXL = 256, TPB = 2304  , MT = 18432, NPAN = 72;
constexpr int INC = 4672, INCP = 4864;
constexpr int C_NAQ = 0, C_NAK = 512, C_NAV = 1024, C_CQ = 1536, C_CKV = 1920, C_KPE = 2048, C_GQ = 2112, C_GK = 2624, C_GV = 2880, C_DQ = 3136, C_DK = 3648, C_DV = 4160;
constexpr int QMW = 768, KVW = 1280;
constexpr int DFF = 5632, DFE = 7168, NEXP = 8;
constexpr int MODW = 12288;
constexpr int MOE_ROWS = 34816, MOE_PAN = 136;
constexpr float EPSN = 1e-6f;
constexpr float SC_NA = 0.08838834764831845f, SC_MLA = 0.07216878364870322f, SC_DIFF = 0.125f;

constexpr size_t MiB = 1u << 20;
constexpr size_t WS_CTL = 0, CTL_ZERO_BYTES = 1 * MiB;
constexpr size_t WS_MOD = 1 * MiB;
constexpr size_t WS_ROPE = 1 * MiB + 900 * 1024;
constexpr size_t WS_ROUTE = 2 * MiB;
constexpr size_t WS_WIN = 3 * MiB;
constexpr size_t WS_WOUT = WS_WIN + 38 * MiB;
constexpr size_t WS_WQUP = WS_WOUT + 16 * MiB;
constexpr size_t WS_WKVUP = WS_WQUP + 2 * MiB;
constexpr size_t WS_WGU = WS_WKVUP + 2 * MiB;
constexpr size_t WS_WD = WS_WGU + 44 * MiB;
constexpr size_t WS_MGU = WS_WD + 22 * MiB;
constexpr size_t WS_MD = WS_MGU + 448 * MiB;
constexpr size_t WS_H = WS_MD + 224 * MiB;
constexpr size_t WS_U = WS_H + 144 * MiB;
constexpr size_t WS_R1 = WS_U + 72 * MiB;
constexpr size_t WS_QKV = WS_R1;
constexpr size_t WS_QM = WS_QKV + 171 * MiB;
constexpr size_t WS_KVM = WS_QM + 27 * MiB;
constexpr size_t WS_O = WS_KVM + 45 * MiB;
constexpr size_t WS_HM2 = WS_R1;
constexpr size_t WS_R2 = WS_R1 + 476 * MiB;
constexpr size_t WS_AS = WS_R2;
constexpr size_t WS_Y = WS_R2 + 136 * MiB;
constexpr size_t WS_HM = WS_R2;
constexpr size_t WS_END = WS_R2 + 272 * MiB;
static_assert(WS_O + 72 * MiB <= WS_R2, "region 1");
static_assert(WS_END <= (size_t)1792 * MiB, "workspace map must fit 4 x the largest input");
constexpr int RT_E = 0;
constexpr int RT_G = 16384;
constexpr int RT_RANK = 16384 * 3;
constexpr int RT_POS = 16384 * 5;
constexpr int RT_CNT = 16384 * 7;
static_assert((RT_CNT + 256 * 8) * 4 <= (int)MiB, "route info");
constexpr int CW_BAR = 4096;

constexpr int RING_OFF = 0, RING_BYTES = 131072;
constexpr int LDSCTL_OFF = RING_BYTES, MISC_OFF = LDSCTL_OFF + 320;
constexpr int LDS_BYTES = 147456;

namespace pg8 {
#define PG8_GAS __attribute__((address_space(1)))
struct LatentOrder : StaticOrder {
    __device__ bool next(int i, Unit& u) const { if (!StaticOrder::next(i, u)) return false; u.pm = u.pm + (u.pm >> 3) + 1; return true; }
};
#ifndef MOE_WGM
#define MOE_WGM 16
#endif
#ifndef MOE_NTB
#define MOE_NTB 0
#endif
struct MoeOrder : StaticOrder {
    static constexpr bool NTB = MOE_NTB;
    const PG8_LAS int* tab;
    __device__ bool next(int i, Unit& u) const {
        {
            const long L = (long)i * G + c; if (L >= nwg) return false;
            int wgid = (int)L; { const int q = nwg / NXCD, r = nwg % NXCD, xcd = wgid % NXCD, off = wgid / NXCD; wgid = (xcd < r ? xcd * (q + 1) : r * (q + 1) + (xcd - r) * q) + off; }
            const int nig = MOE_WGM * nN, gid = wgid / nig, fm = gid * MOE_WGM, gsz = (nM - fm) < MOE_WGM ? (nM - fm) : MOE_WGM;
            u.pm = fm + ((wgid % nig) % gsz); u.pn = (wgid % nig) / gsz;
        }
        int e = 0;
#pragma unroll
        for (int q = 0; q < 7; ++q) e += (u.pm >= __builtin_amdgcn_readfirstlane(tab[32 + q])) ? 1 : 0;
        u.pn += e * nN; return true;
    }
};
#ifndef MOED_WGM
#define MOED_WGM 4
#endif
struct MoeFullOrder : StaticOrder {
    const PG8_LAS int* tab;
    __device__ bool next(int i, Unit& u) const {
        {
            const long L = (long)i * G + c; if (L >= nwg) return false;
            int wgid = (int)L; { const int q = nwg / NXCD, r = nwg % NXCD, xcd = wgid % NXCD, off = wgid / NXCD; wgid = (xcd < r ? xcd * (q + 1) : r * (q + 1) + (xcd - r) * q) + off; }
            const int nig = MOED_WGM * nN, gid = wgid / nig, fm = gid * MOED_WGM, gsz = (nM - fm) < MOED_WGM ? (nM - fm) : MOED_WGM;
            u.pm = fm + ((wgid % nig) % gsz); u.pn = (wgid % nig) / gsz;
        }
        const int f = u.pm; int e = 0;
#pragma unroll
        for (int q = 0; q < 7; ++q) e += (f >= __builtin_amdgcn_readfirstlane(tab[40 + q])) ? 1 : 0;
        u.pm = f + __builtin_amdgcn_readfirstlane(tab[48 + e]); u.pn += e * nN; return true;
    }
    __device__ __forceinline__ void a_ready(const Unit&) const {}
    __device__ __forceinline__ void done(const Unit&) const {}
};
struct MoeRemOrder {
    static constexpr bool NTB = false;
    int nsub, G, c; const PG8_LAS int* tab;
    __device__ bool next(int i, Unit& u) const {
        const int L = i * G + c; if (L >= nsub) return false;
        const int r = L >> 5, pn = (L >> 2) & 7, ks = L & 3, e = tab[64 + r];
        u.pm = tab[32 + e] - 1; u.pn = e * 8 + pn; u.ko = ks * 1792; u.aux = r; return true;
    }
    __device__ __forceinline__ void a_ready(const Unit&) const {}
    __device__ __forceinline__ void done(const Unit&) const {}
};
struct EpiSlab {
    static constexpr bool PERM = false, AFTER_DRAIN = false;
    float* S; float sc = 1.0f;
    __device__ __forceinline__ void operator()(const f32x4 (&acc)[2][2][4][2], const Unit& u, int wr, int wc, int fr_in, int fq_in) const {
        (void)fr_in; (void)fq_in; int t_ = threadIdx.x; asm volatile("" : "+v"(t_)); const int fr = t_ & 15, fq = (t_ >> 4) & 3;
        const int ks = u.ko / 1792, pn = u.pn & 7;
        float* base = S + ((size_t)(ks * 8 + u.aux) * 256 + wr * 64 + fr) * 2048 + pn * BM + wc * 32 + 4 * fq;
#pragma unroll
        for (int ai = 0; ai < 2; ++ai)
#pragma unroll
            for (int m = 0; m < 4; ++m)
#pragma unroll
                for (int bj = 0; bj < 2; ++bj)
#pragma unroll
                    for (int n = 0; n < 2; ++n) *(PG8_GAS f32x4*)(base + (size_t)(ai * HALF + m * 16) * 2048 + bj * HALF + n * 16) = acc[ai][bj][m][n] * sc;
    }
};
struct EpiBf16P {
    static constexpr bool PERM = true, AFTER_DRAIN = false;
    bf16_t* O; int ldc; int pn_mod; float sc = 1.0f;
    __device__ __forceinline__ void operator()(const f32x4 (&acc)[2][2][4][2], const Unit& u, int wr, int wc, int fr_in, int fq_in) const {
        (void)fr_in; (void)fq_in; int t_ = threadIdx.x; asm volatile("" : "+v"(t_)); const int fr = t_ & 15, fq = (t_ >> 4) & 3;
        const int pn = pn_mod ? (u.pn % pn_mod) : u.pn;
        const int row0 = u.pm * BM + wr * 64 + fr, col0 = pn * BM + wc * 32 + 8 * fq;
#pragma unroll
        for (int ai = 0; ai < 2; ++ai)
#pragma unroll
            for (int m = 0; m < 4; ++m) { bf16_t* rowp = O + (size_t)(row0 + ai * HALF + m * 16) * ldc + col0;
#pragma unroll
                for (int bj = 0; bj < 2; ++bj) { const f32x4 v0 = acc[ai][bj][m][0] * sc, v1 = acc[ai][bj][m][1] * sc;
                    u32x4 w; w.x = cvt_pk_bf16(v0[0], v0[1]); w.y = cvt_pk_bf16(v0[2], v0[3]); w.z = cvt_pk_bf16(v1[0], v1[1]); w.w = cvt_pk_bf16(v1[2], v1[3]);
                    *(PG8_GAS u32x4*)(rowp + bj * HALF) = w; } }
    }
};
#ifndef KT_MOE
#define KT_MOE 1
#endif
#ifndef MOE_FP8
#define MOE_FP8 1
#endif
constexpr float MOE_WSCALE = 64.0f;
#ifndef EMU_FP8
#define EMU_FP8 0
#endif
#ifndef EMU_DGU
#define EMU_DGU 0
#endif
__device__ __forceinline__ unsigned pk4_fp8(float a, float b, float c, float d) { int p = __builtin_amdgcn_cvt_pk_fp8_f32(a, b, 0, false); p = __builtin_amdgcn_cvt_pk_fp8_f32(c, d, p, true); return (unsigned)p; }
__device__ __forceinline__ float fp8r(float x) { const int p = __builtin_amdgcn_cvt_pk_fp8_f32(x, x, 0, false); return __builtin_amdgcn_cvt_f32_fp8(p, 0); }
#ifndef NT_HM2
#define NT_HM2 1
#endif
__device__ __forceinline__ float silu_f(float x) { return x * __builtin_amdgcn_rcpf(1.0f + __expf(-x)); }
__device__ __forceinline__ float swiglu_f(float g, float u, float c1, float kk) { const float e = __builtin_amdgcn_exp2f(g * c1); return (g * u) * __builtin_amdgcn_rcpf(fmaf(e, kk, kk)); }
struct EpiSwiGLU {
    static constexpr bool PERM = true, AFTER_DRAIN = false;
    bf16_t* O; int ldc; int pn_mod; float isc = 1.0f;
    __device__ __forceinline__ void operator()(const f32x4 (&acc)[2][2][4][2], const Unit& u, int wr, int wc, int fr_in, int fq_in) const {
        (void)fr_in; (void)fq_in; int t_ = threadIdx.x; asm volatile("" : "+v"(t_)); const int fr = t_ & 15, fq = (t_ >> 4) & 3;
        const int pn = pn_mod ? (u.pn % pn_mod) : u.pn;
        const int row0 = u.pm * BM + wr * 64 + fr, col0 = pn * HALF + wc * 32 + 8 * fq;
        const float c1 = -1.4426950408889634f * isc, kk = 1.0f / (isc * isc);
#pragma unroll
        for (int ai = 0; ai < 2; ++ai)
#pragma unroll
            for (int m = 0; m < 4; ++m) { bf16_t* rowp = O + (size_t)(row0 + ai * HALF + m * 16) * ldc + col0;
                if (KT_MOE && pn_mod) rowp = O + ((size_t)(u.pm * (ldc >> 6) + (col0 >> 6)) * 256 + (wr * 64 + fr + ai * HALF + m * 16)) * 64 + (col0 & 63);
                f32x4 r0, r1;
#pragma unroll
                for (int j = 0; j < 4; ++j) { r0[j] = swiglu_f(acc[ai][0][m][0][j], acc[ai][1][m][0][j], c1, kk); r1[j] = swiglu_f(acc[ai][0][m][1][j], acc[ai][1][m][1][j], c1, kk); }
                if (MOE_FP8 && pn_mod) {
                    typedef unsigned u32x2 __attribute__((ext_vector_type(2)));
                    unsigned char* p8 = (unsigned char*)O + ((size_t)(u.pm * (ldc >> 7) + (col0 >> 7)) * 256 + (wr * 64 + fr + ai * HALF + m * 16)) * 128 + (col0 & 127);
                    u32x2 w8; w8.x = pk4_fp8(r0[0], r0[1], r0[2], r0[3]); w8.y = pk4_fp8(r1[0], r1[1], r1[2], r1[3]);
                    __builtin_nontemporal_store(w8, (PG8_GAS u32x2*)p8); continue; }
                if (EMU_FP8 && pn_mod) {
#pragma unroll
                    for (int j = 0; j < 4; ++j) { r0[j] = fp8r(r0[j]); r1[j] = fp8r(r1[j]); } }
                u32x4 w; w.x = cvt_pk_bf16(r0[0], r0[1]); w.y = cvt_pk_bf16(r0[2], r0[3]); w.z = cvt_pk_bf16(r1[0], r1[1]); w.w = cvt_pk_bf16(r1[2], r1[3]);
                if (NT_HM2 && pn_mod) __builtin_nontemporal_store(w, (PG8_GAS u32x4*)rowp); else *(PG8_GAS u32x4*)rowp = w; }
    }
};
struct EpiResGate {
    static constexpr bool PERM = false, AFTER_DRAIN = false;
    float* H; const float* gate;
    const float* xin; const float* cin;
    __device__ __forceinline__ void operator()(const f32x4 (&acc)[2][2][4][2], const Unit& u, int wr, int wc, int fr, int fq) const {
        const int b = u.pm / 9, j = u.pm - 9 * b, mr = (j == 0) ? 8 : b;
        const int rloc = wr * 64 + fr, col0 = u.pn * BM + wc * 32 + 4 * fq;
        const float* gp = gate + (size_t)mr * 12288 + col0;
        float* outp = H + (size_t)(u.pm * BM + rloc) * 2048 + col0;
        const float* inp = xin ? ((j == 0) ? cin + ((size_t)b * 256 + rloc) * 2048 + col0 : xin + ((size_t)b * 2048 + (size_t)(j - 1) * 256 + rloc) * 2048 + col0) : outp;
        f32x4 gv[2][2];
#pragma unroll
        for (int bj = 0; bj < 2; ++bj)
#pragma unroll
            for (int n = 0; n < 2; ++n) gv[bj][n] = *(const PG8_GAS f32x4*)(gp + bj * HALF + n * 16);
#pragma unroll
        for (int ai = 0; ai < 2; ++ai)
#pragma unroll
            for (int m = 0; m < 4; ++m) {
                const size_t ro = (size_t)(ai * HALF + m * 16) * 2048;
#pragma unroll
                for (int bj = 0; bj < 2; ++bj)
#pragma unroll
                    for (int n = 0; n < 2; ++n) { const f32x4 h = *(const PG8_GAS f32x4*)(inp + ro + bj * HALF + n * 16); *(PG8_GAS f32x4*)(outp + ro + bj * HALF + n * 16) = h + gv[bj][n] * acc[ai][bj][m][n]; }
                asm volatile("" ::: "memory"); }
    }
};
struct EpiQupRope {
    static constexpr bool PERM = false, AFTER_DRAIN = false;
    bf16_t* O; const float* tab;
    __device__ __forceinline__ void operator()(const f32x4 (&acc)[2][2][4][2], const Unit& u, int wr, int wc, int fr, int fq) const {
        const int b = u.pm / 9, j = u.pm - 9 * b; const bool lat = j != 0;
        const int rloc = wr * 64 + fr, col0 = u.pn * BM + wc * 32 + 4 * fq;
        typedef unsigned u32x2 __attribute__((ext_vector_type(2)));
#pragma unroll
        for (int bj = 0; bj < 2; ++bj) {
            const int dblk = (8 * u.pn + 4 * bj + wc) % 6; const bool rope = lat && dblk >= 4; const int axis = dblk - 4;
#pragma unroll
            for (int ai = 0; ai < 2; ++ai)
#pragma unroll
                for (int m = 0; m < 4; ++m) {
                    const int r = ai * HALF + m * 16 + rloc;
                    f32x4 x1 = acc[ai][bj][m][0], x2 = acc[ai][bj][m][1];
                    if (rope) { const int t = (j - 1) * 256 + r, pos = axis ? (t & 63) : (t >> 6);
                        const f32x4 c = *(const PG8_GAS f32x4*)(tab + pos * 16 + 4 * fq), sn = *(const PG8_GAS f32x4*)(tab + 1024 + pos * 16 + 4 * fq);
                        const f32x4 a = x1, bb = x2; x1 = a * c - bb * sn; x2 = bb * c + a * sn; }
                    bf16_t* rowp = O + (size_t)(u.pm * BM + r) * 768 + col0 + bj * HALF;
                    u32x2 w0, w1; w0.x = cvt_pk_bf16(x1[0], x1[1]); w0.y = cvt_pk_bf16(x1[2], x1[3]); w1.x = cvt_pk_bf16(x2[0], x2[1]); w1.y = cvt_pk_bf16(x2[2], x2[3]);
                    *(PG8_GAS u32x2*)rowp = w0; *(PG8_GAS u32x2*)(rowp + 16) = w1;
                    asm volatile("" ::: "memory");
                }
        }
    }
};
}
#define PG8_SP2 true
#define PG8_ALIGN true

struct Frame {
    LAS unsigned char* lds;
    volatile LAS unsigned* MISC;
    gu32* ctl;
    int wave, G, gw, NGW;
    float* out;
    unsigned char* ws;
};
__device__ __forceinline__ int opq_v(int v) { asm volatile("" : "+v"(v)); return v; }
#define TIDX opq_v((int)threadIdx.x)
typedef const float* cfptr;
__device__ __forceinline__ const float* inptr(int i) {
    const __attribute__((address_space(4))) cfptr* p = (const __attribute__((address_space(4))) cfptr*)__builtin_amdgcn_kernarg_segment_ptr();
    asm volatile("" : "+s"(p));
    return p[i];
}
enum { I_X = 0, I_C, I_CTX, I_CCTX, I_WMOD, I_BMOD, I_GMIX, I_WIN, I_NABIAS, I_MLAGQ, I_WQUP, I_MLAGKV, I_WKVUP, I_GQAGQ, I_GQAGK, I_LQ1, I_LK1, I_LQ2, I_LK2, I_GSUB, I_WOUT, I_GFFN,
       I_FG, I_FU, I_FD, I_MR, I_MB, I_MG, I_MU, I_MDN, I_GFIN };

struct TrJob { const float* W; bf16* WT; int N, ldk, k0, n0, drow0, tiled, emu; };
__device__ __forceinline__ void tr_load(const TrJob& j, f32x4 (&v)[16], int lane) {
#pragma unroll
    for (int i = 0; i < 16; ++i) { const int k = 4 * i + (lane >> 4), n4 = (lane & 15) * 4;
        v[i] = __builtin_nontemporal_load((const GAS f32x4*)(j.W + (size_t)(j.k0 + k) * j.N + j.n0 + n4)); }
}
__device__ __forceinline__ void tr_finish8(const TrJob& j, const f32x4 (&v)[16], LAS unsigned char* scr, int lane) {
    constexpr int ROWB = 68;
#pragma unroll
    for (int i = 0; i < 16; ++i) { const int k = 4 * i + (lane >> 4), n4 = (lane & 15) * 4; const f32x4 t = v[i] * pg8::MOE_WSCALE;
        *(LAS unsigned*)(scr + k * ROWB + n4) = pg8::pk4_fp8(t.x, t.y, t.z, t.w); }
    LDS_WAIT();
    const int c = lane & 3;
#pragma unroll 2
    for (int jj = 0; jj < 4; ++jj) {
        const int n = 16 * jj + (lane >> 2);
        const LAS unsigned char* s = scr + (16 * c) * ROWB + n;
        unsigned e[16];
#pragma unroll
        for (int i = 0; i < 16; ++i) e[i] = s[i * ROWB];
        v4u o; o.x = e[0] | (e[1] << 8) | (e[2] << 16) | (e[3] << 24); o.y = e[4] | (e[5] << 8) | (e[6] << 16) | (e[7] << 24);
        o.z = e[8] | (e[9] << 8) | (e[10] << 16) | (e[11] << 24); o.w = e[12] | (e[13] << 8) | (e[14] << 16) | (e[15] << 24);
        const int dr = j.drow0 + n;
        unsigned char* dst = (unsigned char*)j.WT + ((size_t)((dr >> 8) * (j.ldk >> 7) + (j.k0 >> 7)) * 256 + (dr & 255)) * 128 + (j.k0 & 127) + 16 * c;
        __builtin_nontemporal_store(o, (GAS v4u*)dst);
    }
    LDS_WAIT();
}
__device__ __forceinline__ void tr_finish(const TrJob& j, const f32x4 (&v)[16], LAS unsigned char* scr, int lane) {
    constexpr int ROWB = 136;
#pragma unroll
    for (int i = 0; i < 16; ++i) { const int k = 4 * i + (lane >> 4), n4 = (lane & 15) * 4;
        f32x4 t = v[i]; if ((EMU_FP8 && j.tiled) || (EMU_DGU && j.emu)) { t.x = pg8::fp8r(t.x * 64.f) * (1.f / 64.f); t.y = pg8::fp8r(t.y * 64.f) * (1.f / 64.f); t.z = pg8::fp8r(t.z * 64.f) * (1.f / 64.f); t.w = pg8::fp8r(t.w * 64.f) * (1.f / 64.f); }
        v2u w; w.x = pg8::cvt_pk_bf16(t.x, t.y); w.y = pg8::cvt_pk_bf16(t.z, t.w);
        *(LAS v2u*)(scr + k * ROWB + n4 * 2) = w; }
    LDS_WAIT();
    const int c = lane & 7;
#pragma unroll 2
    for (int jj = 0; jj < 8; ++jj) {
        const int n = 8 * jj + (lane >> 3);
        const LAS unsigned short* s = (const LAS unsigned short*)(scr + (8 * c) * ROWB + n * 2);
        unsigned e[8];
#pragma unroll
        for (int i = 0; i < 8; ++i) e[i] = s[i * (ROWB / 2)];
        v4u o; o.x = e[0] | (e[1] << 16); o.y = e[2] | (e[3] << 16); o.z = e[4] | (e[5] << 16); o.w = e[6] | (e[7] << 16);
        const int dr = j.drow0 + n;
        bf16* dst = j.tiled ? j.WT + ((size_t)((dr >> 8) * (j.ldk >> 6) + (j.k0 >> 6)) * 256 + (dr & 255)) * 64 + 8 * c : j.WT + (size_t)dr * j.ldk + j.k0 + 8 * c;
        __builtin_nontemporal_store(o, (GAS v4u*)dst);
    }
    LDS_WAIT();
}
constexpr int IT_WIN = 32 * 73, IT_WOUT = 32 * 32, IT_FGU = 32 * 88, IT_FD = 88 * 32, IT_MGU = 32 * 112, IT_MD = 112 * 32;
constexpr int CV_N0 = 2 * IT_WIN, CV_N1 = CV_N0 + 2 * IT_WOUT, CV_N2 = CV_N1 + 2 * IT_FGU, CV_N3 = CV_N2 + IT_FD, CV_N4 = CV_N3 + 16 * IT_MGU, CV_N5 = CV_N4 + 8 * IT_MD;
constexpr int CVQ_L1 = IT_WIN + IT_WOUT, CVQ_N = CVQ_L1 + (CV_N5 - CV_N1), CVQ_FFN_END = CVQ_L1 + (CV_N3 - CV_N1);
__device__ __forceinline__ int cvq_item(int q) { return q < IT_WIN ? IT_WIN + q : (q < CVQ_L1 ? CV_N0 + IT_WOUT + (q - IT_WIN) : CV_N1 + (q - CVQ_L1)); }
__device__ __forceinline__ TrJob conv_job(int it, unsigned char* ws) {
    const float* W; bf16* WT; int N, ldk, k0, n0, drow0, tiled = 0, emu = 0;
    if (it < CV_N0) { const int l = it / IT_WIN, r = it % IT_WIN, kb = r / 73, nb = r % 73;
        W = inptr(I_WIN) + (size_t)l * 2048 * INC; N = INC; WT = (bf16*)(ws + WS_WIN) + (size_t)l * INCP * 2048; ldk = 2048; k0 = kb * 64; n0 = nb * 64; drow0 = n0; }
    else if (it < CV_N1) { const int q = it - CV_N0, l = q / IT_WOUT, r = q % IT_WOUT, kb = r / 32, nb = r % 32;
        W = inptr(I_WOUT) + (size_t)l * 2048 * 2048; N = 2048; WT = (bf16*)(ws + WS_WOUT) + (size_t)l * 2048 * 2048; ldk = 2048; k0 = kb * 64; n0 = nb * 64; drow0 = n0; }
    else if (it < CV_N2) { const int q = it - CV_N1, which = q / IT_FGU, r = q % IT_FGU, kb = r / 88, nb = r % 88;
        W = which ? inptr(I_FU) : inptr(I_FG); N = DFF; WT = (bf16*)(ws + WS_WGU); ldk = 2048; k0 = kb * 64; n0 = nb * 64; drow0 = (n0 >> 7) * 256 + (n0 & 127) + which * 128; emu = 1; }
    else if (it < CV_N3) { const int r = it - CV_N2, kb = r / 32, nb = r % 32;
        W = inptr(I_FD); N = 2048; WT = (bf16*)(ws + WS_WD); ldk = DFF; k0 = kb * 64; n0 = nb * 64; drow0 = n0; }
    else if (it < CV_N4) { const int q = it - CV_N3, mat = q / IT_MGU, e = mat >> 1, which = mat & 1, r = q % IT_MGU, kb = r / 112, nb = r % 112;
        W = (which ? inptr(I_MU) : inptr(I_MG)) + (size_t)e * 2048 * DFE; N = DFE; WT = MOE_FP8 ? (bf16*)(ws + WS_MGU + (size_t)e * 14336 * 2048) : (bf16*)(ws + WS_MGU) + (size_t)e * 14336 * 2048; ldk = 2048; k0 = kb * 64; n0 = nb * 64; drow0 = (n0 >> 7) * 256 + (n0 & 127) + which * 128; tiled = MOE_FP8 ? 2 : KT_MOE; }
    else { const int q = it - CV_N4, e = q / IT_MD, r = q % IT_MD, kb = r / 32, nb = r % 32;
        W = inptr(I_MDN) + (size_t)e * DFE * 2048; N = 2048; WT = MOE_FP8 ? (bf16*)(ws + WS_MD + (size_t)e * 2048 * DFE) : (bf16*)(ws + WS_MD) + (size_t)e * 2048 * DFE; ldk = DFE; k0 = kb * 64; n0 = nb * 64; drow0 = n0; tiled = MOE_FP8 ? 2 : KT_MOE; }
    TrJob j; j.W = W; j.WT = WT; j.N = N; j.ldk = ldk; j.k0 = k0; j.n0 = n0; j.drow0 = drow0; j.tiled = tiled; j.emu = emu; return j;
}
template <bool QUEUE>
__device__ __forceinline__ void conv_pair(int it0, int it1, int nlim, unsigned char* ws, LAS unsigned char* scr, int lane) {
    if (it0 >= nlim) return;
    const bool two = it1 < nlim;
    const TrJob j0 = conv_job(QUEUE ? cvq_item(it0) : it0, ws), j1 = conv_job(QUEUE ? cvq_item(two ? it1 : it0) : (two ? it1 : it0), ws);
    f32x4 v0[16], v1[16];
#ifdef PROBE_CONV2
    if (QUEUE) { tr_load(j0, v0, lane); if (two) tr_load(j1, v1, lane); if (j0.tiled == 2) tr_finish8(j0, v0, scr, lane); else tr_finish(j0, v0, scr, lane); if (two) { if (j1.tiled == 2) tr_finish8(j1, v1, scr, lane); else tr_finish(j1, v1, scr, lane); } }
#endif
    tr_load(j0, v0, lane); if (two) tr_load(j1, v1, lane);
    if (j0.tiled == 2) tr_finish8(j0, v0, scr, lane); else tr_finish(j0, v0, scr, lane);
    if (two) { if (j1.tiled == 2) tr_finish8(j1, v1, scr, lane); else tr_finish(j1, v1, scr, lane); }
}
#ifndef CV_CHUNK_N
#define CV_CHUNK_N 16
#endif
constexpr int CW_QHEAD = 64, CW_DONE0 = 128, CV_CHUNK = CV_CHUNK_N;
#ifndef NO_TAIL_FILL
#define NO_TAIL_FILL 0
#endif
__device__ __forceinline__ void filler(Frame& F, int slot, int drain_to) {
    if (NO_TAIL_FILL && drain_to < 0) return;
    __syncthreads();
    LAS int* bc = (LAS int*)(F.lds + LDSCTL_OFF + 2048);
    LAS unsigned char* scr = F.lds + F.wave * 8704;
    gu32* qhead = F.ctl + CW_QHEAD; gu32* done = F.ctl + CW_DONE0 + 64 * slot;
    if (TIDX == 0 && drain_to < 0) __hip_atomic_fetch_add(done, 1u, RLX_AGENT);
    const int nq = CVQ_N, lim = drain_to < 0 ? nq : drain_to;
    for (;;) {
        if (TIDX == 0) {
            int h = -1; bool stop = false;
            if (drain_to < 0) stop = __hip_atomic_load(done, RLX_AGENT) >= (unsigned)F.G;
            else stop = __hip_atomic_load(qhead, RLX_AGENT) >= (unsigned)lim;
            if (!stop) { h = (int)__hip_atomic_fetch_add(qhead, (unsigned)CV_CHUNK, RLX_AGENT); if (h >= nq) h = -1; }
            *bc = h;
        }
        __syncthreads();
        const int h = *bc;
        __syncthreads();
        if (h < 0) break;
#pragma unroll 1
        for (int k = F.wave; k < CV_CHUNK; k += 2 * NWAVES) conv_pair<true>(h + k, h + k + NWAVES, CVQ_N, F.ws, scr, (TIDX & 63));
    }
    __syncthreads();
}

__device__ __forceinline__ void rope_cs(int pos, int i, float inv_nfreq, float& c, float& s) {
    const float freq = exp2f(-(float)i * inv_nfreq * 13.287712379549449f);
    const float ang = (float)pos * freq;
    c = __cosf(ang); s = __sinf(ang);
}

__device__ __forceinline__ void filler_quota(Frame& F, int nchunks) {
    __syncthreads();
    LAS int* bc = (LAS int*)(F.lds + LDSCTL_OFF + 2048);
    LAS unsigned char* scr = F.lds + F.wave * 8704;
    gu32* qhead = F.ctl + CW_QHEAD;
    const int nq = CVQ_N;
#pragma unroll 1
    for (int cidx = 0; cidx < nchunks; ++cidx) {
        if (TIDX == 0) { int h = -1;
            if (__hip_atomic_load(qhead, RLX_AGENT) < (unsigned)nq) { h = (int)__hip_atomic_fetch_add(qhead, (unsigned)CV_CHUNK, RLX_AGENT); if (h >= nq) h = -1; }
            *bc = h; }
        __syncthreads();
        const int h = *bc;
        __syncthreads();
        if (h < 0) break;
#pragma unroll 1
        for (int k = F.wave; k < CV_CHUNK; k += 2 * NWAVES) conv_pair<true>(h + k, h + k + NWAVES, CVQ_N, F.ws, scr, (TIDX & 63));
    }
    __syncthreads();
}

__device__ __forceinline__ float silu_g(float x) { return x / (1.0f + __expf(-x)); }

__device__ __forceinline__ void p0_prologue(Frame& F) {
    unsigned char* ws = F.ws;
    __syncthreads();
    {
        LAS float* sv = (LAS float*)(F.lds);
        LAS float* red = (LAS float*)(F.lds + 73728);
        for (int i = TIDX; i < 9 * 2048; i += 512) { const int r = i >> 11, d = i & 2047; const float v = (r < 8) ? inptr(I_C)[r * 2048 + d] : inptr(I_CCTX)[d]; sv[i] = silu_g(v); }
        __syncthreads();
        for (int cb = blockIdx.x; cb < 256; cb += F.G) {
            const int cg = cb * 96, layer = cg / MODW, col0 = cg - layer * MODW;
            const float* W = inptr(I_WMOD) + (size_t)layer * 2048 * MODW;
            if (TIDX < 384) {
                const int cq = TIDX % 24, ks = TIDX / 24;
                f32x4 acc[9];
#pragma unroll
                for (int r = 0; r < 9; ++r) acc[r] = (f32x4){0.f, 0.f, 0.f, 0.f};
                const float* wp = W + (size_t)(ks * 128) * MODW + col0 + cq * 4;
#pragma unroll 2
                for (int k = 0; k < 128; k += 4) {
                    f32x4 w[4];
#pragma unroll
                    for (int q = 0; q < 4; ++q) w[q] = __builtin_nontemporal_load((const GAS f32x4*)(wp + (size_t)(k + q) * MODW));
#pragma unroll
                    for (int r = 0; r < 9; ++r) { const f32x4 s4 = *(const LAS f32x4*)(sv + r * 2048 + ks * 128 + k);
                        acc[r] += w[0] * s4.x; acc[r] += w[1] * s4.y; acc[r] += w[2] * s4.z; acc[r] += w[3] * s4.w; }
                }
#pragma unroll
                for (int r = 0; r < 9; ++r) *(LAS f32x4*)(red + (ks * 9 + r) * 96 + cq * 4) = acc[r];
            }
            __syncthreads();
            for (int i = TIDX; i < 9 * 96; i += 512) {
                const int r = i / 96, c = i - r * 96; float s = inptr(I_BMOD)[layer * MODW + col0 + c];
#pragma unroll
                for (int ks = 0; ks < 16; ++ks) s += red[(ks * 9 + r) * 96 + c];
                ((float*)(ws + WS_MOD))[((size_t)layer * 9 + r) * MODW + col0 + c] = s;
            }
            __syncthreads();
        }
    }
    {
        const size_t gt = (size_t)blockIdx.x * 512 + TIDX, GT = (size_t)F.G * 512;
        for (size_t i = gt; i < (size_t)2 * 768 * 384; i += GT) { const int l = (int)(i / (768 * 384)), r = (int)(i % (768 * 384)), n = r / 384, k = r % 384;
            ((bf16*)(ws + WS_WQUP))[i] = (bf16)f2bf(inptr(I_WQUP)[((size_t)l * 384 + k) * 768 + n]); }
        for (size_t i = gt; i < (size_t)2 * 1280 * 256; i += GT) { const int l = (int)(i / (1280 * 256)), r = (int)(i % (1280 * 256)), row = r >> 8, k = r & 255, h = row / 320, j = row - 320 * h;
            float v = 0.f;
            if (j < 128) { if (k < 128) v = inptr(I_WKVUP)[((size_t)l * 128 + k) * 1024 + h * 256 + j]; }
            else if (j < 192) { if (k == j) v = 1.0f; }
            else { if (k < 128) v = inptr(I_WKVUP)[((size_t)l * 128 + k) * 1024 + h * 256 + 128 + (j - 192)]; }
            ((bf16*)(ws + WS_WKVUP))[i] = (bf16)f2bf(v); }
        for (size_t i = gt; i < 64 * 16 + 64 * 32; i += GT) { float* tb = (float*)(ws + WS_ROPE);
            if (i < 1024) { const int pos = (int)i >> 4, f = (int)i & 15; float c, sn; rope_cs(pos, f, 1.0f / 16.0f, c, sn); tb[i] = c; tb[1024 + i] = sn; }
            else { const int q = (int)i - 1024, pos = q >> 5, f = q & 31; float c, sn; rope_cs(pos, f, 1.0f / 32.0f, c, sn); tb[2048 + q] = c; tb[4096 + q] = sn; } }
        for (size_t i = gt; i < (size_t)2 * 192 * 2048 / 8; i += GT) { const int l = (int)(i / (192 * 256)), r = (int)(i % (192 * 256));
            *(GAS v4u*)((bf16*)(ws + WS_WIN) + ((size_t)l * INCP + INC) * 2048 + (size_t)r * 8) = (v4u){0u, 0u, 0u, 0u}; }
    }
    {
        LAS unsigned char* scr = F.lds + F.wave * 8704;
        for (int it = F.gw; it < IT_WIN + IT_WOUT; it += 2 * F.NGW) {
            const int i1 = it + F.NGW, a0 = it < IT_WIN ? it : CV_N0 + (it - IT_WIN), a1 = i1 < IT_WIN ? i1 : CV_N0 + (i1 - IT_WIN);
            conv_pair<false>(a0, i1 < IT_WIN + IT_WOUT ? a1 : CV_N5, CV_N5, ws, scr, (TIDX & 63)); }
    }
}

struct RowInfo { int b, w, t, mr; bool ctx; };
__device__ __forceinline__ RowInfo row_info(int r) { RowInfo q; q.b = r / TPB; q.w = r - q.b * TPB; q.ctx = q.w < CTXL; q.t = q.w - CTXL; q.mr = q.ctx ? 8 : q.b; return q; }

__device__ __forceinline__ void norm_pass(Frame& F, int layer, bool first  , bool from_input) {
    unsigned char* ws = F.ws;
    const float* modl = (const float*)(ws + WS_MOD) + (size_t)layer * 9 * MODW;
    const float* g = (first ? inptr(I_GMIX) : inptr(I_GFFN)) + layer * DM;
    const int sh_off = first ? 0 : 3 * DM, sc_off = first ? DM : 4 * DM;
    const float* H = (const float*)(ws + WS_H); bf16* U = (bf16*)(ws + WS_U);
    const int tid_ = TIDX, lane_ = tid_ & 63;
    LAS float* ca = (LAS float*)F.lds; LAS float* cb = ca + 4096;
    for (int blk = blockIdx.x; blk < 256; blk += F.G) {
        const int r0 = blk * 72, bb = r0 / TPB;
        __syncthreads();
        for (int i = tid_; i < 2 * 2048; i += 512) { const int slot = i >> 11, col = i & 2047, mr = slot ? bb : 8;
            ca[i] = g[col] * (1.0f + modl[(size_t)mr * MODW + sc_off + col]); cb[i] = modl[(size_t)mr * MODW + sh_off + col]; }
        __syncthreads();
#pragma unroll 1
        for (int k = 0; k < 3; ++k) {
            f32x4 v[3][8];
#pragma unroll
            for (int q = 0; q < 3; ++q) { const int r = r0 + 9 * F.wave + 3 * k + q, w = r - bb * TPB;
                const float* src = from_input ? ((w < CTXL) ? inptr(I_CTX) + ((size_t)bb * CTXL + w) * DM : inptr(I_X) + ((size_t)bb * SEQ + (w - CTXL)) * DM) : H + (size_t)r * DM;
                const GAS f32x4* xr = (const GAS f32x4*)src + lane_;
#pragma unroll
                for (int j = 0; j < 8; ++j) v[q][j] = xr[64 * j]; }
#pragma unroll
            for (int q = 0; q < 3; ++q) { const int r = r0 + 9 * F.wave + 3 * k + q, w = r - bb * TPB, slot = (w < CTXL) ? 0 : 1;
                float ss = 0.f;
#pragma unroll
                for (int j = 0; j < 8; ++j) ss += (v[q][j].x * v[q][j].x + v[q][j].y * v[q][j].y) + (v[q][j].z * v[q][j].z + v[q][j].w * v[q][j].w);
                const float rstd = 1.0f / sqrtf(wave_sum(ss) * (1.0f / DM) + EPSN);
                GAS v2u* o8 = (GAS v2u*)(U + (size_t)r * DM) + lane_;
                const LAS f32x4* ap = (const LAS f32x4*)(ca + slot * 2048) + lane_; const LAS f32x4* bp = (const LAS f32x4*)(cb + slot * 2048) + lane_;
#pragma unroll
                for (int j = 0; j < 8; ++j) { f32x4 y = v[q][j] * rstd * ap[64 * j] + bp[64 * j]; if (EMU_DGU && !first) { y.x = pg8::fp8r(y.x); y.y = pg8::fp8r(y.y); y.z = pg8::fp8r(y.z); y.w = pg8::fp8r(y.w); } v2u wv; wv.x = pg8::cvt_pk_bf16(y.x, y.y); wv.y = pg8::cvt_pk_bf16(y.z, y.w); o8[64 * j] = wv; } }
        }
    }
    __syncthreads();
}

struct PostRow { unsigned cq[3], ckv; float kpe[2], gq[6][2], df[8][2]; };
__device__ __forceinline__ void post_load(const bf16* q, bool lat, int lane, PostRow& R) {
    const GAS unsigned* pc = (const GAS unsigned*)(q + C_CQ);
#pragma unroll
    for (int j = 0; j < 3; ++j) R.cq[j] = pc[lane + 64 * j];
    R.ckv = ((const GAS unsigned*)(q + C_CKV))[lane];
    { const int axis = (lane >> 4) & 1, i = lane & 15; const GAS bf16* pk = (const GAS bf16*)(q + C_KPE + axis * 32); R.kpe[0] = bf1(pk[i]); R.kpe[1] = bf1(pk[16 + i]); }
#pragma unroll
    for (int hh = 0; hh < 6; ++hh) { const int base = (hh < 4) ? (C_GQ + 128 * hh) : (C_GK + 128 * (hh - 4)); const int axis = lane >> 5, i = lane & 31;
        const GAS bf16* pg = (const GAS bf16*)(q + base + axis * 64); R.gq[hh][0] = bf1(pg[i]); R.gq[hh][1] = bf1(pg[32 + i]); }
    if (lat) {
#pragma unroll
        for (int pp = 0; pp < 8; ++pp) { const int blk = 2 * pp + (lane >> 5), axis = (lane >> 4) & 1, i = lane & 15; const int base = (blk < 8) ? (C_DQ + 64 * blk) : (C_DK + 64 * (blk - 8));
            const GAS bf16* pd = (const GAS bf16*)(q + base + axis * 32); R.df[pp][0] = bf1(pd[i]); R.df[pp][1] = bf1(pd[16 + i]); }
    }
}
__device__ __forceinline__ void post_finish(bf16* q, bool lat, int prow, int pcol, int lane, const PostRow& R, const float* g_mq, const float* g_mkv, const float* g_gq, const float* g_gk, const float* rt) {
    { float ss = 0.f;
#pragma unroll
      for (int j = 0; j < 3; ++j) { const float a = bflo(R.cq[j]), b = bfhi(R.cq[j]); ss += a * a + b * b; }
      const float rs = 1.0f / sqrtf(wave_sum(ss) * (1.0f / 384.0f) + EPSN); GAS unsigned* pc = (GAS unsigned*)(q + C_CQ);
#pragma unroll
      for (int j = 0; j < 3; ++j) { const int c = 2 * (lane + 64 * j); pc[lane + 64 * j] = pk2(bflo(R.cq[j]) * rs * g_mq[c], bfhi(R.cq[j]) * rs * g_mq[c + 1]); } }
    { const float a = bflo(R.ckv), b = bfhi(R.ckv); const float rs = 1.0f / sqrtf(wave_sum(a * a + b * b) * (1.0f / 128.0f) + EPSN);
      ((GAS unsigned*)(q + C_CKV))[lane] = pk2(a * rs * g_mkv[2 * lane], b * rs * g_mkv[2 * lane + 1]); }
    if (lat && lane < 32) { const int axis = lane >> 4, i = lane & 15, pos = axis ? pcol : prow; const float c = rt[pos * 16 + i], s = rt[1024 + pos * 16 + i];
      GAS bf16* pk = (GAS bf16*)(q + C_KPE + axis * 32); pk[i] = (bf16)f2bf(R.kpe[0] * c - R.kpe[1] * s); pk[16 + i] = (bf16)f2bf(R.kpe[1] * c + R.kpe[0] * s); }
    { const int axis = lane >> 5, i = lane & 31, pos = axis ? pcol : prow; const float c = rt[2048 + pos * 32 + i], s = rt[4096 + pos * 32 + i];
#pragma unroll
      for (int hh = 0; hh < 6; ++hh) { const int base = (hh < 4) ? (C_GQ + 128 * hh) : (C_GK + 128 * (hh - 4)); const float* gg = (hh < 4) ? g_gq : g_gk;
        const float x1 = R.gq[hh][0], x2 = R.gq[hh][1];
        const float rs = 1.0f / sqrtf(wave_sum(x1 * x1 + x2 * x2) * (1.0f / 128.0f) + EPSN);
        float y1 = x1 * rs * gg[axis * 64 + i], y2 = x2 * rs * gg[axis * 64 + 32 + i];
        if (lat) { const float o1 = y1 * c - y2 * s, o2 = y2 * c + y1 * s; y1 = o1; y2 = o2; }
        GAS bf16* pg = (GAS bf16*)(q + base + axis * 64); pg[i] = (bf16)f2bf(y1); pg[32 + i] = (bf16)f2bf(y2); } }
    if (lat) { const int axis = (lane >> 4) & 1, i = lane & 15, pos = axis ? pcol : prow; const float c = rt[pos * 16 + i], s = rt[1024 + pos * 16 + i];
#pragma unroll
      for (int pp = 0; pp < 8; ++pp) { const int blk = 2 * pp + (lane >> 5); const int base = (blk < 8) ? (C_DQ + 64 * blk) : (C_DK + 64 * (blk - 8));
        GAS bf16* pd = (GAS bf16*)(q + base + axis * 32); pd[i] = (bf16)f2bf(R.df[pp][0] * c - R.df[pp][1] * s); pd[16 + i] = (bf16)f2bf(R.df[pp][1] * c + R.df[pp][0] * s); } }
}
__device__ __forceinline__ void post_pass(Frame& F, int layer) {
    bf16* QKV = (bf16*)(F.ws + WS_QKV); const float* rt = (const float*)(F.ws + WS_ROPE);
    const float* g_mq = inptr(I_MLAGQ) + layer * 384; const float* g_mkv = inptr(I_MLAGKV) + layer * 128;
    const float* g_gq = inptr(I_GQAGQ) + layer * 128; const float* g_gk = inptr(I_GQAGK) + layer * 128;
    const int lane = opq_v((TIDX & 63));
    for (int r = F.gw; r < MT; r += 2 * F.NGW) {
        const int r2 = r + F.NGW; const bool two = r2 < MT;
        const RowInfo ra = row_info(r), rb = row_info(two ? r2 : r);
        bf16* qa = QKV + (size_t)r * INCP; bf16* qb = QKV + (size_t)(two ? r2 : r) * INCP;
        PostRow A, B;
        post_load(qa, !ra.ctx, lane, A); if (two) post_load(qb, !rb.ctx, lane, B);
        post_finish(qa, !ra.ctx, ra.ctx ? 0 : (ra.t >> 6), ra.ctx ? 0 : (ra.t & 63), lane, A, g_mq, g_mkv, g_gq, g_gk, rt);
        if (two) post_finish(qb, !rb.ctx, rb.ctx ? 0 : (rb.t >> 6), rb.ctx ? 0 : (rb.t & 63), lane, B, g_mq, g_mkv, g_gq, g_gk, rt);
    }
}
__device__ __forceinline__ void qm_rope_pass(Frame& F) {
    bf16* QM = (bf16*)(F.ws + WS_QM); const int lane = opq_v((TIDX & 63));
    for (int r = F.gw; r < MT; r += F.NGW) {
        const RowInfo ri = row_info(r); if (ri.ctx) continue;
        const int prow = ri.t >> 6, pcol = ri.t & 63;
#pragma unroll
        for (int pp = 0; pp < 2; ++pp) {
            const int h = 2 * pp + (lane >> 5), axis = (lane >> 4) & 1, i = lane & 15;
            GAS bf16* p = (GAS bf16*)(QM + (size_t)r * QMW + 192 * h + 128 + axis * 32);
            const float x1 = bf1(p[i]), x2 = bf1(p[16 + i]); float c, s; rope_cs(axis ? pcol : prow, i, 1.0f / 16.0f, c, s);
            p[i] = (bf16)f2bf(x1 * c - x2 * s); p[16 + i] = (bf16)f2bf(x2 * c + x1 * s);
        }
    }
}

__device__ __forceinline__ void ffn_tables(Frame& F, int layer, int b, LAS float* ca, LAS float* cb) {
    const float* modl = (const float*)(F.ws + WS_MOD) + (size_t)layer * 9 * MODW + (size_t)b * MODW; const float* g = inptr(I_GFFN) + layer * DM;
    for (int i = TIDX; i < 2048; i += 512) { ca[i] = g[i] * (1.0f + modl[4 * DM + i]); cb[i] = modl[3 * DM + i]; }
}
__device__ __forceinline__ void ffn_u_pair(Frame& F, int r0, int r1, const LAS float* ca, const LAS float* cb, int lane_, f32x4 (&v0)[8], f32x4 (&v1)[8]) {
    const float* H = (const float*)(F.ws + WS_H);
    const GAS f32x4* x0 = (const GAS f32x4*)(H + (size_t)r0 * DM) + lane_; const GAS f32x4* x1 = (const GAS f32x4*)(H + (size_t)r1 * DM) + lane_;
#pragma unroll
    for (int j = 0; j < 8; ++j) { v0[j] = x0[64 * j]; v1[j] = x1[64 * j]; }
    float s0 = 0.f, s1 = 0.f;
#pragma unroll
    for (int j = 0; j < 8; ++j) { s0 += (v0[j].x * v0[j].x + v0[j].y * v0[j].y) + (v0[j].z * v0[j].z + v0[j].w * v0[j].w); s1 += (v1[j].x * v1[j].x + v1[j].y * v1[j].y) + (v1[j].z * v1[j].z + v1[j].w * v1[j].w); }
    const float q0 = 1.0f / sqrtf(wave_sum(s0) * (1.0f / DM) + EPSN), q1 = 1.0f / sqrtf(wave_sum(s1) * (1.0f / DM) + EPSN);
    const LAS f32x4* ap = (const LAS f32x4*)ca + lane_; const LAS f32x4* bp = (const LAS f32x4*)cb + lane_;
#pragma unroll
    for (int j = 0; j < 8; ++j) { const f32x4 a4 = ap[64 * j], b4 = bp[64 * j]; v0[j] = v0[j] * q0 * a4 + b4; v1[j] = v1[j] * q1 * a4 + b4; }
}
__device__ __forceinline__ int moe_tok(int blk, int tl) { return (blk >> 5) * 2048 + (blk & 31) + 32 * tl; }
__device__ __forceinline__ void route_one(const f32x4 (&v)[8], const LAS float* wl, const float* br, int lane_, int& e1o, int& e2o, float& g1o, float& g2o) {
    float lg[8];
#pragma unroll
    for (int e = 0; e < 8; ++e) lg[e] = 0.f;
#pragma unroll
    for (int j = 0; j < 8; ++j) {
        const LAS f32x4* wp = (const LAS f32x4*)(wl + (size_t)(4 * (lane_ + 64 * j)) * 8);
#pragma unroll
        for (int c = 0; c < 4; ++c) { const f32x4 w0 = wp[2 * c], w1 = wp[2 * c + 1]; const float x = v[j][c];
            lg[0] += x * w0.x; lg[1] += x * w0.y; lg[2] += x * w0.z; lg[3] += x * w0.w; lg[4] += x * w1.x; lg[5] += x * w1.y; lg[6] += x * w1.z; lg[7] += x * w1.w; }
    }
#pragma unroll
    for (int e = 0; e < 8; ++e) lg[e] = wave_sum(lg[e]) + br[e];
    int e1 = 0; float v1 = lg[0];
#pragma unroll
    for (int e = 1; e < 8; ++e) if (lg[e] > v1) { v1 = lg[e]; e1 = e; }
    int e2 = -1; float v2 = -3.0e38f;
#pragma unroll
    for (int e = 0; e < 8; ++e) if (e != e1 && lg[e] > v2) { v2 = lg[e]; e2 = e; }
    g2o = 1.0f / (1.0f + expf(v1 - v2)); g1o = 1.0f - g2o; e1o = e1; e2o = e2;
}
__device__ __forceinline__ void moe_route_pass(Frame& F, int layer) {
    const int lane_ = opq_v((TIDX & 63));
    int* rt = (int*)(F.ws + WS_ROUTE); float* rtf = (float*)(F.ws + WS_ROUTE);
    LAS float* ca = (LAS float*)F.lds; LAS float* cb = ca + 2048; LAS float* wl = ca + 4096;
    LAS int* le = (LAS int*)(F.lds + 16384 + 65536);
    const float* wr = inptr(I_MR); const float* br = inptr(I_MB);
    __syncthreads();
    for (int i = TIDX; i < 2048 * 8 / 4; i += 512) ((LAS f32x4*)wl)[i] = ((const GAS f32x4*)wr)[i];
    for (int blk = blockIdx.x; blk < 256; blk += F.G) {
        const int b = blk >> 5;
        __syncthreads();
        ffn_tables(F, layer, b, ca, cb);
        __syncthreads();
#pragma unroll 1
        for (int i = 0; i < 4; ++i) {
            const int tl = F.wave + 16 * i, tl1 = tl + 8, tok = moe_tok(blk, tl), tok1 = moe_tok(blk, tl1);
            f32x4 v0[8], v1[8]; ffn_u_pair(F, b * TPB + CTXL + (tok & 2047), b * TPB + CTXL + (tok1 & 2047), ca, cb, lane_, v0, v1);
            int e1, e2; float g1, g2;
            route_one(v0, wl, br, lane_, e1, e2, g1, g2);
            if (lane_ == 0) { le[tl] = e1 | (e2 << 8); rt[RT_E + tok] = e1 | (e2 << 8); rtf[RT_G + 2 * tok] = g1; rtf[RT_G + 2 * tok + 1] = g2; }
            route_one(v1, wl, br, lane_, e1, e2, g1, g2);
            if (lane_ == 0) { le[tl1] = e1 | (e2 << 8); rt[RT_E + tok1] = e1 | (e2 << 8); rtf[RT_G + 2 * tok1] = g1; rtf[RT_G + 2 * tok1 + 1] = g2; }
        }
        __syncthreads();
        if (TIDX < 8) { const int e = TIDX; int cnt = 0;
            for (int tl = 0; tl < 64; ++tl) { const int w = le[tl], a = w & 255, c = w >> 8;
                if (a == e) rt[RT_RANK + 2 * moe_tok(blk, tl)] = cnt++;
                if (c == e) rt[RT_RANK + 2 * moe_tok(blk, tl) + 1] = cnt++; }
            rt[RT_CNT + blk * 8 + e] = cnt; }
    }
    __syncthreads();
}
__device__ __forceinline__ void moe_tables(Frame& F, LAS int* tab, int blk) {
    const int* rt = (const int*)(F.ws + WS_ROUTE);
    __syncthreads();
    if (TIDX < 8) { const int e = TIDX; int tot = 0, before = 0;
        for (int k = 0; k < 256; ++k) { const int c = rt[RT_CNT + k * 8 + e]; tot += c; before += (k < blk) ? c : 0; }
        tab[e] = tot; tab[16 + e] = before; }
    __syncthreads();
    if (TIDX == 0) { int base = 0, pan = 0, nf = 0, nr = 0;
        for (int e = 0; e < 8; ++e) { tab[8 + e] = base; const int np = (tab[e] + 255) >> 8, fu = tab[e] >> 8; base += np * 256; pan += np; tab[32 + e] = pan;
            tab[48 + e] = nr; nf += fu; tab[40 + e] = nf; if (np != fu) { tab[64 + nr] = e; ++nr; } }
        tab[24] = pan; tab[56] = nf; tab[57] = nr; }
    __syncthreads();
}
__device__ __forceinline__ void moe_scatter_pass(Frame& F, int layer) {
    const int lane_ = opq_v((TIDX & 63));
    int* rt = (int*)(F.ws + WS_ROUTE); bf16* AS = (bf16*)(F.ws + WS_AS);
    LAS int* tab = (LAS int*)(F.lds + 16384); LAS float* ca = (LAS float*)F.lds; LAS float* cb = ca + 2048;
    for (int blk = blockIdx.x; blk < 256; blk += F.G) {
        const int b = blk >> 5;
        moe_tables(F, tab, blk);
        ffn_tables(F, layer, b, ca, cb);
        __syncthreads();
#pragma unroll 1
        for (int i = 0; i < 4; ++i) {
            const int tl = F.wave + 16 * i, tok = moe_tok(blk, tl), tok1 = moe_tok(blk, tl + 8);
            f32x4 v0[8], v1[8]; ffn_u_pair(F, b * TPB + CTXL + (tok & 2047), b * TPB + CTXL + (tok1 & 2047), ca, cb, lane_, v0, v1);
#pragma unroll
            for (int s = 0; s < 2; ++s) {
                const int tk = s ? tok1 : tok; const int w = rt[RT_E + tk], e1 = w & 255, e2 = w >> 8;
                const int p1 = tab[8 + e1] + tab[16 + e1] + rt[RT_RANK + 2 * tk], p2 = tab[8 + e2] + tab[16 + e2] + rt[RT_RANK + 2 * tk + 1];
                if (lane_ == 0) { rt[RT_POS + 2 * tk] = p1; rt[RT_POS + 2 * tk + 1] = p2; }
                if (MOE_FP8) {
                    GAS unsigned* q1 = (GAS unsigned*)((unsigned char*)AS + (size_t)p1 * DM) + lane_; GAS unsigned* q2 = (GAS unsigned*)((unsigned char*)AS + (size_t)p2 * DM) + lane_;
#pragma unroll
                    for (int j = 0; j < 8; ++j) { const f32x4 y = s ? v1[j] : v0[j]; const unsigned x = pg8::pk4_fp8(y.x, y.y, y.z, y.w); q1[64 * j] = x; q2[64 * j] = x; }
                    continue; }
                GAS v2u* o1 = (GAS v2u*)(AS + (size_t)p1 * DM) + lane_; GAS v2u* o2 = (GAS v2u*)(AS + (size_t)p2 * DM) + lane_;
#pragma unroll
                for (int j = 0; j < 8; ++j) { f32x4 y = s ? v1[j] : v0[j]; if (EMU_FP8) { y.x = pg8::fp8r(y.x); y.y = pg8::fp8r(y.y); y.z = pg8::fp8r(y.z); y.w = pg8::fp8r(y.w); } v2u x; x.x = pg8::cvt_pk_bf16(y.x, y.y); x.y = pg8::cvt_pk_bf16(y.z, y.w); o1[64 * j] = x; o2[64 * j] = x; }
            }
        }
        for (int e = 0; e < 8; ++e) { const int tot = tab[e], end = (tot + 255) & ~255;
            for (int pr = tot + blk * 8 + F.wave; pr < end; pr += 2048) {
                if (MOE_FP8) { GAS unsigned* o = (GAS unsigned*)((unsigned char*)AS + (size_t)(tab[8 + e] + pr) * DM) + lane_;
#pragma unroll
                    for (int j = 0; j < 8; ++j) o[64 * j] = 0u; continue; }
                GAS v2u* o = (GAS v2u*)(AS + (size_t)(tab[8 + e] + pr) * DM) + lane_;
#pragma unroll
                for (int j = 0; j < 8; ++j) o[64 * j] = (v2u){0u, 0u}; } }
    }
    __syncthreads();
}
__device__ __forceinline__ void final_pass(Frame& F, int layer) {
    const int lane_ = opq_v((TIDX & 63));
    const int* rt = (const int*)(F.ws + WS_ROUTE); const float* rtf = (const float*)(F.ws + WS_ROUTE);
    const bf16* Y = (const bf16*)(F.ws + WS_Y); const float* H = (const float*)(F.ws + WS_H); const float* SL = (const float*)(F.ws + WS_U);
    const float* modl = (const float*)(F.ws + WS_MOD) + (size_t)layer * 9 * MODW;
    LAS int* tab = (LAS int*)(F.lds);
    moe_tables(F, tab, 0);
    for (int tok = F.gw; tok < NBATCH * SEQ; tok += F.NGW) {
        const int b = tok >> 11, t = tok & 2047, r = b * TPB + CTXL + t;
        const int ee = rt[RT_E + tok]; const float g1 = rtf[RT_G + 2 * tok], g2 = rtf[RT_G + 2 * tok + 1];
        const GAS f32x4* xr = (const GAS f32x4*)(H + (size_t)r * DM) + lane_;
        const GAS f32x4* gt = (const GAS f32x4*)(modl + (size_t)b * MODW + 5 * DM) + lane_;
        f32x4 y[8], v[8];
#pragma unroll
        for (int j = 0; j < 8; ++j) { y[j] = (f32x4){0.f, 0.f, 0.f, 0.f}; v[j] = xr[64 * j]; }
#pragma unroll 1
        for (int s = 0; s < 2; ++s) {
            const int e = s ? (ee >> 8) : (ee & 255), p = rt[RT_POS + 2 * tok + s]; const float g = s ? g2 : g1;
            const int loc = p - tab[8 + e], fu = tab[e] >> 8;
            if (loc < 256 * fu) {
                const GAS v2u* yp = (const GAS v2u*)(Y + (size_t)p * DM) + lane_;
#pragma unroll
                for (int j = 0; j < 8; ++j) { const v2u a = yp[64 * j]; y[j] += (f32x4){bflo(a.x), bfhi(a.x), bflo(a.y), bfhi(a.y)} * g; }
            } else {
                const int rr = tab[48 + e], row = loc - 256 * fu;
#pragma unroll
                for (int ks = 0; ks < 4; ++ks) { const GAS f32x4* sp = (const GAS f32x4*)(SL + ((size_t)(ks * 8 + rr) * 256 + row) * DM) + lane_;
#pragma unroll
                    for (int j = 0; j < 8; ++j) y[j] += sp[64 * j] * g; }
            }
        }
        float ss = 0.f;
#pragma unroll
        for (int j = 0; j < 8; ++j) { v[j] = v[j] + gt[64 * j] * y[j]; ss += (v[j].x * v[j].x + v[j].y * v[j].y) + (v[j].z * v[j].z + v[j].w * v[j].w); }
        const float rstd = 1.0f / sqrtf(wave_sum(ss) * (1.0f / DM) + EPSN);
        const GAS f32x4* gf = (const GAS f32x4*)inptr(I_GFIN) + lane_;
        GAS f32x4* op = (GAS f32x4*)(F.out + (size_t)tok * DM) + lane_;
#pragma unroll
        for (int j = 0; j < 8; ++j) op[64 * j] = v[j] * rstd * gf[64 * j];
    }
}

namespace fa {
using bf16x8 = __attribute__((ext_vector_type(8))) short;
using s16x4  = __attribute__((ext_vector_type(4))) short;
using f32x16 = __attribute__((ext_vector_type(16))) float;
using u32x4  = __attribute__((ext_vector_type(4))) unsigned;
constexpr int SHM_V = 64 * 128 * 2;
constexpr float THRN = 8.f;
#define FA_SBAR() __builtin_amdgcn_sched_barrier(0)
__device__ __forceinline__ int kswz(int row, int colB, int pitch) { return row * pitch + (colB ^ ((row & 7) << 4)); }
__device__ __forceinline__ int crow(int r, int hi) { return (r & 3) + 8 * (r >> 2) + 4 * hi; }
__device__ __forceinline__ unsigned cvtpk(float lo, float hi) { unsigned r; asm volatile("v_cvt_pk_bf16_f32 %0, %1, %2" : "=v"(r) : "v"(lo), "v"(hi)); return r; }

__device__ __forceinline__ void partialSM(f32x16& p0, f32x16& p1, float& m_reg, float& mn, float& alpha, const float C, const float thr_raw) {
  float pmax = p0[0];
#pragma unroll
  for (int r = 1; r < 16; ++r) pmax = fmaxf(pmax, p0[r]);
#pragma unroll
  for (int r = 0; r < 16; ++r) pmax = fmaxf(pmax, p1[r]);
  { auto rr = __builtin_amdgcn_permlane32_swap(__float_as_uint(pmax), __float_as_uint(pmax), false, false);
    pmax = fmaxf(__uint_as_float(rr[0]), __uint_as_float(rr[1])); }
  if (__builtin_expect(__all(pmax - m_reg <= thr_raw), 1)) { mn = m_reg; alpha = 1.f; }
  else { mn = fmaxf(m_reg, pmax); alpha = __builtin_amdgcn_exp2f((m_reg - mn) * C); m_reg = mn; }
  const float mnC = -mn * C;
#pragma unroll
  for (int r = 0; r < 16; ++r) p0[r] = fmaf(p0[r], C, mnC);
#pragma unroll
  for (int r = 0; r < 16; ++r) p1[r] = fmaf(p1[r], C, mnC);
#pragma unroll
  for (int r = 0; r < 16; ++r) p0[r] = __builtin_amdgcn_exp2f(p0[r]);
}
__device__ __forceinline__ void finishSM(f32x16& p0, f32x16& p1, float alpha, float& l_reg, bf16x8& pa0, bf16x8& pa1, bf16x8& pa2, bf16x8& pa3) {
#pragma unroll
  for (int r = 0; r < 16; ++r) p1[r] = __builtin_amdgcn_exp2f(p1[r]);
  float ps = 0;
#pragma unroll
  for (int r = 0; r < 16; ++r) ps += p0[r];
#pragma unroll
  for (int r = 0; r < 16; ++r) ps += p1[r];
  { auto rr = __builtin_amdgcn_permlane32_swap(__float_as_uint(ps), __float_as_uint(ps), false, false);
    ps = __uint_as_float(rr[0]) + __uint_as_float(rr[1]); }
  l_reg = l_reg * alpha + ps;
#define FA_PK4(P, BASE, OUT) do { unsigned a0 = cvtpk(P[BASE + 0], P[BASE + 1]), a1 = cvtpk(P[BASE + 2], P[BASE + 3]);   \
    unsigned b0 = cvtpk(P[BASE + 4], P[BASE + 5]), b1 = cvtpk(P[BASE + 6], P[BASE + 7]);                              \
    auto r0 = __builtin_amdgcn_permlane32_swap(a0, b0, false, false); auto r1 = __builtin_amdgcn_permlane32_swap(a1, b1, false, false); \
    u32x4 w = {r0[0], r1[0], r0[1], r1[1]}; OUT = __builtin_bit_cast(bf16x8, w); } while (0)
  FA_PK4(p0, 0, pa0); FA_PK4(p0, 8, pa1); FA_PK4(p1, 0, pa2); FA_PK4(p1, 8, pa3);
#undef FA_PK4
}
template <int DK>
__device__ __forceinline__ void qkt(f32x16& p0, f32x16& p1, const LAS unsigned char* Ks, const bf16x8 (&qr)[DK / 16], int r32, int hi) {
  p0 = f32x16{}; p1 = f32x16{};
#pragma unroll
  for (int d0 = 0; d0 < DK / 16; ++d0) { const int cb = (d0 * 16 + hi * 8) * 2;
    const bf16x8 b0 = *(const LAS bf16x8*)(Ks + kswz(r32, cb, DK * 2));
    const bf16x8 b1 = *(const LAS bf16x8*)(Ks + kswz(32 + r32, cb, DK * 2));
    p0 = __builtin_amdgcn_mfma_f32_32x32x16_bf16(b0, qr[d0], p0, 0, 0, 0);
    p1 = __builtin_amdgcn_mfma_f32_32x32x16_bf16(b1, qr[d0], p1, 0, 0, 0); }
}
__device__ __forceinline__ int v_st(int k, int c) { const int kk = (k & ~0xC) | ((k & 4) << 1) | ((k & 8) >> 1); return ((kk >> 3) * 4 + (c >> 5)) * 512 + ((kk & 7) * 32 + (c & 31)) * 2; }
__device__ __forceinline__ int v_rd_base(int lane) { return ((lane & 3) << 3) | (((lane >> 2) & 3) << 6) | (((lane >> 4) & 1) << 5) | (((lane >> 5) & 1) << 8); }
constexpr int v_rd_off(int d0, int ks, int half) { return d0 * 512 + ks * 4096 + half * 2048; }
template <int OFF> __device__ __forceinline__ s16x4 tr_read(int vb) {
  s16x4 r; asm volatile("ds_read_b64_tr_b16 %0, %1 offset:%2" : "=&v"(r) : "v"(vb), "i"(OFF) : "memory"); return r;
}
template <int D0> __device__ __forceinline__ void pv_one(f32x16& od, int vb, bf16x8 pa0, bf16x8 pa1, bf16x8 pa2, bf16x8 pa3) {
  const s16x4 l0 = tr_read<v_rd_off(D0, 0, 0)>(vb), h0 = tr_read<v_rd_off(D0, 0, 1)>(vb), l1 = tr_read<v_rd_off(D0, 1, 0)>(vb), h1 = tr_read<v_rd_off(D0, 1, 1)>(vb);
  const s16x4 l2 = tr_read<v_rd_off(D0, 2, 0)>(vb), h2 = tr_read<v_rd_off(D0, 2, 1)>(vb), l3 = tr_read<v_rd_off(D0, 3, 0)>(vb), h3 = tr_read<v_rd_off(D0, 3, 1)>(vb);
  asm volatile("s_waitcnt lgkmcnt(0)" ::: "memory"); FA_SBAR();
#define FA_PK(L, H) (bf16x8){L[0], L[1], L[2], L[3], H[0], H[1], H[2], H[3]}
  od = __builtin_amdgcn_mfma_f32_32x32x16_bf16(pa0, FA_PK(l0, h0), od, 0, 0, 0);
  od = __builtin_amdgcn_mfma_f32_32x32x16_bf16(pa1, FA_PK(l1, h1), od, 0, 0, 0);
  od = __builtin_amdgcn_mfma_f32_32x32x16_bf16(pa2, FA_PK(l2, h2), od, 0, 0, 0);
  od = __builtin_amdgcn_mfma_f32_32x32x16_bf16(pa3, FA_PK(l3, h3), od, 0, 0, 0);
#undef FA_PK
}
__device__ __forceinline__ void pv_d0(f32x16 (&o)[4], int vb, bf16x8 pa0, bf16x8 pa1, bf16x8 pa2, bf16x8 pa3) {
  pv_one<0>(o[0], vb, pa0, pa1, pa2, pa3); pv_one<1>(o[1], vb, pa0, pa1, pa2, pa3); pv_one<2>(o[2], vb, pa0, pa1, pa2, pa3); pv_one<3>(o[3], vb, pa0, pa1, pa2, pa3);
}

struct TileMap { int k0, lat0, r_lo; bool na;
  __device__ __forceinline__ int row(int j) const { if (!na || j < 4) return k0 + 64 * j; const int g = min(r_lo + j - 4, 31); return lat0 + 64 * g; } };
struct NaLane { int qr, qc, rs, cs; const LAS float* btab; };

__device__ __forceinline__ void na_mask(f32x16& p0, f32x16& p1, int j, const TileMap& tm, const NaLane& nl, int hi) {
  if (j < 4) return;
  const int kr = tm.r_lo + j - 4; const bool rowok = (kr >= nl.rs) && (kr < nl.rs + 8);
  const int b0 = (kr - nl.qr + 7) * 31 + 15 - nl.qc;
#pragma unroll
  for (int r = 0; r < 16; ++r) {
    const int kc0 = crow(r, hi), kc1 = 32 + kc0;
    const bool ok0 = rowok && (kc0 >= nl.cs) && (kc0 < nl.cs + 16), ok1 = rowok && (kc1 >= nl.cs) && (kc1 < nl.cs + 16);
    float bv0 = 0.f, bv1 = 0.f; if (ok0) bv0 = nl.btab[b0 + kc0]; if (ok1) bv1 = nl.btab[b0 + kc1];
    p0[r] = ok0 ? p0[r] + bv0 : -1e30f; p1[r] = ok1 ? p1[r] + bv1 : -1e30f;
  }
}

template <int DK, int SDEPTH, bool NA>
__device__ __forceinline__ void body(const bf16* Qb, int ldq, const bf16* Kp, int ldk, const bf16* Vp, int ldv, const TileMap tm, const int NT, const float scale,
                                     const NaLane nl, LAS unsigned char* lds, f32x16 (&o)[4]) {
  constexpr int KP = DK / 64, SHM_K = 64 * DK * 2, KCH = DK / 8;
  int tid = threadIdx.x; asm volatile("" : "+v"(tid));
  const int wid = tid >> 6, lane = tid & 63, r32 = lane & 31, hi = lane >> 5;
  LAS unsigned char* V_lds = lds; LAS unsigned char* K_lds = lds + 2 * SHM_V;
  LAS float* wsl = (LAS float*)(lds + 2 * SHM_V + 2 * SHM_K) + wid * 64; LAS float* li_l = wsl; LAS float* al_l = wsl + 32;
  const float C = scale * 1.4426950408889634f, thr_raw = THRN / scale;
  float m_reg = -1e30f, l_reg = 0;
#pragma unroll
  for (int d = 0; d < 4; ++d) o[d] = f32x16{};
  bf16x8 qr[DK / 16];
  { const bf16* Qw = Qb + (long)(wid * 32 + r32) * ldq + hi * 8;
#pragma unroll
    for (int d0 = 0; d0 < DK / 16; ++d0) qr[d0] = *(const GAS bf16x8*)(Qw + d0 * 16); }
  const int sr = tid >> 4, sc = (tid & 15) * 8, vst0 = v_st(sr, sc), vst1 = v_st(32 + sr, sc);
  int krow[KP], kcol[KP], kst[KP];
#pragma unroll
  for (int i = 0; i < KP; ++i) { const int c = tid + 512 * i; krow[i] = c / KCH; kcol[i] = (c % KCH) * 8; kst[i] = kswz(krow[i], kcol[i] * 2, DK * 2); }
  const int vb0 = (int)(unsigned)(unsigned long)(V_lds) + v_rd_base(lane);
  struct Slot { bf16x8 vs0, vs1, ks[KP]; } sl[SDEPTH];
#define FA_SLOAD(i, j) do { const int r0_ = tm.row(j); sl[i].vs0 = *(const GAS bf16x8*)(Vp + (long)(r0_ + sr) * ldv + sc); sl[i].vs1 = *(const GAS bf16x8*)(Vp + (long)(r0_ + 32 + sr) * ldv + sc); \
    _Pragma("unroll") for (int q_ = 0; q_ < KP; ++q_) sl[i].ks[q_] = *(const GAS bf16x8*)(Kp + (long)(r0_ + krow[q_]) * ldk + kcol[q_]); } while (0)
#define FA_SWRITE(b, i) do { *(LAS bf16x8*)(V_lds + (b) * SHM_V + vst0) = sl[i].vs0; *(LAS bf16x8*)(V_lds + (b) * SHM_V + vst1) = sl[i].vs1; \
    _Pragma("unroll") for (int q_ = 0; q_ < KP; ++q_) *(LAS bf16x8*)(K_lds + (b) * SHM_K + kst[q_]) = sl[i].ks[q_]; } while (0)
#define FA_SWAIT() do { if constexpr (SDEPTH == 2) asm volatile("s_waitcnt vmcnt(%0)" :: "n"(2 + KP) : "memory"); else asm volatile("s_waitcnt vmcnt(0)" ::: "memory"); } while (0)
#define FA_RESC(a) do { if (__any((a) < 1.f)) { if (hi == 0) al_l[r32] = (a); asm volatile("s_waitcnt lgkmcnt(0)" ::: "memory"); \
    _Pragma("unroll") for (int d = 0; d < 4; ++d) _Pragma("unroll") for (int r = 0; r < 16; ++r) o[d][r] *= al_l[crow(r, hi)]; } } while (0)
#define FA_QKT(P0, P1, buf, j) do { qkt<DK>(P0, P1, K_lds + (buf) * SHM_K, qr, r32, hi); if constexpr (NA) na_mask(P0, P1, j, tm, nl, hi); } while (0)
  f32x16 pA0, pA1, pB0, pB1; float mnA, mnB, alA, alB; bf16x8 pa0, pa1, pa2, pa3;
  constexpr int SE = 0, SO = SDEPTH - 1;
  FA_SLOAD(SE, 0); asm volatile("s_waitcnt vmcnt(0)" ::: "memory"); FA_SWRITE(0, SE); __syncthreads();
  FA_QKT(pA0, pA1, 0, 0); partialSM(pA0, pA1, m_reg, mnA, alA, C, thr_raw);
  FA_SLOAD(SO, 1); if constexpr (SDEPTH == 2) { if (2 < NT) FA_SLOAD(SE, 2); }
  FA_SWAIT(); FA_SWRITE(1, SO); __syncthreads();
  for (int j = 1; j + 1 < NT; j += 2) {
    FA_SBAR(); FA_QKT(pB0, pB1, 1, j);
    finishSM(pA0, pA1, alA, l_reg, pa0, pa1, pa2, pa3); FA_SBAR();
    FA_SLOAD(SO, j + SDEPTH); FA_SBAR();
    pv_d0(o, vb0, pa0, pa1, pa2, pa3); partialSM(pB0, pB1, m_reg, mnB, alB, C, thr_raw);
    __syncthreads(); FA_SWAIT(); FA_SWRITE(0, SE);
    FA_RESC(alB); __syncthreads();
    FA_SBAR(); FA_QKT(pA0, pA1, 0, j + 1);
    finishSM(pB0, pB1, alB, l_reg, pa0, pa1, pa2, pa3); FA_SBAR();
    if (SDEPTH == 1 || j + 3 < NT) FA_SLOAD(SE, j + 1 + SDEPTH); FA_SBAR();
    pv_d0(o, vb0 + SHM_V, pa0, pa1, pa2, pa3); partialSM(pA0, pA1, m_reg, mnA, alA, C, thr_raw);
    __syncthreads(); FA_SWAIT(); FA_SWRITE(1, SO);
    FA_RESC(alA); __syncthreads();
  }
  FA_SBAR(); FA_QKT(pB0, pB1, 1, NT - 1);
  finishSM(pA0, pA1, alA, l_reg, pa0, pa1, pa2, pa3); FA_SBAR();
  pv_d0(o, vb0, pa0, pa1, pa2, pa3); partialSM(pB0, pB1, m_reg, mnB, alB, C, thr_raw);
  __syncthreads(); FA_RESC(alB);
  finishSM(pB0, pB1, alB, l_reg, pa0, pa1, pa2, pa3); FA_SBAR();
  pv_d0(o, vb0 + SHM_V, pa0, pa1, pa2, pa3);
  if (hi == 0) li_l[r32] = l_reg; asm volatile("s_waitcnt lgkmcnt(0)" ::: "memory");
#pragma unroll
  for (int r = 0; r < 16; ++r) { const float rl = __builtin_amdgcn_rcpf(li_l[crow(r, hi)]);
#pragma unroll
    for (int d0 = 0; d0 < 4; ++d0) o[d0][r] *= rl; }
#undef FA_SLOAD
#undef FA_SWRITE
#undef FA_SWAIT
#undef FA_RESC
#undef FA_QKT
}

template <int DK, bool NA>
__device__ __forceinline__ void body_seq(const bf16* Qb, int ldq, const bf16* Kp, int ldk, const bf16* Vp, int ldv, const TileMap tm, const int NT, const float scale,
                                         const NaLane nl, LAS unsigned char* lds, f32x16 (&o)[4]) {
  constexpr int KP = DK / 64, SHM_K = 64 * DK * 2, KCH = DK / 8;
  int tid = threadIdx.x; asm volatile("" : "+v"(tid));
  const int wid = tid >> 6, lane = tid & 63, r32 = lane & 31, hi = lane >> 5;
  LAS unsigned char* V_lds = lds; LAS unsigned char* K_lds = lds + 2 * SHM_V;
  LAS float* wsl = (LAS float*)(lds + 2 * SHM_V + 2 * SHM_K) + wid * 64; LAS float* li_l = wsl; LAS float* al_l = wsl + 32;
  const float C = scale * 1.4426950408889634f, thr_raw = THRN / scale;
  float m_reg = -1e30f, l_reg = 0;
#pragma unroll
  for (int d = 0; d < 4; ++d) o[d] = f32x16{};
  bf16x8 qr[DK / 16];
  { const bf16* Qw = Qb + (long)(wid * 32 + r32) * ldq + hi * 8;
#pragma unroll
    for (int d0 = 0; d0 < DK / 16; ++d0) qr[d0] = *(const GAS bf16x8*)(Qw + d0 * 16); }
  const int sr = tid >> 4, sc = (tid & 15) * 8, vst0 = v_st(sr, sc), vst1 = v_st(32 + sr, sc);
  int krow[KP], kcol[KP], kst[KP];
#pragma unroll
  for (int i = 0; i < KP; ++i) { const int c = tid + 512 * i; krow[i] = c / KCH; kcol[i] = (c % KCH) * 8; kst[i] = kswz(krow[i], kcol[i] * 2, DK * 2); }
  const int vb0 = (int)(unsigned)(unsigned long)(V_lds) + v_rd_base(lane);
  bf16x8 vs0, vs1, ks[KP];
#define FS_SLOAD(j) do { const int r0_ = tm.row(j); vs0 = *(const GAS bf16x8*)(Vp + (long)(r0_ + sr) * ldv + sc); vs1 = *(const GAS bf16x8*)(Vp + (long)(r0_ + 32 + sr) * ldv + sc); \
    _Pragma("unroll") for (int q_ = 0; q_ < KP; ++q_) ks[q_] = *(const GAS bf16x8*)(Kp + (long)(r0_ + krow[q_]) * ldk + kcol[q_]); } while (0)
#define FS_SWRITE(b) do { *(LAS bf16x8*)(V_lds + (b) * SHM_V + vst0) = vs0; *(LAS bf16x8*)(V_lds + (b) * SHM_V + vst1) = vs1; \
    _Pragma("unroll") for (int q_ = 0; q_ < KP; ++q_) *(LAS bf16x8*)(K_lds + (b) * SHM_K + kst[q_]) = ks[q_]; } while (0)
  FS_SLOAD(0); FS_SWRITE(0); __syncthreads();
#pragma unroll 1
  for (int j = 0; j < NT; ++j) {
    const int b = j & 1;
    if (j + 1 < NT) FS_SLOAD(j + 1);
    f32x16 p0, p1; float mn, al; bf16x8 pa0, pa1, pa2, pa3;
    qkt<DK>(p0, p1, K_lds + b * SHM_K, qr, r32, hi);
    if constexpr (NA) na_mask(p0, p1, j, tm, nl, hi);
    partialSM(p0, p1, m_reg, mn, al, C, thr_raw);
    finishSM(p0, p1, al, l_reg, pa0, pa1, pa2, pa3);
    if (__any(al < 1.f)) { if (hi == 0) al_l[r32] = al; asm volatile("s_waitcnt lgkmcnt(0)" ::: "memory");
#pragma unroll
      for (int d = 0; d < 4; ++d)
#pragma unroll
        for (int r = 0; r < 16; ++r) o[d][r] *= al_l[crow(r, hi)]; }
    FA_SBAR();
    pv_d0(o, vb0 + b * SHM_V, pa0, pa1, pa2, pa3);
    if (j + 1 < NT) FS_SWRITE(b ^ 1);
    __syncthreads();
  }
  if (hi == 0) li_l[r32] = l_reg; asm volatile("s_waitcnt lgkmcnt(0)" ::: "memory");
#pragma unroll
  for (int r = 0; r < 16; ++r) { const float rl = __builtin_amdgcn_rcpf(li_l[crow(r, hi)]);
#pragma unroll
    for (int d0 = 0; d0 < 4; ++d0) o[d0][r] *= rl; }
#undef FS_SLOAD
#undef FS_SWRITE
}
}

__device__ __forceinline__ void fa_store(const fa::f32x16 (&o)[4], LAS unsigned char* lds, bf16* Orow0  , bool do_norm, const float* gsub, float post) {
    int tid = threadIdx.x; asm volatile("" : "+v"(tid));
    const int wid = tid >> 6, lane = tid & 63, r32 = lane & 31, hi = lane >> 5;
    LAS float* slab = (LAS float*)(lds + wid * 16384);
    __syncthreads();
#pragma unroll
    for (int r = 0; r < 16; ++r) { const int row = fa::crow(r, hi);
#pragma unroll
        for (int d0 = 0; d0 < 4; ++d0) slab[row * 128 + d0 * 32 + r32] = o[d0][r]; }
    LDS_WAIT();
    const int row = lane >> 1, half = lane & 1;
    const LAS f32x4* src = (const LAS f32x4*)(slab + row * 128 + half * 64);
    f32x4 v[16]; float ss = 0.f;
#pragma unroll
    for (int c = 0; c < 16; ++c) { v[c] = src[c]; ss += (v[c].x * v[c].x + v[c].y * v[c].y) + (v[c].z * v[c].z + v[c].w * v[c].w); }
    float sc = 1.0f;
    if (do_norm) { ss += __shfl_xor(ss, 1); sc = post / sqrtf(ss * (1.0f / 128.0f) + EPSN);
#pragma unroll
        for (int c = 0; c < 16; ++c) v[c] = v[c] * *(const GAS f32x4*)(gsub + half * 64 + 4 * c); }
    GAS v4u* dst = (GAS v4u*)(Orow0 + (size_t)(wid * 32 + row) * DM + half * 64);
#pragma unroll
    for (int c = 0; c < 8; ++c) { const f32x4 a = v[2 * c] * sc, b = v[2 * c + 1] * sc; v4u w; w.x = pk2(a.x, a.y); w.y = pk2(a.z, a.w); w.z = pk2(b.x, b.y); w.w = pk2(b.z, b.w); dst[c] = w; }
    __syncthreads();
}

__device__ __forceinline__ void attn_unit_fa(Frame& F, int layer, int b, bool latent, int qb, int type, int h) {
    unsigned char* ws = F.ws;
    const bf16* QKV = (const bf16*)(ws + WS_QKV); const bf16* QM = (const bf16*)(ws + WS_QM); const bf16* KVM = (const bf16*)(ws + WS_KVM); bf16* O = (bf16*)(ws + WS_O);
    const int q0 = b * TPB + (latent ? CTXL + qb * 256 : 0);
    const int kall0 = b * TPB, ntall = latent ? TPB / 64 : CTXL / 64;
    bf16* orow0 = O + (size_t)q0 * DM + type * 512 + h * 128;
    fa::TileMap tm; tm.k0 = kall0; tm.lat0 = kall0 + CTXL; tm.r_lo = 0; tm.na = false;
    fa::NaLane nl; nl.qr = 0; nl.qc = 0; nl.rs = 0; nl.cs = 0; nl.btab = nullptr;
    fa::f32x16 o[4];
#ifdef FA_ONLY
    type = FA_ONLY; if (FA_ONLY != 4) latent = FA_ONLY != 0 ? latent : false; else { type = 0; latent = true; }
#endif
    if (type == 0 && latent) {
        const int r_lo = min(max(4 * qb - 4, 0), 24), r_hi = min(max(4 * qb + 3 - 4, 0), 24) + 8;
        tm.na = true; tm.r_lo = r_lo; int nt = 4 + (r_hi - r_lo); nt += nt & 1;
        LAS float* bt = (LAS float*)(F.lds + 100 * 1024);
        const float* bsrc = inptr(I_NABIAS) + ((size_t)layer * 4 + h) * 465;
        __syncthreads();
        for (int i = TIDX; i < 465; i += 512) bt[i] = bsrc[i] * (1.0f / SC_NA);
        __syncthreads();
        const int t = qb * 256 + (TIDX >> 6) * 32 + (TIDX & 31);
        nl.qr = t >> 6; nl.qc = t & 63; nl.rs = min(max(nl.qr - 4, 0), 24); nl.cs = min(max(nl.qc - 8, 0), 48); nl.btab = bt;
        fa::body_seq<128, true>(QKV + (size_t)q0 * INCP + C_NAQ + 128 * h, INCP, QKV + C_NAK + 128 * h, INCP, QKV + C_NAV + 128 * h, INCP, tm, nt, SC_NA, nl, F.lds, o);
        fa_store(o, F.lds, orow0, false, nullptr, 1.0f);
    } else if (type == 0 || type == 2) {
        const int qc = (type == 0) ? C_NAQ + 128 * h : C_GQ + 128 * h, kc = (type == 0) ? C_NAK + 128 * h : C_GK + 128 * (h >> 1), vc = (type == 0) ? C_NAV + 128 * h : C_GV + 128 * (h >> 1);
        fa::body<128, 2, false>(QKV + (size_t)q0 * INCP + qc, INCP, QKV + kc, INCP, QKV + vc, INCP, tm, ntall, SC_NA, nl, F.lds, o);
        fa_store(o, F.lds, orow0, false, nullptr, 1.0f);
    } else if (type == 1) {
        fa::body_seq<192, false>(QM + (size_t)q0 * QMW + 192 * h, QMW, KVM + 320 * h, KVW, KVM + 320 * h + 192, KVW, tm, ntall, SC_MLA, nl, F.lds, o);
        fa_store(o, F.lds, orow0, false, nullptr, 1.0f);
    } else {
        const float lam_init = layer == 0 ? 0.2f : 0.35550906759096926f;
        LAS float* lm = (LAS float*)(F.lds + 100 * 1024);
        __syncthreads();
        if (TIDX < 64) { const float a = wave_sum(inptr(I_LQ1)[layer * 64 + TIDX] * inptr(I_LK1)[layer * 64 + TIDX]), c = wave_sum(inptr(I_LQ2)[layer * 64 + TIDX] * inptr(I_LK2)[layer * 64 + TIDX]);
            if (TIDX == 0) lm[0] = expf(a) - expf(c) + lam_init; }
        __syncthreads();
        const float lam = lm[0];
        GAS f32x4* stash = (GAS f32x4*)((float*)(ws + WS_U) + ((size_t)blockIdx.x * 512 + TIDX) * 64);
#pragma unroll 1
        for (int pass = 0; pass < 2; ++pass) {
            fa::body<64, 2, false>(QKV + (size_t)q0 * INCP + C_DQ + 128 * h + 64 * pass, INCP, QKV + C_DK + 128 * h + 64 * pass, INCP, QKV + C_DV + 128 * h, INCP, tm, ntall, SC_DIFF, nl, F.lds, o);
            if (pass == 0) {
#pragma unroll
                for (int d0 = 0; d0 < 4; ++d0)
#pragma unroll
                    for (int r4 = 0; r4 < 4; ++r4) stash[d0 * 4 + r4] = (f32x4){o[d0][4 * r4], o[d0][4 * r4 + 1], o[d0][4 * r4 + 2], o[d0][4 * r4 + 3]};
                __syncthreads();
            }
        }
#pragma unroll
        for (int d0 = 0; d0 < 4; ++d0)
#pragma unroll
            for (int r4 = 0; r4 < 4; ++r4) { const f32x4 s1 = stash[d0 * 4 + r4];
#pragma unroll
                for (int q = 0; q < 4; ++q) o[d0][4 * r4 + q] = s1[q] - lam * o[d0][4 * r4 + q]; }
        fa_store(o, F.lds, orow0, true, inptr(I_GSUB) + layer * 128, 1.0f - lam_init);
    }
}
#ifndef ATTN_Q0
#define ATTN_Q0 0
#endif
#ifndef ATTN_Q1
#define ATTN_Q1 0
#endif
__device__ __forceinline__ void attn_phase_fa(Frame& F, int layer) {
    const int total = 1024 + ((layer == 0) ? 128 : 0);
#pragma unroll 1
    for (int n = blockIdx.x; n < total; n += F.G) {
        int type, h, qb, b; bool latent = n < 1024;
        if (latent) { const int i = n >> 8, k = n & 255, idx = i * 64 + (k >> 2); type = (k + i) & 3; h = idx & 3; qb = (idx >> 2) & 7; b = idx >> 5; }
        else { const int v = n - 1024, hh = v & 15; type = hh >> 2; h = hh & 3; qb = 0; b = v >> 4; }
        attn_unit_fa(F, layer, b, latent, qb, type, h);
        if (ATTN_Q0 + ATTN_Q1 > 0) filler_quota(F, layer == 0 ? ATTN_Q0 : ATTN_Q1);
    }
    __syncthreads();
}

#ifndef REP_GEMM
#define REP_GEMM 1
#endif
#ifndef REP_WIN
#define REP_WIN REP_GEMM
#endif
#ifndef REP_FGU
#define REP_FGU REP_GEMM
#endif
#ifndef REP_PASS
#define REP_PASS 1
#endif
#ifndef WO_WGM
#define WO_WGM 4
#endif
#ifndef REV_DOWN
#define REV_DOWN 1
#endif
#ifndef FD_WGM
#define FD_WGM 4
#endif
#ifndef PROBE_HOTB
#define PROBE_HOTB 0
#endif
#ifndef PROBE_LATE_DENSE
#define PROBE_LATE_DENSE 0
#endif
#ifndef REP_FDN
#define REP_FDN REP_GEMM
#endif
#ifndef REP_MGU
#define REP_MGU REP_GEMM
#endif
#ifndef REP_MDN
#define REP_MDN REP_GEMM
#endif
#ifndef REP_ATTN
#define REP_ATTN 1
#endif
#ifndef REP_P0
#define REP_P0 1
#endif
#ifndef MK_MULTI
#define MK_MULTI 0
#endif
constexpr int PH_PER_LAYER = 11, N_PHASES = 1 + 2 * PH_PER_LAYER + 1;
struct Args { const float* in[31]; float* out; unsigned char* ws; int ph_lo, ph_hi; };
static_assert(sizeof(Args) == 31 * 8 + 8 + 8 + 8, "Args has no padding");

#define IN(k) (lo <= (k) && (k) < hi)
#if MK_MULTI
#define SEAM(k) do { } while (0)
#else
#define SEAM(k) do { if (IN(k) && IN((k) + 1)) xcd_barrier(bar); } while (0)
#endif
__device__ __forceinline__ int opq_s(int v) { asm volatile("" : "+s"(v)); return v; }
template <int layer>
__device__ __forceinline__ void layer_phases(Frame& F, const XcdBarrier& bar, const int lo, const int hi, LAS int* mtab) {
    unsigned char* ws = F.ws; asm volatile("" : "+s"(ws));
        const int pb = 1 + layer * PH_PER_LAYER;
        const float* modl = (const float*)(ws + WS_MOD) + (size_t)layer * 9 * MODW;
#ifndef SKIP_NORM
        if (IN(pb + 0)) for (int rp_ = 0; rp_ < REP_PASS; ++rp_) norm_pass(F, layer, true, layer == 0);
#endif
        SEAM(pb + 0);
        if (IN(pb + 1)) {
            pg8::Gemm g{(const bf16*)(ws + WS_U), (const bf16*)(ws + WS_WIN) + (size_t)layer * INCP * 2048, MT, INCP, 2048, 2048, 2048};
            pg8::StaticOrder S; S.init(MT, INCP, F.G, opq_s((int)blockIdx.x));
            pg8::EpiBf16P E{(bf16*)(ws + WS_QKV), INCP, 0};
            for (int rep_ = 0; rep_ < REP_WIN; ++rep_) { pg8::gemm_phase<pg8::EpiBf16P, pg8::StaticOrder, PG8_ALIGN, PG8_SP2>(F.lds + RING_OFF, g, S, E); if (rep_ + 1 < REP_WIN) __syncthreads(); }
            filler(F, layer * 8 + 0, -1);
        }
        SEAM(pb + 1);
#ifndef SKIP_POST
        if (IN(pb + 2)) post_pass(F, layer);
#endif
        SEAM(pb + 2);
#ifndef SKIP_UP
        if (IN(pb + 3)) {
            { pg8::Gemm g{(const bf16*)(ws + WS_QKV) + C_CQ, (const bf16*)(ws + WS_WQUP) + (size_t)layer * QMW * 384, MT, QMW, opq_s(384), INCP, 384};
              pg8::StaticOrder S; S.init(MT, QMW, F.G, opq_s((int)blockIdx.x));
              pg8::EpiQupRope E{(bf16*)(ws + WS_QM), (const float*)(ws + WS_ROPE)};
              for (int rep_ = 0; rep_ < REP_GEMM; ++rep_) { pg8::gemm_phase<pg8::EpiQupRope, pg8::StaticOrder, PG8_ALIGN, PG8_SP2>(F.lds + RING_OFF, g, S, E); if (rep_ + 1 < REP_GEMM) __syncthreads(); } }
            __syncthreads();
            { pg8::Gemm g{(const bf16*)(ws + WS_QKV) + C_CKV, (const bf16*)(ws + WS_WKVUP) + (size_t)layer * KVW * 256, MT, KVW, opq_s(256), INCP, 256};
              pg8::StaticOrder S; S.init(MT, KVW, F.G, opq_s((int)blockIdx.x));
              pg8::EpiBf16P E{(bf16*)(ws + WS_KVM), KVW, 0};
              for (int rep_ = 0; rep_ < REP_GEMM; ++rep_) { pg8::gemm_phase<pg8::EpiBf16P, pg8::StaticOrder, PG8_ALIGN, PG8_SP2>(F.lds + RING_OFF, g, S, E); if (rep_ + 1 < REP_GEMM) __syncthreads(); } }
            filler(F, layer * 8 + 1, -1);
        }
#endif
        SEAM(pb + 3);
        #ifndef SKIP_ATTN
        if (IN(pb + 5)) {
#pragma unroll
            for (int rep_ = 0; rep_ < REP_ATTN; ++rep_) attn_phase_fa(F, layer);
            filler(F, layer * 8 + 2, -1); }
#endif
        SEAM(pb + 5);
#ifndef SKIP_WOUT
        if (IN(pb + 6)) {
            pg8::Gemm g{(const bf16*)(ws + WS_O), (const bf16*)(ws + WS_WOUT) + (size_t)layer * 2048 * 2048, MT, 2048, 2048, 2048, 2048};
            pg8::EpiResGate E{(float*)(ws + WS_H), modl + 2 * DM, layer == 0 ? inptr(I_X) : nullptr, layer == 0 ? inptr(I_CTX) : nullptr};
            pg8::EpiResGate Ed{(float*)(ws + WS_R2), modl + 2 * DM, nullptr, nullptr}; (void)Ed;
            if constexpr (layer == 0) { pg8::StaticOrder S; S.init(MT, 2048, F.G, opq_s((int)blockIdx.x), WO_WGM); for (int rep_ = 1; rep_ < REP_GEMM; ++rep_) { pg8::gemm_phase<pg8::EpiResGate, pg8::StaticOrder, PG8_ALIGN, PG8_SP2>(F.lds + RING_OFF, g, S, Ed); __syncthreads(); } pg8::gemm_phase<pg8::EpiResGate, pg8::StaticOrder, PG8_ALIGN, PG8_SP2>(F.lds + RING_OFF, g, S, E); }
            else { pg8::LatentOrder S; S.init(NBATCH * SEQ, 2048, F.G, opq_s((int)blockIdx.x), WO_WGM); for (int rep_ = 1; rep_ < REP_GEMM; ++rep_) { pg8::gemm_phase<pg8::EpiResGate, pg8::LatentOrder, PG8_ALIGN, PG8_SP2>(F.lds + RING_OFF, g, S, Ed); __syncthreads(); } pg8::gemm_phase<pg8::EpiResGate, pg8::LatentOrder, PG8_ALIGN, PG8_SP2>(F.lds + RING_OFF, g, S, E); }            filler(F, layer * 8 + 3, -1);
        }
#endif
        SEAM(pb + 6);
        if constexpr (layer == 0) {
#ifndef SKIP_DENSE
            if (IN(pb + 7)) { for (int rp_ = 0; rp_ < REP_PASS; ++rp_) norm_pass(F, layer, false, false); filler(F, layer * 8 + 6, CVQ_FFN_END); }
            SEAM(pb + 7);
            if (IN(pb + 9)) {
                pg8::Gemm g{(const bf16*)(ws + WS_U), (const bf16*)(ws + WS_WGU), MT, 2 * DFF, 2048, 2048, 2048};
                pg8::StaticOrder S; S.init(MT, 2 * DFF, F.G, opq_s((int)blockIdx.x));
                pg8::EpiSwiGLU E{(bf16*)(ws + WS_HM), DFF, 0};
                for (int rep_ = 0; rep_ < REP_FGU; ++rep_) { pg8::gemm_phase<pg8::EpiSwiGLU, pg8::StaticOrder, PG8_ALIGN, PG8_SP2>(F.lds + RING_OFF, g, S, E); if (rep_ + 1 < REP_FGU) __syncthreads(); }                filler(F, layer * 8 + 4, -1);
            }
            SEAM(pb + 9);
            if (IN(pb + 10)) {
                pg8::Gemm g{(const bf16*)(ws + WS_HM), (const bf16*)(ws + WS_WD), MT, 2048, DFF, DFF, DFF, 0, 0, REV_DOWN};
                pg8::StaticOrder S; S.init(MT, 2048, F.G, opq_s((int)blockIdx.x), FD_WGM);
                pg8::EpiResGate E{(float*)(ws + WS_H), modl + 5 * DM, nullptr, nullptr};
                pg8::EpiResGate Ed{(float*)(ws + WS_R1), modl + 5 * DM, nullptr, nullptr}; (void)Ed;
                for (int rep_ = 1; rep_ < REP_FDN; ++rep_) { pg8::gemm_phase<pg8::EpiResGate, pg8::StaticOrder, PG8_ALIGN, PG8_SP2>(F.lds + RING_OFF, g, S, Ed); __syncthreads(); }
                pg8::gemm_phase<pg8::EpiResGate, pg8::StaticOrder, PG8_ALIGN, PG8_SP2>(F.lds + RING_OFF, g, S, E);                filler(F, layer * 8 + 5, CVQ_N);
            }
            SEAM(pb + 10);
#endif
        } else {
#ifndef SKIP_MOE
            if (IN(pb + 7)) for (int rp_ = 0; rp_ < REP_PASS; ++rp_) moe_route_pass(F, layer);
            SEAM(pb + 7);
            if (IN(pb + 8)) { for (int rp_ = 0; rp_ < REP_PASS; ++rp_) moe_scatter_pass(F, layer); filler(F, layer * 8 + 6, CVQ_N); }
            SEAM(pb + 8);
            if (IN(pb + 9)) {
#if PROBE_LATE_DENSE
                {
                    pg8::Gemm gd{(const bf16*)(ws + WS_U), (const bf16*)(ws + WS_WGU), MT, 2 * DFF, 2048, 2048, 2048};
                    pg8::StaticOrder Sd; Sd.init(MT, 2 * DFF, F.G, opq_s((int)blockIdx.x));
                    pg8::EpiSwiGLU Ed{(bf16*)(ws + WS_R1), DFF, 0};
                    pg8::gemm_phase<pg8::EpiSwiGLU, pg8::StaticOrder, PG8_ALIGN, PG8_SP2>(F.lds + RING_OFF, gd, Sd, Ed);
                    __syncthreads();
                }
#endif
                moe_tables(F, mtab, 0);
                pg8::Gemm g{(const bf16*)(ws + WS_AS), (const bf16*)(ws + WS_MGU), 0, 2 * DFE, 2048, 2048, 2048, 0, KT_MOE};
                pg8::MoeOrder S; S.init(__builtin_amdgcn_readfirstlane(mtab[24]) * 256, 2 * DFE, F.G, opq_s((int)blockIdx.x));
                S.tab = mtab;
                pg8::EpiSwiGLU E{(bf16*)(ws + WS_HM2), DFE, 2 * DFE / 256, MOE_FP8 ? 1.0f / pg8::MOE_WSCALE : 1.0f};
                for (int rep_ = 0; rep_ < REP_MGU; ++rep_) { pg8::gemm_phase<pg8::EpiSwiGLU, pg8::MoeOrder, PG8_ALIGN, PG8_SP2, (MOE_FP8 != 0)>(F.lds + RING_OFF, g, S, E); if (rep_ + 1 < REP_MGU) __syncthreads(); }
            }
            SEAM(pb + 9);
            if (IN(pb + 10)) {
                moe_tables(F, mtab, 0);
                pg8::Gemm g{(const bf16*)(ws + WS_HM2), (const bf16*)(ws + WS_MD), 0, 2048, DFE, DFE, DFE, KT_MOE, KT_MOE, REV_DOWN};
#define RFL(i) __builtin_amdgcn_readfirstlane(mtab[i])
                { pg8::MoeFullOrder S; S.init(RFL(56) * 256, 2048, F.G, opq_s((int)blockIdx.x));
                  S.tab = mtab;
                  pg8::EpiBf16P E{(bf16*)(ws + WS_Y), 2048, 8, MOE_FP8 ? 1.0f / pg8::MOE_WSCALE : 1.0f};
                  for (int rep_ = 0; rep_ < REP_MDN; ++rep_) { pg8::gemm_phase<pg8::EpiBf16P, pg8::MoeFullOrder, PG8_ALIGN, PG8_SP2, (MOE_FP8 != 0)>(F.lds + RING_OFF, g, S, E); if (rep_ + 1 < REP_MDN) __syncthreads(); } }
                __syncthreads();
                { pg8::Gemm g2{(const bf16*)(ws + WS_HM2), (const bf16*)(ws + WS_MD), 0, 2048, opq_s(1792), DFE, DFE, KT_MOE, KT_MOE, REV_DOWN};
                  pg8::MoeRemOrder S; S.nsub = RFL(57) * 32; S.G = F.G; S.c = opq_s((int)blockIdx.x); S.tab = mtab;
                  pg8::EpiSlab E{(float*)(ws + WS_U), MOE_FP8 ? 1.0f / pg8::MOE_WSCALE : 1.0f};
                  pg8::gemm_phase<pg8::EpiSlab, pg8::MoeRemOrder, PG8_ALIGN, PG8_SP2, (MOE_FP8 != 0)>(F.lds + RING_OFF, g2, S, E); }
#undef RFL
            }
            SEAM(pb + 10);
#endif
        }
}

__global__ void __launch_bounds__(NWAVES * 64, 2) fwd_kernel(Args args) {
    extern __shared__ __attribute__((aligned(16))) unsigned char lds[];
    Frame F;
    F.lds = (LAS unsigned char*)lds;
    F.MISC = (volatile LAS unsigned*)(F.lds + MISC_OFF);
    F.wave = __builtin_amdgcn_readfirstlane((int)threadIdx.x >> 6);
    F.G = gridDim.x; F.gw = blockIdx.x * NWAVES + F.wave; F.NGW = F.G * NWAVES;
    F.out = args.out; F.ws = args.ws; F.ctl = (gu32*)(args.ws + WS_CTL);
    unsigned char* ws = args.ws;
    for (int u = TIDX; u < (LDS_BYTES - LDSCTL_OFF) / 4; u += NWAVES * 64) ((LAS unsigned*)(F.lds + LDSCTL_OFF))[u] = 0u;
    __syncthreads();
    XcdBarrier bar; bar.bar = (unsigned*)(F.ctl + CW_BAR); bar.x = 0; bar.st = nullptr;
#if !MK_MULTI
    bar = xcd_barrier_post((unsigned*)(F.ctl + CW_BAR), F.MISC + 8);
#endif
    const int lo = args.ph_lo, hi = args.ph_hi;
    LAS int* mtab = (LAS int*)(F.lds + LDSCTL_OFF + 1024);

    #ifndef SKIP_P0
    if (IN(0)) {
#pragma unroll
        for (int rep_ = 0; rep_ < REP_P0; ++rep_) p0_prologue(F); }
#endif
    SEAM(0);

    layer_phases<0>(F, bar, lo, hi, mtab);
    layer_phases<1>(F, bar, lo, hi, mtab);
#ifndef SKIP_FINAL
    if (IN(N_PHASES - 1)) for (int rp_ = 0; rp_ < REP_PASS; ++rp_) final_pass(F, 1);
#endif
#undef IN
#undef SEAM
}

extern "C" void kernel_launch(void* const* d_in, const int* in_sizes, int n_in, void* d_out, int out_size, void* d_ws, size_t ws_size, hipStream_t stream) {
    static int grid = 0;
    if (grid == 0) {
        if (n_in != 31 || in_sizes[0] != NBATCH * SEQ * DM || out_size != NBATCH * SEQ * DM || ws_size < WS_END) {
            fprintf(stderr, "kernel_launch: unexpected shapes (n_in %d, in0 %d, out %d, ws %zu, need %zu); nothing launched\n", n_in, n_in > 0 ? in_sizes[0] : -1, out_size, ws_size, (size_t)WS_END); grid = -1; return; }
        int dev = 0, cus = 0, per_cu = 0;
        if (hipGetDevice(&dev) != hipSuccess || hipDeviceGetAttribute(&cus, hipDeviceAttributeMultiprocessorCount, dev) != hipSuccess) { fprintf(stderr, "kernel_launch: device query failed\n"); grid = -1; return; }
        if (hipFuncSetAttribute((const void*)fwd_kernel, hipFuncAttributeMaxDynamicSharedMemorySize, LDS_BYTES) != hipSuccess) { fprintf(stderr, "kernel_launch: hipFuncSetAttribute failed\n"); grid = -1; return; }
        if (hipOccupancyMaxActiveBlocksPerMultiprocessor(&per_cu, (const void*)fwd_kernel, NWAVES * 64, LDS_BYTES) != hipSuccess || per_cu < 1)
            fprintf(stderr, "kernel_launch: note: occupancy query reports %d workgroups per CU\n", per_cu);
        (void)hipGetLastError();
        grid = cus < 256 ? cus : 256;
    }
    if (grid < 0) return;
    if (hipMemsetAsync((char*)d_ws + WS_CTL, 0, CTL_ZERO_BYTES, stream) != hipSuccess) { fprintf(stderr, "kernel_launch: memset failed\n"); return; }
    Args a{};
    for (int i = 0; i < 31; ++i) a.in[i] = (const float*)d_in[i];
    a.out = (float*)d_out; a.ws = (unsigned char*)d_ws;
#if MK_MULTI
    for (int p = 0; p < N_PHASES; ++p) {
        if (p == 1 + 8) continue;
        a.ph_lo = p; a.ph_hi = p + 1;
        hipLaunchKernelGGL(fwd_kernel, dim3(grid), dim3(NWAVES * 64), LDS_BYTES, stream, a);
    }
#else
    a.ph_lo = 0; a.ph_hi = N_PHASES;
    hipLaunchKernelGGL(fwd_kernel, dim3(grid), dim3(NWAVES * 64), LDS_BYTES, stream, a);
#endif
    const hipError_t le = hipPeekAtLastError();
    if (le != hipSuccess) fprintf(stderr, "kernel_launch: launch failed: %s\n", hipGetErrorName(le));
}
```

```cpp
#include <hip/hip_runtime.h>
#include <cstdio>
#include <cstdint>
namespace pg8 {
#define PG8_LAS __attribute__((address_space(3)))
typedef unsigned short bf16_t;
typedef short bf16x8 __attribute__((ext_vector_type(8)));
typedef float f32x4 __attribute__((ext_vector_type(4)));
typedef unsigned u32x4 __attribute__((ext_vector_type(4)));
typedef int v8i32 __attribute__((ext_vector_type(8)));
constexpr int BM = 256, BK = 64, HALF = 128, HTB = HALF * BK * 2  , STAGE_BYTES = 8 * HTB, NXCD = 8, WGM = 8;

__host__ __device__ __forceinline__ int lds_byte(int r, int c) { const int st = (r >> 4) * 2 + (c >> 5), rr = r & 15, cc = c & 31, ob = rr * 64 + cc * 2; return st * 1024 + (ob ^ (((ob >> 9) & 1) << 5)); }
__host__ __device__ __forceinline__ void stage_rc(int b, int& R, int& C) { const int st = b / 1024, sb = b % 1024, swz = sb ^ (((sb >> 9) & 1) << 5); R = (st >> 1) * 16 + swz / 64; C = (st & 1) * 32 + (swz % 64) / 2; }
__host__ __device__ __forceinline__ int perm32(int rho) { const int n = rho >> 4, i = rho & 15; return 8 * (i >> 2) + 4 * n + (i & 3); }

struct Unit { int pm, pn, ko = 0, aux = 0; };
struct Gemm { const bf16_t* A; const bf16_t* Bt; int M, N, K, lda, ldb; int ktA = 0, ktB = 0, rev = 0; };

struct StaticOrder {
    static constexpr bool NTB = false;
    int nM, nN, nwg, G, c, wgm;
    __host__ __device__ void init(int M, int N, int G_, int c_, int wgm_ = WGM) { nM = M / BM; nN = N / BM; nwg = nM * nN; G = G_; c = c_; wgm = wgm_; }
    __host__ __device__ bool next(int i, Unit& u) const {
        const long L = (long)i * G + c; if (L >= nwg) return false;
        int wgid = (int)L; { const int q = nwg / NXCD, r = nwg % NXCD, xcd = wgid % NXCD, off = wgid / NXCD; wgid = (xcd < r ? xcd * (q + 1) : r * (q + 1) + (xcd - r) * q) + off; }
        const int nig = wgm * nN, gid = wgid / nig, fm = gid * wgm, gsz = (nM - fm) < wgm ? (nM - fm) : wgm;
        u.pm = fm + ((wgid % nig) % gsz); u.pn = (wgid % nig) / gsz; return true;
    }
    __device__ __forceinline__ void a_ready(const Unit&) const {}
    __device__ __forceinline__ void done(const Unit&) const {}
};

__device__ __forceinline__ unsigned cvt_pk_bf16(float lo, float hi) { unsigned r; asm volatile("v_cvt_pk_bf16_f32 %0, %1, %2" : "=v"(r) : "v"(lo), "v"(hi)); return r; }
typedef float f32x2 __attribute__((ext_vector_type(2)));
__device__ __forceinline__ void mfma_e4m3(f32x4& acc, const v8i32& a, const v8i32& b, int one) {
    asm volatile("v_mfma_scale_f32_16x16x128_f8f6f4 %0, %1, %2, %0, %3, %3 op_sel_hi:[0,0,0]" : "+v"(acc) : "v"(a), "v"(b), "v"(one));
}
template <class Epi, class Sched, bool ALIGN_EPI = false, bool SP2 = false, bool FP8 = false>
__device__ __forceinline__ void gemm_phase(PG8_LAS unsigned char* lds, const Gemm g, const Sched& S, const Epi& E) {
    int tid_ = threadIdx.x; asm volatile("" : "+v"(tid_));
    const int tid = tid_, wid = __builtin_amdgcn_readfirstlane(tid >> 6), lane = tid & 63, wr = wid >> 2, wc = wid & 3, fr = lane & 15, fq = lane >> 4;
    constexpr int ES = FP8 ? 1 : 2, KE = FP8 ? 128 : 64;
    const int K = g.K, nt = K / KE;
    unsigned voffA[2], voffB[2];
#pragma unroll
    for (int i = 0; i < 2; ++i) { int R, C; stage_rc(tid * 16 + i * 8192, R, C); const int Rb = Epi::PERM ? ((R & ~31) + perm32(R & 31)) : R;
        voffA[i] = (unsigned)(R * (g.ktA ? 128 : g.lda * ES) + C * 2); voffB[i] = (unsigned)(Rb * (g.ktB ? 128 : g.ldb * ES) + C * 2); }
    const long kabsA = g.ktA ? 32768 : (BK * 2), kabsB = g.ktB ? 32768 : (BK * 2);
    const long kstepA = g.rev ? -kabsA : kabsA, kstepB = g.rev ? -kabsB : kabsB;
    const long kfirstA = g.rev ? (long)(nt - 1) * kabsA : 0, kfirstB = g.rev ? (long)(nt - 1) * kabsB : 0;
    const size_t hstepA = g.ktA ? (size_t)16384 : (size_t)HALF * g.lda * ES, hstepB = g.ktB ? (size_t)16384 : (size_t)HALF * g.ldb * ES;
    const size_t tstepA = (size_t)BM * g.lda * ES, tstepB = (size_t)BM * g.ldb * ES;
    const unsigned ldsw = (unsigned)wid * 1024u;
    const int fcol = FP8 ? ((fq >> 1) * 32 + (fq & 1) * 16) : fq * 8;
    const int aoff = lds_byte(wr * 64 + fr, fcol), boff = lds_byte(wc * 32 + fr, fcol);
#define PG8_SA(b, h) (((b) * 2 + (h)) * HTB)
#define PG8_SB(b, h) ((4 + (b) * 2 + (h)) * HTB)
#define PG8_STAGE(bufoff, gbase, voff) do { _Pragma("unroll") for (int _i = 0; _i < 2; ++_i) { \
        if constexpr (FP8) { unsigned vo_ = (voff)[_i]; asm volatile("" : "+v"(vo_));   \
            __builtin_amdgcn_global_load_lds((const unsigned*)((const char*)(gbase) + vo_), (PG8_LAS unsigned*)(lds + (bufoff) + ldsw + _i * 8192), 16, 0, 0); } else \
        if constexpr (Sched::NTB && (bufoff) >= 4 * HTB) __builtin_amdgcn_global_load_lds((const unsigned*)((const char*)(gbase) + (voff)[_i]), (PG8_LAS unsigned*)(lds + (bufoff) + ldsw + _i * 8192), 16, 0, 2); \
        else __builtin_amdgcn_global_load_lds((const unsigned*)((const char*)(gbase) + (voff)[_i]), (PG8_LAS unsigned*)(lds + (bufoff) + ldsw + _i * 8192), 16, 0, 0); } } while (0)
#define PG8_LDA(dst, b, h) do { if constexpr (FP8) { _Pragma("unroll") for (int m = 0; m < 4; ++m) { const PG8_LAS unsigned char* p_ = lds + PG8_SA(b, h) + aoff + m * 2048; \
        const u32x4 lo_ = *(const PG8_LAS u32x4*)p_, hi_ = *(const PG8_LAS u32x4*)(p_ + 16); dst##8[m] = (v8i32){(int)lo_.x, (int)lo_.y, (int)lo_.z, (int)lo_.w, (int)hi_.x, (int)hi_.y, (int)hi_.z, (int)hi_.w}; } } \
    else { _Pragma("unroll") for (int m = 0; m < 4; ++m) _Pragma("unroll") for (int k = 0; k < 2; ++k) dst[m][k] = *(const PG8_LAS bf16x8*)(lds + PG8_SA(b, h) + aoff + m * 2048 + k * 1024); } } while (0)
#define PG8_LDB(dst, b, h) do { if constexpr (FP8) { _Pragma("unroll") for (int n = 0; n < 2; ++n) { const PG8_LAS unsigned char* p_ = lds + PG8_SB(b, h) + boff + n * 2048; \
        const u32x4 lo_ = *(const PG8_LAS u32x4*)p_, hi_ = *(const PG8_LAS u32x4*)(p_ + 16); dst##8[n] = (v8i32){(int)lo_.x, (int)lo_.y, (int)lo_.z, (int)lo_.w, (int)hi_.x, (int)hi_.y, (int)hi_.z, (int)hi_.w}; } } \
    else { _Pragma("unroll") for (int n = 0; n < 2; ++n) _Pragma("unroll") for (int k = 0; k < 2; ++k) dst[n][k] = *(const PG8_LAS bf16x8*)(lds + PG8_SB(b, h) + boff + n * 2048 + k * 1024); } } while (0)
#define PG8_MMA(ai, bj, At, Bt) do { __builtin_amdgcn_s_setprio(1); if constexpr (FP8) { _Pragma("unroll") for (int m = 0; m < 4; ++m) _Pragma("unroll") for (int n = 0; n < 2; ++n) \
        mfma_e4m3(acc[ai][bj][m][n], Bt##8[n], At##8[m], one8); } \
    else { _Pragma("unroll") for (int m = 0; m < 4; ++m) _Pragma("unroll") for (int n = 0; n < 2; ++n) _Pragma("unroll") for (int k = 0; k < 2; ++k) \
        acc[ai][bj][m][n] = __builtin_amdgcn_mfma_f32_16x16x32_bf16(Bt[n][k], At[m][k], acc[ai][bj][m][n], 0, 0, 0); } __builtin_amdgcn_s_setprio(0); } while (0)
#define PG8_WAIT_V(n) asm volatile("s_waitcnt vmcnt(" #n ")" ::: "memory")
#define PG8_WAIT_L(n) asm volatile("s_waitcnt lgkmcnt(" #n ")" ::: "memory")
#define PG8_BAR __builtin_amdgcn_s_barrier()
#define PG8_SCHED __builtin_amdgcn_sched_barrier(0)
    Unit cur, nxt; int ui = 0;
    if (!S.next(0, cur)) return;
    f32x4 acc[2][2][4][2];
#pragma unroll
    for (int a = 0; a < 2; ++a)
#pragma unroll
        for (int b = 0; b < 2; ++b)
#pragma unroll
            for (int m = 0; m < 4; ++m)
#pragma unroll
                for (int n = 0; n < 2; ++n) acc[a][b][m][n] = (f32x4){0.f, 0.f, 0.f, 0.f};
    int one8 = 0x7F7F7F7F; asm volatile("" : "+v"(one8));
    bf16x8 At[4][2], B0[2][2], B1[2][2]; v8i32 At8[4], B08[2], B18[2];
    const char* cA = (const char*)g.A + (size_t)cur.pm * tstepA + (g.ktA ? (size_t)(cur.ko / KE) * 32768 : (size_t)cur.ko * ES) + kfirstA; const char* cB = (const char*)g.Bt + (size_t)cur.pn * tstepB + (g.ktB ? (size_t)(cur.ko / KE) * 32768 : (size_t)cur.ko * ES) + kfirstB;
    S.a_ready(cur);
    if constexpr (SP2) {
        PG8_STAGE(PG8_SB(0, 0), cB, voffB); PG8_STAGE(PG8_SB(0, 1), cB + hstepB, voffB); PG8_STAGE(PG8_SA(0, 0), cA, voffA); PG8_STAGE(PG8_SA(0, 1), cA + hstepA, voffA);
        if (wr == 1) PG8_BAR;
        PG8_WAIT_V(2); PG8_BAR;
        PG8_STAGE(PG8_SB(1, 0), cB + kstepB, voffB); PG8_STAGE(PG8_SA(1, 0), cA + kstepA, voffA); PG8_STAGE(PG8_SB(1, 1), cB + hstepB + kstepB, voffB);
        PG8_WAIT_V(6); PG8_BAR;
    } else {
        PG8_STAGE(PG8_SB(0, 0), cB, voffB); PG8_STAGE(PG8_SA(0, 0), cA, voffA); PG8_STAGE(PG8_SB(0, 1), cB + hstepB, voffB); PG8_STAGE(PG8_SA(0, 1), cA + hstepA, voffA);
        if (wr == 1) PG8_BAR;
        PG8_WAIT_V(4); PG8_BAR;
        PG8_STAGE(PG8_SB(1, 0), cB + kstepB, voffB); PG8_STAGE(PG8_SA(1, 0), cA + kstepA, voffA); PG8_STAGE(PG8_SB(1, 1), cB + hstepB + kstepB, voffB);
        PG8_WAIT_V(6); PG8_BAR;
    }
    for (;;) {
        const bool has_next = S.next(ui + 1, nxt);
        const char* nA = has_next ? (const char*)g.A + (size_t)nxt.pm * tstepA + (g.ktA ? (size_t)(nxt.ko / KE) * 32768 : (size_t)nxt.ko * ES) + kfirstA : cA; const char* nB = has_next ? (const char*)g.Bt + (size_t)nxt.pn * tstepB + (g.ktB ? (size_t)(nxt.ko / KE) * 32768 : (size_t)nxt.ko * ES) + kfirstB : cB;
        for (int t = 0; t < nt; t += 2) {
            const bool last = (t == nt - 2);
            const char* a1 = cA + (long)(t + 1) * kstepA;
            const char* a2 = last ? nA : cA + (long)(t + 2) * kstepA; const char* b2 = last ? nB : cB + (long)(t + 2) * kstepB;
            const char* a3 = a2 + kstepA; const char* b3 = b2 + kstepB;
            if (last && has_next) S.a_ready(nxt);
            if constexpr (SP2) {
            PG8_LDB(B0, 0, 0); PG8_LDB(B1, 0, 1); PG8_SCHED; PG8_LDA(At, 0, 0); PG8_STAGE(PG8_SA(1, 1), a1 + hstepA, voffA);
            PG8_WAIT_V(8); PG8_WAIT_L(0); PG8_BAR; PG8_MMA(0, 0, At, B0); PG8_MMA(0, 1, At, B1); PG8_BAR; PG8_SCHED;
            PG8_LDA(At, 0, 1); PG8_STAGE(PG8_SB(0, 0), b2, voffB); PG8_STAGE(PG8_SB(0, 1), b2 + hstepB, voffB); PG8_STAGE(PG8_SA(0, 0), a2, voffA);
            PG8_WAIT_V(8); PG8_WAIT_L(0); PG8_BAR; PG8_MMA(1, 0, At, B0); PG8_MMA(1, 1, At, B1); PG8_BAR; PG8_SCHED;
            PG8_LDB(B0, 1, 0); PG8_LDB(B1, 1, 1); PG8_SCHED; PG8_LDA(At, 1, 0); PG8_STAGE(PG8_SA(0, 1), a2 + hstepA, voffA);
            PG8_WAIT_V(8); PG8_WAIT_L(0); PG8_BAR; PG8_MMA(0, 0, At, B0); PG8_MMA(0, 1, At, B1); PG8_BAR; PG8_SCHED;
            PG8_LDA(At, 1, 1); PG8_STAGE(PG8_SB(1, 0), b3, voffB); PG8_STAGE(PG8_SB(1, 1), b3 + hstepB, voffB); PG8_STAGE(PG8_SA(1, 0), a3, voffA);
            PG8_WAIT_V(8); PG8_WAIT_L(0); PG8_BAR; PG8_MMA(1, 0, At, B0); PG8_MMA(1, 1, At, B1); PG8_BAR; PG8_SCHED;
            } else {
            PG8_LDB(B0, 0, 0); PG8_SCHED; PG8_LDA(At, 0, 0); PG8_STAGE(PG8_SA(1, 1), a1 + hstepA, voffA);
            PG8_WAIT_L(8); PG8_BAR; PG8_WAIT_L(0); PG8_MMA(0, 0, At, B0); PG8_BAR; PG8_SCHED;
            PG8_LDB(B1, 0, 1); PG8_STAGE(PG8_SB(0, 0), b2, voffB);
            PG8_BAR; PG8_WAIT_L(0); PG8_MMA(0, 1, At, B1); PG8_BAR;
            PG8_LDA(At, 0, 1); PG8_STAGE(PG8_SA(0, 0), a2, voffA);
            PG8_BAR; PG8_WAIT_L(0); PG8_MMA(1, 0, At, B0); PG8_BAR; PG8_SCHED;
            PG8_STAGE(PG8_SB(0, 1), b2 + hstepB, voffB);
            PG8_WAIT_V(6); PG8_BAR; PG8_MMA(1, 1, At, B1); PG8_BAR;
            PG8_LDB(B0, 1, 0); PG8_SCHED; PG8_LDA(At, 1, 0); PG8_STAGE(PG8_SA(0, 1), a2 + hstepA, voffA);
            PG8_WAIT_L(8); PG8_BAR; PG8_WAIT_L(0); PG8_MMA(0, 0, At, B0); PG8_BAR; PG8_SCHED;
            PG8_LDB(B1, 1, 1); PG8_STAGE(PG8_SB(1, 0), b3, voffB);
            PG8_BAR; PG8_WAIT_L(0); PG8_MMA(0, 1, At, B1); PG8_BAR;
            PG8_LDA(At, 1, 1); PG8_STAGE(PG8_SA(1, 0), a3, voffA);
            PG8_BAR; PG8_WAIT_L(0); PG8_MMA(1, 0, At, B0); PG8_BAR; PG8_SCHED;
            PG8_STAGE(PG8_SB(1, 1), b3 + hstepB, voffB);
            PG8_WAIT_V(6); PG8_BAR; PG8_MMA(1, 1, At, B1); PG8_BAR;
            }
        }
        if constexpr (FP8) {
#define PG8_ACC16(a) "+v"(acc[a][0][0][0]), "+v"(acc[a][0][0][1]), "+v"(acc[a][0][1][0]), "+v"(acc[a][0][1][1]), "+v"(acc[a][0][2][0]), "+v"(acc[a][0][2][1]), "+v"(acc[a][0][3][0]), "+v"(acc[a][0][3][1]), \
                     "+v"(acc[a][1][0][0]), "+v"(acc[a][1][0][1]), "+v"(acc[a][1][1][0]), "+v"(acc[a][1][1][1]), "+v"(acc[a][1][2][0]), "+v"(acc[a][1][2][1]), "+v"(acc[a][1][3][0]), "+v"(acc[a][1][3][1])
            asm volatile("s_nop 15\n\ts_nop 15" : PG8_ACC16(0));
            asm volatile("s_nop 0" : PG8_ACC16(1));
#undef PG8_ACC16
        }
        if constexpr (ALIGN_EPI) { if (wr == 0) PG8_BAR; }
        if constexpr (!Epi::AFTER_DRAIN) { E(acc, cur, wr, wc, fr, fq); S.done(cur); }
        if (!has_next) break;
#pragma unroll
        for (int a = 0; a < 2; ++a)
#pragma unroll
            for (int b = 0; b < 2; ++b)
#pragma unroll
                for (int m = 0; m < 4; ++m)
#pragma unroll
                    for (int n = 0; n < 2; ++n) acc[a][b][m][n] = (f32x4){0.f, 0.f, 0.f, 0.f};
        cur = nxt; cA = nA; cB = nB; ++ui;
        if constexpr (ALIGN_EPI) { if (wr == 1) PG8_BAR; }
    }
    PG8_WAIT_V(0);
    if constexpr (!ALIGN_EPI) { if (wr == 0) PG8_BAR; }
    PG8_BAR;
    if constexpr (Epi::AFTER_DRAIN) { E.fused(acc, cur, wr, wc, fr, fq, lds, wid, lane); S.done(cur); }
#undef PG8_SA
#undef PG8_SB
#undef PG8_STAGE
#undef PG8_LDA
#undef PG8_LDB
#undef PG8_MMA
#undef PG8_WAIT_V
#undef PG8_WAIT_L
#undef PG8_BAR
#undef PG8_SCHED
}
}

#define GAS __attribute__((address_space(1)))
#define LAS __attribute__((address_space(3)))
typedef unsigned short bf16;
typedef unsigned v4u __attribute__((ext_vector_type(4)));
typedef unsigned v2u __attribute__((ext_vector_type(2)));
typedef float f32x4 __attribute__((ext_vector_type(4)));
typedef __bf16 bf2_t __attribute__((ext_vector_type(2)));
typedef GAS unsigned gu32;
#define RLX_AGENT __ATOMIC_RELAXED, __HIP_MEMORY_SCOPE_AGENT
#define LDS_WAIT() asm volatile("s_waitcnt lgkmcnt(0)" ::: "memory")
#define VM_WAIT() asm volatile("s_waitcnt vmcnt(0)" ::: "memory")
__device__ __forceinline__ unsigned f2bf(float f) { unsigned u = __builtin_bit_cast(unsigned, f); return (u + 0x7fffu + ((u >> 16) & 1u)) >> 16; }
__device__ __forceinline__ unsigned pk2(float lo, float hi) { return f2bf(lo) | (f2bf(hi) << 16); }
__device__ __forceinline__ float bflo(unsigned u) { return __builtin_bit_cast(float, u << 16); }
__device__ __forceinline__ float bfhi(unsigned u) { return __builtin_bit_cast(float, u & 0xffff0000u); }
__device__ __forceinline__ float bf1(bf16 h) { return __builtin_bit_cast(float, ((unsigned)h) << 16); }
__device__ __forceinline__ float dot2bf(unsigned a, unsigned b, float c) { return __builtin_amdgcn_fdot2_f32_bf16(__builtin_bit_cast(bf2_t, a), __builtin_bit_cast(bf2_t, b), c, false); }
__device__ __forceinline__ float wave_sum(float v) {
#pragma unroll
    for (int o = 1; o < 64; o <<= 1) v += __shfl_xor(v, o);
    return v;
}

#define XB_TMO      128
#define XB_XCNT(j)  (256  + 64 * (j))
#define XB_XSUB(j)  (1280 + 64 * (j))
#define XB_XGEN(j)  (2304 + 64 * (j))
#define XB_TOP      3328
#define XB_TOPGEN   3392
#define XCD_BAR_WORDS 3456
#define XB_SPIN_CAP (1u << 18)

__device__ __forceinline__ unsigned xb_ld(unsigned* p)              { return __hip_atomic_load(p, __ATOMIC_RELAXED, __HIP_MEMORY_SCOPE_AGENT); }
__device__ __forceinline__ unsigned xb_add(unsigned* p, unsigned v) { return __hip_atomic_fetch_add(p, v, __ATOMIC_RELAXED, __HIP_MEMORY_SCOPE_AGENT); }
__device__ __forceinline__ unsigned xb_xcc_id() { return (unsigned)__builtin_amdgcn_s_getreg((3 << 11) | 20) & 0xFu; }
#define XB_SPIN(cond, bar) do { unsigned _sp = 0; while (cond) { __builtin_amdgcn_s_sleep(1); \
    if ((++_sp & 255u) == 0u) { if (xb_ld(&(bar)[XB_TMO])) break; if (_sp > XB_SPIN_CAP) { atomicAdd(&(bar)[XB_TMO], 1u); break; } } } } while (0)

struct XcdBarrier {
    unsigned* bar; unsigned x;
    volatile LAS unsigned* st;
};

__device__ __forceinline__ XcdBarrier xcd_barrier_post(unsigned* bar, volatile LAS unsigned* st) {
    XcdBarrier b; b.bar = bar; b.x = xb_xcc_id(); b.st = st;
    if (threadIdx.x == 0) (void)xb_add(&bar[XB_XCNT(b.x)], 1u);
    return b;
}
__device__ __forceinline__ void xcd_barrier_complete(unsigned* bar, unsigned x, unsigned& nloc, unsigned& nx) {
    const unsigned G = gridDim.x * gridDim.y * gridDim.z;
    unsigned sum, cnt, mine, sp = 0u;
    for (;;) {
        sum = 0u; cnt = 0u; mine = 0u;
#pragma unroll
        for (unsigned j = 0; j < 16; ++j) { const unsigned c = xb_ld(&bar[XB_XCNT(j)]); sum += c; cnt += (c > 0u) ? 1u : 0u; mine = (j == x) ? c : mine; }
        if (sum == G) break;
        __builtin_amdgcn_s_sleep(1);
        if ((++sp & 255u) == 0u) { if (xb_ld(&bar[XB_TMO])) break; if (sp > XB_SPIN_CAP) { atomicAdd(&bar[XB_TMO], 1u); break; } }
    }
    nloc = mine > 0u ? mine : 1u; nx = cnt > 0u ? cnt : 1u;
}

__device__ __forceinline__ void xcd_barrier(const XcdBarrier& b) {
    asm volatile("s_waitcnt vmcnt(0)" ::: "memory");
    __syncthreads();
    if (threadIdx.x == 0) {
        unsigned* bar = b.bar;
        __builtin_amdgcn_s_waitcnt(0);
        unsigned nloc = b.st[0], nx = b.st[1];
        if (nloc == 0u) { xcd_barrier_complete(bar, b.x, nloc, nx); b.st[0] = nloc; b.st[1] = nx; }
        const unsigned old = xb_add(&bar[XB_XSUB(b.x)], 1u);
        const unsigned gen = old / nloc;
        if (old + 1u == (gen + 1u) * nloc) {
            __builtin_amdgcn_fence(__ATOMIC_RELEASE, "agent");
            asm volatile("s_waitcnt vmcnt(0)" ::: "memory");
            const unsigned og = xb_add(&bar[XB_TOP], 1u);
            const unsigned tg = og / nx;
            if (og + 1u == (tg + 1u) * nx) xb_add(&bar[XB_TOPGEN], 1u);
            else XB_SPIN(xb_ld(&bar[XB_TOPGEN]) == tg, bar);
            __builtin_amdgcn_fence(__ATOMIC_ACQUIRE, "agent");
            xb_add(&bar[XB_XGEN(b.x)], 1u);
            asm volatile("s_waitcnt vmcnt(0)" ::: "memory");
        } else {
            XB_SPIN(xb_ld(&bar[XB_XGEN(b.x)]) == gen, bar);
            __builtin_amdgcn_fence(__ATOMIC_ACQUIRE, "agent");
            asm volatile("s_waitcnt vmcnt(0)" ::: "memory");
        }
    }
    __syncthreads();
}

constexpr int NWAVES = 8;
constexpr int DM = 2048, NBATCH = 8, SEQ = 2048, CTXL = 256, TPB = 2304  , MT = 18432, NPAN = 72;
constexpr int INC = 4672, INCP = 4864;
constexpr int C_NAQ = 0, C_NAK = 512, C_NAV = 1024, C_CQ = 1536, C_CKV = 1920, C_KPE = 2048, C_GQ = 2112, C_GK = 2624, C_GV = 2880, C_DQ = 3136, C_DK = 3648, C_DV = 4160;
constexpr int QMW = 768, KVW = 1280;
constexpr int DFF = 5632, DFE = 7168, NEXP = 8;
constexpr int MODW = 12288;
constexpr int MOE_ROWS = 34816, MOE_PAN = 136;
constexpr float EPSN = 1e-6f;
constexpr float SC_NA = 0.08838834764831845f, SC_MLA = 0.07216878364870322f, SC_DIFF = 0.125f;

constexpr size_t MiB = 1u << 20;
constexpr size_t WS_CTL = 0, CTL_ZERO_BYTES = 1 * MiB;
constexpr size_t WS_MOD = 1 * MiB;
constexpr size_t WS_ROPE = 1 * MiB + 900 * 1024;
constexpr size_t WS_ROUTE = 2 * MiB;
constexpr size_t WS_WIN = 3 * MiB;
constexpr size_t WS_WOUT = WS_WIN + 38 * MiB;
constexpr size_t WS_WQUP = WS_WOUT + 16 * MiB;
constexpr size_t WS_WKVUP = WS_WQUP + 2 * MiB;
constexpr size_t WS_WGU = WS_WKVUP + 2 * MiB;
constexpr size_t WS_WD = WS_WGU + 44 * MiB;
constexpr size_t WS_MGU = WS_WD + 22 * MiB;
constexpr size_t WS_MD = WS_MGU + 448 * MiB;
constexpr size_t WS_H = WS_MD + 224 * MiB;
constexpr size_t WS_U = WS_H + 144 * MiB;
constexpr size_t WS_R1 = WS_U + 72 * MiB;
constexpr size_t WS_QKV = WS_R1;
constexpr size_t WS_QM = WS_QKV + 171 * MiB;
constexpr size_t WS_KVM = WS_QM + 27 * MiB;
constexpr size_t WS_O = WS_KVM + 45 * MiB;
constexpr size_t WS_HM2 = WS_R1;
constexpr size_t WS_R2 = WS_R1 + 476 * MiB;
constexpr size_t WS_AS = WS_R2;
constexpr size_t WS_Y = WS_R2 + 136 * MiB;
constexpr size_t WS_HM = WS_R2;
constexpr size_t WS_END = WS_R2 + 272 * MiB;
static_assert(WS_O + 72 * MiB <= WS_R2, "region 1");
static_assert(WS_END <= (size_t)1792 * MiB, "workspace map must fit 4 x the largest input");
constexpr int RT_E = 0;
constexpr int RT_G = 16384;
constexpr int RT_RANK = 16384 * 3;
constexpr int RT_POS = 16384 * 5;
constexpr int RT_CNT = 16384 * 7;
static_assert((RT_CNT + 256 * 8) * 4 <= (int)MiB, "route info");
constexpr int CW_BAR = 4096;

constexpr int RING_OFF = 0, RING_BYTES = 131072;
constexpr int LDSCTL_OFF = RING_BYTES, MISC_OFF = LDSCTL_OFF + 320;
constexpr int LDS_BYTES = 147456;

namespace pg8 {
#define PG8_GAS __attribute__((address_space(1)))
struct LatentOrder : StaticOrder {
    __device__ bool next(int i, Unit& u) const { if (!StaticOrder::next(i, u)) return false; u.pm = u.pm + (u.pm >> 3) + 1; return true; }
};
#ifndef MOE_WGM
#define MOE_WGM 16
#endif
#ifndef MOE_NTB
#define MOE_NTB 0
#endif
struct MoeOrder : StaticOrder {
    static constexpr bool NTB = MOE_NTB;
    const PG8_LAS int* tab;
    __device__ bool next(int i, Unit& u) const {
        {
            const long L = (long)i * G + c; if (L >= nwg) return false;
            int wgid = (int)L; { const int q = nwg / NXCD, r = nwg % NXCD, xcd = wgid % NXCD, off = wgid / NXCD; wgid = (xcd < r ? xcd * (q + 1) : r * (q + 1) + (xcd - r) * q) + off; }
            const int nig = MOE_WGM * nN, gid = wgid / nig, fm = gid * MOE_WGM, gsz = (nM - fm) < MOE_WGM ? (nM - fm) : MOE_WGM;
            u.pm = fm + ((wgid % nig) % gsz); u.pn = (wgid % nig) / gsz;
        }
        int e = 0;
#pragma unroll
        for (int q = 0; q < 7; ++q) e += (u.pm >= __builtin_amdgcn_readfirstlane(tab[32 + q])) ? 1 : 0;
        u.pn += e * nN; return true;
    }
};
#ifndef MOED_WGM
#define MOED_WGM 4
#endif
struct MoeFullOrder : StaticOrder {
    const PG8_LAS int* tab;
    __device__ bool next(int i, Unit& u) const {
        {
            const long L = (long)i * G + c; if (L >= nwg) return false;
            int wgid = (int)L; { const int q = nwg / NXCD, r = nwg % NXCD, xcd = wgid % NXCD, off = wgid / NXCD; wgid = (xcd < r ? xcd * (q + 1) : r * (q + 1) + (xcd - r) * q) + off; }
            const int nig = MOED_WGM * nN, gid = wgid / nig, fm = gid * MOED_WGM, gsz = (nM - fm) < MOED_WGM ? (nM - fm) : MOED_WGM;
            u.pm = fm + ((wgid % nig) % gsz); u.pn = (wgid % nig) / gsz;
        }
        const int f = u.pm; int e = 0;
#pragma unroll
        for (int q = 0; q < 7; ++q) e += (f >= __builtin_amdgcn_readfirstlane(tab[40 + q])) ? 1 : 0;
        u.pm = f + __builtin_amdgcn_readfirstlane(tab[48 + e]); u.pn += e * nN; return true;
    }
    __device__ __forceinline__ void a_ready(const Unit&) const {}
    __device__ __forceinline__ void done(const Unit&) const {}
};
struct MoeRemOrder {
    static constexpr bool NTB = false;
    int nsub, G, c; const PG8_LAS int* tab;
    __device__ bool next(int i, Unit& u) const {
        const int L = i * G + c; if (L >= nsub) return false;
        const int r = L >> 5, pn = (L >> 2) & 7, ks = L & 3, e = tab[64 + r];
        u.pm = tab[32 + e] - 1; u.pn = e * 8 + pn; u.ko = ks * 1792; u.aux = r; return true;
    }
    __device__ __forceinline__ void a_ready(const Unit&) const {}
    __device__ __forceinline__ void done(const Unit&) const {}
};
struct CtxRemOrder {
    static constexpr bool NTB = false;
    int G, c;
    __device__ bool next(int i, Unit& u) const {
        const int L = i * G + c; if (L >= 256) return false;
        const int r = L >> 5, pn = (L >> 2) & 7, ks = L & 3;
        u.pm = 9 * r; u.pn = pn; u.ko = ks * 1408; u.aux = r; return true;
    }
    __device__ __forceinline__ void a_ready(const Unit&) const {}
    __device__ __forceinline__ void done(const Unit&) const {}
};
struct EpiSlab {
    static constexpr bool PERM = false, AFTER_DRAIN = false;
    float* S; float sc = 1.0f; int kdiv = 1792;
    __device__ __forceinline__ void operator()(const f32x4 (&acc)[2][2][4][2], const Unit& u, int wr, int wc, int fr_in, int fq_in) const {
        (void)fr_in; (void)fq_in; int t_ = threadIdx.x; asm volatile("" : "+v"(t_)); const int fr = t_ & 15, fq = (t_ >> 4) & 3;
        const int ks = u.ko / kdiv, pn = u.pn & 7;
        float* base = S + ((size_t)(ks * 8 + u.aux) * 256 + wr * 64 + fr) * 2048 + pn * BM + wc * 32 + 4 * fq;
#pragma unroll
        for (int ai = 0; ai < 2; ++ai)
#pragma unroll
            for (int m = 0; m < 4; ++m)
#pragma unroll
                for (int bj = 0; bj < 2; ++bj)
#pragma unroll
                    for (int n = 0; n < 2; ++n) *(PG8_GAS f32x4*)(base + (size_t)(ai * HALF + m * 16) * 2048 + bj * HALF + n * 16) = acc[ai][bj][m][n] * sc;
    }
};
struct EpiBf16P {
    static constexpr bool PERM = true, AFTER_DRAIN = false;
    bf16_t* O; int ldc; int pn_mod; float sc = 1.0f;
    __device__ __forceinline__ void operator()(const f32x4 (&acc)[2][2][4][2], const Unit& u, int wr, int wc, int fr_in, int fq_in) const {
        (void)fr_in; (void)fq_in; int t_ = threadIdx.x; asm volatile("" : "+v"(t_)); const int fr = t_ & 15, fq = (t_ >> 4) & 3;
        const int pn = pn_mod ? (u.pn % pn_mod) : u.pn;
        const int row0 = u.pm * BM + wr * 64 + fr, col0 = pn * BM + wc * 32 + 8 * fq;
#pragma unroll
        for (int ai = 0; ai < 2; ++ai)
#pragma unroll
            for (int m = 0; m < 4; ++m) { bf16_t* rowp = O + (size_t)(row0 + ai * HALF + m * 16) * ldc + col0;
#pragma unroll
                for (int bj = 0; bj < 2; ++bj) { const f32x4 v0 = acc[ai][bj][m][0] * sc, v1 = acc[ai][bj][m][1] * sc;
                    u32x4 w; w.x = cvt_pk_bf16(v0[0], v0[1]); w.y = cvt_pk_bf16(v0[2], v0[3]); w.z = cvt_pk_bf16(v1[0], v1[1]); w.w = cvt_pk_bf16(v1[2], v1[3]);
                    *(PG8_GAS u32x4*)(rowp + bj * HALF) = w; } }
    }
};
#ifndef KT_MOE
#define KT_MOE 1
#endif
#ifndef MOE_FP8
#define MOE_FP8 1
#endif
constexpr float MOE_WSCALE = 64.0f;
#ifndef EMU_FP8
#define EMU_FP8 0
#endif
#ifndef EMU_DGU
#define EMU_DGU 0
#endif
__device__ __forceinline__ unsigned pk4_fp8(float a, float b, float c, float d) { int p = __builtin_amdgcn_cvt_pk_fp8_f32(a, b, 0, false); p = __builtin_amdgcn_cvt_pk_fp8_f32(c, d, p, true); return (unsigned)p; }
__device__ __forceinline__ float fp8r(float x) { const int p = __builtin_amdgcn_cvt_pk_fp8_f32(x, x, 0, false); return __builtin_amdgcn_cvt_f32_fp8(p, 0); }
#ifndef NT_HM2
#define NT_HM2 1
#endif
__device__ __forceinline__ float silu_f(float x) { return x * __builtin_amdgcn_rcpf(1.0f + __expf(-x)); }
__device__ __forceinline__ float swiglu_f(float g, float u, float c1, float kk) { const float e = __builtin_amdgcn_exp2f(g * c1); return (g * u) * __builtin_amdgcn_rcpf(fmaf(e, kk, kk)); }
struct EpiSwiGLU {
    static constexpr bool PERM = true, AFTER_DRAIN = false;
    bf16_t* O; int ldc; int pn_mod; float isc = 1.0f;
    __device__ __forceinline__ void operator()(const f32x4 (&acc)[2][2][4][2], const Unit& u, int wr, int wc, int fr_in, int fq_in) const {
        (void)fr_in; (void)fq_in; int t_ = threadIdx.x; asm volatile("" : "+v"(t_)); const int fr = t_ & 15, fq = (t_ >> 4) & 3;
        const int pn = pn_mod ? (u.pn % pn_mod) : u.pn;
        const int row0 = u.pm * BM + wr * 64 + fr, col0 = pn * HALF + wc * 32 + 8 * fq;
        const float c1 = -1.4426950408889634f * isc, kk = 1.0f / (isc * isc);
#pragma unroll
        for (int ai = 0; ai < 2; ++ai)
#pragma unroll
            for (int m = 0; m < 4; ++m) { bf16_t* rowp = O + (size_t)(row0 + ai * HALF + m * 16) * ldc + col0;
                if (KT_MOE && pn_mod) rowp = O + ((size_t)(u.pm * (ldc >> 6) + (col0 >> 6)) * 256 + (wr * 64 + fr + ai * HALF + m * 16)) * 64 + (col0 & 63);
                f32x4 r0, r1;
#pragma unroll
                for (int j = 0; j < 4; ++j) { r0[j] = swiglu_f(acc[ai][0][m][0][j], acc[ai][1][m][0][j], c1, kk); r1[j] = swiglu_f(acc[ai][0][m][1][j], acc[ai][1][m][1][j], c1, kk); }
                if (MOE_FP8 && pn_mod) {
                    typedef unsigned u32x2 __attribute__((ext_vector_type(2)));
                    unsigned char* p8 = (unsigned char*)O + ((size_t)(u.pm * (ldc >> 7) + (col0 >> 7)) * 256 + (wr * 64 + fr + ai * HALF + m * 16)) * 128 + (col0 & 127);
                    u32x2 w8; w8.x = pk4_fp8(r0[0], r0[1], r0[2], r0[3]); w8.y = pk4_fp8(r1[0], r1[1], r1[2], r1[3]);
                    __builtin_nontemporal_store(w8, (PG8_GAS u32x2*)p8); continue; }
                if (EMU_FP8 && pn_mod) {
#pragma unroll
                    for (int j = 0; j < 4; ++j) { r0[j] = fp8r(r0[j]); r1[j] = fp8r(r1[j]); } }
                u32x4 w; w.x = cvt_pk_bf16(r0[0], r0[1]); w.y = cvt_pk_bf16(r0[2], r0[3]); w.z = cvt_pk_bf16(r1[0], r1[1]); w.w = cvt_pk_bf16(r1[2], r1[3]);
                if (NT_HM2 && pn_mod) __builtin_nontemporal_store(w, (PG8_GAS u32x4*)rowp); else *(PG8_GAS u32x4*)rowp = w; }
    }
};
struct EpiResGate {
    static constexpr bool PERM = false, AFTER_DRAIN = false;
    float* H; const float* gate;
    const float* xin; const float* cin;
    __device__ __forceinline__ void operator()(const f32x4 (&acc)[2][2][4][2], const Unit& u, int wr, int wc, int fr, int fq) const {
        const int b = u.pm / 9, j = u.pm - 9 * b, mr = (j == 0) ? 8 : b;
        const int rloc = wr * 64 + fr, col0 = u.pn * BM + wc * 32 + 4 * fq;
        const float* gp = gate + (size_t)mr * 12288 + col0;
        float* outp = H + (size_t)(u.pm * BM + rloc) * 2048 + col0;
        const float* inp = xin ? ((j == 0) ? cin + ((size_t)b * 256 + rloc) * 2048 + col0 : xin + ((size_t)b * 2048 + (size_t)(j - 1) * 256 + rloc) * 2048 + col0) : outp;
        f32x4 gv[2][2];
#pragma unroll
        for (int bj = 0; bj < 2; ++bj)
#pragma unroll
            for (int n = 0; n < 2; ++n) gv[bj][n] = *(const PG8_GAS f32x4*)(gp + bj * HALF + n * 16);
#pragma unroll
        for (int ai = 0; ai < 2; ++ai)
#pragma unroll
            for (int m = 0; m < 4; ++m) {
                const size_t ro = (size_t)(ai * HALF + m * 16) * 2048;
#pragma unroll
                for (int bj = 0; bj < 2; ++bj)
#pragma unroll
                    for (int n = 0; n < 2; ++n) { const f32x4 h = *(const PG8_GAS f32x4*)(inp + ro + bj * HALF + n * 16); *(PG8_GAS f32x4*)(outp + ro + bj * HALF + n * 16) = h + gv[bj][n] * acc[ai][bj][m][n]; }
                asm volatile("" ::: "memory"); }
    }
};
struct EpiQupRope {
    static constexpr bool PERM = false, AFTER_DRAIN = false;
    bf16_t* O; const float* tab;
    __device__ __forceinline__ void operator()(const f32x4 (&acc)[2][2][4][2], const Unit& u, int wr, int wc, int fr, int fq) const {
        const int b = u.pm / 9, j = u.pm - 9 * b; const bool lat = j != 0;
        const int rloc = wr * 64 + fr, col0 = u.pn * BM + wc * 32 + 4 * fq;
        typedef unsigned u32x2 __attribute__((ext_vector_type(2)));
#pragma unroll
        for (int bj = 0; bj < 2; ++bj) {
            const int dblk = (8 * u.pn + 4 * bj + wc) % 6; const bool rope = lat && dblk >= 4; const int axis = dblk - 4;
#pragma unroll
            for (int ai = 0; ai < 2; ++ai)
#pragma unroll
                for (int m = 0; m < 4; ++m) {
                    const int r = ai * HALF + m * 16 + rloc;
                    f32x4 x1 = acc[ai][bj][m][0], x2 = acc[ai][bj][m][1];
                    if (rope) { const int t = (j - 1) * 256 + r, pos = axis ? (t & 63) : (t >> 6);
                        const f32x4 c = *(const PG8_GAS f32x4*)(tab + pos * 16 + 4 * fq), sn = *(const PG8_GAS f32x4*)(tab + 1024 + pos * 16 + 4 * fq);
                        const f32x4 a = x1, bb = x2; x1 = a * c - bb * sn; x2 = bb * c + a * sn; }
                    bf16_t* rowp = O + (size_t)(u.pm * BM + r) * 768 + col0 + bj * HALF;
                    u32x2 w0, w1; w0.x = cvt_pk_bf16(x1[0], x1[1]); w0.y = cvt_pk_bf16(x1[2], x1[3]); w1.x = cvt_pk_bf16(x2[0], x2[1]); w1.y = cvt_pk_bf16(x2[2], x2[3]);
                    *(PG8_GAS u32x2*)rowp = w0; *(PG8_GAS u32x2*)(rowp + 16) = w1;
                    asm volatile("" ::: "memory");
                }
        }
    }
};
}
#define PG8_SP2 true
#define PG8_ALIGN true

struct Frame {
    LAS unsigned char* lds;
    volatile LAS unsigned* MISC;
    gu32* ctl;
    int wave, G, gw, NGW;
    float* out;
    unsigned char* ws;
};
__device__ __forceinline__ int opq_v(int v) { asm volatile("" : "+v"(v)); return v; }
#define TIDX opq_v((int)threadIdx.x)
typedef const float* cfptr;
__device__ __forceinline__ const float* inptr(int i) {
    const __attribute__((address_space(4))) cfptr* p = (const __attribute__((address_space(4))) cfptr*)__builtin_amdgcn_kernarg_segment_ptr();
    asm volatile("" : "+s"(p));
    return p[i];
}
enum { I_X = 0, I_C, I_CTX, I_CCTX, I_WMOD, I_BMOD, I_GMIX, I_WIN, I_NABIAS, I_MLAGQ, I_WQUP, I_MLAGKV, I_WKVUP, I_GQAGQ, I_GQAGK, I_LQ1, I_LK1, I_LQ2, I_LK2, I_GSUB, I_WOUT, I_GFFN,
       I_FG, I_FU, I_FD, I_MR, I_MB, I_MG, I_MU, I_MDN, I_GFIN };

struct TrJob { const float* W; bf16* WT; int N, ldk, k0, n0, drow0, tiled, emu; };
__device__ __forceinline__ void tr_load(const TrJob& j, f32x4 (&v)[16], int lane) {
#pragma unroll
    for (int i = 0; i < 16; ++i) { const int k = 4 * i + (lane >> 4), n4 = (lane & 15) * 4;
        v[i] = __builtin_nontemporal_load((const GAS f32x4*)(j.W + (size_t)(j.k0 + k) * j.N + j.n0 + n4)); }
}
__device__ __forceinline__ void tr_finish8(const TrJob& j, const f32x4 (&v)[16], LAS unsigned char* scr, int lane) {
    constexpr int ROWB = 68;
#pragma unroll
    for (int i = 0; i < 16; ++i) { const int k = 4 * i + (lane >> 4), n4 = (lane & 15) * 4; const f32x4 t = v[i] * pg8::MOE_WSCALE;
        *(LAS unsigned*)(scr + k * ROWB + n4) = pg8::pk4_fp8(t.x, t.y, t.z, t.w); }
    LDS_WAIT();
    const int c = lane & 3;
#pragma unroll 2
    for (int jj = 0; jj < 4; ++jj) {
        const int n = 16 * jj + (lane >> 2);
        const LAS unsigned char* s = scr + (16 * c) * ROWB + n;
        unsigned e[16];
#pragma unroll
        for (int i = 0; i < 16; ++i) e[i] = s[i * ROWB];
        v4u o; o.x = e[0] | (e[1] << 8) | (e[2] << 16) | (e[3] << 24); o.y = e[4] | (e[5] << 8) | (e[6] << 16) | (e[7] << 24);
        o.z = e[8] | (e[9] << 8) | (e[10] << 16) | (e[11] << 24); o.w = e[12] | (e[13] << 8) | (e[14] << 16) | (e[15] << 24);
        const int dr = j.drow0 + n;
        unsigned char* dst = (unsigned char*)j.WT + ((size_t)((dr >> 8) * (j.ldk >> 7) + (j.k0 >> 7)) * 256 + (dr & 255)) * 128 + (j.k0 & 127) + 16 * c;
        __builtin_nontemporal_store(o, (GAS v4u*)dst);
    }
    LDS_WAIT();
}
__device__ __forceinline__ void tr_finish(const TrJob& j, const f32x4 (&v)[16], LAS unsigned char* scr, int lane) {
    constexpr int ROWB = 136;
#pragma unroll
    for (int i = 0; i < 16; ++i) { const int k = 4 * i + (lane >> 4), n4 = (lane & 15) * 4;
        f32x4 t = v[i]; if ((EMU_FP8 && j.tiled) || (EMU_DGU && j.emu)) { t.x = pg8::fp8r(t.x * 64.f) * (1.f / 64.f); t.y = pg8::fp8r(t.y * 64.f) * (1.f / 64.f); t.z = pg8::fp8r(t.z * 64.f) * (1.f / 64.f); t.w = pg8::fp8r(t.w * 64.f) * (1.f / 64.f); }
        v2u w; w.x = pg8::cvt_pk_bf16(t.x, t.y); w.y = pg8::cvt_pk_bf16(t.z, t.w);
        *(LAS v2u*)(scr + k * ROWB + n4 * 2) = w; }
    LDS_WAIT();
    const int c = lane & 7;
#pragma unroll 2
    for (int jj = 0; jj < 8; ++jj) {
        const int n = 8 * jj + (lane >> 3);
        const LAS unsigned short* s = (const LAS unsigned short*)(scr + (8 * c) * ROWB + n * 2);
        unsigned e[8];
#pragma unroll
        for (int i = 0; i < 8; ++i) e[i] = s[i * (ROWB / 2)];
        v4u o; o.x = e[0] | (e[1] << 16); o.y = e[2] | (e[3] << 16); o.z = e[4] | (e[5] << 16); o.w = e[6] | (e[7] << 16);
        const int dr = j.drow0 + n;
        bf16* dst = j.tiled ? j.WT + ((size_t)((dr >> 8) * (j.ldk >> 6) + (j.k0 >> 6)) * 256 + (dr & 255)) * 64 + 8 * c : j.WT + (size_t)dr * j.ldk + j.k0 + 8 * c;
        __builtin_nontemporal_store(o, (GAS v4u*)dst);
    }
    LDS_WAIT();
}
constexpr int IT_WIN = 32 * 73, IT_WOUT = 32 * 32, IT_FGU = 32 * 88, IT_FD = 88 * 32, IT_MGU = 32 * 112, IT_MD = 112 * 32;
constexpr int CV_N0 = 2 * IT_WIN, CV_N1 = CV_N0 + 2 * IT_WOUT, CV_N2 = CV_N1 + 2 * IT_FGU, CV_N3 = CV_N2 + IT_FD, CV_N4 = CV_N3 + 16 * IT_MGU, CV_N5 = CV_N4 + 8 * IT_MD;
constexpr int CVQ_L1 = IT_WIN + IT_WOUT, CVQ_N = CVQ_L1 + (CV_N5 - CV_N1), CVQ_FFN_END = CVQ_L1 + (CV_N3 - CV_N1);
__device__ __forceinline__ int cvq_item(int q) { return q < IT_WIN ? IT_WIN + q : (q < CVQ_L1 ? CV_N0 + IT_WOUT + (q - IT_WIN) : CV_N1 + (q - CVQ_L1)); }
__device__ __forceinline__ TrJob conv_job(int it, unsigned char* ws) {
    const float* W; bf16* WT; int N, ldk, k0, n0, drow0, tiled = 0, emu = 0;
    if (it < CV_N0) { const int l = it / IT_WIN, r = it % IT_WIN, kb = r / 73, nb = r % 73;
        W = inptr(I_WIN) + (size_t)l * 2048 * INC; N = INC; WT = (bf16*)(ws + WS_WIN) + (size_t)l * INCP * 2048; ldk = 2048; k0 = kb * 64; n0 = nb * 64; drow0 = n0; }
    else if (it < CV_N1) { const int q = it - CV_N0, l = q / IT_WOUT, r = q % IT_WOUT, kb = r / 32, nb = r % 32;
        W = inptr(I_WOUT) + (size_t)l * 2048 * 2048; N = 2048; WT = (bf16*)(ws + WS_WOUT) + (size_t)l * 2048 * 2048; ldk = 2048; k0 = kb * 64; n0 = nb * 64; drow0 = n0; }
    else if (it < CV_N2) { const int q = it - CV_N1, which = q / IT_FGU, r = q % IT_FGU, kb = r / 88, nb = r % 88;
        W = which ? inptr(I_FU) : inptr(I_FG); N = DFF; WT = (bf16*)(ws + WS_WGU); ldk = 2048; k0 = kb * 64; n0 = nb * 64; drow0 = (n0 >> 7) * 256 + (n0 & 127) + which * 128; emu = 1; }
    else if (it < CV_N3) { const int r = it - CV_N2, kb = r / 32, nb = r % 32;
        W = inptr(I_FD); N = 2048; WT = (bf16*)(ws + WS_WD); ldk = DFF; k0 = kb * 64; n0 = nb * 64; drow0 = n0; }
    else if (it < CV_N4) { const int q = it - CV_N3, mat = q / IT_MGU, e = mat >> 1, which = mat & 1, r = q % IT_MGU, kb = r / 112, nb = r % 112;
        W = (which ? inptr(I_MU) : inptr(I_MG)) + (size_t)e * 2048 * DFE; N = DFE; WT = MOE_FP8 ? (bf16*)(ws + WS_MGU + (size_t)e * 14336 * 2048) : (bf16*)(ws + WS_MGU) + (size_t)e * 14336 * 2048; ldk = 2048; k0 = kb * 64; n0 = nb * 64; drow0 = (n0 >> 7) * 256 + (n0 & 127) + which * 128; tiled = MOE_FP8 ? 2 : KT_MOE; }
    else { const int q = it - CV_N4, e = q / IT_MD, r = q % IT_MD, kb = r / 32, nb = r % 32;
        W = inptr(I_MDN) + (size_t)e * DFE * 2048; N = 2048; WT = MOE_FP8 ? (bf16*)(ws + WS_MD + (size_t)e * 2048 * DFE) : (bf16*)(ws + WS_MD) + (size_t)e * 2048 * DFE; ldk = DFE; k0 = kb * 64; n0 = nb * 64; drow0 = n0; tiled = MOE_FP8 ? 2 : KT_MOE; }
    TrJob j; j.W = W; j.WT = WT; j.N = N; j.ldk = ldk; j.k0 = k0; j.n0 = n0; j.drow0 = drow0; j.tiled = tiled; j.emu = emu; return j;
}
template <bool QUEUE>
__device__ __forceinline__ void conv_pair(int it0, int it1, int nlim, unsigned char* ws, LAS unsigned char* scr, int lane) {
    if (it0 >= nlim) return;
    const bool two = it1 < nlim;
    const TrJob j0 = conv_job(QUEUE ? cvq_item(it0) : it0, ws), j1 = conv_job(QUEUE ? cvq_item(two ? it1 : it0) : (two ? it1 : it0), ws);
    f32x4 v0[16], v1[16];
#ifdef PROBE_CONV2
    if (QUEUE) { tr_load(j0, v0, lane); if (two) tr_load(j1, v1, lane); if (j0.tiled == 2) tr_finish8(j0, v0, scr, lane); else tr_finish(j0, v0, scr, lane); if (two) { if (j1.tiled == 2) tr_finish8(j1, v1, scr, lane); else tr_finish(j1, v1, scr, lane); } }
#endif
    tr_load(j0, v0, lane); if (two) tr_load(j1, v1, lane);
    if (j0.tiled == 2) tr_finish8(j0, v0, scr, lane); else tr_finish(j0, v0, scr, lane);
    if (two) { if (j1.tiled == 2) tr_finish8(j1, v1, scr, lane); else tr_finish(j1, v1, scr, lane); }
}
#ifndef CV_CHUNK_N
#define CV_CHUNK_N 16
#endif
constexpr int CW_QHEAD = 64, CW_DONE0 = 128, CV_CHUNK = CV_CHUNK_N;
#ifndef NO_TAIL_FILL
#define NO_TAIL_FILL 0
#endif
__device__ __forceinline__ void filler(Frame& F, int slot, int drain_to) {
    if (NO_TAIL_FILL && drain_to < 0) return;
    __syncthreads();
    LAS int* bc = (LAS int*)(F.lds + LDSCTL_OFF + 2048);
    LAS unsigned char* scr = F.lds + F.wave * 8704;
    gu32* qhead = F.ctl + CW_QHEAD; gu32* done = F.ctl + CW_DONE0 + 64 * slot;
    if (TIDX == 0 && drain_to < 0) __hip_atomic_fetch_add(done, 1u, RLX_AGENT);
    const int nq = CVQ_N, lim = drain_to < 0 ? nq : drain_to;
    for (;;) {
        if (TIDX == 0) {
            int h = -1; bool stop = false;
            if (drain_to < 0) stop = __hip_atomic_load(done, RLX_AGENT) >= (unsigned)F.G;
            else stop = __hip_atomic_load(qhead, RLX_AGENT) >= (unsigned)lim;
            if (!stop) { h = (int)__hip_atomic_fetch_add(qhead, (unsigned)CV_CHUNK, RLX_AGENT); if (h >= nq) h = -1; }
            *bc = h;
        }
        __syncthreads();
        const int h = *bc;
        __syncthreads();
        if (h < 0) break;
#pragma unroll 1
        for (int k = F.wave; k < CV_CHUNK; k += 2 * NWAVES) conv_pair<true>(h + k, h + k + NWAVES, CVQ_N, F.ws, scr, (TIDX & 63));
    }
    __syncthreads();
}

__device__ __forceinline__ void rope_cs(int pos, int i, float inv_nfreq, float& c, float& s) {
    const float freq = exp2f(-(float)i * inv_nfreq * 13.287712379549449f);
    const float ang = (float)pos * freq;
    c = __cosf(ang); s = __sinf(ang);
}

__device__ __forceinline__ void filler_quota(Frame& F, int nchunks) {
    __syncthreads();
    LAS int* bc = (LAS int*)(F.lds + LDSCTL_OFF + 2048);
    LAS unsigned char* scr = F.lds + F.wave * 8704;
    gu32* qhead = F.ctl + CW_QHEAD;
    const int nq = CVQ_N;
#pragma unroll 1
    for (int cidx = 0; cidx < nchunks; ++cidx) {
        if (TIDX == 0) { int h = -1;
            if (__hip_atomic_load(qhead, RLX_AGENT) < (unsigned)nq) { h = (int)__hip_atomic_fetch_add(qhead, (unsigned)CV_CHUNK, RLX_AGENT); if (h >= nq) h = -1; }
            *bc = h; }
        __syncthreads();
        const int h = *bc;
        __syncthreads();
        if (h < 0) break;
#pragma unroll 1
        for (int k = F.wave; k < CV_CHUNK; k += 2 * NWAVES) conv_pair<true>(h + k, h + k + NWAVES, CVQ_N, F.ws, scr, (TIDX & 63));
    }
    __syncthreads();
}

__device__ __forceinline__ float silu_g(float x) { return x / (1.0f + __expf(-x)); }

__device__ __forceinline__ void p0_prologue(Frame& F) {
    unsigned char* ws = F.ws;
    __syncthreads();
    {
        LAS float* sv = (LAS float*)(F.lds);
        LAS float* red = (LAS float*)(F.lds + 73728);
        for (int i = TIDX; i < 9 * 2048; i += 512) { const int r = i >> 11, d = i & 2047; const float v = (r < 8) ? inptr(I_C)[r * 2048 + d] : inptr(I_CCTX)[d]; sv[i] = silu_g(v); }
        __syncthreads();
        for (int cb = blockIdx.x; cb < 256; cb += F.G) {
            const int cg = cb * 96, layer = cg / MODW, col0 = cg - layer * MODW;
            const float* W = inptr(I_WMOD) + (size_t)layer * 2048 * MODW;
            if (TIDX < 384) {
                const int cq = TIDX % 24, ks = TIDX / 24;
                f32x4 acc[9];
#pragma unroll
                for (int r = 0; r < 9; ++r) acc[r] = (f32x4){0.f, 0.f, 0.f, 0.f};
                const float* wp = W + (size_t)(ks * 128) * MODW + col0 + cq * 4;
#pragma unroll 2
                for (int k = 0; k < 128; k += 4) {
                    f32x4 w[4];
#pragma unroll
                    for (int q = 0; q < 4; ++q) w[q] = __builtin_nontemporal_load((const GAS f32x4*)(wp + (size_t)(k + q) * MODW));
#pragma unroll
                    for (int r = 0; r < 9; ++r) { const f32x4 s4 = *(const LAS f32x4*)(sv + r * 2048 + ks * 128 + k);
                        acc[r] += w[0] * s4.x; acc[r] += w[1] * s4.y; acc[r] += w[2] * s4.z; acc[r] += w[3] * s4.w; }
                }
#pragma unroll
                for (int r = 0; r < 9; ++r) *(LAS f32x4*)(red + (ks * 9 + r) * 96 + cq * 4) = acc[r];
            }
            __syncthreads();
            for (int i = TIDX; i < 9 * 96; i += 512) {
                const int r = i / 96, c = i - r * 96; float s = inptr(I_BMOD)[layer * MODW + col0 + c];
#pragma unroll
                for (int ks = 0; ks < 16; ++ks) s += red[(ks * 9 + r) * 96 + c];
                ((float*)(ws + WS_MOD))[((size_t)layer * 9 + r) * MODW + col0 + c] = s;
            }
            __syncthreads();
        }
    }
    {
        const size_t gt = (size_t)blockIdx.x * 512 + TIDX, GT = (size_t)F.G * 512;
        for (size_t i = gt; i < (size_t)2 * 768 * 384; i += GT) { const int l = (int)(i / (768 * 384)), r = (int)(i % (768 * 384)), n = r / 384, k = r % 384;
            ((bf16*)(ws + WS_WQUP))[i] = (bf16)f2bf(inptr(I_WQUP)[((size_t)l * 384 + k) * 768 + n]); }
        for (size_t i = gt; i < (size_t)2 * 1280 * 256; i += GT) { const int l = (int)(i / (1280 * 256)), r = (int)(i % (1280 * 256)), row = r >> 8, k = r & 255, h = row / 320, j = row - 320 * h;
            float v = 0.f;
            if (j < 128) { if (k < 128) v = inptr(I_WKVUP)[((size_t)l * 128 + k) * 1024 + h * 256 + j]; }
            else if (j < 192) { if (k == j) v = 1.0f; }
            else { if (k < 128) v = inptr(I_WKVUP)[((size_t)l * 128 + k) * 1024 + h * 256 + 128 + (j - 192)]; }
            ((bf16*)(ws + WS_WKVUP))[i] = (bf16)f2bf(v); }
        for (size_t i = gt; i < 64 * 16 + 64 * 32; i += GT) { float* tb = (float*)(ws + WS_ROPE);
            if (i < 1024) { const int pos = (int)i >> 4, f = (int)i & 15; float c, sn; rope_cs(pos, f, 1.0f / 16.0f, c, sn); tb[i] = c; tb[1024 + i] = sn; }
            else { const int q = (int)i - 1024, pos = q >> 5, f = q & 31; float c, sn; rope_cs(pos, f, 1.0f / 32.0f, c, sn); tb[2048 + q] = c; tb[4096 + q] = sn; } }
        for (size_t i = gt; i < (size_t)2 * 192 * 2048 / 8; i += GT) { const int l = (int)(i / (192 * 256)), r = (int)(i % (192 * 256));
            *(GAS v4u*)((bf16*)(ws + WS_WIN) + ((size_t)l * INCP + INC) * 2048 + (size_t)r * 8) = (v4u){0u, 0u, 0u, 0u}; }
    }
    {
        LAS unsigned char* scr = F.lds + F.wave * 8704;
        for (int it = F.gw; it < IT_WIN + IT_WOUT; it += 2 * F.NGW) {
            const int i1 = it + F.NGW, a0 = it < IT_WIN ? it : CV_N0 + (it - IT_WIN), a1 = i1 < IT_WIN ? i1 : CV_N0 + (i1 - IT_WIN);
            conv_pair<false>(a0, i1 < IT_WIN + IT_WOUT ? a1 : CV_N5, CV_N5, ws, scr, (TIDX & 63)); }
    }
}

struct RowInfo { int b, w, t, mr; bool ctx; };
__device__ __forceinline__ RowInfo row_info(int r) { RowInfo q; q.b = r / TPB; q.w = r - q.b * TPB; q.ctx = q.w < CTXL; q.t = q.w - CTXL; q.mr = q.ctx ? 8 : q.b; return q; }

__device__ __forceinline__ void norm_pass(Frame& F, int layer, bool first  , bool from_input, bool split_ctx = false) {
    unsigned char* ws = F.ws;
    const float* modl = (const float*)(ws + WS_MOD) + (size_t)layer * 9 * MODW;
    const float* g = (first ? inptr(I_GMIX) : inptr(I_GFFN)) + layer * DM;
    const int sh_off = first ? 0 : 3 * DM, sc_off = first ? DM : 4 * DM;
    const float* H = (const float*)(ws + WS_H); bf16* U = (bf16*)(ws + WS_U);
    const int tid_ = TIDX, lane_ = tid_ & 63;
    LAS float* ca = (LAS float*)F.lds; LAS float* cb = ca + 4096;
    LAS float* cg = ca + 8192;
    for (int blk = blockIdx.x; blk < 256; blk += F.G) {
        const int r0 = blk * 72, bb = r0 / TPB;
        __syncthreads();
        for (int i = tid_; i < 2 * 2048; i += 512) { const int slot = i >> 11, col = i & 2047, mr = slot ? bb : 8;
            ca[i] = g[col] * (1.0f + modl[(size_t)mr * MODW + sc_off + col]); cb[i] = modl[(size_t)mr * MODW + sh_off + col]; }
        if (split_ctx) for (int i = tid_; i < 2048; i += 512) cg[i] = ((const float*)(ws + WS_MOD))[(size_t)8 * MODW + 5 * DM + i];
        __syncthreads();
#define NP_ROW(k_, q_) (split_ctx ? bb * TPB + ((3 * (k_) + (q_)) < 8 ? CTXL + 64 * (blk & 31) + 8 * F.wave + 3 * (k_) + (q_) : 8 * (blk & 31) + F.wave) : r0 + 9 * F.wave + 3 * (k_) + (q_))
#pragma unroll 1
        for (int k = 0; k < 3; ++k) {
            f32x4 v[3][8];
#pragma unroll
            for (int q = 0; q < 3; ++q) { const int r = NP_ROW(k, q), w = r - bb * TPB;
                const float* src = from_input ? ((w < CTXL) ? inptr(I_CTX) + ((size_t)bb * CTXL + w) * DM : inptr(I_X) + ((size_t)bb * SEQ + (w - CTXL)) * DM) : H + (size_t)r * DM;
                const GAS f32x4* xr = (const GAS f32x4*)src + lane_;
#pragma unroll
                for (int j = 0; j < 8; ++j) v[q][j] = xr[64 * j]; }
            if (split_ctx && k == 2) {
                const GAS f32x4* sl = (const GAS f32x4*)((const float*)(ws + WS_R1) + ((size_t)bb * 256 + 8 * (blk & 31) + F.wave) * 2048) + lane_;
                const LAS f32x4* gp = (const LAS f32x4*)cg + lane_;
#pragma unroll 1
                for (int s4 = 0; s4 < 4; ++s4) { f32x4 t[8];
#pragma unroll
                    for (int j = 0; j < 8; ++j) t[j] = sl[(size_t)s4 * (8 * 256 * 2048 / 4) + 64 * j];
#pragma unroll
                    for (int j = 0; j < 8; ++j) v[2][j] += gp[64 * j] * t[j]; }
            }
#pragma unroll
            for (int q = 0; q < 3; ++q) { const int r = NP_ROW(k, q), w = r - bb * TPB, slot = (w < CTXL) ? 0 : 1;
                float ss = 0.f;
#pragma unroll
                for (int j = 0; j < 8; ++j) ss += (v[q][j].x * v[q][j].x + v[q][j].y * v[q][j].y) + (v[q][j].z * v[q][j].z + v[q][j].w * v[q][j].w);
                const float rstd = 1.0f / sqrtf(wave_sum(ss) * (1.0f / DM) + EPSN);
                GAS v2u* o8 = (GAS v2u*)(U + (size_t)r * DM) + lane_;
                const LAS f32x4* ap = (const LAS f32x4*)(ca + slot * 2048) + lane_; const LAS f32x4* bp = (const LAS f32x4*)(cb + slot * 2048) + lane_;
#pragma unroll
                for (int j = 0; j < 8; ++j) { f32x4 y = v[q][j] * rstd * ap[64 * j] + bp[64 * j]; if (EMU_DGU && !first) { y.x = pg8::fp8r(y.x); y.y = pg8::fp8r(y.y); y.z = pg8::fp8r(y.z); y.w = pg8::fp8r(y.w); } v2u wv; wv.x = pg8::cvt_pk_bf16(y.x, y.y); wv.y = pg8::cvt_pk_bf16(y.z, y.w); o8[64 * j] = wv; } }
        }
#undef NP_ROW
    }
    __syncthreads();
}

struct PostRow { unsigned cq[3], ckv; float kpe[2], gq[6][2], df[8][2]; };
__device__ __forceinline__ void post_load(const bf16* q, bool lat, int lane, PostRow& R) {
    const GAS unsigned* pc = (const GAS unsigned*)(q + C_CQ);
#pragma unroll
    for (int j = 0; j < 3; ++j) R.cq[j] = pc[lane + 64 * j];
    R.ckv = ((const GAS unsigned*)(q + C_CKV))[lane];
    { const int axis = (lane >> 4) & 1, i = lane & 15; const GAS bf16* pk = (const GAS bf16*)(q + C_KPE + axis * 32); R.kpe[0] = bf1(pk[i]); R.kpe[1] = bf1(pk[16 + i]); }
#pragma unroll
    for (int hh = 0; hh < 6; ++hh) { const int base = (hh < 4) ? (C_GQ + 128 * hh) : (C_GK + 128 * (hh - 4)); const int axis = lane >> 5, i = lane & 31;
        const GAS bf16* pg = (const GAS bf16*)(q + base + axis * 64); R.gq[hh][0] = bf1(pg[i]); R.gq[hh][1] = bf1(pg[32 + i]); }
    if (lat) {
#pragma unroll
        for (int pp = 0; pp < 8; ++pp) { const int blk = 2 * pp + (lane >> 5), axis = (lane >> 4) & 1, i = lane & 15; const int base = (blk < 8) ? (C_DQ + 64 * blk) : (C_DK + 64 * (blk - 8));
            const GAS bf16* pd = (const GAS bf16*)(q + base + axis * 32); R.df[pp][0] = bf1(pd[i]); R.df[pp][1] = bf1(pd[16 + i]); }
    }
}
__device__ __forceinline__ void post_finish(bf16* q, bool lat, int prow, int pcol, int lane, const PostRow& R, const float* g_mq, const float* g_mkv, const float* g_gq, const float* g_gk, const float* rt) {
    { float ss = 0.f;
#pragma unroll
      for (int j = 0; j < 3; ++j) { const float a = bflo(R.cq[j]), b = bfhi(R.cq[j]); ss += a * a + b * b; }
      const float rs = 1.0f / sqrtf(wave_sum(ss) * (1.0f / 384.0f) + EPSN); GAS unsigned* pc = (GAS unsigned*)(q + C_CQ);
#pragma unroll
      for (int j = 0; j < 3; ++j) { const int c = 2 * (lane + 64 * j); pc[lane + 64 * j] = pk2(bflo(R.cq[j]) * rs * g_mq[c], bfhi(R.cq[j]) * rs * g_mq[c + 1]); } }
    { const float a = bflo(R.ckv), b = bfhi(R.ckv); const float rs = 1.0f / sqrtf(wave_sum(a * a + b * b) * (1.0f / 128.0f) + EPSN);
      ((GAS unsigned*)(q + C_CKV))[lane] = pk2(a * rs * g_mkv[2 * lane], b * rs * g_mkv[2 * lane + 1]); }
    if (lat && lane < 32) { const int axis = lane >> 4, i = lane & 15, pos = axis ? pcol : prow; const float c = rt[pos * 16 + i], s = rt[1024 + pos * 16 + i];
      GAS bf16* pk = (GAS bf16*)(q + C_KPE + axis * 32); pk[i] = (bf16)f2bf(R.kpe[0] * c - R.kpe[1] * s); pk[16 + i] = (bf16)f2bf(R.kpe[1] * c + R.kpe[0] * s); }
    { const int axis = lane >> 5, i = lane & 31, pos = axis ? pcol : prow; const float c = rt[2048 + pos * 32 + i], s = rt[4096 + pos * 32 + i];
#pragma unroll
      for (int hh = 0; hh < 6; ++hh) { const int base = (hh < 4) ? (C_GQ + 128 * hh) : (C_GK + 128 * (hh - 4)); const float* gg = (hh < 4) ? g_gq : g_gk;
        const float x1 = R.gq[hh][0], x2 = R.gq[hh][1];
        const float rs = 1.0f / sqrtf(wave_sum(x1 * x1 + x2 * x2) * (1.0f / 128.0f) + EPSN);
        float y1 = x1 * rs * gg[axis * 64 + i], y2 = x2 * rs * gg[axis * 64 + 32 + i];
        if (lat) { const float o1 = y1 * c - y2 * s, o2 = y2 * c + y1 * s; y1 = o1; y2 = o2; }
        GAS bf16* pg = (GAS bf16*)(q + base + axis * 64); pg[i] = (bf16)f2bf(y1); pg[32 + i] = (bf16)f2bf(y2); } }
    if (lat) { const int axis = (lane >> 4) & 1, i = lane & 15, pos = axis ? pcol : prow; const float c = rt[pos * 16 + i], s = rt[1024 + pos * 16 + i];
#pragma unroll
      for (int pp = 0; pp < 8; ++pp) { const int blk = 2 * pp + (lane >> 5); const int base = (blk < 8) ? (C_DQ + 64 * blk) : (C_DK + 64 * (blk - 8));
        GAS bf16* pd = (GAS bf16*)(q + base + axis * 32); pd[i] = (bf16)f2bf(R.df[pp][0] * c - R.df[pp][1] * s); pd[16 + i] = (bf16)f2bf(R.df[pp][1] * c + R.df[pp][0] * s); } }
}
__device__ __forceinline__ void post_pass(Frame& F, int layer) {
    bf16* QKV = (bf16*)(F.ws + WS_QKV); const float* rt = (const float*)(F.ws + WS_ROPE);
    const float* g_mq = inptr(I_MLAGQ) + layer * 384; const float* g_mkv = inptr(I_MLAGKV) + layer * 128;
    const float* g_gq = inptr(I_GQAGQ) + layer * 128; const float* g_gk = inptr(I_GQAGK) + layer * 128;
    const int lane = opq_v((TIDX & 63));
    for (int r = F.gw; r < MT; r += 2 * F.NGW) {
        const int r2 = r + F.NGW; const bool two = r2 < MT;
        const RowInfo ra = row_info(r), rb = row_info(two ? r2 : r);
        bf16* qa = QKV + (size_t)r * INCP; bf16* qb = QKV + (size_t)(two ? r2 : r) * INCP;
        PostRow A, B;
        post_load(qa, !ra.ctx, lane, A); if (two) post_load(qb, !rb.ctx, lane, B);
        post_finish(qa, !ra.ctx, ra.ctx ? 0 : (ra.t >> 6), ra.ctx ? 0 : (ra.t & 63), lane, A, g_mq, g_mkv, g_gq, g_gk, rt);
        if (two) post_finish(qb, !rb.ctx, rb.ctx ? 0 : (rb.t >> 6), rb.ctx ? 0 : (rb.t & 63), lane, B, g_mq, g_mkv, g_gq, g_gk, rt);
    }
}
__device__ __forceinline__ void qm_rope_pass(Frame& F) {
    bf16* QM = (bf16*)(F.ws + WS_QM); const int lane = opq_v((TIDX & 63));
    for (int r = F.gw; r < MT; r += F.NGW) {
        const RowInfo ri = row_info(r); if (ri.ctx) continue;
        const int prow = ri.t >> 6, pcol = ri.t & 63;
#pragma unroll
        for (int pp = 0; pp < 2; ++pp) {
            const int h = 2 * pp + (lane >> 5), axis = (lane >> 4) & 1, i = lane & 15;
            GAS bf16* p = (GAS bf16*)(QM + (size_t)r * QMW + 192 * h + 128 + axis * 32);
            const float x1 = bf1(p[i]), x2 = bf1(p[16 + i]); float c, s; rope_cs(axis ? pcol : prow, i, 1.0f / 16.0f, c, s);
            p[i] = (bf16)f2bf(x1 * c - x2 * s); p[16 + i] = (bf16)f2bf(x2 * c + x1 * s);
        }
    }
}

__device__ __forceinline__ void ffn_tables(Frame& F, int layer, int b, LAS float* ca, LAS float* cb) {
    const float* modl = (const float*)(F.ws + WS_MOD) + (size_t)layer * 9 * MODW + (size_t)b * MODW; const float* g = inptr(I_GFFN) + layer * DM;
    for (int i = TIDX; i < 2048; i += 512) { ca[i] = g[i] * (1.0f + modl[4 * DM + i]); cb[i] = modl[3 * DM + i]; }
}
__device__ __forceinline__ void ffn_u_pair(Frame& F, int r0, int r1, const LAS float* ca, const LAS float* cb, int lane_, f32x4 (&v0)[8], f32x4 (&v1)[8]) {
    const float* H = (const float*)(F.ws + WS_H);
    const GAS f32x4* x0 = (const GAS f32x4*)(H + (size_t)r0 * DM) + lane_; const GAS f32x4* x1 = (const GAS f32x4*)(H + (size_t)r1 * DM) + lane_;
#pragma unroll
    for (int j = 0; j < 8; ++j) { v0[j] = x0[64 * j]; v1[j] = x1[64 * j]; }
    float s0 = 0.f, s1 = 0.f;
#pragma unroll
    for (int j = 0; j < 8; ++j) { s0 += (v0[j].x * v0[j].x + v0[j].y * v0[j].y) + (v0[j].z * v0[j].z + v0[j].w * v0[j].w); s1 += (v1[j].x * v1[j].x + v1[j].y * v1[j].y) + (v1[j].z * v1[j].z + v1[j].w * v1[j].w); }
    const float q0 = 1.0f / sqrtf(wave_sum(s0) * (1.0f / DM) + EPSN), q1 = 1.0f / sqrtf(wave_sum(s1) * (1.0f / DM) + EPSN);
    const LAS f32x4* ap = (const LAS f32x4*)ca + lane_; const LAS f32x4* bp = (const LAS f32x4*)cb + lane_;
#pragma unroll
    for (int j = 0; j < 8; ++j) { const f32x4 a4 = ap[64 * j], b4 = bp[64 * j]; v0[j] = v0[j] * q0 * a4 + b4; v1[j] = v1[j] * q1 * a4 + b4; }
}
__device__ __forceinline__ int moe_tok(int blk, int tl) { return (blk >> 5) * 2048 + (blk & 31) + 32 * tl; }
__device__ __forceinline__ void route_one(const f32x4 (&v)[8], const LAS float* wl, const float* br, int lane_, int& e1o, int& e2o, float& g1o, float& g2o) {
    float lg[8];
#pragma unroll
    for (int e = 0; e < 8; ++e) lg[e] = 0.f;
#pragma unroll
    for (int j = 0; j < 8; ++j) {
        const LAS f32x4* wp = (const LAS f32x4*)(wl + (size_t)(4 * (lane_ + 64 * j)) * 8);
#pragma unroll
        for (int c = 0; c < 4; ++c) { const f32x4 w0 = wp[2 * c], w1 = wp[2 * c + 1]; const float x = v[j][c];
            lg[0] += x * w0.x; lg[1] += x * w0.y; lg[2] += x * w0.z; lg[3] += x * w0.w; lg[4] += x * w1.x; lg[5] += x * w1.y; lg[6] += x * w1.z; lg[7] += x * w1.w; }
    }
#pragma unroll
    for (int e = 0; e < 8; ++e) lg[e] = wave_sum(lg[e]) + br[e];
    int e1 = 0; float v1 = lg[0];
#pragma unroll
    for (int e = 1; e < 8; ++e) if (lg[e] > v1) { v1 = lg[e]; e1 = e; }
    int e2 = -1; float v2 = -3.0e38f;
#pragma unroll
    for (int e = 0; e < 8; ++e) if (e != e1 && lg[e] > v2) { v2 = lg[e]; e2 = e; }
    g2o = 1.0f / (1.0f + expf(v1 - v2)); g1o = 1.0f - g2o; e1o = e1; e2o = e2;
}
__device__ __forceinline__ void moe_route_pass(Frame& F, int layer) {
    const int lane_ = opq_v((TIDX & 63));
    int* rt = (int*)(F.ws + WS_ROUTE); float* rtf = (float*)(F.ws + WS_ROUTE);
    LAS float* ca = (LAS float*)F.lds; LAS float* cb = ca + 2048; LAS float* wl = ca + 4096;
    LAS int* le = (LAS int*)(F.lds + 16384 + 65536);
    const float* wr = inptr(I_MR); const float* br = inptr(I_MB);
    __syncthreads();
    for (int i = TIDX; i < 2048 * 8 / 4; i += 512) ((LAS f32x4*)wl)[i] = ((const GAS f32x4*)wr)[i];
    for (int blk = blockIdx.x; blk < 256; blk += F.G) {
        const int b = blk >> 5;
        __syncthreads();
        ffn_tables(F, layer, b, ca, cb);
        __syncthreads();
#pragma unroll 1
        for (int i = 0; i < 4; ++i) {
            const int tl = F.wave + 16 * i, tl1 = tl + 8, tok = moe_tok(blk, tl), tok1 = moe_tok(blk, tl1);
            f32x4 v0[8], v1[8]; ffn_u_pair(F, b * TPB + CTXL + (tok & 2047), b * TPB + CTXL + (tok1 & 2047), ca, cb, lane_, v0, v1);
            int e1, e2; float g1, g2;
            route_one(v0, wl, br, lane_, e1, e2, g1, g2);
            if (lane_ == 0) { le[tl] = e1 | (e2 << 8); rt[RT_E + tok] = e1 | (e2 << 8); rtf[RT_G + 2 * tok] = g1; rtf[RT_G + 2 * tok + 1] = g2; }
            route_one(v1, wl, br, lane_, e1, e2, g1, g2);
            if (lane_ == 0) { le[tl1] = e1 | (e2 << 8); rt[RT_E + tok1] = e1 | (e2 << 8); rtf[RT_G + 2 * tok1] = g1; rtf[RT_G + 2 * tok1 + 1] = g2; }
        }
        __syncthreads();
        if (TIDX < 8) { const int e = TIDX; int cnt = 0;
            for (int tl = 0; tl < 64; ++tl) { const int w = le[tl], a = w & 255, c = w >> 8;
                if (a == e) rt[RT_RANK + 2 * moe_tok(blk, tl)] = cnt++;
                if (c == e) rt[RT_RANK + 2 * moe_tok(blk, tl) + 1] = cnt++; }
            rt[RT_CNT + blk * 8 + e] = cnt; }
    }
    __syncthreads();
}
__device__ __forceinline__ void moe_tables(Frame& F, LAS int* tab, int blk) {
    const int* rt = (const int*)(F.ws + WS_ROUTE);
    __syncthreads();
    if (TIDX < 8) { const int e = TIDX; int tot = 0, before = 0;
        for (int k = 0; k < 256; ++k) { const int c = rt[RT_CNT + k * 8 + e]; tot += c; before += (k < blk) ? c : 0; }
        tab[e] = tot; tab[16 + e] = before; }
    __syncthreads();
    if (TIDX == 0) { int base = 0, pan = 0, nf = 0, nr = 0;
        for (int e = 0; e < 8; ++e) { tab[8 + e] = base; const int np = (tab[e] + 255) >> 8, fu = tab[e] >> 8; base += np * 256; pan += np; tab[32 + e] = pan;
            tab[48 + e] = nr; nf += fu; tab[40 + e] = nf; if (np != fu) { tab[64 + nr] = e; ++nr; } }
        tab[24] = pan; tab[56] = nf; tab[57] = nr; }
    __syncthreads();
}
__device__ __forceinline__ void moe_scatter_pass(Frame& F, int layer) {
    const int lane_ = opq_v((TIDX & 63));
    int* rt = (int*)(F.ws + WS_ROUTE); bf16* AS = (bf16*)(F.ws + WS_AS);
    LAS int* tab = (LAS int*)(F.lds + 16384); LAS float* ca = (LAS float*)F.lds; LAS float* cb = ca + 2048;
    for (int blk = blockIdx.x; blk < 256; blk += F.G) {
        const int b = blk >> 5;
        moe_tables(F, tab, blk);
        ffn_tables(F, layer, b, ca, cb);
        __syncthreads();
#pragma unroll 1
        for (int i = 0; i < 4; ++i) {
            const int tl = F.wave + 16 * i, tok = moe_tok(blk, tl), tok1 = moe_tok(blk, tl + 8);
            f32x4 v0[8], v1[8]; ffn_u_pair(F, b * TPB + CTXL + (tok & 2047), b * TPB + CTXL + (tok1 & 2047), ca, cb, lane_, v0, v1);
#pragma unroll
            for (int s = 0; s < 2; ++s) {
                const int tk = s ? tok1 : tok; const int w = rt[RT_E + tk], e1 = w & 255, e2 = w >> 8;
                const int p1 = tab[8 + e1] + tab[16 + e1] + rt[RT_RANK + 2 * tk], p2 = tab[8 + e2] + tab[16 + e2] + rt[RT_RANK + 2 * tk + 1];
                if (lane_ == 0) { rt[RT_POS + 2 * tk] = p1; rt[RT_POS + 2 * tk + 1] = p2; }
                if (MOE_FP8) {
                    GAS unsigned* q1 = (GAS unsigned*)((unsigned char*)AS + (size_t)p1 * DM) + lane_; GAS unsigned* q2 = (GAS unsigned*)((unsigned char*)AS + (size_t)p2 * DM) + lane_;
#pragma unroll
                    for (int j = 0; j < 8; ++j) { const f32x4 y = s ? v1[j] : v0[j]; const unsigned x = pg8::pk4_fp8(y.x, y.y, y.z, y.w); q1[64 * j] = x; q2[64 * j] = x; }
                    continue; }
                GAS v2u* o1 = (GAS v2u*)(AS + (size_t)p1 * DM) + lane_; GAS v2u* o2 = (GAS v2u*)(AS + (size_t)p2 * DM) + lane_;
#pragma unroll
                for (int j = 0; j < 8; ++j) { f32x4 y = s ? v1[j] : v0[j]; if (EMU_FP8) { y.x = pg8::fp8r(y.x); y.y = pg8::fp8r(y.y); y.z = pg8::fp8r(y.z); y.w = pg8::fp8r(y.w); } v2u x; x.x = pg8::cvt_pk_bf16(y.x, y.y); x.y = pg8::cvt_pk_bf16(y.z, y.w); o1[64 * j] = x; o2[64 * j] = x; }
            }
        }
        for (int e = 0; e < 8; ++e) { const int tot = tab[e], end = (tot + 255) & ~255;
            for (int pr = tot + blk * 8 + F.wave; pr < end; pr += 2048) {
                if (MOE_FP8) { GAS unsigned* o = (GAS unsigned*)((unsigned char*)AS + (size_t)(tab[8 + e] + pr) * DM) + lane_;
#pragma unroll
                    for (int j = 0; j < 8; ++j) o[64 * j] = 0u; continue; }
                GAS v2u* o = (GAS v2u*)(AS + (size_t)(tab[8 + e] + pr) * DM) + lane_;
#pragma unroll
                for (int j = 0; j < 8; ++j) o[64 * j] = (v2u){0u, 0u}; } }
    }
    __syncthreads();
}
__device__ __forceinline__ void final_pass(Frame& F, int layer) {
    const int lane_ = opq_v((TIDX & 63));
    const int* rt = (const int*)(F.ws + WS_ROUTE); const float* rtf = (const float*)(F.ws + WS_ROUTE);
    const bf16* Y = (const bf16*)(F.ws + WS_Y); const float* H = (const float*)(F.ws + WS_H); const float* SL = (const float*)(F.ws + WS_U);
    const float* modl = (const float*)(F.ws + WS_MOD) + (size_t)layer * 9 * MODW;
    LAS int* tab = (LAS int*)(F.lds);
    moe_tables(F, tab, 0);
    for (int tok = F.gw; tok < NBATCH * SEQ; tok += F.NGW) {
        const int b = tok >> 11, t = tok & 2047, r = b * TPB + CTXL + t;
        const int ee = rt[RT_E + tok]; const float g1 = rtf[RT_G + 2 * tok], g2 = rtf[RT_G + 2 * tok + 1];
        const GAS f32x4* xr = (const GAS f32x4*)(H + (size_t)r * DM) + lane_;
        const GAS f32x4* gt = (const GAS f32x4*)(modl + (size_t)b * MODW + 5 * DM) + lane_;
        f32x4 y[8], v[8];
#pragma unroll
        for (int j = 0; j < 8; ++j) { y[j] = (f32x4){0.f, 0.f, 0.f, 0.f}; v[j] = xr[64 * j]; }
#pragma unroll 1
        for (int s = 0; s < 2; ++s) {
            const int e = s ? (ee >> 8) : (ee & 255), p = rt[RT_POS + 2 * tok + s]; const float g = s ? g2 : g1;
            const int loc = p - tab[8 + e], fu = tab[e] >> 8;
            if (loc < 256 * fu) {
                const GAS v2u* yp = (const GAS v2u*)(Y + (size_t)p * DM) + lane_;
#pragma unroll
                for (int j = 0; j < 8; ++j) { const v2u a = yp[64 * j]; y[j] += (f32x4){bflo(a.x), bfhi(a.x), bflo(a.y), bfhi(a.y)} * g; }
            } else {
                const int rr = tab[48 + e], row = loc - 256 * fu;
#pragma unroll
                for (int ks = 0; ks < 4; ++ks) { const GAS f32x4* sp = (const GAS f32x4*)(SL + ((size_t)(ks * 8 + rr) * 256 + row) * DM) + lane_;
#pragma unroll
                    for (int j = 0; j < 8; ++j) y[j] += sp[64 * j] * g; }
            }
        }
        float ss = 0.f;
#pragma unroll
        for (int j = 0; j < 8; ++j) { v[j] = v[j] + gt[64 * j] * y[j]; ss += (v[j].x * v[j].x + v[j].y * v[j].y) + (v[j].z * v[j].z + v[j].w * v[j].w); }
        const float rstd = 1.0f / sqrtf(wave_sum(ss) * (1.0f / DM) + EPSN);
        const GAS f32x4* gf = (const GAS f32x4*)inptr(I_GFIN) + lane_;
        GAS f32x4* op = (GAS f32x4*)(F.out + (size_t)tok * DM) + lane_;
#pragma unroll
        for (int j = 0; j < 8; ++j) op[64 * j] = v[j] * rstd * gf[64 * j];
    }
}

namespace fa {
using bf16x8 = __attribute__((ext_vector_type(8))) short;
using s16x4  = __attribute__((ext_vector_type(4))) short;
using f32x16 = __attribute__((ext_vector_type(16))) float;
using u32x4  = __attribute__((ext_vector_type(4))) unsigned;
constexpr int SHM_V = 64 * 128 * 2;
constexpr float THRN = 8.f;
#define FA_SBAR() __builtin_amdgcn_sched_barrier(0)
__device__ __forceinline__ int kswz(int row, int colB, int pitch) { return row * pitch + (colB ^ ((row & 7) << 4)); }
__device__ __forceinline__ int crow(int r, int hi) { return (r & 3) + 8 * (r >> 2) + 4 * hi; }
__device__ __forceinline__ unsigned cvtpk(float lo, float hi) { unsigned r; asm volatile("v_cvt_pk_bf16_f32 %0, %1, %2" : "=v"(r) : "v"(lo), "v"(hi)); return r; }

__device__ __forceinline__ void partialSM(f32x16& p0, f32x16& p1, float& m_reg, float& mn, float& alpha, const float C, const float thr_raw) {
  float pmax = p0[0];
#pragma unroll
  for (int r = 1; r < 16; ++r) pmax = fmaxf(pmax, p0[r]);
#pragma unroll
  for (int r = 0; r < 16; ++r) pmax = fmaxf(pmax, p1[r]);
  { auto rr = __builtin_amdgcn_permlane32_swap(__float_as_uint(pmax), __float_as_uint(pmax), false, false);
    pmax = fmaxf(__uint_as_float(rr[0]), __uint_as_float(rr[1])); }
  if (__builtin_expect(__all(pmax - m_reg <= thr_raw), 1)) { mn = m_reg; alpha = 1.f; }
  else { mn = fmaxf(m_reg, pmax); alpha = __builtin_amdgcn_exp2f((m_reg - mn) * C); m_reg = mn; }
  const float mnC = -mn * C;
#pragma unroll
  for (int r = 0; r < 16; ++r) p0[r] = fmaf(p0[r], C, mnC);
#pragma unroll
  for (int r = 0; r < 16; ++r) p1[r] = fmaf(p1[r], C, mnC);
#pragma unroll
  for (int r = 0; r < 16; ++r) p0[r] = __builtin_amdgcn_exp2f(p0[r]);
}
__device__ __forceinline__ void finishSM(f32x16& p0, f32x16& p1, float alpha, float& l_reg, bf16x8& pa0, bf16x8& pa1, bf16x8& pa2, bf16x8& pa3) {
#pragma unroll
  for (int r = 0; r < 16; ++r) p1[r] = __builtin_amdgcn_exp2f(p1[r]);
  float ps = 0;
#pragma unroll
  for (int r = 0; r < 16; ++r) ps += p0[r];
#pragma unroll
  for (int r = 0; r < 16; ++r) ps += p1[r];
  { auto rr = __builtin_amdgcn_permlane32_swap(__float_as_uint(ps), __float_as_uint(ps), false, false);
    ps = __uint_as_float(rr[0]) + __uint_as_float(rr[1]); }
  l_reg = l_reg * alpha + ps;
#define FA_PK4(P, BASE, OUT) do { unsigned a0 = cvtpk(P[BASE + 0], P[BASE + 1]), a1 = cvtpk(P[BASE + 2], P[BASE + 3]);   \
    unsigned b0 = cvtpk(P[BASE + 4], P[BASE + 5]), b1 = cvtpk(P[BASE + 6], P[BASE + 7]);                              \
    auto r0 = __builtin_amdgcn_permlane32_swap(a0, b0, false, false); auto r1 = __builtin_amdgcn_permlane32_swap(a1, b1, false, false); \
    u32x4 w = {r0[0], r1[0], r0[1], r1[1]}; OUT = __builtin_bit_cast(bf16x8, w); } while (0)
  FA_PK4(p0, 0, pa0); FA_PK4(p0, 8, pa1); FA_PK4(p1, 0, pa2); FA_PK4(p1, 8, pa3);
#undef FA_PK4
}
template <int DK>
__device__ __forceinline__ void qkt(f32x16& p0, f32x16& p1, const LAS unsigned char* Ks, const bf16x8 (&qr)[DK / 16], int r32, int hi) {
  p0 = f32x16{}; p1 = f32x16{};
#pragma unroll
  for (int d0 = 0; d0 < DK / 16; ++d0) { const int cb = (d0 * 16 + hi * 8) * 2;
    const bf16x8 b0 = *(const LAS bf16x8*)(Ks + kswz(r32, cb, DK * 2));
    const bf16x8 b1 = *(const LAS bf16x8*)(Ks + kswz(32 + r32, cb, DK * 2));
    p0 = __builtin_amdgcn_mfma_f32_32x32x16_bf16(b0, qr[d0], p0, 0, 0, 0);
    p1 = __builtin_amdgcn_mfma_f32_32x32x16_bf16(b1, qr[d0], p1, 0, 0, 0); }
}
__device__ __forceinline__ int v_st(int k, int c) { const int kk = (k & ~0xC) | ((k & 4) << 1) | ((k & 8) >> 1); return ((kk >> 3) * 4 + (c >> 5)) * 512 + ((kk & 7) * 32 + (c & 31)) * 2; }
__device__ __forceinline__ int v_rd_base(int lane) { return ((lane & 3) << 3) | (((lane >> 2) & 3) << 6) | (((lane >> 4) & 1) << 5) | (((lane >> 5) & 1) << 8); }
constexpr int v_rd_off(int d0, int ks, int half) { return d0 * 512 + ks * 4096 + half * 2048; }
template <int OFF> __device__ __forceinline__ s16x4 tr_read(int vb) {
  s16x4 r; asm volatile("ds_read_b64_tr_b16 %0, %1 offset:%2" : "=&v"(r) : "v"(vb), "i"(OFF) : "memory"); return r;
}
template <int D0> __device__ __forceinline__ void pv_one(f32x16& od, int vb, bf16x8 pa0, bf16x8 pa1, bf16x8 pa2, bf16x8 pa3) {
  const s16x4 l0 = tr_read<v_rd_off(D0, 0, 0)>(vb), h0 = tr_read<v_rd_off(D0, 0, 1)>(vb), l1 = tr_read<v_rd_off(D0, 1, 0)>(vb), h1 = tr_read<v_rd_off(D0, 1, 1)>(vb);
  const s16x4 l2 = tr_read<v_rd_off(D0, 2, 0)>(vb), h2 = tr_read<v_rd_off(D0, 2, 1)>(vb), l3 = tr_read<v_rd_off(D0, 3, 0)>(vb), h3 = tr_read<v_rd_off(D0, 3, 1)>(vb);
  asm volatile("s_waitcnt lgkmcnt(0)" ::: "memory"); FA_SBAR();
#define FA_PK(L, H) (bf16x8){L[0], L[1], L[2], L[3], H[0], H[1], H[2], H[3]}
  od = __builtin_amdgcn_mfma_f32_32x32x16_bf16(pa0, FA_PK(l0, h0), od, 0, 0, 0);
  od = __builtin_amdgcn_mfma_f32_32x32x16_bf16(pa1, FA_PK(l1, h1), od, 0, 0, 0);
  od = __builtin_amdgcn_mfma_f32_32x32x16_bf16(pa2, FA_PK(l2, h2), od, 0, 0, 0);
  od = __builtin_amdgcn_mfma_f32_32x32x16_bf16(pa3, FA_PK(l3, h3), od, 0, 0, 0);
#undef FA_PK
}
__device__ __forceinline__ void pv_d0(f32x16 (&o)[4], int vb, bf16x8 pa0, bf16x8 pa1, bf16x8 pa2, bf16x8 pa3) {
  pv_one<0>(o[0], vb, pa0, pa1, pa2, pa3); pv_one<1>(o[1], vb, pa0, pa1, pa2, pa3); pv_one<2>(o[2], vb, pa0, pa1, pa2, pa3); pv_one<3>(o[3], vb, pa0, pa1, pa2, pa3);
}

struct TileMap { int k0, lat0, r_lo; bool na;
  __device__ __forceinline__ int row(int j) const { if (!na || j < 4) return k0 + 64 * j; const int g = min(r_lo + j - 4, 31); return lat0 + 64 * g; } };
struct NaLane { int qr, qc, rs, cs; const LAS float* btab; };

__device__ __forceinline__ void na_mask(f32x16& p0, f32x16& p1, int j, const TileMap& tm, const NaLane& nl, int hi) {
  if (j < 4) return;
  const int kr = tm.r_lo + j - 4; const bool rowok = (kr >= nl.rs) && (kr < nl.rs + 8);
  const int b0 = (kr - nl.qr + 7) * 31 + 15 - nl.qc;
#pragma unroll
  for (int r = 0; r < 16; ++r) {
    const int kc0 = crow(r, hi), kc1 = 32 + kc0;
    const bool ok0 = rowok && (kc0 >= nl.cs) && (kc0 < nl.cs + 16), ok1 = rowok && (kc1 >= nl.cs) && (kc1 < nl.cs + 16);
    float bv0 = 0.f, bv1 = 0.f; if (ok0) bv0 = nl.btab[b0 + kc0]; if (ok1) bv1 = nl.btab[b0 + kc1];
    p0[r] = ok0 ? p0[r] + bv0 : -1e30f; p1[r] = ok1 ? p1[r] + bv1 : -1e30f;
  }
}

template <int DK, int SDEPTH, bool NA>
__device__ __forceinline__ void body(const bf16* Qb, int ldq, const bf16* Kp, int ldk, const bf16* Vp, int ldv, const TileMap tm, const int NT, const float scale,
                                     const NaLane nl, LAS unsigned char* lds, f32x16 (&o)[4]) {
  constexpr int KP = DK / 64, SHM_K = 64 * DK * 2, KCH = DK / 8;
  int tid = threadIdx.x; asm volatile("" : "+v"(tid));
  const int wid = tid >> 6, lane = tid & 63, r32 = lane & 31, hi = lane >> 5;
  LAS unsigned char* V_lds = lds; LAS unsigned char* K_lds = lds + 2 * SHM_V;
  LAS float* wsl = (LAS float*)(lds + 2 * SHM_V + 2 * SHM_K) + wid * 64; LAS float* li_l = wsl; LAS float* al_l = wsl + 32;
  const float C = scale * 1.4426950408889634f, thr_raw = THRN / scale;
  float m_reg = -1e30f, l_reg = 0;
#pragma unroll
  for (int d = 0; d < 4; ++d) o[d] = f32x16{};
  bf16x8 qr[DK / 16];
  { const bf16* Qw = Qb + (long)(wid * 32 + r32) * ldq + hi * 8;
#pragma unroll
    for (int d0 = 0; d0 < DK / 16; ++d0) qr[d0] = *(const GAS bf16x8*)(Qw + d0 * 16); }
  const int sr = tid >> 4, sc = (tid & 15) * 8, vst0 = v_st(sr, sc), vst1 = v_st(32 + sr, sc);
  int krow[KP], kcol[KP], kst[KP];
#pragma unroll
  for (int i = 0; i < KP; ++i) { const int c = tid + 512 * i; krow[i] = c / KCH; kcol[i] = (c % KCH) * 8; kst[i] = kswz(krow[i], kcol[i] * 2, DK * 2); }
  const int vb0 = (int)(unsigned)(unsigned long)(V_lds) + v_rd_base(lane);
  struct Slot { bf16x8 vs0, vs1, ks[KP]; } sl[SDEPTH];
#define FA_SLOAD(i, j) do { const int r0_ = tm.row(j); sl[i].vs0 = *(const GAS bf16x8*)(Vp + (long)(r0_ + sr) * ldv + sc); sl[i].vs1 = *(const GAS bf16x8*)(Vp + (long)(r0_ + 32 + sr) * ldv + sc); \
    _Pragma("unroll") for (int q_ = 0; q_ < KP; ++q_) sl[i].ks[q_] = *(const GAS bf16x8*)(Kp + (long)(r0_ + krow[q_]) * ldk + kcol[q_]); } while (0)
#define FA_SWRITE(b, i) do { *(LAS bf16x8*)(V_lds + (b) * SHM_V + vst0) = sl[i].vs0; *(LAS bf16x8*)(V_lds + (b) * SHM_V + vst1) = sl[i].vs1; \
    _Pragma("unroll") for (int q_ = 0; q_ < KP; ++q_) *(LAS bf16x8*)(K_lds + (b) * SHM_K + kst[q_]) = sl[i].ks[q_]; } while (0)
#define FA_SWAIT() do { if constexpr (SDEPTH == 2) asm volatile("s_waitcnt vmcnt(%0)" :: "n"(2 + KP) : "memory"); else asm volatile("s_waitcnt vmcnt(0)" ::: "memory"); } while (0)
#define FA_RESC(a) do { if (__any((a) < 1.f)) { if (hi == 0) al_l[r32] = (a); asm volatile("s_waitcnt lgkmcnt(0)" ::: "memory"); \
    _Pragma("unroll") for (int d = 0; d < 4; ++d) _Pragma("unroll") for (int r = 0; r < 16; ++r) o[d][r] *= al_l[crow(r, hi)]; } } while (0)
#define FA_QKT(P0, P1, buf, j) do { qkt<DK>(P0, P1, K_lds + (buf) * SHM_K, qr, r32, hi); if constexpr (NA) na_mask(P0, P1, j, tm, nl, hi); } while (0)
  f32x16 pA0, pA1, pB0, pB1; float mnA, mnB, alA, alB; bf16x8 pa0, pa1, pa2, pa3;
  constexpr int SE = 0, SO = SDEPTH - 1;
  FA_SLOAD(SE, 0); asm volatile("s_waitcnt vmcnt(0)" ::: "memory"); FA_SWRITE(0, SE); __syncthreads();
  FA_QKT(pA0, pA1, 0, 0); partialSM(pA0, pA1, m_reg, mnA, alA, C, thr_raw);
  FA_SLOAD(SO, 1); if constexpr (SDEPTH == 2) { if (2 < NT) FA_SLOAD(SE, 2); }
  FA_SWAIT(); FA_SWRITE(1, SO); __syncthreads();
  for (int j = 1; j + 1 < NT; j += 2) {
    FA_SBAR(); FA_QKT(pB0, pB1, 1, j);
    finishSM(pA0, pA1, alA, l_reg, pa0, pa1, pa2, pa3); FA_SBAR();
    FA_SLOAD(SO, j + SDEPTH); FA_SBAR();
    pv_d0(o, vb0, pa0, pa1, pa2, pa3); partialSM(pB0, pB1, m_reg, mnB, alB, C, thr_raw);
    __syncthreads(); FA_SWAIT(); FA_SWRITE(0, SE);
    FA_RESC(alB); __syncthreads();
    FA_SBAR(); FA_QKT(pA0, pA1, 0, j + 1);
    finishSM(pB0, pB1, alB, l_reg, pa0, pa1, pa2, pa3); FA_SBAR();
    if (SDEPTH == 1 || j + 3 < NT) FA_SLOAD(SE, j + 1 + SDEPTH); FA_SBAR();
    pv_d0(o, vb0 + SHM_V, pa0, pa1, pa2, pa3); partialSM(pA0, pA1, m_reg, mnA, alA, C, thr_raw);
    __syncthreads(); FA_SWAIT(); FA_SWRITE(1, SO);
    FA_RESC(alA); __syncthreads();
  }
  FA_SBAR(); FA_QKT(pB0, pB1, 1, NT - 1);
  finishSM(pA0, pA1, alA, l_reg, pa0, pa1, pa2, pa3); FA_SBAR();
  pv_d0(o, vb0, pa0, pa1, pa2, pa3); partialSM(pB0, pB1, m_reg, mnB, alB, C, thr_raw);
  __syncthreads(); FA_RESC(alB);
  finishSM(pB0, pB1, alB, l_reg, pa0, pa1, pa2, pa3); FA_SBAR();
  pv_d0(o, vb0 + SHM_V, pa0, pa1, pa2, pa3);
  if (hi == 0) li_l[r32] = l_reg; asm volatile("s_waitcnt lgkmcnt(0)" ::: "memory");
#pragma unroll
  for (int r = 0; r < 16; ++r) { const float rl = __builtin_amdgcn_rcpf(li_l[crow(r, hi)]);
#pragma unroll
    for (int d0 = 0; d0 < 4; ++d0) o[d0][r] *= rl; }
#undef FA_SLOAD
#undef FA_SWRITE
#undef FA_SWAIT
#undef FA_RESC
#undef FA_QKT
}

template <int DK, bool NA>
__device__ __forceinline__ void body_seq(const bf16* Qb, int ldq, const bf16* Kp, int ldk, const bf16* Vp, int ldv, const TileMap tm, const int NT, const float scale,
                                         const NaLane nl, LAS unsigned char* lds, f32x16 (&o)[4]) {
  constexpr int KP = DK / 64, SHM_K = 64 * DK * 2, KCH = DK / 8;
  int tid = threadIdx.x; asm volatile("" : "+v"(tid));
  const int wid = tid >> 6, lane = tid & 63, r32 = lane & 31, hi = lane >> 5;
  LAS unsigned char* V_lds = lds; LAS unsigned char* K_lds = lds + 2 * SHM_V;
  LAS float* wsl = (LAS float*)(lds + 2 * SHM_V + 2 * SHM_K) + wid * 64; LAS float* li_l = wsl; LAS float* al_l = wsl + 32;
  const float C = scale * 1.4426950408889634f, thr_raw = THRN / scale;
  float m_reg = -1e30f, l_reg = 0;
#pragma unroll
  for (int d = 0; d < 4; ++d) o[d] = f32x16{};
  bf16x8 qr[DK / 16];
  { const bf16* Qw = Qb + (long)(wid * 32 + r32) * ldq + hi * 8;
#pragma unroll
    for (int d0 = 0; d0 < DK / 16; ++d0) qr[d0] = *(const GAS bf16x8*)(Qw + d0 * 16); }
  const int sr = tid >> 4, sc = (tid & 15) * 8, vst0 = v_st(sr, sc), vst1 = v_st(32 + sr, sc);
  int krow[KP], kcol[KP], kst[KP];
#pragma unroll
  for (int i = 0; i < KP; ++i) { const int c = tid + 512 * i; krow[i] = c / KCH; kcol[i] = (c % KCH) * 8; kst[i] = kswz(krow[i], kcol[i] * 2, DK * 2); }
  const int vb0 = (int)(unsigned)(unsigned long)(V_lds) + v_rd_base(lane);
  bf16x8 vs0, vs1, ks[KP];
#define FS_SLOAD(j) do { const int r0_ = tm.row(j); vs0 = *(const GAS bf16x8*)(Vp + (long)(r0_ + sr) * ldv + sc); vs1 = *(const GAS bf16x8*)(Vp + (long)(r0_ + 32 + sr) * ldv + sc); \
    _Pragma("unroll") for (int q_ = 0; q_ < KP; ++q_) ks[q_] = *(const GAS bf16x8*)(Kp + (long)(r0_ + krow[q_]) * ldk + kcol[q_]); } while (0)
#define FS_SWRITE(b) do { *(LAS bf16x8*)(V_lds + (b) * SHM_V + vst0) = vs0; *(LAS bf16x8*)(V_lds + (b) * SHM_V + vst1) = vs1; \
    _Pragma("unroll") for (int q_ = 0; q_ < KP; ++q_) *(LAS bf16x8*)(K_lds + (b) * SHM_K + kst[q_]) = ks[q_]; } while (0)
  FS_SLOAD(0); FS_SWRITE(0); __syncthreads();
#pragma unroll 1
  for (int j = 0; j < NT; ++j) {
    const int b = j & 1;
    if (j + 1 < NT) FS_SLOAD(j + 1);
    f32x16 p0, p1; float mn, al; bf16x8 pa0, pa1, pa2, pa3;
    qkt<DK>(p0, p1, K_lds + b * SHM_K, qr, r32, hi);
    if constexpr (NA) na_mask(p0, p1, j, tm, nl, hi);
    partialSM(p0, p1, m_reg, mn, al, C, thr_raw);
    finishSM(p0, p1, al, l_reg, pa0, pa1, pa2, pa3);
    if (__any(al < 1.f)) { if (hi == 0) al_l[r32] = al; asm volatile("s_waitcnt lgkmcnt(0)" ::: "memory");
#pragma unroll
      for (int d = 0; d < 4; ++d)
#pragma unroll
        for (int r = 0; r < 16; ++r) o[d][r] *= al_l[crow(r, hi)]; }
    FA_SBAR();
    pv_d0(o, vb0 + b * SHM_V, pa0, pa1, pa2, pa3);
    if (j + 1 < NT) FS_SWRITE(b ^ 1);
    __syncthreads();
  }
  if (hi == 0) li_l[r32] = l_reg; asm volatile("s_waitcnt lgkmcnt(0)" ::: "memory");
#pragma unroll
  for (int r = 0; r < 16; ++r) { const float rl = __builtin_amdgcn_rcpf(li_l[crow(r, hi)]);
#pragma unroll
    for (int d0 = 0; d0 < 4; ++d0) o[d0][r] *= rl; }
#undef FS_SLOAD
#undef FS_SWRITE
}
}

__device__ __forceinline__ void fa_store(const fa::f32x16 (&o)[4], LAS unsigned char* lds, bf16* Orow0  , bool do_norm, const float* gsub, float post) {
    int tid = threadIdx.x; asm volatile("" : "+v"(tid));
    const int wid = tid >> 6, lane = tid & 63, r32 = lane & 31, hi = lane >> 5;
    LAS float* slab = (LAS float*)(lds + wid * 16384);
    __syncthreads();
#pragma unroll
    for (int r = 0; r < 16; ++r) { const int row = fa::crow(r, hi);
#pragma unroll
        for (int d0 = 0; d0 < 4; ++d0) slab[row * 128 + d0 * 32 + r32] = o[d0][r]; }
    LDS_WAIT();
    const int row = lane >> 1, half = lane & 1;
    const LAS f32x4* src = (const LAS f32x4*)(slab + row * 128 + half * 64);
    f32x4 v[16]; float ss = 0.f;
#pragma unroll
    for (int c = 0; c < 16; ++c) { v[c] = src[c]; ss += (v[c].x * v[c].x + v[c].y * v[c].y) + (v[c].z * v[c].z + v[c].w * v[c].w); }
    float sc = 1.0f;
    if (do_norm) { ss += __shfl_xor(ss, 1); sc = post / sqrtf(ss * (1.0f / 128.0f) + EPSN);
#pragma unroll
        for (int c = 0; c < 16; ++c) v[c] = v[c] * *(const GAS f32x4*)(gsub + half * 64 + 4 * c); }
    GAS v4u* dst = (GAS v4u*)(Orow0 + (size_t)(wid * 32 + row) * DM + half * 64);
#pragma unroll
    for (int c = 0; c < 8; ++c) { const f32x4 a = v[2 * c] * sc, b = v[2 * c + 1] * sc; v4u w; w.x = pk2(a.x, a.y); w.y = pk2(a.z, a.w); w.z = pk2(b.x, b.y); w.w = pk2(b.z, b.w); dst[c] = w; }
    __syncthreads();
}

__device__ __forceinline__ void attn_unit_fa(Frame& F, int layer, int b, bool latent, int qb, int type, int h) {
    unsigned char* ws = F.ws;
    const bf16* QKV = (const bf16*)(ws + WS_QKV); const bf16* QM = (const bf16*)(ws + WS_QM); const bf16* KVM = (const bf16*)(ws + WS_KVM); bf16* O = (bf16*)(ws + WS_O);
    const int q0 = b * TPB + (latent ? CTXL + qb * 256 : 0);
    const int kall0 = b * TPB, ntall = latent ? TPB / 64 : CTXL / 64;
    bf16* orow0 = O + (size_t)q0 * DM + type * 512 + h * 128;
    fa::TileMap tm; tm.k0 = kall0; tm.lat0 = kall0 + CTXL; tm.r_lo = 0; tm.na = false;
    fa::NaLane nl; nl.qr = 0; nl.qc = 0; nl.rs = 0; nl.cs = 0; nl.btab = nullptr;
    fa::f32x16 o[4];
#ifdef FA_ONLY
    type = FA_ONLY; if (FA_ONLY != 4) latent = FA_ONLY != 0 ? latent : false; else { type = 0; latent = true; }
#endif
    if (type == 0 && latent) {
        const int r_lo = min(max(4 * qb - 4, 0), 24), r_hi = min(max(4 * qb + 3 - 4, 0), 24) + 8;
        tm.na = true; tm.r_lo = r_lo; int nt = 4 + (r_hi - r_lo); nt += nt & 1;
        LAS float* bt = (LAS float*)(F.lds + 100 * 1024);
        const float* bsrc = inptr(I_NABIAS) + ((size_t)layer * 4 + h) * 465;
        __syncthreads();
        for (int i = TIDX; i < 465; i += 512) bt[i] = bsrc[i] * (1.0f / SC_NA);
        __syncthreads();
        const int t = qb * 256 + (TIDX >> 6) * 32 + (TIDX & 31);
        nl.qr = t >> 6; nl.qc = t & 63; nl.rs = min(max(nl.qr - 4, 0), 24); nl.cs = min(max(nl.qc - 8, 0), 48); nl.btab = bt;
        fa::body_seq<128, true>(QKV + (size_t)q0 * INCP + C_NAQ + 128 * h, INCP, QKV + C_NAK + 128 * h, INCP, QKV + C_NAV + 128 * h, INCP, tm, nt, SC_NA, nl, F.lds, o);
        fa_store(o, F.lds, orow0, false, nullptr, 1.0f);
    } else if (type == 0 || type == 2) {
        const int qc = (type == 0) ? C_NAQ + 128 * h : C_GQ + 128 * h, kc = (type == 0) ? C_NAK + 128 * h : C_GK + 128 * (h >> 1), vc = (type == 0) ? C_NAV + 128 * h : C_GV + 128 * (h >> 1);
        fa::body<128, 2, false>(QKV + (size_t)q0 * INCP + qc, INCP, QKV + kc, INCP, QKV + vc, INCP, tm, ntall, SC_NA, nl, F.lds, o);
        fa_store(o, F.lds, orow0, false, nullptr, 1.0f);
    } else if (type == 1) {
        fa::body_seq<192, false>(QM + (size_t)q0 * QMW + 192 * h, QMW, KVM + 320 * h, KVW, KVM + 320 * h + 192, KVW, tm, ntall, SC_MLA, nl, F.lds, o);
        fa_store(o, F.lds, orow0, false, nullptr, 1.0f);
    } else {
        const float lam_init = layer == 0 ? 0.2f : 0.35550906759096926f;
        LAS float* lm = (LAS float*)(F.lds + 100 * 1024);
        __syncthreads();
        if (TIDX < 64) { const float a = wave_sum(inptr(I_LQ1)[layer * 64 + TIDX] * inptr(I_LK1)[layer * 64 + TIDX]), c = wave_sum(inptr(I_LQ2)[layer * 64 + TIDX] * inptr(I_LK2)[layer * 64 + TIDX]);
            if (TIDX == 0) lm[0] = expf(a) - expf(c) + lam_init; }
        __syncthreads();
        const float lam = lm[0];
        GAS f32x4* stash = (GAS f32x4*)((float*)(ws + WS_U) + ((size_t)blockIdx.x * 512 + TIDX) * 64);
#pragma unroll 1
        for (int pass = 0; pass < 2; ++pass) {
            fa::body<64, 2, false>(QKV + (size_t)q0 * INCP + C_DQ + 128 * h + 64 * pass, INCP, QKV + C_DK + 128 * h + 64 * pass, INCP, QKV + C_DV + 128 * h, INCP, tm, ntall, SC_DIFF, nl, F.lds, o);
            if (pass == 0) {
#pragma unroll
                for (int d0 = 0; d0 < 4; ++d0)
#pragma unroll
                    for (int r4 = 0; r4 < 4; ++r4) stash[d0 * 4 + r4] = (f32x4){o[d0][4 * r4], o[d0][4 * r4 + 1], o[d0][4 * r4 + 2], o[d0][4 * r4 + 3]};
                __syncthreads();
            }
        }
#pragma unroll
        for (int d0 = 0; d0 < 4; ++d0)
#pragma unroll
            for (int r4 = 0; r4 < 4; ++r4) { const f32x4 s1 = stash[d0 * 4 + r4];
#pragma unroll
                for (int q = 0; q < 4; ++q) o[d0][4 * r4 + q] = s1[q] - lam * o[d0][4 * r4 + q]; }
        fa_store(o, F.lds, orow0, true, inptr(I_GSUB) + layer * 128, 1.0f - lam_init);
    }
}
#ifndef ATTN_Q0
#define ATTN_Q0 0
#endif
#ifndef ATTN_Q1
#define ATTN_Q1 0
#endif
__device__ __forceinline__ void attn_phase_fa(Frame& F, int layer) {
    const int total = 1024 + ((layer == 0) ? 128 : 0);
#pragma unroll 1
    for (int n = blockIdx.x; n < total; n += F.G) {
        int type, h, qb, b; bool latent = n < 1024;
        if (latent) { const int i = n >> 8, k = n & 255, idx = i * 64 + (k >> 2); type = (k + i) & 3; h = idx & 3; qb = (idx >> 2) & 7; b = idx >> 5; }
        else { const int v = n - 1024, hh = v & 15; type = hh >> 2; h = hh & 3; qb = 0; b = v >> 4; }
        attn_unit_fa(F, layer, b, latent, qb, type, h);
        if (ATTN_Q0 + ATTN_Q1 > 0) filler_quota(F, layer == 0 ? ATTN_Q0 : ATTN_Q1);
    }
    __syncthreads();
}

#ifndef REP_GEMM
#define REP_GEMM 1
#endif
#ifndef REP_WIN
#define REP_WIN REP_GEMM
#endif
#ifndef REP_FGU
#define REP_FGU REP_GEMM
#endif
#ifndef REP_PASS
#define REP_PASS 1
#endif
#ifndef WO_WGM
#define WO_WGM 4
#endif
#ifndef REV_DOWN
#define REV_DOWN 1
#endif
#ifndef FD_WGM
#define FD_WGM 4
#endif
#ifndef PROBE_HOTB
#define PROBE_HOTB 0
#endif
#ifndef PROBE_LATE_DENSE
#define PROBE_LATE_DENSE 0
#endif
#ifndef REP_FDN
#define REP_FDN REP_GEMM
#endif
#ifndef REP_MGU
#define REP_MGU REP_GEMM
#endif
#ifndef REP_MDN
#define REP_MDN REP_GEMM
#endif
#ifndef REP_ATTN
#define REP_ATTN 1
#endif
#ifndef REP_P0
#define REP_P0 1
#endif
#ifndef MK_MULTI
#define MK_MULTI 0
#endif
constexpr int PH_PER_LAYER = 11, N_PHASES = 1 + 2 * PH_PER_LAYER + 1;
struct Args { const float* in[31]; float* out; unsigned char* ws; int ph_lo, ph_hi; };
static_assert(sizeof(Args) == 31 * 8 + 8 + 8 + 8, "Args has no padding");

#define IN(k) (lo <= (k) && (k) < hi)
#if MK_MULTI
#define SEAM(k) do { } while (0)
#else
#define SEAM(k) do { if (IN(k) && IN((k) + 1)) xcd_barrier(bar); } while (0)
#endif
__device__ __forceinline__ int opq_s(int v) { asm volatile("" : "+s"(v)); return v; }
template <int layer>
__device__ __forceinline__ void layer_phases(Frame& F, const XcdBarrier& bar, const int lo, const int hi, LAS int* mtab) {
    unsigned char* ws = F.ws; asm volatile("" : "+s"(ws));
        const int pb = 1 + layer * PH_PER_LAYER;
        const float* modl = (const float*)(ws + WS_MOD) + (size_t)layer * 9 * MODW;
#ifndef SKIP_NORM
        if (IN(pb + 0)) for (int rp_ = 0; rp_ < REP_PASS; ++rp_) norm_pass(F, layer, true, layer == 0, layer == 1);
#endif
        SEAM(pb + 0);
        if (IN(pb + 1)) {
            pg8::Gemm g{(const bf16*)(ws + WS_U), (const bf16*)(ws + WS_WIN) + (size_t)layer * INCP * 2048, MT, INCP, 2048, 2048, 2048};
            pg8::StaticOrder S; S.init(MT, INCP, F.G, opq_s((int)blockIdx.x));
            pg8::EpiBf16P E{(bf16*)(ws + WS_QKV), INCP, 0};
            for (int rep_ = 0; rep_ < REP_WIN; ++rep_) { pg8::gemm_phase<pg8::EpiBf16P, pg8::StaticOrder, PG8_ALIGN, PG8_SP2>(F.lds + RING_OFF, g, S, E); if (rep_ + 1 < REP_WIN) __syncthreads(); }
            filler(F, layer * 8 + 0, -1);
        }
        SEAM(pb + 1);
#ifndef SKIP_POST
        if (IN(pb + 2)) post_pass(F, layer);
#endif
        SEAM(pb + 2);
#ifndef SKIP_UP
        if (IN(pb + 3)) {
            { pg8::Gemm g{(const bf16*)(ws + WS_QKV) + C_CQ, (const bf16*)(ws + WS_WQUP) + (size_t)layer * QMW * 384, MT, QMW, opq_s(384), INCP, 384};
              pg8::StaticOrder S; S.init(MT, QMW, F.G, opq_s((int)blockIdx.x));
              pg8::EpiQupRope E{(bf16*)(ws + WS_QM), (const float*)(ws + WS_ROPE)};
              for (int rep_ = 0; rep_ < REP_GEMM; ++rep_) { pg8::gemm_phase<pg8::EpiQupRope, pg8::StaticOrder, PG8_ALIGN, PG8_SP2>(F.lds + RING_OFF, g, S, E); if (rep_ + 1 < REP_GEMM) __syncthreads(); } }
            __syncthreads();
            { pg8::Gemm g{(const bf16*)(ws + WS_QKV) + C_CKV, (const bf16*)(ws + WS_WKVUP) + (size_t)layer * KVW * 256, MT, KVW, opq_s(256), INCP, 256};
              pg8::StaticOrder S; S.init(MT, KVW, F.G, opq_s((int)blockIdx.x));
              pg8::EpiBf16P E{(bf16*)(ws + WS_KVM), KVW, 0};
              for (int rep_ = 0; rep_ < REP_GEMM; ++rep_) { pg8::gemm_phase<pg8::EpiBf16P, pg8::StaticOrder, PG8_ALIGN, PG8_SP2>(F.lds + RING_OFF, g, S, E); if (rep_ + 1 < REP_GEMM) __syncthreads(); } }
            filler(F, layer * 8 + 1, -1);
        }
#endif
        SEAM(pb + 3);
        #ifndef SKIP_ATTN
        if (IN(pb + 5)) {
#pragma unroll
            for (int rep_ = 0; rep_ < REP_ATTN; ++rep_) attn_phase_fa(F, layer);
            filler(F, layer * 8 + 2, -1); }
#endif
        SEAM(pb + 5);
#ifndef SKIP_WOUT
        if (IN(pb + 6)) {
            pg8::Gemm g{(const bf16*)(ws + WS_O), (const bf16*)(ws + WS_WOUT) + (size_t)layer * 2048 * 2048, MT, 2048, 2048, 2048, 2048};
            pg8::EpiResGate E{(float*)(ws + WS_H), modl + 2 * DM, layer == 0 ? inptr(I_X) : nullptr, layer == 0 ? inptr(I_CTX) : nullptr};
            pg8::EpiResGate Ed{(float*)(ws + WS_R2), modl + 2 * DM, nullptr, nullptr}; (void)Ed;
            if constexpr (layer == 0) { pg8::StaticOrder S; S.init(MT, 2048, F.G, opq_s((int)blockIdx.x), WO_WGM); for (int rep_ = 1; rep_ < REP_GEMM; ++rep_) { pg8::gemm_phase<pg8::EpiResGate, pg8::StaticOrder, PG8_ALIGN, PG8_SP2>(F.lds + RING_OFF, g, S, Ed); __syncthreads(); } pg8::gemm_phase<pg8::EpiResGate, pg8::StaticOrder, PG8_ALIGN, PG8_SP2>(F.lds + RING_OFF, g, S, E); }
            else { pg8::LatentOrder S; S.init(NBATCH * SEQ, 2048, F.G, opq_s((int)blockIdx.x), WO_WGM); for (int rep_ = 1; rep_ < REP_GEMM; ++rep_) { pg8::gemm_phase<pg8::EpiResGate, pg8::LatentOrder, PG8_ALIGN, PG8_SP2>(F.lds + RING_OFF, g, S, Ed); __syncthreads(); } pg8::gemm_phase<pg8::EpiResGate, pg8::LatentOrder, PG8_ALIGN, PG8_SP2>(F.lds + RING_OFF, g, S, E); }            filler(F, layer * 8 + 3, -1);
        }
#endif
        SEAM(pb + 6);
        if constexpr (layer == 0) {
#ifndef SKIP_DENSE
            if (IN(pb + 7)) { for (int rp_ = 0; rp_ < REP_PASS; ++rp_) norm_pass(F, layer, false, false); filler(F, layer * 8 + 6, CVQ_FFN_END); }
            SEAM(pb + 7);
            if (IN(pb + 9)) {
                pg8::Gemm g{(const bf16*)(ws + WS_U), (const bf16*)(ws + WS_WGU), MT, 2 * DFF, 2048, 2048, 2048};
                pg8::StaticOrder S; S.init(MT, 2 * DFF, F.G, opq_s((int)blockIdx.x));
                pg8::EpiSwiGLU E{(bf16*)(ws + WS_HM), DFF, 0};
                for (int rep_ = 0; rep_ < REP_FGU; ++rep_) { pg8::gemm_phase<pg8::EpiSwiGLU, pg8::StaticOrder, PG8_ALIGN, PG8_SP2>(F.lds + RING_OFF, g, S, E); if (rep_ + 1 < REP_FGU) __syncthreads(); }                filler(F, layer * 8 + 4, -1);
            }
            SEAM(pb + 9);
            if (IN(pb + 10)) {
                pg8::Gemm g{(const bf16*)(ws + WS_HM), (const bf16*)(ws + WS_WD), MT, 2048, DFF, DFF, DFF, 0, 0, REV_DOWN};
                pg8::LatentOrder S; S.init(NBATCH * SEQ, 2048, F.G, opq_s((int)blockIdx.x), FD_WGM);
                pg8::EpiResGate E{(float*)(ws + WS_H), modl + 5 * DM, nullptr, nullptr};
                pg8::gemm_phase<pg8::EpiResGate, pg8::LatentOrder, PG8_ALIGN, PG8_SP2>(F.lds + RING_OFF, g, S, E);
                __syncthreads();
                { pg8::Gemm g2{(const bf16*)(ws + WS_HM), (const bf16*)(ws + WS_WD), MT, 2048, opq_s(1408), DFF, DFF, 0, 0, REV_DOWN};
                  pg8::CtxRemOrder S2; S2.G = F.G; S2.c = opq_s((int)blockIdx.x);
                  pg8::EpiSlab E2{(float*)(ws + WS_R1), 1.0f, 1408};
                  pg8::gemm_phase<pg8::EpiSlab, pg8::CtxRemOrder, PG8_ALIGN, PG8_SP2>(F.lds + RING_OFF, g2, S2, E2); }
                filler(F, layer * 8 + 5, -1);
            }
            SEAM(pb + 10);
#endif
        } else {
#ifndef SKIP_MOE
            if (IN(pb + 7)) for (int rp_ = 0; rp_ < REP_PASS; ++rp_) moe_route_pass(F, layer);
            SEAM(pb + 7);
            if (IN(pb + 8)) { for (int rp_ = 0; rp_ < REP_PASS; ++rp_) moe_scatter_pass(F, layer); filler(F, layer * 8 + 6, CVQ_N); }
            SEAM(pb + 8);
            if (IN(pb + 9)) {
#if PROBE_LATE_DENSE
                {
                    pg8::Gemm gd{(const bf16*)(ws + WS_U), (const bf16*)(ws + WS_WGU), MT, 2 * DFF, 2048, 2048, 2048};
                    pg8::StaticOrder Sd; Sd.init(MT, 2 * DFF, F.G, opq_s((int)blockIdx.x));
                    pg8::EpiSwiGLU Ed{(bf16*)(ws + WS_R1), DFF, 0};
                    pg8::gemm_phase<pg8::EpiSwiGLU, pg8::StaticOrder, PG8_ALIGN, PG8_SP2>(F.lds + RING_OFF, gd, Sd, Ed);
                    __syncthreads();
                }
#endif
                moe_tables(F, mtab, 0);
                pg8::Gemm g{(const bf16*)(ws + WS_AS), (const bf16*)(ws + WS_MGU), 0, 2 * DFE, 2048, 2048, 2048, 0, KT_MOE};
                pg8::MoeOrder S; S.init(__builtin_amdgcn_readfirstlane(mtab[24]) * 256, 2 * DFE, F.G, opq_s((int)blockIdx.x));
                S.tab = mtab;
                pg8::EpiSwiGLU E{(bf16*)(ws + WS_HM2), DFE, 2 * DFE / 256, MOE_FP8 ? 1.0f / pg8::MOE_WSCALE : 1.0f};
                for (int rep_ = 0; rep_ < REP_MGU; ++rep_) { pg8::gemm_phase<pg8::EpiSwiGLU, pg8::MoeOrder, PG8_ALIGN, PG8_SP2, (MOE_FP8 != 0)>(F.lds + RING_OFF, g, S, E); if (rep_ + 1 < REP_MGU) __syncthreads(); }
            }
            SEAM(pb + 9);
            if (IN(pb + 10)) {
                moe_tables(F, mtab, 0);
                pg8::Gemm g{(const bf16*)(ws + WS_HM2), (const bf16*)(ws + WS_MD), 0, 2048, DFE, DFE, DFE, KT_MOE, KT_MOE, REV_DOWN};
#define RFL(i) __builtin_amdgcn_readfirstlane(mtab[i])
                { pg8::MoeFullOrder S; S.init(RFL(56) * 256, 2048, F.G, opq_s((int)blockIdx.x));
                  S.tab = mtab;
                  pg8::EpiBf16P E{(bf16*)(ws + WS_Y), 2048, 8, MOE_FP8 ? 1.0f / pg8::MOE_WSCALE : 1.0f};
                  for (int rep_ = 0; rep_ < REP_MDN; ++rep_) { pg8::gemm_phase<pg8::EpiBf16P, pg8::MoeFullOrder, PG8_ALIGN, PG8_SP2, (MOE_FP8 != 0)>(F.lds + RING_OFF, g, S, E); if (rep_ + 1 < REP_MDN) __syncthreads(); } }
                __syncthreads();
                { pg8::Gemm g2{(const bf16*)(ws + WS_HM2), (const bf16*)(ws + WS_MD), 0, 2048, opq_s(1792), DFE, DFE, KT_MOE, KT_MOE, REV_DOWN};
                  pg8::MoeRemOrder S; S.nsub = RFL(57) * 32; S.G = F.G; S.c = opq_s((int)blockIdx.x); S.tab = mtab;
                  pg8::EpiSlab E{(float*)(ws + WS_U), MOE_FP8 ? 1.0f / pg8::MOE_WSCALE : 1.0f};
                  pg8::gemm_phase<pg8::EpiSlab, pg8::MoeRemOrder, PG8_ALIGN, PG8_SP2, (MOE_FP8 != 0)>(F.lds + RING_OFF, g2, S, E); }
#undef RFL
            }
            SEAM(pb + 10);
#endif
        }
}

__global__ void __launch_bounds__(NWAVES * 64, 2) fwd_kernel(Args args) {
    extern __shared__ __attribute__((aligned(16))) unsigned char lds[];
    Frame F;
    F.lds = (LAS unsigned char*)lds;
    F.MISC = (volatile LAS unsigned*)(F.lds + MISC_OFF);
    F.wave = __builtin_amdgcn_readfirstlane((int)threadIdx.x >> 6);
    F.G = gridDim.x; F.gw = blockIdx.x * NWAVES + F.wave; F.NGW = F.G * NWAVES;
    F.out = args.out; F.ws = args.ws; F.ctl = (gu32*)(args.ws + WS_CTL);
    unsigned char* ws = args.ws;
    for (int u = TIDX; u < (LDS_BYTES - LDSCTL_OFF) / 4; u += NWAVES * 64) ((LAS unsigned*)(F.lds + LDSCTL_OFF))[u] = 0u;
    __syncthreads();
    XcdBarrier bar; bar.bar = (unsigned*)(F.ctl + CW_BAR); bar.x = 0; bar.st = nullptr;
#if !MK_MULTI
    bar = xcd_barrier_post((unsigned*)(F.ctl + CW_BAR), F.MISC + 8);
#endif
    const int lo = args.ph_lo, hi = args.ph_hi;
    LAS int* mtab = (LAS int*)(F.lds + LDSCTL_OFF + 1024);

    #ifndef SKIP_P0
    if (IN(0)) {
#pragma unroll
        for (int rep_ = 0; rep_ < REP_P0; ++rep_) p0_prologue(F); }
#endif
    SEAM(0);

    layer_phases<0>(F, bar, lo, hi, mtab);
    layer_phases<1>(F, bar, lo, hi, mtab);
#ifndef SKIP_FINAL
    if (IN(N_PHASES - 1)) for (int rp_ = 0; rp_ < REP_PASS; ++rp_) final_pass(F, 1);
#endif
#undef IN
#undef SEAM
}

extern "C" void kernel_launch(void* const* d_in, const int* in_sizes, int n_in, void* d_out, int out_size, void* d_ws, size_t ws_size, hipStream_t stream) {
    static int grid = 0;
    if (grid == 0) {
        if (n_in != 31 || in_sizes[0] != NBATCH * SEQ * DM || out_size != NBATCH * SEQ * DM || ws_size < WS_END) {
            fprintf(stderr, "kernel_launch: unexpected shapes (n_in %d, in0 %d, out %d, ws %zu, need %zu); nothing launched\n", n_in, n_in > 0 ? in_sizes[0] : -1, out_size, ws_size, (size_t)WS_END); grid = -1; return; }
        int dev = 0, cus = 0, per_cu = 0;
        if (hipGetDevice(&dev) != hipSuccess || hipDeviceGetAttribute(&cus, hipDeviceAttributeMultiprocessorCount, dev) != hipSuccess) { fprintf(stderr, "kernel_launch: device query failed\n"); grid = -1; return; }
        if (hipFuncSetAttribute((const void*)fwd_kernel, hipFuncAttributeMaxDynamicSharedMemorySize, LDS_BYTES) != hipSuccess) { fprintf(stderr, "kernel_launch: hipFuncSetAttribute failed\n"); grid = -1; return; }
        if (hipOccupancyMaxActiveBlocksPerMultiprocessor(&per_cu, (const void*)fwd_kernel, NWAVES * 64, LDS_BYTES) != hipSuccess || per_cu < 1)
            fprintf(stderr, "kernel_launch: note: occupancy query reports %d workgroups per CU\n", per_cu);
        (void)hipGetLastError();
        grid = cus < 256 ? cus : 256;
    }
    if (grid < 0) return;
    if (hipMemsetAsync((char*)d_ws + WS_CTL, 0, CTL_ZERO_BYTES, stream) != hipSuccess) { fprintf(stderr, "kernel_launch: memset failed\n"); return; }
    Args a{};
    for (int i = 0; i < 31; ++i) a.in[i] = (const float*)d_in[i];
    a.out = (float*)d_out; a.ws = (unsigned char*)d_ws;
#if MK_MULTI
    for (int p = 0; p < N_PHASES; ++p) {
        if (p == 1 + 8) continue;
        a.ph_lo = p; a.ph_hi = p + 1;
        hipLaunchKernelGGL(fwd_kernel, dim3(grid), dim3(NWAVES * 64), LDS_BYTES, stream, a);
    }
#else
    a.ph_lo = 0; a.ph_hi = N_PHASES;
    hipLaunchKernelGGL(fwd_kernel, dim3(grid), dim3(NWAVES * 64), LDS_BYTES, stream, a);
#endif
    const hipError_t le = hipPeekAtLastError();
    if (le != hipSuccess) fprintf(stderr, "kernel_launch: launch failed: %s\n", hipGetErrorName(le));
}
```

```cpp
#include <hip/hip_runtime.h>
#include <cstdio>
#include <cstdint>
namespace pg8 {
#define PG8_LAS __attribute__((address_space(3)))
typedef unsigned short bf16_t;
typedef short bf16x8 __attribute__((ext_vector_type(8)));
typedef float f32x4 __attribute__((ext_vector_type(4)));
typedef unsigned u32x4 __attribute__((ext_vector_type(4)));
typedef int v8i32 __attribute__((ext_vector_type(8)));
constexpr int BM = 256, BK = 64, HALF = 128, HTB = HALF * BK * 2  , STAGE_BYTES = 8 * HTB, NXCD = 8, WGM = 8;

__host__ __device__ __forceinline__ int lds_byte(int r, int c) { const int st = (r >> 4) * 2 + (c >> 5), rr = r & 15, cc = c & 31, ob = rr * 64 + cc * 2; return st * 1024 + (ob ^ (((ob >> 9) & 1) << 5)); }
__host__ __device__ __forceinline__ void stage_rc(int b, int& R, int& C) { const int st = b / 1024, sb = b % 1024, swz = sb ^ (((sb >> 9) & 1) << 5); R = (st >> 1) * 16 + swz / 64; C = (st & 1) * 32 + (swz % 64) / 2; }
__host__ __device__ __forceinline__ int perm32(int rho) { const int n = rho >> 4, i = rho & 15; return 8 * (i >> 2) + 4 * n + (i & 3); }

struct Unit { int pm, pn, ko = 0, aux = 0; };
struct Gemm { const bf16_t* A; const bf16_t* Bt; int M, N, K, lda, ldb; int ktA = 0, ktB = 0, rev = 0; };

struct StaticOrder {
    static constexpr bool NTB = false;
    int nM, nN, nwg, G, c, wgm;
    __host__ __device__ void init(int M, int N, int G_, int c_, int wgm_ = WGM) { nM = M / BM; nN = N / BM; nwg = nM * nN; G = G_; c = c_; wgm = wgm_; }
    __host__ __device__ bool next(int i, Unit& u) const {
        const long L = (long)i * G + c; if (L >= nwg) return false;
        int wgid = (int)L; { const int q = nwg / NXCD, r = nwg % NXCD, xcd = wgid % NXCD, off = wgid / NXCD; wgid = (xcd < r ? xcd * (q + 1) : r * (q + 1) + (xcd - r) * q) + off; }
        const int nig = wgm * nN, gid = wgid / nig, fm = gid * wgm, gsz = (nM - fm) < wgm ? (nM - fm) : wgm;
        u.pm = fm + ((wgid % nig) % gsz); u.pn = (wgid % nig) / gsz; return true;
    }
    __device__ __forceinline__ void a_ready(const Unit&) const {}
    __device__ __forceinline__ void done(const Unit&) const {}
};

__device__ __forceinline__ unsigned cvt_pk_bf16(float lo, float hi) { unsigned r; asm volatile("v_cvt_pk_bf16_f32 %0, %1, %2" : "=v"(r) : "v"(lo), "v"(hi)); return r; }
typedef float f32x2 __attribute__((ext_vector_type(2)));
__device__ __forceinline__ void mfma_e4m3(f32x4& acc, const v8i32& a, const v8i32& b, int one) {
    asm volatile("v_mfma_scale_f32_16x16x128_f8f6f4 %0, %1, %2, %0, %3, %3 op_sel_hi:[0,0,0]" : "+v"(acc) : "v"(a), "v"(b), "v"(one));
}
template <class Epi, class Sched, bool ALIGN_EPI = false, bool SP2 = false, bool FP8 = false>
__device__ __forceinline__ void gemm_phase(PG8_LAS unsigned char* lds, const Gemm g, const Sched& S, const Epi& E) {
    int tid_ = threadIdx.x; asm volatile("" : "+v"(tid_));
    const int tid = tid_, wid = __builtin_amdgcn_readfirstlane(tid >> 6), lane = tid & 63, wr = wid >> 2, wc = wid & 3, fr = lane & 15, fq = lane >> 4;
    constexpr int ES = FP8 ? 1 : 2, KE = FP8 ? 128 : 64;
    const int K = g.K, nt = K / KE;
    unsigned voffA[2], voffB[2];
#pragma unroll
    for (int i = 0; i < 2; ++i) { int R, C; stage_rc(tid * 16 + i * 8192, R, C); const int Rb = Epi::PERM ? ((R & ~31) + perm32(R & 31)) : R;
        voffA[i] = (unsigned)(R * (g.ktA ? 128 : g.lda * ES) + C * 2); voffB[i] = (unsigned)(Rb * (g.ktB ? 128 : g.ldb * ES) + C * 2); }
    const long kabsA = g.ktA ? 32768 : (BK * 2), kabsB = g.ktB ? 32768 : (BK * 2);
    const long kstepA = g.rev ? -kabsA : kabsA, kstepB = g.rev ? -kabsB : kabsB;
    const long kfirstA = g.rev ? (long)(nt - 1) * kabsA : 0, kfirstB = g.rev ? (long)(nt - 1) * kabsB : 0;
    const size_t hstepA = g.ktA ? (size_t)16384 : (size_t)HALF * g.lda * ES, hstepB = g.ktB ? (size_t)16384 : (size_t)HALF * g.ldb * ES;
    const size_t tstepA = (size_t)BM * g.lda * ES, tstepB = (size_t)BM * g.ldb * ES;
    const unsigned ldsw = (unsigned)wid * 1024u;
    const int fcol = FP8 ? ((fq >> 1) * 32 + (fq & 1) * 16) : fq * 8;
    const int aoff = lds_byte(wr * 64 + fr, fcol), boff = lds_byte(wc * 32 + fr, fcol);
#define PG8_SA(b, h) (((b) * 2 + (h)) * HTB)
#define PG8_SB(b, h) ((4 + (b) * 2 + (h)) * HTB)
#define PG8_STAGE(bufoff, gbase, voff) do { _Pragma("unroll") for (int _i = 0; _i < 2; ++_i) { \
        if constexpr (FP8) { unsigned vo_ = (voff)[_i]; asm volatile("" : "+v"(vo_));   \
            __builtin_amdgcn_global_load_lds((const unsigned*)((const char*)(gbase) + vo_), (PG8_LAS unsigned*)(lds + (bufoff) + ldsw + _i * 8192), 16, 0, 0); } else \
        if constexpr (Sched::NTB && (bufoff) >= 4 * HTB) __builtin_amdgcn_global_load_lds((const unsigned*)((const char*)(gbase) + (voff)[_i]), (PG8_LAS unsigned*)(lds + (bufoff) + ldsw + _i * 8192), 16, 0, 2); \
        else __builtin_amdgcn_global_load_lds((const unsigned*)((const char*)(gbase) + (voff)[_i]), (PG8_LAS unsigned*)(lds + (bufoff) + ldsw + _i * 8192), 16, 0, 0); } } while (0)
#define PG8_LDA(dst, b, h) do { if constexpr (FP8) { _Pragma("unroll") for (int m = 0; m < 4; ++m) { const PG8_LAS unsigned char* p_ = lds + PG8_SA(b, h) + aoff + m * 2048; \
        const u32x4 lo_ = *(const PG8_LAS u32x4*)p_, hi_ = *(const PG8_LAS u32x4*)(p_ + 16); dst##8[m] = (v8i32){(int)lo_.x, (int)lo_.y, (int)lo_.z, (int)lo_.w, (int)hi_.x, (int)hi_.y, (int)hi_.z, (int)hi_.w}; } } \
    else { _Pragma("unroll") for (int m = 0; m < 4; ++m) _Pragma("unroll") for (int k = 0; k < 2; ++k) dst[m][k] = *(const PG8_LAS bf16x8*)(lds + PG8_SA(b, h) + aoff + m * 2048 + k * 1024); } } while (0)
#define PG8_LDB(dst, b, h) do { if constexpr (FP8) { _Pragma("unroll") for (int n = 0; n < 2; ++n) { const PG8_LAS unsigned char* p_ = lds + PG8_SB(b, h) + boff + n * 2048; \
        const u32x4 lo_ = *(const PG8_LAS u32x4*)p_, hi_ = *(const PG8_LAS u32x4*)(p_ + 16); dst##8[n] = (v8i32){(int)lo_.x, (int)lo_.y, (int)lo_.z, (int)lo_.w, (int)hi_.x, (int)hi_.y, (int)hi_.z, (int)hi_.w}; } } \
    else { _Pragma("unroll") for (int n = 0; n < 2; ++n) _Pragma("unroll") for (int k = 0; k < 2; ++k) dst[n][k] = *(const PG8_LAS bf16x8*)(lds + PG8_SB(b, h) + boff + n * 2048 + k * 1024); } } while (0)
#define PG8_MMA(ai, bj, At, Bt) do { __builtin_amdgcn_s_setprio(1); if constexpr (FP8) { _Pragma("unroll") for (int m = 0; m < 4; ++m) _Pragma("unroll") for (int n = 0; n < 2; ++n) \
        mfma_e4m3(acc[ai][bj][m][n], Bt##8[n], At##8[m], one8); } \
    else { _Pragma("unroll") for (int m = 0; m < 4; ++m) _Pragma("unroll") for (int n = 0; n < 2; ++n) _Pragma("unroll") for (int k = 0; k < 2; ++k) \
        acc[ai][bj][m][n] = __builtin_amdgcn_mfma_f32_16x16x32_bf16(Bt[n][k], At[m][k], acc[ai][bj][m][n], 0, 0, 0); } __builtin_amdgcn_s_setprio(0); } while (0)
#define PG8_WAIT_V(n) asm volatile("s_waitcnt vmcnt(" #n ")" ::: "memory")
#define PG8_WAIT_L(n) asm volatile("s_waitcnt lgkmcnt(" #n ")" ::: "memory")
#define PG8_BAR __builtin_amdgcn_s_barrier()
#define PG8_SCHED __builtin_amdgcn_sched_barrier(0)
    Unit cur, nxt; int ui = 0;
    if (!S.next(0, cur)) return;
    f32x4 acc[2][2][4][2];
#pragma unroll
    for (int a = 0; a < 2; ++a)
#pragma unroll
        for (int b = 0; b < 2; ++b)
#pragma unroll
            for (int m = 0; m < 4; ++m)
#pragma unroll
                for (int n = 0; n < 2; ++n) acc[a][b][m][n] = (f32x4){0.f, 0.f, 0.f, 0.f};
    int one8 = 0x7F7F7F7F; asm volatile("" : "+v"(one8));
    bf16x8 At[4][2], B0[2][2], B1[2][2]; v8i32 At8[4], B08[2], B18[2];
    const char* cA = (const char*)g.A + (size_t)cur.pm * tstepA + (g.ktA ? (size_t)(cur.ko / KE) * 32768 : (size_t)cur.ko * ES) + kfirstA; const char* cB = (const char*)g.Bt + (size_t)cur.pn * tstepB + (g.ktB ? (size_t)(cur.ko / KE) * 32768 : (size_t)cur.ko * ES) + kfirstB;
    S.a_ready(cur);
    if constexpr (SP2) {
        PG8_STAGE(PG8_SB(0, 0), cB, voffB); PG8_STAGE(PG8_SB(0, 1), cB + hstepB, voffB); PG8_STAGE(PG8_SA(0, 0), cA, voffA); PG8_STAGE(PG8_SA(0, 1), cA + hstepA, voffA);
        if (wr == 1) PG8_BAR;
        PG8_WAIT_V(2); PG8_BAR;
        PG8_STAGE(PG8_SB(1, 0), cB + kstepB, voffB); PG8_STAGE(PG8_SA(1, 0), cA + kstepA, voffA); PG8_STAGE(PG8_SB(1, 1), cB + hstepB + kstepB, voffB);
        PG8_WAIT_V(6); PG8_BAR;
    } else {
        PG8_STAGE(PG8_SB(0, 0), cB, voffB); PG8_STAGE(PG8_SA(0, 0), cA, voffA); PG8_STAGE(PG8_SB(0, 1), cB + hstepB, voffB); PG8_STAGE(PG8_SA(0, 1), cA + hstepA, voffA);
        if (wr == 1) PG8_BAR;
        PG8_WAIT_V(4); PG8_BAR;
        PG8_STAGE(PG8_SB(1, 0), cB + kstepB, voffB); PG8_STAGE(PG8_SA(1, 0), cA + kstepA, voffA); PG8_STAGE(PG8_SB(1, 1), cB + hstepB + kstepB, voffB);
        PG8_WAIT_V(6); PG8_BAR;
    }
    for (;;) {
        const bool has_next = S.next(ui + 1, nxt);
        const char* nA = has_next ? (const char*)g.A + (size_t)nxt.pm * tstepA + (g.ktA ? (size_t)(nxt.ko / KE) * 32768 : (size_t)nxt.ko * ES) + kfirstA : cA; const char* nB = has_next ? (const char*)g.Bt + (size_t)nxt.pn * tstepB + (g.ktB ? (size_t)(nxt.ko / KE) * 32768 : (size_t)nxt.ko * ES) + kfirstB : cB;
        for (int t = 0; t < nt; t += 2) {
            const bool last = (t == nt - 2);
            const char* a1 = cA + (long)(t + 1) * kstepA;
            const char* a2 = last ? nA : cA + (long)(t + 2) * kstepA; const char* b2 = last ? nB : cB + (long)(t + 2) * kstepB;
            const char* a3 = a2 + kstepA; const char* b3 = b2 + kstepB;
            if (last && has_next) S.a_ready(nxt);
            if constexpr (SP2) {
            PG8_LDB(B0, 0, 0); PG8_LDB(B1, 0, 1); PG8_SCHED; PG8_LDA(At, 0, 0); PG8_STAGE(PG8_SA(1, 1), a1 + hstepA, voffA);
            PG8_WAIT_V(8); PG8_WAIT_L(0); PG8_BAR; PG8_MMA(0, 0, At, B0); PG8_MMA(0, 1, At, B1); PG8_BAR; PG8_SCHED;
            PG8_LDA(At, 0, 1); PG8_STAGE(PG8_SB(0, 0), b2, voffB); PG8_STAGE(PG8_SB(0, 1), b2 + hstepB, voffB); PG8_STAGE(PG8_SA(0, 0), a2, voffA);
            PG8_WAIT_V(8); PG8_WAIT_L(0); PG8_BAR; PG8_MMA(1, 0, At, B0); PG8_MMA(1, 1, At, B1); PG8_BAR; PG8_SCHED;
            PG8_LDB(B0, 1, 0); PG8_LDB(B1, 1, 1); PG8_SCHED; PG8_LDA(At, 1, 0); PG8_STAGE(PG8_SA(0, 1), a2 + hstepA, voffA);
            PG8_WAIT_V(8); PG8_WAIT_L(0); PG8_BAR; PG8_MMA(0, 0, At, B0); PG8_MMA(0, 1, At, B1); PG8_BAR; PG8_SCHED;
            PG8_LDA(At, 1, 1); PG8_STAGE(PG8_SB(1, 0), b3, voffB); PG8_STAGE(PG8_SB(1, 1), b3 + hstepB, voffB); PG8_STAGE(PG8_SA(1, 0), a3, voffA);
            PG8_WAIT_V(8); PG8_WAIT_L(0); PG8_BAR; PG8_MMA(1, 0, At, B0); PG8_MMA(1, 1, At, B1); PG8_BAR; PG8_SCHED;
            } else {
            PG8_LDB(B0, 0, 0); PG8_SCHED; PG8_LDA(At, 0, 0); PG8_STAGE(PG8_SA(1, 1), a1 + hstepA, voffA);
            PG8_WAIT_L(8); PG8_BAR; PG8_WAIT_L(0); PG8_MMA(0, 0, At, B0); PG8_BAR; PG8_SCHED;
            PG8_LDB(B1, 0, 1); PG8_STAGE(PG8_SB(0, 0), b2, voffB);
            PG8_BAR; PG8_WAIT_L(0); PG8_MMA(0, 1, At, B1); PG8_BAR;
            PG8_LDA(At, 0, 1); PG8_STAGE(PG8_SA(0, 0), a2, voffA);
            PG8_BAR; PG8_WAIT_L(0); PG8_MMA(1, 0, At, B0); PG8_BAR; PG8_SCHED;
            PG8_STAGE(PG8_SB(0, 1), b2 + hstepB, voffB);
            PG8_WAIT_V(6); PG8_BAR; PG8_MMA(1, 1, At, B1); PG8_BAR;
            PG8_LDB(B0, 1, 0); PG8_SCHED; PG8_LDA(At, 1, 0); PG8_STAGE(PG8_SA(0, 1), a2 + hstepA, voffA);
            PG8_WAIT_L(8); PG8_BAR; PG8_WAIT_L(0); PG8_MMA(0, 0, At, B0); PG8_BAR; PG8_SCHED;
            PG8_LDB(B1, 1, 1); PG8_STAGE(PG8_SB(1, 0), b3, voffB);
            PG8_BAR; PG8_WAIT_L(0); PG8_MMA(0, 1, At, B1); PG8_BAR;
            PG8_LDA(At, 1, 1); PG8_STAGE(PG8_SA(1, 0), a3, voffA);
            PG8_BAR; PG8_WAIT_L(0); PG8_MMA(1, 0, At, B0); PG8_BAR; PG8_SCHED;
            PG8_STAGE(PG8_SB(1, 1), b3 + hstepB, voffB);
            PG8_WAIT_V(6); PG8_BAR; PG8_MMA(1, 1, At, B1); PG8_BAR;
            }
        }
        if constexpr (FP8) {
#define PG8_ACC16(a) "+v"(acc[a][0][0][0]), "+v"(acc[a][0][0][1]), "+v"(acc[a][0][1][0]), "+v"(acc[a][0][1][1]), "+v"(acc[a][0][2][0]), "+v"(acc[a][0][2][1]), "+v"(acc[a][0][3][0]), "+v"(acc[a][0][3][1]), \
                     "+v"(acc[a][1][0][0]), "+v"(acc[a][1][0][1]), "+v"(acc[a][1][1][0]), "+v"(acc[a][1][1][1]), "+v"(acc[a][1][2][0]), "+v"(acc[a][1][2][1]), "+v"(acc[a][1][3][0]), "+v"(acc[a][1][3][1])
            asm volatile("s_nop 15\n\ts_nop 15" : PG8_ACC16(0));
            asm volatile("s_nop 0" : PG8_ACC16(1));
#undef PG8_ACC16
        }
        if constexpr (ALIGN_EPI) { if (wr == 0) PG8_BAR; }
        if constexpr (!Epi::AFTER_DRAIN) { E(acc, cur, wr, wc, fr, fq); S.done(cur); }
        if (!has_next) break;
#pragma unroll
        for (int a = 0; a < 2; ++a)
#pragma unroll
            for (int b = 0; b < 2; ++b)
#pragma unroll
                for (int m = 0; m < 4; ++m)
#pragma unroll
                    for (int n = 0; n < 2; ++n) acc[a][b][m][n] = (f32x4){0.f, 0.f, 0.f, 0.f};
        cur = nxt; cA = nA; cB = nB; ++ui;
        if constexpr (ALIGN_EPI) { if (wr == 1) PG8_BAR; }
    }
    PG8_WAIT_V(0);
    if constexpr (!ALIGN_EPI) { if (wr == 0) PG8_BAR; }
    PG8_BAR;
    if constexpr (Epi::AFTER_DRAIN) { E.fused(acc, cur, wr, wc, fr, fq, lds, wid, lane); S.done(cur); }
#undef PG8_SA
#undef PG8_SB
#undef PG8_STAGE
#undef PG8_LDA
#undef PG8_LDB
#undef PG8_MMA
#undef PG8_WAIT_V
#undef PG8_WAIT_L
#undef PG8_BAR
#undef PG8_SCHED
}
}

#define GAS __attribute__((address_space(1)))
#define LAS __attribute__((address_space(3)))
typedef unsigned short bf16;
typedef unsigned v4u __attribute__((ext_vector_type(4)));
typedef unsigned v2u __attribute__((ext_vector_type(2)));
typedef float f32x4 __attribute__((ext_vector_type(4)));
typedef __bf16 bf2_t __attribute__((ext_vector_type(2)));
typedef GAS unsigned gu32;
#define RLX_AGENT __ATOMIC_RELAXED, __HIP_MEMORY_SCOPE_AGENT
#define LDS_WAIT() asm volatile("s_waitcnt lgkmcnt(0)" ::: "memory")
#define VM_WAIT() asm volatile("s_waitcnt vmcnt(0)" ::: "memory")
__device__ __forceinline__ unsigned f2bf(float f) { unsigned u = __builtin_bit_cast(unsigned, f); return (u + 0x7fffu + ((u >> 16) & 1u)) >> 16; }
__device__ __forceinline__ unsigned pk2(float lo, float hi) { return f2bf(lo) | (f2bf(hi) << 16); }
__device__ __forceinline__ float bflo(unsigned u) { return __builtin_bit_cast(float, u << 16); }
__device__ __forceinline__ float bfhi(unsigned u) { return __builtin_bit_cast(float, u & 0xffff0000u); }
__device__ __forceinline__ float bf1(bf16 h) { return __builtin_bit_cast(float, ((unsigned)h) << 16); }
__device__ __forceinline__ float dot2bf(unsigned a, unsigned b, float c) { return __builtin_amdgcn_fdot2_f32_bf16(__builtin_bit_cast(bf2_t, a), __builtin_bit_cast(bf2_t, b), c, false); }
__device__ __forceinline__ float wave_sum(float v) {
#pragma unroll
    for (int o = 1; o < 64; o <<= 1) v += __shfl_xor(v, o);
    return v;
}

#define XB_TMO      128
#define XB_XCNT(j)  (256  + 64 * (j))
#define XB_XSUB(j)  (1280 + 64 * (j))
#define XB_XGEN(j)  (2304 + 64 * (j))
#define XB_TOP      3328
#define XB_TOPGEN   3392
#define XCD_BAR_WORDS 3456
#define XB_SPIN_CAP (1u << 18)

__device__ __forceinline__ unsigned xb_ld(unsigned* p)              { return __hip_atomic_load(p, __ATOMIC_RELAXED, __HIP_MEMORY_SCOPE_AGENT); }
__device__ __forceinline__ unsigned xb_add(unsigned* p, unsigned v) { return __hip_atomic_fetch_add(p, v, __ATOMIC_RELAXED, __HIP_MEMORY_SCOPE_AGENT); }
__device__ __forceinline__ unsigned xb_xcc_id() { return (unsigned)__builtin_amdgcn_s_getreg((3 << 11) | 20) & 0xFu; }
#define XB_SPIN(cond, bar) do { unsigned _sp = 0; while (cond) { __builtin_amdgcn_s_sleep(1); \
    if ((++_sp & 255u) == 0u) { if (xb_ld(&(bar)[XB_TMO])) break; if (_sp > XB_SPIN_CAP) { atomicAdd(&(bar)[XB_TMO], 1u); break; } } } } while (0)

struct XcdBarrier {
    unsigned* bar; unsigned x;
    volatile LAS unsigned* st;
};

__device__ __forceinline__ XcdBarrier xcd_barrier_post(unsigned* bar, volatile LAS unsigned* st) {
    XcdBarrier b; b.bar = bar; b.x = xb_xcc_id(); b.st = st;
    if (threadIdx.x == 0) (void)xb_add(&bar[XB_XCNT(b.x)], 1u);
    return b;
}
__device__ __forceinline__ void xcd_barrier_complete(unsigned* bar, unsigned x, unsigned& nloc, unsigned& nx) {
    const unsigned G = gridDim.x * gridDim.y * gridDim.z;
    unsigned sum, cnt, mine, sp = 0u;
    for (;;) {
        sum = 0u; cnt = 0u; mine = 0u;
#pragma unroll
        for (unsigned j = 0; j < 16; ++j) { const unsigned c = xb_ld(&bar[XB_XCNT(j)]); sum += c; cnt += (c > 0u) ? 1u : 0u; mine = (j == x) ? c : mine; }
        if (sum == G) break;
        __builtin_amdgcn_s_sleep(1);
        if ((++sp & 255u) == 0u) { if (xb_ld(&bar[XB_TMO])) break; if (sp > XB_SPIN_CAP) { atomicAdd(&bar[XB_TMO], 1u); break; } }
    }
    nloc = mine > 0u ? mine : 1u; nx = cnt > 0u ? cnt : 1u;
}

__device__ __forceinline__ void xcd_barrier(const XcdBarrier& b) {
    asm volatile("s_waitcnt vmcnt(0)" ::: "memory");
    __syncthreads();
    if (threadIdx.x == 0) {
        unsigned* bar = b.bar;
        __builtin_amdgcn_s_waitcnt(0);
        unsigned nloc = b.st[0], nx = b.st[1];
        if (nloc == 0u) { xcd_barrier_complete(bar, b.x, nloc, nx); b.st[0] = nloc; b.st[1] = nx; }
        const unsigned old = xb_add(&bar[XB_XSUB(b.x)], 1u);
        const unsigned gen = old / nloc;
        if (old + 1u == (gen + 1u) * nloc) {
            __builtin_amdgcn_fence(__ATOMIC_RELEASE, "agent");
            asm volatile("s_waitcnt vmcnt(0)" ::: "memory");
            const unsigned og = xb_add(&bar[XB_TOP], 1u);
            const unsigned tg = og / nx;
            if (og + 1u == (tg + 1u) * nx) xb_add(&bar[XB_TOPGEN], 1u);
            else XB_SPIN(xb_ld(&bar[XB_TOPGEN]) == tg, bar);
            __builtin_amdgcn_fence(__ATOMIC_ACQUIRE, "agent");
            xb_add(&bar[XB_XGEN(b.x)], 1u);
            asm volatile("s_waitcnt vmcnt(0)" ::: "memory");
        } else {
            XB_SPIN(xb_ld(&bar[XB_XGEN(b.x)]) == gen, bar);
            __builtin_amdgcn_fence(__ATOMIC_ACQUIRE, "agent");
            asm volatile("s_waitcnt vmcnt(0)" ::: "memory");
        }
    }
    __syncthreads();
}

constexpr int NWAVES = 8;
constexpr int DM = 2048, NBATCH = 8, SEQ = 2048, CTXL = 256, TPB = 2304  , MT = 18432, NPAN = 72;
constexpr int INC = 4672, INCP = 4864;
constexpr int C_NAQ = 0, C_NAK = 512, C_NAV = 1024, C_CQ = 1536, C_CKV = 1920, C_KPE = 2048, C_GQ = 2112, C_GK = 2624, C_GV = 2880, C_DQ = 3136, C_DK = 3648, C_DV = 4160;
constexpr int QMW = 768, KVW = 1280;
constexpr int DFF = 5632, DFE = 7168, NEXP = 8;
constexpr int MODW = 12288;
constexpr int MOE_ROWS = 34816, MOE_PAN = 136;
constexpr float EPSN = 1e-6f;
constexpr float SC_NA = 0.08838834764831845f, SC_MLA = 0.07216878364870322f, SC_DIFF = 0.125f;

constexpr size_t MiB = 1u << 20;
constexpr size_t WS_CTL = 0, CTL_ZERO_BYTES = 1 * MiB;
constexpr size_t WS_MOD = 1 * MiB;
constexpr size_t WS_ROPE = 1 * MiB + 900 * 1024;
constexpr size_t WS_ROUTE = 2 * MiB;
constexpr size_t WS_WIN = 3 * MiB;
constexpr size_t WS_WOUT = WS_WIN + 38 * MiB;
constexpr size_t WS_WQUP = WS_WOUT + 16 * MiB;
constexpr size_t WS_WKVUP = WS_WQUP + 2 * MiB;
constexpr size_t WS_WGU = WS_WKVUP + 2 * MiB;
constexpr size_t WS_WD = WS_WGU + 44 * MiB;
constexpr size_t WS_MGU = WS_WD + 22 * MiB;
constexpr size_t WS_MD = WS_MGU + 448 * MiB;
constexpr size_t WS_H = WS_MD + 224 * MiB;
constexpr size_t WS_U = WS_H + 144 * MiB;
constexpr size_t WS_R1 = WS_U + 72 * MiB;
constexpr size_t WS_QKV = WS_R1;
constexpr size_t WS_QM = WS_QKV + 171 * MiB;
constexpr size_t WS_KVM = WS_QM + 27 * MiB;
constexpr size_t WS_O = WS_KVM + 45 * MiB;
constexpr size_t WS_HM2 = WS_R1;
constexpr size_t WS_R2 = WS_R1 + 476 * MiB;
constexpr size_t WS_AS = WS_R2;
constexpr size_t WS_Y = WS_R2 + 136 * MiB;
constexpr size_t WS_HM = WS_R2;
constexpr size_t WS_END = WS_R2 + 272 * MiB;
static_assert(WS_O + 72 * MiB <= WS_R2, "region 1");
static_assert(WS_END <= (size_t)1792 * MiB, "workspace map must fit 4 x the largest input");
constexpr int RT_E = 0;
constexpr int RT_G = 16384;
constexpr int RT_RANK = 16384 * 3;
constexpr int RT_POS = 16384 * 5;
constexpr int RT_CNT = 16384 * 7;
static_assert((RT_CNT + 256 * 8) * 4 <= (int)MiB, "route info");
constexpr int CW_BAR = 4096;

constexpr int RING_OFF = 0, RING_BYTES = 131072;
constexpr int LDSCTL_OFF = RING_BYTES, MISC_OFF = LDSCTL_OFF + 320;
constexpr int LDS_BYTES = 147456;

namespace pg8 {
#define PG8_GAS __attribute__((address_space(1)))
struct LatentOrder : StaticOrder {
    __device__ bool next(int i, Unit& u) const { if (!StaticOrder::next(i, u)) return false; u.pm = u.pm + (u.pm >> 3) + 1; return true; }
};
#ifndef MOE_WGM
#define MOE_WGM 16
#endif
#ifndef MOE_NTB
#define MOE_NTB 0
#endif
struct MoeOrder : StaticOrder {
    static constexpr bool NTB = MOE_NTB;
    const PG8_LAS int* tab;
    __device__ bool next(int i, Unit& u) const {
        {
            const long L = (long)i * G + c; if (L >= nwg) return false;
            int wgid = (int)L; { const int q = nwg / NXCD, r = nwg % NXCD, xcd = wgid % NXCD, off = wgid / NXCD; wgid = (xcd < r ? xcd * (q + 1) : r * (q + 1) + (xcd - r) * q) + off; }
            const int nig = MOE_WGM * nN, gid = wgid / nig, fm = gid * MOE_WGM, gsz = (nM - fm) < MOE_WGM ? (nM - fm) : MOE_WGM;
            u.pm = fm + ((wgid % nig) % gsz); u.pn = (wgid % nig) / gsz;
        }
        int e = 0;
#pragma unroll
        for (int q = 0; q < 7; ++q) e += (u.pm >= __builtin_amdgcn_readfirstlane(tab[32 + q])) ? 1 : 0;
        u.pn += e * nN; return true;
    }
};
#ifndef MOED_WGM
#define MOED_WGM 4
#endif
struct MoeFullOrder : StaticOrder {
    const PG8_LAS int* tab;
    __device__ bool next(int i, Unit& u) const {
        {
            const long L = (long)i * G + c; if (L >= nwg) return false;
            int wgid = (int)L; { const int q = nwg / NXCD, r = nwg % NXCD, xcd = wgid % NXCD, off = wgid / NXCD; wgid = (xcd < r ? xcd * (q + 1) : r * (q + 1) + (xcd - r) * q) + off; }
            const int nig = MOED_WGM * nN, gid = wgid / nig, fm = gid * MOED_WGM, gsz = (nM - fm) < MOED_WGM ? (nM - fm) : MOED_WGM;
            u.pm = fm + ((wgid % nig) % gsz); u.pn = (wgid % nig) / gsz;
        }
        const int f = u.pm; int e = 0;
#pragma unroll
        for (int q = 0; q < 7; ++q) e += (f >= __builtin_amdgcn_readfirstlane(tab[40 + q])) ? 1 : 0;
        u.pm = f + __builtin_amdgcn_readfirstlane(tab[48 + e]); u.pn += e * nN; return true;
    }
    __device__ __forceinline__ void a_ready(const Unit&) const {}
    __device__ __forceinline__ void done(const Unit&) const {}
};
struct MoeRemOrder {
    static constexpr bool NTB = false;
    int nsub, G, c; const PG8_LAS int* tab;
    __device__ bool next(int i, Unit& u) const {
        const int L = i * G + c; if (L >= nsub) return false;
        const int r = L >> 5, pn = (L >> 2) & 7, ks = L & 3, e = tab[64 + r];
        u.pm = tab[32 + e] - 1; u.pn = e * 8 + pn; u.ko = ks * 1792; u.aux = r; return true;
    }
    __device__ __forceinline__ void a_ready(const Unit&) const {}
    __device__ __forceinline__ void done(const Unit&) const {}
};
struct CtxRemOrder {
    static constexpr bool NTB = false;
    int G, c;
    __device__ bool next(int i, Unit& u) const {
        const int L = i * G + c; if (L >= 256) return false;
        const int r = L >> 5, pn = (L >> 2) & 7, ks = L & 3;
        u.pm = 9 * r; u.pn = pn; u.ko = ks * 1408; u.aux = r; return true;
    }
    __device__ __forceinline__ void a_ready(const Unit&) const {}
    __device__ __forceinline__ void done(const Unit&) const {}
};
struct EpiSlab {
    static constexpr bool PERM = false, AFTER_DRAIN = false;
    float* S; float sc = 1.0f; int kdiv = 1792;
    __device__ __forceinline__ void operator()(const f32x4 (&acc)[2][2][4][2], const Unit& u, int wr, int wc, int fr_in, int fq_in) const {
        (void)fr_in; (void)fq_in; int t_ = threadIdx.x; asm volatile("" : "+v"(t_)); const int fr = t_ & 15, fq = (t_ >> 4) & 3;
        const int ks = u.ko / kdiv, pn = u.pn & 7;
        float* base = S + ((size_t)(ks * 8 + u.aux) * 256 + wr * 64 + fr) * 2048 + pn * BM + wc * 32 + 4 * fq;
#pragma unroll
        for (int ai = 0; ai < 2; ++ai)
#pragma unroll
            for (int m = 0; m < 4; ++m)
#pragma unroll
                for (int bj = 0; bj < 2; ++bj)
#pragma unroll
                    for (int n = 0; n < 2; ++n) *(PG8_GAS f32x4*)(base + (size_t)(ai * HALF + m * 16) * 2048 + bj * HALF + n * 16) = acc[ai][bj][m][n] * sc;
    }
};
struct EpiBf16P {
    static constexpr bool PERM = true, AFTER_DRAIN = false;
    bf16_t* O; int ldc; int pn_mod; float sc = 1.0f;
    __device__ __forceinline__ void operator()(const f32x4 (&acc)[2][2][4][2], const Unit& u, int wr, int wc, int fr_in, int fq_in) const {
        (void)fr_in; (void)fq_in; int t_ = threadIdx.x; asm volatile("" : "+v"(t_)); const int fr = t_ & 15, fq = (t_ >> 4) & 3;
        const int pn = pn_mod ? (u.pn % pn_mod) : u.pn;
        const int row0 = u.pm * BM + wr * 64 + fr, col0 = pn * BM + wc * 32 + 8 * fq;
#pragma unroll
        for (int ai = 0; ai < 2; ++ai)
#pragma unroll
            for (int m = 0; m < 4; ++m) { bf16_t* rowp = O + (size_t)(row0 + ai * HALF + m * 16) * ldc + col0;
#pragma unroll
                for (int bj = 0; bj < 2; ++bj) { const f32x4 v0 = acc[ai][bj][m][0] * sc, v1 = acc[ai][bj][m][1] * sc;
                    u32x4 w; w.x = cvt_pk_bf16(v0[0], v0[1]); w.y = cvt_pk_bf16(v0[2], v0[3]); w.z = cvt_pk_bf16(v1[0], v1[1]); w.w = cvt_pk_bf16(v1[2], v1[3]);
                    *(PG8_GAS u32x4*)(rowp + bj * HALF) = w; } }
    }
};
#ifndef KT_MOE
#define KT_MOE 1
#endif
#ifndef MOE_FP8
#define MOE_FP8 1
#endif
constexpr float MOE_WSCALE = 64.0f;
#ifndef EMU_FP8
#define EMU_FP8 0
#endif
#ifndef EMU_DGU
#define EMU_DGU 0
#endif
__device__ __forceinline__ unsigned pk4_fp8(float a, float b, float c, float d) { int p = __builtin_amdgcn_cvt_pk_fp8_f32(a, b, 0, false); p = __builtin_amdgcn_cvt_pk_fp8_f32(c, d, p, true); return (unsigned)p; }
__device__ __forceinline__ float fp8r(float x) { const int p = __builtin_amdgcn_cvt_pk_fp8_f32(x, x, 0, false); return __builtin_amdgcn_cvt_f32_fp8(p, 0); }
#ifndef NT_HM2
#define NT_HM2 1
#endif
__device__ __forceinline__ float silu_f(float x) { return x * __builtin_amdgcn_rcpf(1.0f + __expf(-x)); }
__device__ __forceinline__ float swiglu_f(float g, float u, float c1, float kk) { const float e = __builtin_amdgcn_exp2f(g * c1); return (g * u) * __builtin_amdgcn_rcpf(fmaf(e, kk, kk)); }
struct EpiSwiGLU {
    static constexpr bool PERM = true, AFTER_DRAIN = false;
    bf16_t* O; int ldc; int pn_mod; float isc = 1.0f;
    __device__ __forceinline__ void operator()(const f32x4 (&acc)[2][2][4][2], const Unit& u, int wr, int wc, int fr_in, int fq_in) const {
        (void)fr_in; (void)fq_in; int t_ = threadIdx.x; asm volatile("" : "+v"(t_)); const int fr = t_ & 15, fq = (t_ >> 4) & 3;
        const int pn = pn_mod ? (u.pn % pn_mod) : u.pn;
        const int row0 = u.pm * BM + wr * 64 + fr, col0 = pn * HALF + wc * 32 + 8 * fq;
        const float c1 = -1.4426950408889634f * isc, kk = 1.0f / (isc * isc);
#pragma unroll
        for (int ai = 0; ai < 2; ++ai)
#pragma unroll
            for (int m = 0; m < 4; ++m) { bf16_t* rowp = O + (size_t)(row0 + ai * HALF + m * 16) * ldc + col0;
                if (KT_MOE && pn_mod) rowp = O + ((size_t)(u.pm * (ldc >> 6) + (col0 >> 6)) * 256 + (wr * 64 + fr + ai * HALF + m * 16)) * 64 + (col0 & 63);
                f32x4 r0, r1;
#pragma unroll
                for (int j = 0; j < 4; ++j) { r0[j] = swiglu_f(acc[ai][0][m][0][j], acc[ai][1][m][0][j], c1, kk); r1[j] = swiglu_f(acc[ai][0][m][1][j], acc[ai][1][m][1][j], c1, kk); }
                if (MOE_FP8 && pn_mod) {
                    typedef unsigned u32x2 __attribute__((ext_vector_type(2)));
                    unsigned char* p8 = (unsigned char*)O + ((size_t)(u.pm * (ldc >> 7) + (col0 >> 7)) * 256 + (wr * 64 + fr + ai * HALF + m * 16)) * 128 + (col0 & 127);
                    u32x2 w8; w8.x = pk4_fp8(r0[0], r0[1], r0[2], r0[3]); w8.y = pk4_fp8(r1[0], r1[1], r1[2], r1[3]);
                    __builtin_nontemporal_store(w8, (PG8_GAS u32x2*)p8); continue; }
                if (EMU_FP8 && pn_mod) {
#pragma unroll
                    for (int j = 0; j < 4; ++j) { r0[j] = fp8r(r0[j]); r1[j] = fp8r(r1[j]); } }
                u32x4 w; w.x = cvt_pk_bf16(r0[0], r0[1]); w.y = cvt_pk_bf16(r0[2], r0[3]); w.z = cvt_pk_bf16(r1[0], r1[1]); w.w = cvt_pk_bf16(r1[2], r1[3]);
                if (NT_HM2 && pn_mod) __builtin_nontemporal_store(w, (PG8_GAS u32x4*)rowp); else *(PG8_GAS u32x4*)rowp = w; }
    }
};
struct EpiResGate {
    static constexpr bool PERM = false, AFTER_DRAIN = false;
    float* H; const float* gate;
    const float* xin; const float* cin;
    __device__ __forceinline__ void operator()(const f32x4 (&acc)[2][2][4][2], const Unit& u, int wr, int wc, int fr, int fq) const {
        const int b = u.pm / 9, j = u.pm - 9 * b, mr = (j == 0) ? 8 : b;
        const int rloc = wr * 64 + fr, col0 = u.pn * BM + wc * 32 + 4 * fq;
        const float* gp = gate + (size_t)mr * 12288 + col0;
        float* outp = H + (size_t)(u.pm * BM + rloc) * 2048 + col0;
        const float* inp = xin ? ((j == 0) ? cin + ((size_t)b * 256 + rloc) * 2048 + col0 : xin + ((size_t)b * 2048 + (size_t)(j - 1) * 256 + rloc) * 2048 + col0) : outp;
        f32x4 gv[2][2];
#pragma unroll
        for (int bj = 0; bj < 2; ++bj)
#pragma unroll
            for (int n = 0; n < 2; ++n) gv[bj][n] = *(const PG8_GAS f32x4*)(gp + bj * HALF + n * 16);
#pragma unroll
        for (int ai = 0; ai < 2; ++ai)
#pragma unroll
            for (int m = 0; m < 4; ++m) {
                const size_t ro = (size_t)(ai * HALF + m * 16) * 2048;
#pragma unroll
                for (int bj = 0; bj < 2; ++bj)
#pragma unroll
                    for (int n = 0; n < 2; ++n) { const f32x4 h = *(const PG8_GAS f32x4*)(inp + ro + bj * HALF + n * 16); *(PG8_GAS f32x4*)(outp + ro + bj * HALF + n * 16) = h + gv[bj][n] * acc[ai][bj][m][n]; }
                asm volatile("" ::: "memory"); }
    }
};
struct EpiQupRope {
    static constexpr bool PERM = false, AFTER_DRAIN = false;
    bf16_t* O; const float* tab;
    __device__ __forceinline__ void operator()(const f32x4 (&acc)[2][2][4][2], const Unit& u, int wr, int wc, int fr, int fq) const {
        const int b = u.pm / 9, j = u.pm - 9 * b; const bool lat = j != 0;
        const int rloc = wr * 64 + fr, col0 = u.pn * BM + wc * 32 + 4 * fq;
        typedef unsigned u32x2 __attribute__((ext_vector_type(2)));
#pragma unroll
        for (int bj = 0; bj < 2; ++bj) {
            const int dblk = (8 * u.pn + 4 * bj + wc) % 6; const bool rope = lat && dblk >= 4; const int axis = dblk - 4;
#pragma unroll
            for (int ai = 0; ai < 2; ++ai)
#pragma unroll
                for (int m = 0; m < 4; ++m) {
                    const int r = ai * HALF + m * 16 + rloc;
                    f32x4 x1 = acc[ai][bj][m][0], x2 = acc[ai][bj][m][1];
                    if (rope) { const int t = (j - 1) * 256 + r, pos = axis ? (t & 63) : (t >> 6);
                        const f32x4 c = *(const PG8_GAS f32x4*)(tab + pos * 16 + 4 * fq), sn = *(const PG8_GAS f32x4*)(tab + 1024 + pos * 16 + 4 * fq);
                        const f32x4 a = x1, bb = x2; x1 = a * c - bb * sn; x2 = bb * c + a * sn; }
                    bf16_t* rowp = O + (size_t)(u.pm * BM + r) * 768 + col0 + bj * HALF;
                    u32x2 w0, w1; w0.x = cvt_pk_bf16(x1[0], x1[1]); w0.y = cvt_pk_bf16(x1[2], x1[3]); w1.x = cvt_pk_bf16(x2[0], x2[1]); w1.y = cvt_pk_bf16(x2[2], x2[3]);
                    *(PG8_GAS u32x2*)rowp = w0; *(PG8_GAS u32x2*)(rowp + 16) = w1;
                    asm volatile("" ::: "memory");
                }
        }
    }
};
}
#define PG8_SP2 true
#define PG8_ALIGN true

struct Frame {
    LAS unsigned char* lds;
    volatile LAS unsigned* MISC;
    gu32* ctl;
    int wave, G, gw, NGW;
    float* out;
    unsigned char* ws;
};
__device__ __forceinline__ int opq_v(int v) { asm volatile("" : "+v"(v)); return v; }
#define TIDX opq_v((int)threadIdx.x)
typedef const float* cfptr;
__device__ __forceinline__ const float* inptr(int i) {
    const __attribute__((address_space(4))) cfptr* p = (const __attribute__((address_space(4))) cfptr*)__builtin_amdgcn_kernarg_segment_ptr();
    asm volatile("" : "+s"(p));
    return p[i];
}
enum { I_X = 0, I_C, I_CTX, I_CCTX, I_WMOD, I_BMOD, I_GMIX, I_WIN, I_NABIAS, I_MLAGQ, I_WQUP, I_MLAGKV, I_WKVUP, I_GQAGQ, I_GQAGK, I_LQ1, I_LK1, I_LQ2, I_LK2, I_GSUB, I_WOUT, I_GFFN,
       I_FG, I_FU, I_FD, I_MR, I_MB, I_MG, I_MU, I_MDN, I_GFIN };

struct TrJob { const float* W; bf16* WT; int N, ldk, k0, n0, drow0, tiled, emu; };
__device__ __forceinline__ void tr_load(const TrJob& j, f32x4 (&v)[16], int lane) {
#pragma unroll
    for (int i = 0; i < 16; ++i) { const int k = 4 * i + (lane >> 4), n4 = (lane & 15) * 4;
        v[i] = __builtin_nontemporal_load((const GAS f32x4*)(j.W + (size_t)(j.k0 + k) * j.N + j.n0 + n4)); }
}
__device__ __forceinline__ void tr_finish8(const TrJob& j, const f32x4 (&v)[16], LAS unsigned char* scr, int lane) {
    constexpr int ROWB = 68;
#pragma unroll
    for (int i = 0; i < 16; ++i) { const int k = 4 * i + (lane >> 4), n4 = (lane & 15) * 4; const f32x4 t = v[i] * pg8::MOE_WSCALE;
        *(LAS unsigned*)(scr + k * ROWB + n4) = pg8::pk4_fp8(t.x, t.y, t.z, t.w); }
    LDS_WAIT();
    const int c = lane & 3;
#pragma unroll 2
    for (int jj = 0; jj < 4; ++jj) {
        const int n = 16 * jj + (lane >> 2);
        const LAS unsigned char* s = scr + (16 * c) * ROWB + n;
        unsigned e[16];
#pragma unroll
        for (int i = 0; i < 16; ++i) e[i] = s[i * ROWB];
        v4u o; o.x = e[0] | (e[1] << 8) | (e[2] << 16) | (e[3] << 24); o.y = e[4] | (e[5] << 8) | (e[6] << 16) | (e[7] << 24);
        o.z = e[8] | (e[9] << 8) | (e[10] << 16) | (e[11] << 24); o.w = e[12] | (e[13] << 8) | (e[14] << 16) | (e[15] << 24);
        const int dr = j.drow0 + n;
        unsigned char* dst = (unsigned char*)j.WT + ((size_t)((dr >> 8) * (j.ldk >> 7) + (j.k0 >> 7)) * 256 + (dr & 255)) * 128 + (j.k0 & 127) + 16 * c;
        __builtin_nontemporal_store(o, (GAS v4u*)dst);
    }
    LDS_WAIT();
}
__device__ __forceinline__ void tr_finish(const TrJob& j, const f32x4 (&v)[16], LAS unsigned char* scr, int lane) {
    constexpr int ROWB = 136;
#pragma unroll
    for (int i = 0; i < 16; ++i) { const int k = 4 * i + (lane >> 4), n4 = (lane & 15) * 4;
        f32x4 t = v[i]; if ((EMU_FP8 && j.tiled) || (EMU_DGU && j.emu)) { t.x = pg8::fp8r(t.x * 64.f) * (1.f / 64.f); t.y = pg8::fp8r(t.y * 64.f) * (1.f / 64.f); t.z = pg8::fp8r(t.z * 64.f) * (1.f / 64.f); t.w = pg8::fp8r(t.w * 64.f) * (1.f / 64.f); }
        v2u w; w.x = pg8::cvt_pk_bf16(t.x, t.y); w.y = pg8::cvt_pk_bf16(t.z, t.w);
        *(LAS v2u*)(scr + k * ROWB + n4 * 2) = w; }
    LDS_WAIT();
    const int c = lane & 7;
#pragma unroll 2
    for (int jj = 0; jj < 8; ++jj) {
        const int n = 8 * jj + (lane >> 3);
        const LAS unsigned short* s = (const LAS unsigned short*)(scr + (8 * c) * ROWB + n * 2);
        unsigned e[8];
#pragma unroll
        for (int i = 0; i < 8; ++i) e[i] = s[i * (ROWB / 2)];
        v4u o; o.x = e[0] | (e[1] << 16); o.y = e[2] | (e[3] << 16); o.z = e[4] | (e[5] << 16); o.w = e[6] | (e[7] << 16);
        const int dr = j.drow0 + n;
        bf16* dst = j.tiled ? j.WT + ((size_t)((dr >> 8) * (j.ldk >> 6) + (j.k0 >> 6)) * 256 + (dr & 255)) * 64 + 8 * c : j.WT + (size_t)dr * j.ldk + j.k0 + 8 * c;
        __builtin_nontemporal_store(o, (GAS v4u*)dst);
    }
    LDS_WAIT();
}
constexpr int IT_WIN = 32 * 73, IT_WOUT = 32 * 32, IT_FGU = 32 * 88, IT_FD = 88 * 32, IT_MGU = 32 * 112, IT_MD = 112 * 32;
constexpr int CV_N0 = 2 * IT_WIN, CV_N1 = CV_N0 + 2 * IT_WOUT, CV_N2 = CV_N1 + 2 * IT_FGU, CV_N3 = CV_N2 + IT_FD, CV_N4 = CV_N3 + 16 * IT_MGU, CV_N5 = CV_N4 + 8 * IT_MD;
constexpr int CVQ_L1 = IT_WIN + IT_WOUT, CVQ_N = CVQ_L1 + (CV_N5 - CV_N1), CVQ_FFN_END = CVQ_L1 + (CV_N3 - CV_N1);
__device__ __forceinline__ int cvq_item(int q) { return q < IT_WIN ? IT_WIN + q : (q < CVQ_L1 ? CV_N0 + IT_WOUT + (q - IT_WIN) : CV_N1 + (q - CVQ_L1)); }
__device__ __forceinline__ TrJob conv_job(int it, unsigned char* ws) {
    const float* W; bf16* WT; int N, ldk, k0, n0, drow0, tiled = 0, emu = 0;
    if (it < CV_N0) { const int l = it / IT_WIN, r = it % IT_WIN, kb = r / 73, nb = r % 73;
        W = inptr(I_WIN) + (size_t)l * 2048 * INC; N = INC; WT = (bf16*)(ws + WS_WIN) + (size_t)l * INCP * 2048; ldk = 2048; k0 = kb * 64; n0 = nb * 64; drow0 = n0; }
    else if (it < CV_N1) { const int q = it - CV_N0, l = q / IT_WOUT, r = q % IT_WOUT, kb = r / 32, nb = r % 32;
        W = inptr(I_WOUT) + (size_t)l * 2048 * 2048; N = 2048; WT = (bf16*)(ws + WS_WOUT) + (size_t)l * 2048 * 2048; ldk = 2048; k0 = kb * 64; n0 = nb * 64; drow0 = n0; }
    else if (it < CV_N2) { const int q = it - CV_N1, which = q / IT_FGU, r = q % IT_FGU, kb = r / 88, nb = r % 88;
        W = which ? inptr(I_FU) : inptr(I_FG); N = DFF; WT = (bf16*)(ws + WS_WGU); ldk = 2048; k0 = kb * 64; n0 = nb * 64; drow0 = (n0 >> 7) * 256 + (n0 & 127) + which * 128; emu = 1; }
    else if (it < CV_N3) { const int r = it - CV_N2, kb = r / 32, nb = r % 32;
        W = inptr(I_FD); N = 2048; WT = (bf16*)(ws + WS_WD); ldk = DFF; k0 = kb * 64; n0 = nb * 64; drow0 = n0; }
    else if (it < CV_N4) { const int q = it - CV_N3, mat = q / IT_MGU, e = mat >> 1, which = mat & 1, r = q % IT_MGU, kb = r / 112, nb = r % 112;
        W = (which ? inptr(I_MU) : inptr(I_MG)) + (size_t)e * 2048 * DFE; N = DFE; WT = MOE_FP8 ? (bf16*)(ws + WS_MGU + (size_t)e * 14336 * 2048) : (bf16*)(ws + WS_MGU) + (size_t)e * 14336 * 2048; ldk = 2048; k0 = kb * 64; n0 = nb * 64; drow0 = (n0 >> 7) * 256 + (n0 & 127) + which * 128; tiled = MOE_FP8 ? 2 : KT_MOE; }
    else { const int q = it - CV_N4, e = q / IT_MD, r = q % IT_MD, kb = r / 32, nb = r % 32;
        W = inptr(I_MDN) + (size_t)e * DFE * 2048; N = 2048; WT = MOE_FP8 ? (bf16*)(ws + WS_MD + (size_t)e * 2048 * DFE) : (bf16*)(ws + WS_MD) + (size_t)e * 2048 * DFE; ldk = DFE; k0 = kb * 64; n0 = nb * 64; drow0 = n0; tiled = MOE_FP8 ? 2 : KT_MOE; }
    TrJob j; j.W = W; j.WT = WT; j.N = N; j.ldk = ldk; j.k0 = k0; j.n0 = n0; j.drow0 = drow0; j.tiled = tiled; j.emu = emu; return j;
}
template <bool QUEUE>
__device__ __forceinline__ void conv_pair(int it0, int it1, int nlim, unsigned char* ws, LAS unsigned char* scr, int lane) {
    if (it0 >= nlim) return;
    const bool two = it1 < nlim;
    const TrJob j0 = conv_job(QUEUE ? cvq_item(it0) : it0, ws), j1 = conv_job(QUEUE ? cvq_item(two ? it1 : it0) : (two ? it1 : it0), ws);
    f32x4 v0[16], v1[16];
#ifdef PROBE_CONV2
    if (QUEUE) { tr_load(j0, v0, lane); if (two) tr_load(j1, v1, lane); if (j0.tiled == 2) tr_finish8(j0, v0, scr, lane); else tr_finish(j0, v0, scr, lane); if (two) { if (j1.tiled == 2) tr_finish8(j1, v1, scr, lane); else tr_finish(j1, v1, scr, lane); } }
#endif
    tr_load(j0, v0, lane); if (two) tr_load(j1, v1, lane);
    if (j0.tiled == 2) tr_finish8(j0, v0, scr, lane); else tr_finish(j0, v0, scr, lane);
    if (two) { if (j1.tiled == 2) tr_finish8(j1, v1, scr, lane); else tr_finish(j1, v1, scr, lane); }
}
#ifndef CV_CHUNK_N
#define CV_CHUNK_N 16
#endif
constexpr int CW_QHEAD = 64, CW_DONE0 = 128, CV_CHUNK = CV_CHUNK_N;
#ifndef NO_TAIL_FILL
#define NO_TAIL_FILL 0
#endif
__device__ __forceinline__ void filler(Frame& F, int slot, int drain_to) {
    if (NO_TAIL_FILL && drain_to < 0) return;
    __syncthreads();
    LAS int* bc = (LAS int*)(F.lds + LDSCTL_OFF + 2048);
    LAS unsigned char* scr = F.lds + F.wave * 8704;
    gu32* qhead = F.ctl + CW_QHEAD; gu32* done = F.ctl + CW_DONE0 + 64 * slot;
    if (TIDX == 0 && drain_to < 0) __hip_atomic_fetch_add(done, 1u, RLX_AGENT);
    const int nq = CVQ_N, lim = drain_to < 0 ? nq : drain_to;
    for (;;) {
        if (TIDX == 0) {
            int h = -1; bool stop = false;
            if (drain_to < 0) stop = __hip_atomic_load(done, RLX_AGENT) >= (unsigned)F.G;
            else stop = __hip_atomic_load(qhead, RLX_AGENT) >= (unsigned)lim;
            if (!stop) { h = (int)__hip_atomic_fetch_add(qhead, (unsigned)CV_CHUNK, RLX_AGENT); if (h >= nq) h = -1; }
            *bc = h;
        }
        __syncthreads();
        const int h = *bc;
        __syncthreads();
        if (h < 0) break;
#pragma unroll 1
        for (int k = F.wave; k < CV_CHUNK; k += 2 * NWAVES) conv_pair<true>(h + k, h + k + NWAVES, CVQ_N, F.ws, scr, (TIDX & 63));
    }
    __syncthreads();
}

__device__ __forceinline__ void xcd_barrier_fill(const XcdBarrier& b, Frame& F) {
    asm volatile("s_waitcnt vmcnt(0)" ::: "memory");
    __syncthreads();
    LAS int* bc = (LAS int*)(F.lds + LDSCTL_OFF + 2048);
    if (threadIdx.x == 0) {
        unsigned* bar = b.bar;
        __builtin_amdgcn_s_waitcnt(0);
        unsigned nloc = b.st[0], nx = b.st[1];
        if (nloc == 0u) { xcd_barrier_complete(bar, b.x, nloc, nx); b.st[0] = nloc; b.st[1] = nx; }
        const unsigned old = xb_add(&bar[XB_XSUB(b.x)], 1u);
        const unsigned gen = old / nloc;
        if (old + 1u == (gen + 1u) * nloc) {
            __builtin_amdgcn_fence(__ATOMIC_RELEASE, "agent");
            asm volatile("s_waitcnt vmcnt(0)" ::: "memory");
            const unsigned og = xb_add(&bar[XB_TOP], 1u);
            const unsigned tg = og / nx;
            if (og + 1u == (tg + 1u) * nx) xb_add(&bar[XB_TOPGEN], 1u);
            else XB_SPIN(xb_ld(&bar[XB_TOPGEN]) == tg, bar);
            __builtin_amdgcn_fence(__ATOMIC_ACQUIRE, "agent");
            xb_add(&bar[XB_XGEN(b.x)], 1u);
            asm volatile("s_waitcnt vmcnt(0)" ::: "memory");
            bc[2] = 1;
        } else { bc[1] = (int)gen; bc[2] = 0; }
    }
    __syncthreads();
    if (bc[2] == 0) {
        LAS unsigned char* scr = F.lds + F.wave * 8704;
        gu32* qhead = F.ctl + CW_QHEAD;
        for (;;) {
            if (threadIdx.x == 0) {
                int h = -2;
                if (xb_ld(&b.bar[XB_XGEN(b.x)]) == (unsigned)bc[1]) { h = (int)__hip_atomic_fetch_add(qhead, 8u, RLX_AGENT); if (h >= CVQ_N) h = -1; }
                bc[0] = h;
            }
            __syncthreads();
            const int h = bc[0];
            __syncthreads();
            if (h < 0) { if (h == -1 && threadIdx.x == 0) XB_SPIN(xb_ld(&b.bar[XB_XGEN(b.x)]) == (unsigned)bc[1], b.bar); break; }
            conv_pair<true>(h + F.wave, CVQ_N, CVQ_N, F.ws, scr, (TIDX & 63));
        }
        if (threadIdx.x == 0) { __builtin_amdgcn_fence(__ATOMIC_ACQUIRE, "agent"); asm volatile("s_waitcnt vmcnt(0)" ::: "memory"); }
    }
    __syncthreads();
}

__device__ __forceinline__ void rope_cs(int pos, int i, float inv_nfreq, float& c, float& s) {
    const float freq = exp2f(-(float)i * inv_nfreq * 13.287712379549449f);
    const float ang = (float)pos * freq;
    c = __cosf(ang); s = __sinf(ang);
}

__device__ __forceinline__ void filler_quota(Frame& F, int nchunks) {
    __syncthreads();
    LAS int* bc = (LAS int*)(F.lds + LDSCTL_OFF + 2048);
    LAS unsigned char* scr = F.lds + F.wave * 8704;
    gu32* qhead = F.ctl + CW_QHEAD;
    const int nq = CVQ_N;
#pragma unroll 1
    for (int cidx = 0; cidx < nchunks; ++cidx) {
        if (TIDX == 0) { int h = -1;
            if (__hip_atomic_load(qhead, RLX_AGENT) < (unsigned)nq) { h = (int)__hip_atomic_fetch_add(qhead, (unsigned)CV_CHUNK, RLX_AGENT); if (h >= nq) h = -1; }
            *bc = h; }
        __syncthreads();
        const int h = *bc;
        __syncthreads();
        if (h < 0) break;
#pragma unroll 1
        for (int k = F.wave; k < CV_CHUNK; k += 2 * NWAVES) conv_pair<true>(h + k, h + k + NWAVES, CVQ_N, F.ws, scr, (TIDX & 63));
    }
    __syncthreads();
}

__device__ __forceinline__ float silu_g(float x) { return x / (1.0f + __expf(-x)); }

__device__ __forceinline__ void p0_prologue(Frame& F) {
    unsigned char* ws = F.ws;
    __syncthreads();
    {
        LAS float* sv = (LAS float*)(F.lds);
        LAS float* red = (LAS float*)(F.lds + 73728);
        for (int i = TIDX; i < 9 * 2048; i += 512) { const int r = i >> 11, d = i & 2047; const float v = (r < 8) ? inptr(I_C)[r * 2048 + d] : inptr(I_CCTX)[d]; sv[i] = silu_g(v); }
        __syncthreads();
        for (int cb = blockIdx.x; cb < 256; cb += F.G) {
            const int cg = cb * 96, layer = cg / MODW, col0 = cg - layer * MODW;
            const float* W = inptr(I_WMOD) + (size_t)layer * 2048 * MODW;
            if (TIDX < 384) {
                const int cq = TIDX % 24, ks = TIDX / 24;
                f32x4 acc[9];
#pragma unroll
                for (int r = 0; r < 9; ++r) acc[r] = (f32x4){0.f, 0.f, 0.f, 0.f};
                const float* wp = W + (size_t)(ks * 128) * MODW + col0 + cq * 4;
#pragma unroll 2
                for (int k = 0; k < 128; k += 4) {
                    f32x4 w[4];
#pragma unroll
                    for (int q = 0; q < 4; ++q) w[q] = __builtin_nontemporal_load((const GAS f32x4*)(wp + (size_t)(k + q) * MODW));
#pragma unroll
                    for (int r = 0; r < 9; ++r) { const f32x4 s4 = *(const LAS f32x4*)(sv + r * 2048 + ks * 128 + k);
                        acc[r] += w[0] * s4.x; acc[r] += w[1] * s4.y; acc[r] += w[2] * s4.z; acc[r] += w[3] * s4.w; }
                }
#pragma unroll
                for (int r = 0; r < 9; ++r) *(LAS f32x4*)(red + (ks * 9 + r) * 96 + cq * 4) = acc[r];
            }
            __syncthreads();
            for (int i = TIDX; i < 9 * 96; i += 512) {
                const int r = i / 96, c = i - r * 96; float s = inptr(I_BMOD)[layer * MODW + col0 + c];
#pragma unroll
                for (int ks = 0; ks < 16; ++ks) s += red[(ks * 9 + r) * 96 + c];
                ((float*)(ws + WS_MOD))[((size_t)layer * 9 + r) * MODW + col0 + c] = s;
            }
            __syncthreads();
        }
    }
    {
        const size_t gt = (size_t)blockIdx.x * 512 + TIDX, GT = (size_t)F.G * 512;
        for (size_t i = gt; i < (size_t)2 * 768 * 384; i += GT) { const int l = (int)(i / (768 * 384)), r = (int)(i % (768 * 384)), n = r / 384, k = r % 384;
            ((bf16*)(ws + WS_WQUP))[i] = (bf16)f2bf(inptr(I_WQUP)[((size_t)l * 384 + k) * 768 + n]); }
        for (size_t i = gt; i < (size_t)2 * 1280 * 256; i += GT) { const int l = (int)(i / (1280 * 256)), r = (int)(i % (1280 * 256)), row = r >> 8, k = r & 255, h = row / 320, j = row - 320 * h;
            float v = 0.f;
            if (j < 128) { if (k < 128) v = inptr(I_WKVUP)[((size_t)l * 128 + k) * 1024 + h * 256 + j]; }
            else if (j < 192) { if (k == j) v = 1.0f; }
            else { if (k < 128) v = inptr(I_WKVUP)[((size_t)l * 128 + k) * 1024 + h * 256 + 128 + (j - 192)]; }
            ((bf16*)(ws + WS_WKVUP))[i] = (bf16)f2bf(v); }
        for (size_t i = gt; i < 64 * 16 + 64 * 32; i += GT) { float* tb = (float*)(ws + WS_ROPE);
            if (i < 1024) { const int pos = (int)i >> 4, f = (int)i & 15; float c, sn; rope_cs(pos, f, 1.0f / 16.0f, c, sn); tb[i] = c; tb[1024 + i] = sn; }
            else { const int q = (int)i - 1024, pos = q >> 5, f = q & 31; float c, sn; rope_cs(pos, f, 1.0f / 32.0f, c, sn); tb[2048 + q] = c; tb[4096 + q] = sn; } }
        for (size_t i = gt; i < (size_t)2 * 192 * 2048 / 8; i += GT) { const int l = (int)(i / (192 * 256)), r = (int)(i % (192 * 256));
            *(GAS v4u*)((bf16*)(ws + WS_WIN) + ((size_t)l * INCP + INC) * 2048 + (size_t)r * 8) = (v4u){0u, 0u, 0u, 0u}; }
    }
    {
        LAS unsigned char* scr = F.lds + F.wave * 8704;
        for (int it = F.gw; it < IT_WIN + IT_WOUT; it += 2 * F.NGW) {
            const int i1 = it + F.NGW, a0 = it < IT_WIN ? it : CV_N0 + (it - IT_WIN), a1 = i1 < IT_WIN ? i1 : CV_N0 + (i1 - IT_WIN);
            conv_pair<false>(a0, i1 < IT_WIN + IT_WOUT ? a1 : CV_N5, CV_N5, ws, scr, (TIDX & 63)); }
    }
}

struct RowInfo { int b, w, t, mr; bool ctx; };
__device__ __forceinline__ RowInfo row_info(int r) { RowInfo q; q.b = r / TPB; q.w = r - q.b * TPB; q.ctx = q.w < CTXL; q.t = q.w - CTXL; q.mr = q.ctx ? 8 : q.b; return q; }

__device__ __forceinline__ void norm_pass(Frame& F, int layer, bool first  , bool from_input, bool split_ctx = false) {
    unsigned char* ws = F.ws;
    const float* modl = (const float*)(ws + WS_MOD) + (size_t)layer * 9 * MODW;
    const float* g = (first ? inptr(I_GMIX) : inptr(I_GFFN)) + layer * DM;
    const int sh_off = first ? 0 : 3 * DM, sc_off = first ? DM : 4 * DM;
    const float* H = (const float*)(ws + WS_H); bf16* U = (bf16*)(ws + WS_U);
    const int tid_ = TIDX, lane_ = tid_ & 63;
    LAS float* ca = (LAS float*)F.lds; LAS float* cb = ca + 4096;
    LAS float* cg = ca + 8192;
    for (int blk = blockIdx.x; blk < 256; blk += F.G) {
        const int r0 = blk * 72, bb = r0 / TPB;
        __syncthreads();
        for (int i = tid_; i < 2 * 2048; i += 512) { const int slot = i >> 11, col = i & 2047, mr = slot ? bb : 8;
            ca[i] = g[col] * (1.0f + modl[(size_t)mr * MODW + sc_off + col]); cb[i] = modl[(size_t)mr * MODW + sh_off + col]; }
        if (split_ctx) for (int i = tid_; i < 2048; i += 512) cg[i] = ((const float*)(ws + WS_MOD))[(size_t)8 * MODW + 5 * DM + i];
        __syncthreads();
#define NP_ROW(k_, q_) (split_ctx ? bb * TPB + ((3 * (k_) + (q_)) < 8 ? CTXL + 64 * (blk & 31) + 8 * F.wave + 3 * (k_) + (q_) : 8 * (blk & 31) + F.wave) : r0 + 9 * F.wave + 3 * (k_) + (q_))
#pragma unroll 1
        for (int k = 0; k < 3; ++k) {
            f32x4 v[3][8];
#pragma unroll
            for (int q = 0; q < 3; ++q) { const int r = NP_ROW(k, q), w = r - bb * TPB;
                const float* src = from_input ? ((w < CTXL) ? inptr(I_CTX) + ((size_t)bb * CTXL + w) * DM : inptr(I_X) + ((size_t)bb * SEQ + (w - CTXL)) * DM) : H + (size_t)r * DM;
                const GAS f32x4* xr = (const GAS f32x4*)src + lane_;
#pragma unroll
                for (int j = 0; j < 8; ++j) v[q][j] = xr[64 * j]; }
            if (split_ctx && k == 2) {
                const GAS f32x4* sl = (const GAS f32x4*)((const float*)(ws + WS_R1) + ((size_t)bb * 256 + 8 * (blk & 31) + F.wave) * 2048) + lane_;
                const LAS f32x4* gp = (const LAS f32x4*)cg + lane_;
#pragma unroll 1
                for (int s4 = 0; s4 < 4; ++s4) { f32x4 t[8];
#pragma unroll
                    for (int j = 0; j < 8; ++j) t[j] = sl[(size_t)s4 * (8 * 256 * 2048 / 4) + 64 * j];
#pragma unroll
                    for (int j = 0; j < 8; ++j) v[2][j] += gp[64 * j] * t[j]; }
            }
#pragma unroll
            for (int q = 0; q < 3; ++q) { const int r = NP_ROW(k, q), w = r - bb * TPB, slot = (w < CTXL) ? 0 : 1;
                float ss = 0.f;
#pragma unroll
                for (int j = 0; j < 8; ++j) ss += (v[q][j].x * v[q][j].x + v[q][j].y * v[q][j].y) + (v[q][j].z * v[q][j].z + v[q][j].w * v[q][j].w);
                const float rstd = 1.0f / sqrtf(wave_sum(ss) * (1.0f / DM) + EPSN);
                GAS v2u* o8 = (GAS v2u*)(U + (size_t)r * DM) + lane_;
                const LAS f32x4* ap = (const LAS f32x4*)(ca + slot * 2048) + lane_; const LAS f32x4* bp = (const LAS f32x4*)(cb + slot * 2048) + lane_;
#pragma unroll
                for (int j = 0; j < 8; ++j) { f32x4 y = v[q][j] * rstd * ap[64 * j] + bp[64 * j]; if (EMU_DGU && !first) { y.x = pg8::fp8r(y.x); y.y = pg8::fp8r(y.y); y.z = pg8::fp8r(y.z); y.w = pg8::fp8r(y.w); } v2u wv; wv.x = pg8::cvt_pk_bf16(y.x, y.y); wv.y = pg8::cvt_pk_bf16(y.z, y.w); o8[64 * j] = wv; } }
        }
#undef NP_ROW
    }
    __syncthreads();
}

struct PostRow { unsigned cq[3], ckv; float kpe[2], gq[6][2], df[8][2]; };
__device__ __forceinline__ void post_load(const bf16* q, bool lat, int lane, PostRow& R) {
    const GAS unsigned* pc = (const GAS unsigned*)(q + C_CQ);
#pragma unroll
    for (int j = 0; j < 3; ++j) R.cq[j] = pc[lane + 64 * j];
    R.ckv = ((const GAS unsigned*)(q + C_CKV))[lane];
    { const int axis = (lane >> 4) & 1, i = lane & 15; const GAS bf16* pk = (const GAS bf16*)(q + C_KPE + axis * 32); R.kpe[0] = bf1(pk[i]); R.kpe[1] = bf1(pk[16 + i]); }
#pragma unroll
    for (int hh = 0; hh < 6; ++hh) { const int base = (hh < 4) ? (C_GQ + 128 * hh) : (C_GK + 128 * (hh - 4)); const int axis = lane >> 5, i = lane & 31;
        const GAS bf16* pg = (const GAS bf16*)(q + base + axis * 64); R.gq[hh][0] = bf1(pg[i]); R.gq[hh][1] = bf1(pg[32 + i]); }
    if (lat) {
#pragma unroll
        for (int pp = 0; pp < 8; ++pp) { const int blk = 2 * pp + (lane >> 5), axis = (lane >> 4) & 1, i = lane & 15; const int base = (blk < 8) ? (C_DQ + 64 * blk) : (C_DK + 64 * (blk - 8));
            const GAS bf16* pd = (const GAS bf16*)(q + base + axis * 32); R.df[pp][0] = bf1(pd[i]); R.df[pp][1] = bf1(pd[16 + i]); }
    }
}
__device__ __forceinline__ void post_finish(bf16* q, bool lat, int prow, int pcol, int lane, const PostRow& R, const float* g_mq, const float* g_mkv, const float* g_gq, const float* g_gk, const float* rt) {
    { float ss = 0.f;
#pragma unroll
      for (int j = 0; j < 3; ++j) { const float a = bflo(R.cq[j]), b = bfhi(R.cq[j]); ss += a * a + b * b; }
      const float rs = 1.0f / sqrtf(wave_sum(ss) * (1.0f / 384.0f) + EPSN); GAS unsigned* pc = (GAS unsigned*)(q + C_CQ);
#pragma unroll
      for (int j = 0; j < 3; ++j) { const int c = 2 * (lane + 64 * j); pc[lane + 64 * j] = pk2(bflo(R.cq[j]) * rs * g_mq[c], bfhi(R.cq[j]) * rs * g_mq[c + 1]); } }
    { const float a = bflo(R.ckv), b = bfhi(R.ckv); const float rs = 1.0f / sqrtf(wave_sum(a * a + b * b) * (1.0f / 128.0f) + EPSN);
      ((GAS unsigned*)(q + C_CKV))[lane] = pk2(a * rs * g_mkv[2 * lane], b * rs * g_mkv[2 * lane + 1]); }
    if (lat && lane < 32) { const int axis = lane >> 4, i = lane & 15, pos = axis ? pcol : prow; const float c = rt[pos * 16 + i], s = rt[1024 + pos * 16 + i];
      GAS bf16* pk = (GAS bf16*)(q + C_KPE + axis * 32); pk[i] = (bf16)f2bf(R.kpe[0] * c - R.kpe[1] * s); pk[16 + i] = (bf16)f2bf(R.kpe[1] * c + R.kpe[0] * s); }
    { const int axis = lane >> 5, i = lane & 31, pos = axis ? pcol : prow; const float c = rt[2048 + pos * 32 + i], s = rt[4096 + pos * 32 + i];
#pragma unroll
      for (int hh = 0; hh < 6; ++hh) { const int base = (hh < 4) ? (C_GQ + 128 * hh) : (C_GK + 128 * (hh - 4)); const float* gg = (hh < 4) ? g_gq : g_gk;
        const float x1 = R.gq[hh][0], x2 = R.gq[hh][1];
        const float rs = 1.0f / sqrtf(wave_sum(x1 * x1 + x2 * x2) * (1.0f / 128.0f) + EPSN);
        float y1 = x1 * rs * gg[axis * 64 + i], y2 = x2 * rs * gg[axis * 64 + 32 + i];
        if (lat) { const float o1 = y1 * c - y2 * s, o2 = y2 * c + y1 * s; y1 = o1; y2 = o2; }
        GAS bf16* pg = (GAS bf16*)(q + base + axis * 64); pg[i] = (bf16)f2bf(y1); pg[32 + i] = (bf16)f2bf(y2); } }
    if (lat) { const int axis = (lane >> 4) & 1, i = lane & 15, pos = axis ? pcol : prow; const float c = rt[pos * 16 + i], s = rt[1024 + pos * 16 + i];
#pragma unroll
      for (int pp = 0; pp < 8; ++pp) { const int blk = 2 * pp + (lane >> 5); const int base = (blk < 8) ? (C_DQ + 64 * blk) : (C_DK + 64 * (blk - 8));
        GAS bf16* pd = (GAS bf16*)(q + base + axis * 32); pd[i] = (bf16)f2bf(R.df[pp][0] * c - R.df[pp][1] * s); pd[16 + i] = (bf16)f2bf(R.df[pp][1] * c + R.df[pp][0] * s); } }
}
__device__ __forceinline__ void post_pass(Frame& F, int layer) {
    bf16* QKV = (bf16*)(F.ws + WS_QKV); const float* rt = (const float*)(F.ws + WS_ROPE);
    const float* g_mq = inptr(I_MLAGQ) + layer * 384; const float* g_mkv = inptr(I_MLAGKV) + layer * 128;
    const float* g_gq = inptr(I_GQAGQ) + layer * 128; const float* g_gk = inptr(I_GQAGK) + layer * 128;
    const int lane = opq_v((TIDX & 63));
    for (int r = F.gw; r < MT; r += 2 * F.NGW) {
        const int r2 = r + F.NGW; const bool two = r2 < MT;
        const RowInfo ra = row_info(r), rb = row_info(two ? r2 : r);
        bf16* qa = QKV + (size_t)r * INCP; bf16* qb = QKV + (size_t)(two ? r2 : r) * INCP;
        PostRow A, B;
        post_load(qa, !ra.ctx, lane, A); if (two) post_load(qb, !rb.ctx, lane, B);
        post_finish(qa, !ra.ctx, ra.ctx ? 0 : (ra.t >> 6), ra.ctx ? 0 : (ra.t & 63), lane, A, g_mq, g_mkv, g_gq, g_gk, rt);
        if (two) post_finish(qb, !rb.ctx, rb.ctx ? 0 : (rb.t >> 6), rb.ctx ? 0 : (rb.t & 63), lane, B, g_mq, g_mkv, g_gq, g_gk, rt);
    }
}
__device__ __forceinline__ void qm_rope_pass(Frame& F) {
    bf16* QM = (bf16*)(F.ws + WS_QM); const int lane = opq_v((TIDX & 63));
    for (int r = F.gw; r < MT; r += F.NGW) {
        const RowInfo ri = row_info(r); if (ri.ctx) continue;
        const int prow = ri.t >> 6, pcol = ri.t & 63;
#pragma unroll
        for (int pp = 0; pp < 2; ++pp) {
            const int h = 2 * pp + (lane >> 5), axis = (lane >> 4) & 1, i = lane & 15;
            GAS bf16* p = (GAS bf16*)(QM + (size_t)r * QMW + 192 * h + 128 + axis * 32);
            const float x1 = bf1(p[i]), x2 = bf1(p[16 + i]); float c, s; rope_cs(axis ? pcol : prow, i, 1.0f / 16.0f, c, s);
            p[i] = (bf16)f2bf(x1 * c - x2 * s); p[16 + i] = (bf16)f2bf(x2 * c + x1 * s);
        }
    }
}

__device__ __forceinline__ void ffn_tables(Frame& F, int layer, int b, LAS float* ca, LAS float* cb) {
    const float* modl = (const float*)(F.ws + WS_MOD) + (size_t)layer * 9 * MODW + (size_t)b * MODW; const float* g = inptr(I_GFFN) + layer * DM;
    for (int i = TIDX; i < 2048; i += 512) { ca[i] = g[i] * (1.0f + modl[4 * DM + i]); cb[i] = modl[3 * DM + i]; }
}
__device__ __forceinline__ void ffn_u_pair(Frame& F, int r0, int r1, const LAS float* ca, const LAS float* cb, int lane_, f32x4 (&v0)[8], f32x4 (&v1)[8]) {
    const float* H = (const float*)(F.ws + WS_H);
    const GAS f32x4* x0 = (const GAS f32x4*)(H + (size_t)r0 * DM) + lane_; const GAS f32x4* x1 = (const GAS f32x4*)(H + (size_t)r1 * DM) + lane_;
#pragma unroll
    for (int j = 0; j < 8; ++j) { v0[j] = x0[64 * j]; v1[j] = x1[64 * j]; }
    float s0 = 0.f, s1 = 0.f;
#pragma unroll
    for (int j = 0; j < 8; ++j) { s0 += (v0[j].x * v0[j].x + v0[j].y * v0[j].y) + (v0[j].z * v0[j].z + v0[j].w * v0[j].w); s1 += (v1[j].x * v1[j].x + v1[j].y * v1[j].y) + (v1[j].z * v1[j].z + v1[j].w * v1[j].w); }
    const float q0 = 1.0f / sqrtf(wave_sum(s0) * (1.0f / DM) + EPSN), q1 = 1.0f / sqrtf(wave_sum(s1) * (1.0f / DM) + EPSN);
    const LAS f32x4* ap = (const LAS f32x4*)ca + lane_; const LAS f32x4* bp = (const LAS f32x4*)cb + lane_;
#pragma unroll
    for (int j = 0; j < 8; ++j) { const f32x4 a4 = ap[64 * j], b4 = bp[64 * j]; v0[j] = v0[j] * q0 * a4 + b4; v1[j] = v1[j] * q1 * a4 + b4; }
}
__device__ __forceinline__ int moe_tok(int blk, int tl) { return (blk >> 5) * 2048 + (blk & 31) + 32 * tl; }
__device__ __forceinline__ void route_one(const f32x4 (&v)[8], const LAS float* wl, const float* br, int lane_, int& e1o, int& e2o, float& g1o, float& g2o) {
    float lg[8];
#pragma unroll
    for (int e = 0; e < 8; ++e) lg[e] = 0.f;
#pragma unroll
    for (int j = 0; j < 8; ++j) {
        const LAS f32x4* wp = (const LAS f32x4*)(wl + (size_t)(4 * (lane_ + 64 * j)) * 8);
#pragma unroll
        for (int c = 0; c < 4; ++c) { const f32x4 w0 = wp[2 * c], w1 = wp[2 * c + 1]; const float x = v[j][c];
            lg[0] += x * w0.x; lg[1] += x * w0.y; lg[2] += x * w0.z; lg[3] += x * w0.w; lg[4] += x * w1.x; lg[5] += x * w1.y; lg[6] += x * w1.z; lg[7] += x * w1.w; }
    }
#pragma unroll
    for (int e = 0; e < 8; ++e) lg[e] = wave_sum(lg[e]) + br[e];
    int e1 = 0; float v1 = lg[0];
#pragma unroll
    for (int e = 1; e < 8; ++e) if (lg[e] > v1) { v1 = lg[e]; e1 = e; }
    int e2 = -1; float v2 = -3.0e38f;
#pragma unroll
    for (int e = 0; e < 8; ++e) if (e != e1 && lg[e] > v2) { v2 = lg[e]; e2 = e; }
    g2o = 1.0f / (1.0f + expf(v1 - v2)); g1o = 1.0f - g2o; e1o = e1; e2o = e2;
}
__device__ __forceinline__ void moe_route_pass(Frame& F, int layer) {
    const int lane_ = opq_v((TIDX & 63));
    int* rt = (int*)(F.ws + WS_ROUTE); float* rtf = (float*)(F.ws + WS_ROUTE);
    LAS float* ca = (LAS float*)F.lds; LAS float* cb = ca + 2048; LAS float* wl = ca + 4096;
    LAS int* le = (LAS int*)(F.lds + 16384 + 65536);
    const float* wr = inptr(I_MR); const float* br = inptr(I_MB);
    __syncthreads();
    for (int i = TIDX; i < 2048 * 8 / 4; i += 512) ((LAS f32x4*)wl)[i] = ((const GAS f32x4*)wr)[i];
    for (int blk = blockIdx.x; blk < 256; blk += F.G) {
        const int b = blk >> 5;
        __syncthreads();
        ffn_tables(F, layer, b, ca, cb);
        __syncthreads();
#pragma unroll 1
        for (int i = 0; i < 4; ++i) {
            const int tl = F.wave + 16 * i, tl1 = tl + 8, tok = moe_tok(blk, tl), tok1 = moe_tok(blk, tl1);
            f32x4 v0[8], v1[8]; ffn_u_pair(F, b * TPB + CTXL + (tok & 2047), b * TPB + CTXL + (tok1 & 2047), ca, cb, lane_, v0, v1);
            int e1, e2; float g1, g2;
            route_one(v0, wl, br, lane_, e1, e2, g1, g2);
            if (lane_ == 0) { le[tl] = e1 | (e2 << 8); rt[RT_E + tok] = e1 | (e2 << 8); rtf[RT_G + 2 * tok] = g1; rtf[RT_G + 2 * tok + 1] = g2; }
            route_one(v1, wl, br, lane_, e1, e2, g1, g2);
            if (lane_ == 0) { le[tl1] = e1 | (e2 << 8); rt[RT_E + tok1] = e1 | (e2 << 8); rtf[RT_G + 2 * tok1] = g1; rtf[RT_G + 2 * tok1 + 1] = g2; }
        }
        __syncthreads();
        if (TIDX < 8) { const int e = TIDX; int cnt = 0;
            for (int tl = 0; tl < 64; ++tl) { const int w = le[tl], a = w & 255, c = w >> 8;
                if (a == e) rt[RT_RANK + 2 * moe_tok(blk, tl)] = cnt++;
                if (c == e) rt[RT_RANK + 2 * moe_tok(blk, tl) + 1] = cnt++; }
            rt[RT_CNT + blk * 8 + e] = cnt; }
    }
    __syncthreads();
}
__device__ __forceinline__ void moe_tables(Frame& F, LAS int* tab, int blk) {
    const int* rt = (const int*)(F.ws + WS_ROUTE);
    __syncthreads();
    if (TIDX < 8) { const int e = TIDX; int tot = 0, before = 0;
        for (int k = 0; k < 256; ++k) { const int c = rt[RT_CNT + k * 8 + e]; tot += c; before += (k < blk) ? c : 0; }
        tab[e] = tot; tab[16 + e] = before; }
    __syncthreads();
    if (TIDX == 0) { int base = 0, pan = 0, nf = 0, nr = 0;
        for (int e = 0; e < 8; ++e) { tab[8 + e] = base; const int np = (tab[e] + 255) >> 8, fu = tab[e] >> 8; base += np * 256; pan += np; tab[32 + e] = pan;
            tab[48 + e] = nr; nf += fu; tab[40 + e] = nf; if (np != fu) { tab[64 + nr] = e; ++nr; } }
        tab[24] = pan; tab[56] = nf; tab[57] = nr; }
    __syncthreads();
}
__device__ __forceinline__ void moe_scatter_pass(Frame& F, int layer) {
    const int lane_ = opq_v((TIDX & 63));
    int* rt = (int*)(F.ws + WS_ROUTE); bf16* AS = (bf16*)(F.ws + WS_AS);
    LAS int* tab = (LAS int*)(F.lds + 16384); LAS float* ca = (LAS float*)F.lds; LAS float* cb = ca + 2048;
    for (int blk = blockIdx.x; blk < 256; blk += F.G) {
        const int b = blk >> 5;
        moe_tables(F, tab, blk);
        ffn_tables(F, layer, b, ca, cb);
        __syncthreads();
#pragma unroll 1
        for (int i = 0; i < 4; ++i) {
            const int tl = F.wave + 16 * i, tok = moe_tok(blk, tl), tok1 = moe_tok(blk, tl + 8);
            f32x4 v0[8], v1[8]; ffn_u_pair(F, b * TPB + CTXL + (tok & 2047), b * TPB + CTXL + (tok1 & 2047), ca, cb, lane_, v0, v1);
#pragma unroll
            for (int s = 0; s < 2; ++s) {
                const int tk = s ? tok1 : tok; const int w = rt[RT_E + tk], e1 = w & 255, e2 = w >> 8;
                const int p1 = tab[8 + e1] + tab[16 + e1] + rt[RT_RANK + 2 * tk], p2 = tab[8 + e2] + tab[16 + e2] + rt[RT_RANK + 2 * tk + 1];
                if (lane_ == 0) { rt[RT_POS + 2 * tk] = p1; rt[RT_POS + 2 * tk + 1] = p2; }
                if (MOE_FP8) {
                    GAS unsigned* q1 = (GAS unsigned*)((unsigned char*)AS + (size_t)p1 * DM) + lane_; GAS unsigned* q2 = (GAS unsigned*)((unsigned char*)AS + (size_t)p2 * DM) + lane_;
#pragma unroll
                    for (int j = 0; j < 8; ++j) { const f32x4 y = s ? v1[j] : v0[j]; const unsigned x = pg8::pk4_fp8(y.x, y.y, y.z, y.w); q1[64 * j] = x; q2[64 * j] = x; }
                    continue; }
                GAS v2u* o1 = (GAS v2u*)(AS + (size_t)p1 * DM) + lane_; GAS v2u* o2 = (GAS v2u*)(AS + (size_t)p2 * DM) + lane_;
#pragma unroll
                for (int j = 0; j < 8; ++j) { f32x4 y = s ? v1[j] : v0[j]; if (EMU_FP8) { y.x = pg8::fp8r(y.x); y.y = pg8::fp8r(y.y); y.z = pg8::fp8r(y.z); y.w = pg8::fp8r(y.w); } v2u x; x.x = pg8::cvt_pk_bf16(y.x, y.y); x.y = pg8::cvt_pk_bf16(y.z, y.w); o1[64 * j] = x; o2[64 * j] = x; }
            }
        }
        for (int e = 0; e < 8; ++e) { const int tot = tab[e], end = (tot + 255) & ~255;
            for (int pr = tot + blk * 8 + F.wave; pr < end; pr += 2048) {
                if (MOE_FP8) { GAS unsigned* o = (GAS unsigned*)((unsigned char*)AS + (size_t)(tab[8 + e] + pr) * DM) + lane_;
#pragma unroll
                    for (int j = 0; j < 8; ++j) o[64 * j] = 0u; continue; }
                GAS v2u* o = (GAS v2u*)(AS + (size_t)(tab[8 + e] + pr) * DM) + lane_;
#pragma unroll
                for (int j = 0; j < 8; ++j) o[64 * j] = (v2u){0u, 0u}; } }
    }
    __syncthreads();
}
__device__ __forceinline__ void final_pass(Frame& F, int layer) {
    const int lane_ = opq_v((TIDX & 63));
    const int* rt = (const int*)(F.ws + WS_ROUTE); const float* rtf = (const float*)(F.ws + WS_ROUTE);
    const bf16* Y = (const bf16*)(F.ws + WS_Y); const float* H = (const float*)(F.ws + WS_H); const float* SL = (const float*)(F.ws + WS_U);
    const float* modl = (const float*)(F.ws + WS_MOD) + (size_t)layer * 9 * MODW;
    LAS int* tab = (LAS int*)(F.lds);
    moe_tables(F, tab, 0);
    for (int tok = F.gw; tok < NBATCH * SEQ; tok += F.NGW) {
        const int b = tok >> 11, t = tok & 2047, r = b * TPB + CTXL + t;
        const int ee = rt[RT_E + tok]; const float g1 = rtf[RT_G + 2 * tok], g2 = rtf[RT_G + 2 * tok + 1];
        const GAS f32x4* xr = (const GAS f32x4*)(H + (size_t)r * DM) + lane_;
        const GAS f32x4* gt = (const GAS f32x4*)(modl + (size_t)b * MODW + 5 * DM) + lane_;
        f32x4 y[8], v[8];
#pragma unroll
        for (int j = 0; j < 8; ++j) { y[j] = (f32x4){0.f, 0.f, 0.f, 0.f}; v[j] = xr[64 * j]; }
#pragma unroll 1
        for (int s = 0; s < 2; ++s) {
            const int e = s ? (ee >> 8) : (ee & 255), p = rt[RT_POS + 2 * tok + s]; const float g = s ? g2 : g1;
            const int loc = p - tab[8 + e], fu = tab[e] >> 8;
            if (loc < 256 * fu) {
                const GAS v2u* yp = (const GAS v2u*)(Y + (size_t)p * DM) + lane_;
#pragma unroll
                for (int j = 0; j < 8; ++j) { const v2u a = yp[64 * j]; y[j] += (f32x4){bflo(a.x), bfhi(a.x), bflo(a.y), bfhi(a.y)} * g; }
            } else {
                const int rr = tab[48 + e], row = loc - 256 * fu;
#pragma unroll
                for (int ks = 0; ks < 4; ++ks) { const GAS f32x4* sp = (const GAS f32x4*)(SL + ((size_t)(ks * 8 + rr) * 256 + row) * DM) + lane_;
#pragma unroll
                    for (int j = 0; j < 8; ++j) y[j] += sp[64 * j] * g; }
            }
        }
        float ss = 0.f;
#pragma unroll
        for (int j = 0; j < 8; ++j) { v[j] = v[j] + gt[64 * j] * y[j]; ss += (v[j].x * v[j].x + v[j].y * v[j].y) + (v[j].z * v[j].z + v[j].w * v[j].w); }
        const float rstd = 1.0f / sqrtf(wave_sum(ss) * (1.0f / DM) + EPSN);
        const GAS f32x4* gf = (const GAS f32x4*)inptr(I_GFIN) + lane_;
        GAS f32x4* op = (GAS f32x4*)(F.out + (size_t)tok * DM) + lane_;
#pragma unroll
        for (int j = 0; j < 8; ++j) op[64 * j] = v[j] * rstd * gf[64 * j];
    }
}

namespace fa {
using bf16x8 = __attribute__((ext_vector_type(8))) short;
using s16x4  = __attribute__((ext_vector_type(4))) short;
using f32x16 = __attribute__((ext_vector_type(16))) float;
using u32x4  = __attribute__((ext_vector_type(4))) unsigned;
constexpr int SHM_V = 64 * 128 * 2;
constexpr float THRN = 8.f;
#define FA_SBAR() __builtin_amdgcn_sched_barrier(0)
__device__ __forceinline__ int kswz(int row, int colB, int pitch) { return row * pitch + (colB ^ ((row & 7) << 4)); }
__device__ __forceinline__ int crow(int r, int hi) { return (r & 3) + 8 * (r >> 2) + 4 * hi; }
__device__ __forceinline__ unsigned cvtpk(float lo, float hi) { unsigned r; asm volatile("v_cvt_pk_bf16_f32 %0, %1, %2" : "=v"(r) : "v"(lo), "v"(hi)); return r; }

__device__ __forceinline__ void partialSM(f32x16& p0, f32x16& p1, float& m_reg, float& mn, float& alpha, const float C, const float thr_raw) {
  float pmax = p0[0];
#pragma unroll
  for (int r = 1; r < 16; ++r) pmax = fmaxf(pmax, p0[r]);
#pragma unroll
  for (int r = 0; r < 16; ++r) pmax = fmaxf(pmax, p1[r]);
  { auto rr = __builtin_amdgcn_permlane32_swap(__float_as_uint(pmax), __float_as_uint(pmax), false, false);
    pmax = fmaxf(__uint_as_float(rr[0]), __uint_as_float(rr[1])); }
  if (__builtin_expect(__all(pmax - m_reg <= thr_raw), 1)) { mn = m_reg; alpha = 1.f; }
  else { mn = fmaxf(m_reg, pmax); alpha = __builtin_amdgcn_exp2f((m_reg - mn) * C); m_reg = mn; }
  const float mnC = -mn * C;
#pragma unroll
  for (int r = 0; r < 16; ++r) p0[r] = fmaf(p0[r], C, mnC);
#pragma unroll
  for (int r = 0; r < 16; ++r) p1[r] = fmaf(p1[r], C, mnC);
#pragma unroll
  for (int r = 0; r < 16; ++r) p0[r] = __builtin_amdgcn_exp2f(p0[r]);
}
__device__ __forceinline__ void finishSM(f32x16& p0, f32x16& p1, float alpha, float& l_reg, bf16x8& pa0, bf16x8& pa1, bf16x8& pa2, bf16x8& pa3) {
#pragma unroll
  for (int r = 0; r < 16; ++r) p1[r] = __builtin_amdgcn_exp2f(p1[r]);
  float ps = 0;
#pragma unroll
  for (int r = 0; r < 16; ++r) ps += p0[r];
#pragma unroll
  for (int r = 0; r < 16; ++r) ps += p1[r];
  { auto rr = __builtin_amdgcn_permlane32_swap(__float_as_uint(ps), __float_as_uint(ps), false, false);
    ps = __uint_as_float(rr[0]) + __uint_as_float(rr[1]); }
  l_reg = l_reg * alpha + ps;
#define FA_PK4(P, BASE, OUT) do { unsigned a0 = cvtpk(P[BASE + 0], P[BASE + 1]), a1 = cvtpk(P[BASE + 2], P[BASE + 3]);   \
    unsigned b0 = cvtpk(P[BASE + 4], P[BASE + 5]), b1 = cvtpk(P[BASE + 6], P[BASE + 7]);                              \
    auto r0 = __builtin_amdgcn_permlane32_swap(a0, b0, false, false); auto r1 = __builtin_amdgcn_permlane32_swap(a1, b1, false, false); \
    u32x4 w = {r0[0], r1[0], r0[1], r1[1]}; OUT = __builtin_bit_cast(bf16x8, w); } while (0)
  FA_PK4(p0, 0, pa0); FA_PK4(p0, 8, pa1); FA_PK4(p1, 0, pa2); FA_PK4(p1, 8, pa3);
#undef FA_PK4
}
template <int DK>
__device__ __forceinline__ void qkt(f32x16& p0, f32x16& p1, const LAS unsigned char* Ks, const bf16x8 (&qr)[DK / 16], int r32, int hi) {
  p0 = f32x16{}; p1 = f32x16{};
#pragma unroll
  for (int d0 = 0; d0 < DK / 16; ++d0) { const int cb = (d0 * 16 + hi * 8) * 2;
    const bf16x8 b0 = *(const LAS bf16x8*)(Ks + kswz(r32, cb, DK * 2));
    const bf16x8 b1 = *(const LAS bf16x8*)(Ks + kswz(32 + r32, cb, DK * 2));
    p0 = __builtin_amdgcn_mfma_f32_32x32x16_bf16(b0, qr[d0], p0, 0, 0, 0);
    p1 = __builtin_amdgcn_mfma_f32_32x32x16_bf16(b1, qr[d0], p1, 0, 0, 0); }
}
__device__ __forceinline__ int v_st(int k, int c) { const int kk = (k & ~0xC) | ((k & 4) << 1) | ((k & 8) >> 1); return ((kk >> 3) * 4 + (c >> 5)) * 512 + ((kk & 7) * 32 + (c & 31)) * 2; }
__device__ __forceinline__ int v_rd_base(int lane) { return ((lane & 3) << 3) | (((lane >> 2) & 3) << 6) | (((lane >> 4) & 1) << 5) | (((lane >> 5) & 1) << 8); }
constexpr int v_rd_off(int d0, int ks, int half) { return d0 * 512 + ks * 4096 + half * 2048; }
template <int OFF> __device__ __forceinline__ s16x4 tr_read(int vb) {
  s16x4 r; asm volatile("ds_read_b64_tr_b16 %0, %1 offset:%2" : "=&v"(r) : "v"(vb), "i"(OFF) : "memory"); return r;
}
template <int D0> __device__ __forceinline__ void pv_one(f32x16& od, int vb, bf16x8 pa0, bf16x8 pa1, bf16x8 pa2, bf16x8 pa3) {
  const s16x4 l0 = tr_read<v_rd_off(D0, 0, 0)>(vb), h0 = tr_read<v_rd_off(D0, 0, 1)>(vb), l1 = tr_read<v_rd_off(D0, 1, 0)>(vb), h1 = tr_read<v_rd_off(D0, 1, 1)>(vb);
  const s16x4 l2 = tr_read<v_rd_off(D0, 2, 0)>(vb), h2 = tr_read<v_rd_off(D0, 2, 1)>(vb), l3 = tr_read<v_rd_off(D0, 3, 0)>(vb), h3 = tr_read<v_rd_off(D0, 3, 1)>(vb);
  asm volatile("s_waitcnt lgkmcnt(0)" ::: "memory"); FA_SBAR();
#define FA_PK(L, H) (bf16x8){L[0], L[1], L[2], L[3], H[0], H[1], H[2], H[3]}
  od = __builtin_amdgcn_mfma_f32_32x32x16_bf16(pa0, FA_PK(l0, h0), od, 0, 0, 0);
  od = __builtin_amdgcn_mfma_f32_32x32x16_bf16(pa1, FA_PK(l1, h1), od, 0, 0, 0);
  od = __builtin_amdgcn_mfma_f32_32x32x16_bf16(pa2, FA_PK(l2, h2), od, 0, 0, 0);
  od = __builtin_amdgcn_mfma_f32_32x32x16_bf16(pa3, FA_PK(l3, h3), od, 0, 0, 0);
#undef FA_PK
}
__device__ __forceinline__ void pv_d0(f32x16 (&o)[4], int vb, bf16x8 pa0, bf16x8 pa1, bf16x8 pa2, bf16x8 pa3) {
  pv_one<0>(o[0], vb, pa0, pa1, pa2, pa3); pv_one<1>(o[1], vb, pa0, pa1, pa2, pa3); pv_one<2>(o[2], vb, pa0, pa1, pa2, pa3); pv_one<3>(o[3], vb, pa0, pa1, pa2, pa3);
}

struct TileMap { int k0, lat0, r_lo; bool na;
  __device__ __forceinline__ int row(int j) const { if (!na || j < 4) return k0 + 64 * j; const int g = min(r_lo + j - 4, 31); return lat0 + 64 * g; } };
struct NaLane { int qr, qc, rs, cs; const LAS float* btab; };

__device__ __forceinline__ void na_mask(f32x16& p0, f32x16& p1, int j, const TileMap& tm, const NaLane& nl, int hi) {
  if (j < 4) return;
  const int kr = tm.r_lo + j - 4; const bool rowok = (kr >= nl.rs) && (kr < nl.rs + 8);
  const int b0 = (kr - nl.qr + 7) * 31 + 15 - nl.qc;
#pragma unroll
  for (int r = 0; r < 16; ++r) {
    const int kc0 = crow(r, hi), kc1 = 32 + kc0;
    const bool ok0 = rowok && (kc0 >= nl.cs) && (kc0 < nl.cs + 16), ok1 = rowok && (kc1 >= nl.cs) && (kc1 < nl.cs + 16);
    float bv0 = 0.f, bv1 = 0.f; if (ok0) bv0 = nl.btab[b0 + kc0]; if (ok1) bv1 = nl.btab[b0 + kc1];
    p0[r] = ok0 ? p0[r] + bv0 : -1e30f; p1[r] = ok1 ? p1[r] + bv1 : -1e30f;
  }
}

template <int DK, int SDEPTH, bool NA>
__device__ __forceinline__ void body(const bf16* Qb, int ldq, const bf16* Kp, int ldk, const bf16* Vp, int ldv, const TileMap tm, const int NT, const float scale,
                                     const NaLane nl, LAS unsigned char* lds, f32x16 (&o)[4]) {
  constexpr int KP = DK / 64, SHM_K = 64 * DK * 2, KCH = DK / 8;
  int tid = threadIdx.x; asm volatile("" : "+v"(tid));
  const int wid = tid >> 6, lane = tid & 63, r32 = lane & 31, hi = lane >> 5;
  LAS unsigned char* V_lds = lds; LAS unsigned char* K_lds = lds + 2 * SHM_V;
  LAS float* wsl = (LAS float*)(lds + 2 * SHM_V + 2 * SHM_K) + wid * 64; LAS float* li_l = wsl; LAS float* al_l = wsl + 32;
  const float C = scale * 1.4426950408889634f, thr_raw = THRN / scale;
  float m_reg = -1e30f, l_reg = 0;
#pragma unroll
  for (int d = 0; d < 4; ++d) o[d] = f32x16{};
  bf16x8 qr[DK / 16];
  { const bf16* Qw = Qb + (long)(wid * 32 + r32) * ldq + hi * 8;
#pragma unroll
    for (int d0 = 0; d0 < DK / 16; ++d0) qr[d0] = *(const GAS bf16x8*)(Qw + d0 * 16); }
  const int sr = tid >> 4, sc = (tid & 15) * 8, vst0 = v_st(sr, sc), vst1 = v_st(32 + sr, sc);
  int krow[KP], kcol[KP], kst[KP];
#pragma unroll
  for (int i = 0; i < KP; ++i) { const int c = tid + 512 * i; krow[i] = c / KCH; kcol[i] = (c % KCH) * 8; kst[i] = kswz(krow[i], kcol[i] * 2, DK * 2); }
  const int vb0 = (int)(unsigned)(unsigned long)(V_lds) + v_rd_base(lane);
  struct Slot { bf16x8 vs0, vs1, ks[KP]; } sl[SDEPTH];
#define FA_SLOAD(i, j) do { const int r0_ = tm.row(j); sl[i].vs0 = *(const GAS bf16x8*)(Vp + (long)(r0_ + sr) * ldv + sc); sl[i].vs1 = *(const GAS bf16x8*)(Vp + (long)(r0_ + 32 + sr) * ldv + sc); \
    _Pragma("unroll") for (int q_ = 0; q_ < KP; ++q_) sl[i].ks[q_] = *(const GAS bf16x8*)(Kp + (long)(r0_ + krow[q_]) * ldk + kcol[q_]); } while (0)
#define FA_SWRITE(b, i) do { *(LAS bf16x8*)(V_lds + (b) * SHM_V + vst0) = sl[i].vs0; *(LAS bf16x8*)(V_lds + (b) * SHM_V + vst1) = sl[i].vs1; \
    _Pragma("unroll") for (int q_ = 0; q_ < KP; ++q_) *(LAS bf16x8*)(K_lds + (b) * SHM_K + kst[q_]) = sl[i].ks[q_]; } while (0)
#define FA_SWAIT() do { if constexpr (SDEPTH == 2) asm volatile("s_waitcnt vmcnt(%0)" :: "n"(2 + KP) : "memory"); else asm volatile("s_waitcnt vmcnt(0)" ::: "memory"); } while (0)
#define FA_RESC(a) do { if (__any((a) < 1.f)) { if (hi == 0) al_l[r32] = (a); asm volatile("s_waitcnt lgkmcnt(0)" ::: "memory"); \
    _Pragma("unroll") for (int d = 0; d < 4; ++d) _Pragma("unroll") for (int r = 0; r < 16; ++r) o[d][r] *= al_l[crow(r, hi)]; } } while (0)
#define FA_QKT(P0, P1, buf, j) do { qkt<DK>(P0, P1, K_lds + (buf) * SHM_K, qr, r32, hi); if constexpr (NA) na_mask(P0, P1, j, tm, nl, hi); } while (0)
  f32x16 pA0, pA1, pB0, pB1; float mnA, mnB, alA, alB; bf16x8 pa0, pa1, pa2, pa3;
  constexpr int SE = 0, SO = SDEPTH - 1;
  FA_SLOAD(SE, 0); asm volatile("s_waitcnt vmcnt(0)" ::: "memory"); FA_SWRITE(0, SE); __syncthreads();
  FA_QKT(pA0, pA1, 0, 0); partialSM(pA0, pA1, m_reg, mnA, alA, C, thr_raw);
  FA_SLOAD(SO, 1); if constexpr (SDEPTH == 2) { if (2 < NT) FA_SLOAD(SE, 2); }
  FA_SWAIT(); FA_SWRITE(1, SO); __syncthreads();
  for (int j = 1; j + 1 < NT; j += 2) {
    FA_SBAR(); FA_QKT(pB0, pB1, 1, j);
    finishSM(pA0, pA1, alA, l_reg, pa0, pa1, pa2, pa3); FA_SBAR();
    FA_SLOAD(SO, j + SDEPTH); FA_SBAR();
    pv_d0(o, vb0, pa0, pa1, pa2, pa3); partialSM(pB0, pB1, m_reg, mnB, alB, C, thr_raw);
    __syncthreads(); FA_SWAIT(); FA_SWRITE(0, SE);
    FA_RESC(alB); __syncthreads();
    FA_SBAR(); FA_QKT(pA0, pA1, 0, j + 1);
    finishSM(pB0, pB1, alB, l_reg, pa0, pa1, pa2, pa3); FA_SBAR();
    if (SDEPTH == 1 || j + 3 < NT) FA_SLOAD(SE, j + 1 + SDEPTH); FA_SBAR();
    pv_d0(o, vb0 + SHM_V, pa0, pa1, pa2, pa3); partialSM(pA0, pA1, m_reg, mnA, alA, C, thr_raw);
    __syncthreads(); FA_SWAIT(); FA_SWRITE(1, SO);
    FA_RESC(alA); __syncthreads();
  }
  FA_SBAR(); FA_QKT(pB0, pB1, 1, NT - 1);
  finishSM(pA0, pA1, alA, l_reg, pa0, pa1, pa2, pa3); FA_SBAR();
  pv_d0(o, vb0, pa0, pa1, pa2, pa3); partialSM(pB0, pB1, m_reg, mnB, alB, C, thr_raw);
  __syncthreads(); FA_RESC(alB);
  finishSM(pB0, pB1, alB, l_reg, pa0, pa1, pa2, pa3); FA_SBAR();
  pv_d0(o, vb0 + SHM_V, pa0, pa1, pa2, pa3);
  if (hi == 0) li_l[r32] = l_reg; asm volatile("s_waitcnt lgkmcnt(0)" ::: "memory");
#pragma unroll
  for (int r = 0; r < 16; ++r) { const float rl = __builtin_amdgcn_rcpf(li_l[crow(r, hi)]);
#pragma unroll
    for (int d0 = 0; d0 < 4; ++d0) o[d0][r] *= rl; }
#undef FA_SLOAD
#undef FA_SWRITE
#undef FA_SWAIT
#undef FA_RESC
#undef FA_QKT
}

template <int DK, bool NA>
__device__ __forceinline__ void body_seq(const bf16* Qb, int ldq, const bf16* Kp, int ldk, const bf16* Vp, int ldv, const TileMap tm, const int NT, const float scale,
                                         const NaLane nl, LAS unsigned char* lds, f32x16 (&o)[4]) {
  constexpr int KP = DK / 64, SHM_K = 64 * DK * 2, KCH = DK / 8;
  int tid = threadIdx.x; asm volatile("" : "+v"(tid));
  const int wid = tid >> 6, lane = tid & 63, r32 = lane & 31, hi = lane >> 5;
  LAS unsigned char* V_lds = lds; LAS unsigned char* K_lds = lds + 2 * SHM_V;
  LAS float* wsl = (LAS float*)(lds + 2 * SHM_V + 2 * SHM_K) + wid * 64; LAS float* li_l = wsl; LAS float* al_l = wsl + 32;
  const float C = scale * 1.4426950408889634f, thr_raw = THRN / scale;
  float m_reg = -1e30f, l_reg = 0;
#pragma unroll
  for (int d = 0; d < 4; ++d) o[d] = f32x16{};
  bf16x8 qr[DK / 16];
  { const bf16* Qw = Qb + (long)(wid * 32 + r32) * ldq + hi * 8;
#pragma unroll
    for (int d0 = 0; d0 < DK / 16; ++d0) qr[d0] = *(const GAS bf16x8*)(Qw + d0 * 16); }
  const int sr = tid >> 4, sc = (tid & 15) * 8, vst0 = v_st(sr, sc), vst1 = v_st(32 + sr, sc);
  int krow[KP], kcol[KP], kst[KP];
#pragma unroll
  for (int i = 0; i < KP; ++i) { const int c = tid + 512 * i; krow[i] = c / KCH; kcol[i] = (c % KCH) * 8; kst[i] = kswz(krow[i], kcol[i] * 2, DK * 2); }
  const int vb0 = (int)(unsigned)(unsigned long)(V_lds) + v_rd_base(lane);
  bf16x8 vs0, vs1, ks[KP];
#define FS_SLOAD(j) do { const int r0_ = tm.row(j); vs0 = *(const GAS bf16x8*)(Vp + (long)(r0_ + sr) * ldv + sc); vs1 = *(const GAS bf16x8*)(Vp + (long)(r0_ + 32 + sr) * ldv + sc); \
    _Pragma("unroll") for (int q_ = 0; q_ < KP; ++q_) ks[q_] = *(const GAS bf16x8*)(Kp + (long)(r0_ + krow[q_]) * ldk + kcol[q_]); } while (0)
#define FS_SWRITE(b) do { *(LAS bf16x8*)(V_lds + (b) * SHM_V + vst0) = vs0; *(LAS bf16x8*)(V_lds + (b) * SHM_V + vst1) = vs1; \
    _Pragma("unroll") for (int q_ = 0; q_ < KP; ++q_) *(LAS bf16x8*)(K_lds + (b) * SHM_K + kst[q_]) = ks[q_]; } while (0)
  FS_SLOAD(0); FS_SWRITE(0); __syncthreads();
#pragma unroll 1
  for (int j = 0; j < NT; ++j) {
    const int b = j & 1;
    if (j + 1 < NT) FS_SLOAD(j + 1);
    f32x16 p0, p1; float mn, al; bf16x8 pa0, pa1, pa2, pa3;
    qkt<DK>(p0, p1, K_lds + b * SHM_K, qr, r32, hi);
    if constexpr (NA) na_mask(p0, p1, j, tm, nl, hi);
    partialSM(p0, p1, m_reg, mn, al, C, thr_raw);
    finishSM(p0, p1, al, l_reg, pa0, pa1, pa2, pa3);
    if (__any(al < 1.f)) { if (hi == 0) al_l[r32] = al; asm volatile("s_waitcnt lgkmcnt(0)" ::: "memory");
#pragma unroll
      for (int d = 0; d < 4; ++d)
#pragma unroll
        for (int r = 0; r < 16; ++r) o[d][r] *= al_l[crow(r, hi)]; }
    FA_SBAR();
    pv_d0(o, vb0 + b * SHM_V, pa0, pa1, pa2, pa3);
    if (j + 1 < NT) FS_SWRITE(b ^ 1);
    __syncthreads();
  }
  if (hi == 0) li_l[r32] = l_reg; asm volatile("s_waitcnt lgkmcnt(0)" ::: "memory");
#pragma unroll
  for (int r = 0; r < 16; ++r) { const float rl = __builtin_amdgcn_rcpf(li_l[crow(r, hi)]);
#pragma unroll
    for (int d0 = 0; d0 < 4; ++d0) o[d0][r] *= rl; }
#undef FS_SLOAD
#undef FS_SWRITE
}
}

__device__ __forceinline__ void fa_store(const fa::f32x16 (&o)[4], LAS unsigned char* lds, bf16* Orow0  , bool do_norm, const float* gsub, float post) {
    int tid = threadIdx.x; asm volatile("" : "+v"(tid));
    const int wid = tid >> 6, lane = tid & 63, r32 = lane & 31, hi = lane >> 5;
    LAS float* slab = (LAS float*)(lds + wid * 16384);
    __syncthreads();
#pragma unroll
    for (int r = 0; r < 16; ++r) { const int row = fa::crow(r, hi);
#pragma unroll
        for (int d0 = 0; d0 < 4; ++d0) slab[row * 128 + d0 * 32 + r32] = o[d0][r]; }
    LDS_WAIT();
    const int row = lane >> 1, half = lane & 1;
    const LAS f32x4* src = (const LAS f32x4*)(slab + row * 128 + half * 64);
    f32x4 v[16]; float ss = 0.f;
#pragma unroll
    for (int c = 0; c < 16; ++c) { v[c] = src[c]; ss += (v[c].x * v[c].x + v[c].y * v[c].y) + (v[c].z * v[c].z + v[c].w * v[c].w); }
    float sc = 1.0f;
    if (do_norm) { ss += __shfl_xor(ss, 1); sc = post / sqrtf(ss * (1.0f / 128.0f) + EPSN);
#pragma unroll
        for (int c = 0; c < 16; ++c) v[c] = v[c] * *(const GAS f32x4*)(gsub + half * 64 + 4 * c); }
    GAS v4u* dst = (GAS v4u*)(Orow0 + (size_t)(wid * 32 + row) * DM + half * 64);
#pragma unroll
    for (int c = 0; c < 8; ++c) { const f32x4 a = v[2 * c] * sc, b = v[2 * c + 1] * sc; v4u w; w.x = pk2(a.x, a.y); w.y = pk2(a.z, a.w); w.z = pk2(b.x, b.y); w.w = pk2(b.z, b.w); dst[c] = w; }
    __syncthreads();
}

__device__ __forceinline__ void attn_unit_fa(Frame& F, int layer, int b, bool latent, int qb, int type, int h) {
    unsigned char* ws = F.ws;
    const bf16* QKV = (const bf16*)(ws + WS_QKV); const bf16* QM = (const bf16*)(ws + WS_QM); const bf16* KVM = (const bf16*)(ws + WS_KVM); bf16* O = (bf16*)(ws + WS_O);
    const int q0 = b * TPB + (latent ? CTXL + qb * 256 : 0);
    const int kall0 = b * TPB, ntall = latent ? TPB / 64 : CTXL / 64;
    bf16* orow0 = O + (size_t)q0 * DM + type * 512 + h * 128;
    fa::TileMap tm; tm.k0 = kall0; tm.lat0 = kall0 + CTXL; tm.r_lo = 0; tm.na = false;
    fa::NaLane nl; nl.qr = 0; nl.qc = 0; nl.rs = 0; nl.cs = 0; nl.btab = nullptr;
    fa::f32x16 o[4];
#ifdef FA_ONLY
    type = FA_ONLY; if (FA_ONLY != 4) latent = FA_ONLY != 0 ? latent : false; else { type = 0; latent = true; }
#endif
    if (type == 0 && latent) {
        const int r_lo = min(max(4 * qb - 4, 0), 24), r_hi = min(max(4 * qb + 3 - 4, 0), 24) + 8;
        tm.na = true; tm.r_lo = r_lo; int nt = 4 + (r_hi - r_lo); nt += nt & 1;
        LAS float* bt = (LAS float*)(F.lds + 100 * 1024);
        const float* bsrc = inptr(I_NABIAS) + ((size_t)layer * 4 + h) * 465;
        __syncthreads();
        for (int i = TIDX; i < 465; i += 512) bt[i] = bsrc[i] * (1.0f / SC_NA);
        __syncthreads();
        const int t = qb * 256 + (TIDX >> 6) * 32 + (TIDX & 31);
        nl.qr = t >> 6; nl.qc = t & 63; nl.rs = min(max(nl.qr - 4, 0), 24); nl.cs = min(max(nl.qc - 8, 0), 48); nl.btab = bt;
        fa::body_seq<128, true>(QKV + (size_t)q0 * INCP + C_NAQ + 128 * h, INCP, QKV + C_NAK + 128 * h, INCP, QKV + C_NAV + 128 * h, INCP, tm, nt, SC_NA, nl, F.lds, o);
        fa_store(o, F.lds, orow0, false, nullptr, 1.0f);
    } else if (type == 0 || type == 2) {
        const int qc = (type == 0) ? C_NAQ + 128 * h : C_GQ + 128 * h, kc = (type == 0) ? C_NAK + 128 * h : C_GK + 128 * (h >> 1), vc = (type == 0) ? C_NAV + 128 * h : C_GV + 128 * (h >> 1);
        fa::body<128, 2, false>(QKV + (size_t)q0 * INCP + qc, INCP, QKV + kc, INCP, QKV + vc, INCP, tm, ntall, SC_NA, nl, F.lds, o);
        fa_store(o, F.lds, orow0, false, nullptr, 1.0f);
    } else if (type == 1) {
        fa::body_seq<192, false>(QM + (size_t)q0 * QMW + 192 * h, QMW, KVM + 320 * h, KVW, KVM + 320 * h + 192, KVW, tm, ntall, SC_MLA, nl, F.lds, o);
        fa_store(o, F.lds, orow0, false, nullptr, 1.0f);
    } else {
        const float lam_init = layer == 0 ? 0.2f : 0.35550906759096926f;
        LAS float* lm = (LAS float*)(F.lds + 100 * 1024);
        __syncthreads();
        if (TIDX < 64) { const float a = wave_sum(inptr(I_LQ1)[layer * 64 + TIDX] * inptr(I_LK1)[layer * 64 + TIDX]), c = wave_sum(inptr(I_LQ2)[layer * 64 + TIDX] * inptr(I_LK2)[layer * 64 + TIDX]);
            if (TIDX == 0) lm[0] = expf(a) - expf(c) + lam_init; }
        __syncthreads();
        const float lam = lm[0];
        GAS f32x4* stash = (GAS f32x4*)((float*)(ws + WS_U) + ((size_t)blockIdx.x * 512 + TIDX) * 64);
#pragma unroll 1
        for (int pass = 0; pass < 2; ++pass) {
            fa::body<64, 2, false>(QKV + (size_t)q0 * INCP + C_DQ + 128 * h + 64 * pass, INCP, QKV + C_DK + 128 * h + 64 * pass, INCP, QKV + C_DV + 128 * h, INCP, tm, ntall, SC_DIFF, nl, F.lds, o);
            if (pass == 0) {
#pragma unroll
                for (int d0 = 0; d0 < 4; ++d0)
#pragma unroll
                    for (int r4 = 0; r4 < 4; ++r4) stash[d0 * 4 + r4] = (f32x4){o[d0][4 * r4], o[d0][4 * r4 + 1], o[d0][4 * r4 + 2], o[d0][4 * r4 + 3]};
                __syncthreads();
            }
        }
#pragma unroll
        for (int d0 = 0; d0 < 4; ++d0)
#pragma unroll
            for (int r4 = 0; r4 < 4; ++r4) { const f32x4 s1 = stash[d0 * 4 + r4];
#pragma unroll
                for (int q = 0; q < 4; ++q) o[d0][4 * r4 + q] = s1[q] - lam * o[d0][4 * r4 + q]; }
        fa_store(o, F.lds, orow0, true, inptr(I_GSUB) + layer * 128, 1.0f - lam_init);
    }
}
#ifndef ATTN_Q0
#define ATTN_Q0 0
#endif
#ifndef ATTN_Q1
#define ATTN_Q1 0
#endif
__device__ __forceinline__ void attn_phase_fa(Frame& F, int layer) {
    const int total = 1024 + ((layer == 0) ? 128 : 0);
#pragma unroll 1
    for (int n = blockIdx.x; n < total; n += F.G) {
        int type, h, qb, b; bool latent = n < 1024;
        if (latent) { const int i = n >> 8, k = n & 255, idx = i * 64 + (k >> 2); type = (k + i) & 3; h = idx & 3; qb = (idx >> 2) & 7; b = idx >> 5; }
        else { const int v = n - 1024, hh = v & 15; type = hh >> 2; h = hh & 3; qb = 0; b = v >> 4; }
        attn_unit_fa(F, layer, b, latent, qb, type, h);
        if (ATTN_Q0 + ATTN_Q1 > 0) filler_quota(F, layer == 0 ? ATTN_Q0 : ATTN_Q1);
    }
    __syncthreads();
}

#ifndef REP_GEMM
#define REP_GEMM 1
#endif
#ifndef REP_WIN
#define REP_WIN REP_GEMM
#endif
#ifndef REP_FGU
#define REP_FGU REP_GEMM
#endif
#ifndef REP_PASS
#define REP_PASS 1
#endif
#ifndef WO_WGM
#define WO_WGM 4
#endif
#ifndef REV_DOWN
#define REV_DOWN 1
#endif
#ifndef FD_WGM
#define FD_WGM 4
#endif
#ifndef PROBE_HOTB
#define PROBE_HOTB 0
#endif
#ifndef PROBE_LATE_DENSE
#define PROBE_LATE_DENSE 0
#endif
#ifndef REP_FDN
#define REP_FDN REP_GEMM
#endif
#ifndef REP_MGU
#define REP_MGU REP_GEMM
#endif
#ifndef REP_MDN
#define REP_MDN REP_GEMM
#endif
#ifndef REP_ATTN
#define REP_ATTN 1
#endif
#ifndef REP_P0
#define REP_P0 1
#endif
#ifndef MK_MULTI
#define MK_MULTI 0
#endif
constexpr int PH_PER_LAYER = 11, N_PHASES = 1 + 2 * PH_PER_LAYER + 1;
struct Args { const float* in[31]; float* out; unsigned char* ws; int ph_lo, ph_hi; };
static_assert(sizeof(Args) == 31 * 8 + 8 + 8 + 8, "Args has no padding");

#define IN(k) (lo <= (k) && (k) < hi)
#if MK_MULTI
#define SEAM(k) do { } while (0)
#else
#define SEAM(k) do { if (IN(k) && IN((k) + 1)) xcd_barrier(bar); } while (0)
#endif
#ifndef FILL_BAR
#define FILL_BAR 1
#endif
#if MK_MULTI || !FILL_BAR
#define SEAM_FILL(k) SEAM(k)
#define TAIL_FILL(slot) filler(F, slot, -1)
#else
#define SEAM_FILL(k) do { if (IN(k) && IN((k) + 1)) xcd_barrier_fill(bar, F); } while (0)
#define TAIL_FILL(slot) do { } while (0)
#endif
__device__ __forceinline__ int opq_s(int v) { asm volatile("" : "+s"(v)); return v; }
template <int layer>
__device__ __forceinline__ void layer_phases(Frame& F, const XcdBarrier& bar, const int lo, const int hi, LAS int* mtab) {
    unsigned char* ws = F.ws; asm volatile("" : "+s"(ws));
        const int pb = 1 + layer * PH_PER_LAYER;
        const float* modl = (const float*)(ws + WS_MOD) + (size_t)layer * 9 * MODW;
#ifndef SKIP_NORM
        if (IN(pb + 0)) for (int rp_ = 0; rp_ < REP_PASS; ++rp_) norm_pass(F, layer, true, layer == 0, layer == 1);
#endif
        SEAM_FILL(pb + 0);
        if (IN(pb + 1)) {
            pg8::Gemm g{(const bf16*)(ws + WS_U), (const bf16*)(ws + WS_WIN) + (size_t)layer * INCP * 2048, MT, INCP, 2048, 2048, 2048};
            pg8::StaticOrder S; S.init(MT, INCP, F.G, opq_s((int)blockIdx.x));
            pg8::EpiBf16P E{(bf16*)(ws + WS_QKV), INCP, 0};
            for (int rep_ = 0; rep_ < REP_WIN; ++rep_) { pg8::gemm_phase<pg8::EpiBf16P, pg8::StaticOrder, PG8_ALIGN, PG8_SP2>(F.lds + RING_OFF, g, S, E); if (rep_ + 1 < REP_WIN) __syncthreads(); }
            TAIL_FILL(layer * 8 + 0);
        }
        SEAM_FILL(pb + 1);
#ifndef SKIP_POST
        if (IN(pb + 2)) post_pass(F, layer);
#endif
        SEAM_FILL(pb + 2);
#ifndef SKIP_UP
        if (IN(pb + 3)) {
            { pg8::Gemm g{(const bf16*)(ws + WS_QKV) + C_CQ, (const bf16*)(ws + WS_WQUP) + (size_t)layer * QMW * 384, MT, QMW, opq_s(384), INCP, 384};
              pg8::StaticOrder S; S.init(MT, QMW, F.G, opq_s((int)blockIdx.x));
              pg8::EpiQupRope E{(bf16*)(ws + WS_QM), (const float*)(ws + WS_ROPE)};
              for (int rep_ = 0; rep_ < REP_GEMM; ++rep_) { pg8::gemm_phase<pg8::EpiQupRope, pg8::StaticOrder, PG8_ALIGN, PG8_SP2>(F.lds + RING_OFF, g, S, E); if (rep_ + 1 < REP_GEMM) __syncthreads(); } }
            __syncthreads();
            { pg8::Gemm g{(const bf16*)(ws + WS_QKV) + C_CKV, (const bf16*)(ws + WS_WKVUP) + (size_t)layer * KVW * 256, MT, KVW, opq_s(256), INCP, 256};
              pg8::StaticOrder S; S.init(MT, KVW, F.G, opq_s((int)blockIdx.x));
              pg8::EpiBf16P E{(bf16*)(ws + WS_KVM), KVW, 0};
              for (int rep_ = 0; rep_ < REP_GEMM; ++rep_) { pg8::gemm_phase<pg8::EpiBf16P, pg8::StaticOrder, PG8_ALIGN, PG8_SP2>(F.lds + RING_OFF, g, S, E); if (rep_ + 1 < REP_GEMM) __syncthreads(); } }
            TAIL_FILL(layer * 8 + 1);
        }
#endif
        SEAM_FILL(pb + 3);
        #ifndef SKIP_ATTN
        if (IN(pb + 5)) {
#pragma unroll
            for (int rep_ = 0; rep_ < REP_ATTN; ++rep_) attn_phase_fa(F, layer);
            TAIL_FILL(layer * 8 + 2); }
#endif
        SEAM_FILL(pb + 5);
#ifndef SKIP_WOUT
        if (IN(pb + 6)) {
            pg8::Gemm g{(const bf16*)(ws + WS_O), (const bf16*)(ws + WS_WOUT) + (size_t)layer * 2048 * 2048, MT, 2048, 2048, 2048, 2048};
            pg8::EpiResGate E{(float*)(ws + WS_H), modl + 2 * DM, layer == 0 ? inptr(I_X) : nullptr, layer == 0 ? inptr(I_CTX) : nullptr};
            pg8::EpiResGate Ed{(float*)(ws + WS_R2), modl + 2 * DM, nullptr, nullptr}; (void)Ed;
            if constexpr (layer == 0) { pg8::StaticOrder S; S.init(MT, 2048, F.G, opq_s((int)blockIdx.x), WO_WGM); for (int rep_ = 1; rep_ < REP_GEMM; ++rep_) { pg8::gemm_phase<pg8::EpiResGate, pg8::StaticOrder, PG8_ALIGN, PG8_SP2>(F.lds + RING_OFF, g, S, Ed); __syncthreads(); } pg8::gemm_phase<pg8::EpiResGate, pg8::StaticOrder, PG8_ALIGN, PG8_SP2>(F.lds + RING_OFF, g, S, E); }
            else { pg8::LatentOrder S; S.init(NBATCH * SEQ, 2048, F.G, opq_s((int)blockIdx.x), WO_WGM); for (int rep_ = 1; rep_ < REP_GEMM; ++rep_) { pg8::gemm_phase<pg8::EpiResGate, pg8::LatentOrder, PG8_ALIGN, PG8_SP2>(F.lds + RING_OFF, g, S, Ed); __syncthreads(); } pg8::gemm_phase<pg8::EpiResGate, pg8::LatentOrder, PG8_ALIGN, PG8_SP2>(F.lds + RING_OFF, g, S, E); }            TAIL_FILL(layer * 8 + 3);
        }
#endif
        SEAM_FILL(pb + 6);
        if constexpr (layer == 0) {
#ifndef SKIP_DENSE
            if (IN(pb + 7)) { for (int rp_ = 0; rp_ < REP_PASS; ++rp_) norm_pass(F, layer, false, false); filler(F, layer * 8 + 6, CVQ_FFN_END); }
            SEAM_FILL(pb + 7);
            if (IN(pb + 9)) {
                pg8::Gemm g{(const bf16*)(ws + WS_U), (const bf16*)(ws + WS_WGU), MT, 2 * DFF, 2048, 2048, 2048};
                pg8::StaticOrder S; S.init(MT, 2 * DFF, F.G, opq_s((int)blockIdx.x));
                pg8::EpiSwiGLU E{(bf16*)(ws + WS_HM), DFF, 0};
                for (int rep_ = 0; rep_ < REP_FGU; ++rep_) { pg8::gemm_phase<pg8::EpiSwiGLU, pg8::StaticOrder, PG8_ALIGN, PG8_SP2>(F.lds + RING_OFF, g, S, E); if (rep_ + 1 < REP_FGU) __syncthreads(); }                TAIL_FILL(layer * 8 + 4);
            }
            SEAM_FILL(pb + 9);
            if (IN(pb + 10)) {
                pg8::Gemm g{(const bf16*)(ws + WS_HM), (const bf16*)(ws + WS_WD), MT, 2048, DFF, DFF, DFF, 0, 0, REV_DOWN};
                pg8::LatentOrder S; S.init(NBATCH * SEQ, 2048, F.G, opq_s((int)blockIdx.x), FD_WGM);
                pg8::EpiResGate E{(float*)(ws + WS_H), modl + 5 * DM, nullptr, nullptr};
                pg8::gemm_phase<pg8::EpiResGate, pg8::LatentOrder, PG8_ALIGN, PG8_SP2>(F.lds + RING_OFF, g, S, E);
                __syncthreads();
                { pg8::Gemm g2{(const bf16*)(ws + WS_HM), (const bf16*)(ws + WS_WD), MT, 2048, opq_s(1408), DFF, DFF, 0, 0, REV_DOWN};
                  pg8::CtxRemOrder S2; S2.G = F.G; S2.c = opq_s((int)blockIdx.x);
                  pg8::EpiSlab E2{(float*)(ws + WS_R1), 1.0f, 1408};
                  pg8::gemm_phase<pg8::EpiSlab, pg8::CtxRemOrder, PG8_ALIGN, PG8_SP2>(F.lds + RING_OFF, g2, S2, E2); }
                TAIL_FILL(layer * 8 + 5);
            }
            SEAM_FILL(pb + 10);
#endif
        } else {
#ifndef SKIP_MOE
            if (IN(pb + 7)) for (int rp_ = 0; rp_ < REP_PASS; ++rp_) moe_route_pass(F, layer);
            SEAM_FILL(pb + 7);
            if (IN(pb + 8)) { for (int rp_ = 0; rp_ < REP_PASS; ++rp_) moe_scatter_pass(F, layer); filler(F, layer * 8 + 6, CVQ_N); }
            SEAM(pb + 8);
            if (IN(pb + 9)) {
#if PROBE_LATE_DENSE
                {
                    pg8::Gemm gd{(const bf16*)(ws + WS_U), (const bf16*)(ws + WS_WGU), MT, 2 * DFF, 2048, 2048, 2048};
                    pg8::StaticOrder Sd; Sd.init(MT, 2 * DFF, F.G, opq_s((int)blockIdx.x));
                    pg8::EpiSwiGLU Ed{(bf16*)(ws + WS_R1), DFF, 0};
                    pg8::gemm_phase<pg8::EpiSwiGLU, pg8::StaticOrder, PG8_ALIGN, PG8_SP2>(F.lds + RING_OFF, gd, Sd, Ed);
                    __syncthreads();
                }
#endif
                moe_tables(F, mtab, 0);
                pg8::Gemm g{(const bf16*)(ws + WS_AS), (const bf16*)(ws + WS_MGU), 0, 2 * DFE, 2048, 2048, 2048, 0, KT_MOE};
                pg8::MoeOrder S; S.init(__builtin_amdgcn_readfirstlane(mtab[24]) * 256, 2 * DFE, F.G, opq_s((int)blockIdx.x));
                S.tab = mtab;
                pg8::EpiSwiGLU E{(bf16*)(ws + WS_HM2), DFE, 2 * DFE / 256, MOE_FP8 ? 1.0f / pg8::MOE_WSCALE : 1.0f};
                for (int rep_ = 0; rep_ < REP_MGU; ++rep_) { pg8::gemm_phase<pg8::EpiSwiGLU, pg8::MoeOrder, PG8_ALIGN, PG8_SP2, (MOE_FP8 != 0)>(F.lds + RING_OFF, g, S, E); if (rep_ + 1 < REP_MGU) __syncthreads(); }
            }
            SEAM(pb + 9);
            if (IN(pb + 10)) {
                moe_tables(F, mtab, 0);
                pg8::Gemm g{(const bf16*)(ws + WS_HM2), (const bf16*)(ws + WS_MD), 0, 2048, DFE, DFE, DFE, KT_MOE, KT_MOE, REV_DOWN};
#define RFL(i) __builtin_amdgcn_readfirstlane(mtab[i])
                { pg8::MoeFullOrder S; S.init(RFL(56) * 256, 2048, F.G, opq_s((int)blockIdx.x));
                  S.tab = mtab;
                  pg8::EpiBf16P E{(bf16*)(ws + WS_Y), 2048, 8, MOE_FP8 ? 1.0f / pg8::MOE_WSCALE : 1.0f};
                  for (int rep_ = 0; rep_ < REP_MDN; ++rep_) { pg8::gemm_phase<pg8::EpiBf16P, pg8::MoeFullOrder, PG8_ALIGN, PG8_SP2, (MOE_FP8 != 0)>(F.lds + RING_OFF, g, S, E); if (rep_ + 1 < REP_MDN) __syncthreads(); } }
                __syncthreads();
                { pg8::Gemm g2{(const bf16*)(ws + WS_HM2), (const bf16*)(ws + WS_MD), 0, 2048, opq_s(1792), DFE, DFE, KT_MOE, KT_MOE, REV_DOWN};
                  pg8::MoeRemOrder S; S.nsub = RFL(57) * 32; S.G = F.G; S.c = opq_s((int)blockIdx.x); S.tab = mtab;
                  pg8::EpiSlab E{(float*)(ws + WS_U), MOE_FP8 ? 1.0f / pg8::MOE_WSCALE : 1.0f};
                  pg8::gemm_phase<pg8::EpiSlab, pg8::MoeRemOrder, PG8_ALIGN, PG8_SP2, (MOE_FP8 != 0)>(F.lds + RING_OFF, g2, S, E); }
#undef RFL
            }
            SEAM(pb + 10);
#endif
        }
}

__global__ void __launch_bounds__(NWAVES * 64, 2) fwd_kernel(Args args) {
    extern __shared__ __attribute__((aligned(16))) unsigned char lds[];
    Frame F;
    F.lds = (LAS unsigned char*)lds;
    F.MISC = (volatile LAS unsigned*)(F.lds + MISC_OFF);
    F.wave = __builtin_amdgcn_readfirstlane((int)threadIdx.x >> 6);
    F.G = gridDim.x; F.gw = blockIdx.x * NWAVES + F.wave; F.NGW = F.G * NWAVES;
    F.out = args.out; F.ws = args.ws; F.ctl = (gu32*)(args.ws + WS_CTL);
    unsigned char* ws = args.ws;
    for (int u = TIDX; u < (LDS_BYTES - LDSCTL_OFF) / 4; u += NWAVES * 64) ((LAS unsigned*)(F.lds + LDSCTL_OFF))[u] = 0u;
    __syncthreads();
    XcdBarrier bar; bar.bar = (unsigned*)(F.ctl + CW_BAR); bar.x = 0; bar.st = nullptr;
#if !MK_MULTI
    bar = xcd_barrier_post((unsigned*)(F.ctl + CW_BAR), F.MISC + 8);
#endif
    const int lo = args.ph_lo, hi = args.ph_hi;
    LAS int* mtab = (LAS int*)(F.lds + LDSCTL_OFF + 1024);

    #ifndef SKIP_P0
    if (IN(0)) {
#pragma unroll
        for (int rep_ = 0; rep_ < REP_P0; ++rep_) p0_prologue(F); }
#endif
    SEAM_FILL(0);

    layer_phases<0>(F, bar, lo, hi, mtab);
    layer_phases<1>(F, bar, lo, hi, mtab);
#ifndef SKIP_FINAL
    if (IN(N_PHASES - 1)) for (int rp_ = 0; rp_ < REP_PASS; ++rp_) final_pass(F, 1);
#endif
#undef IN
#undef SEAM
}

extern "C" void kernel_launch(void* const* d_in, const int* in_sizes, int n_in, void* d_out, int out_size, void* d_ws, size_t ws_size, hipStream_t stream) {
    static int grid = 0;
    if (grid == 0) {
        if (n_in != 31 || in_sizes[0] != NBATCH * SEQ * DM || out_size != NBATCH * SEQ * DM || ws_size < WS_END) {
            fprintf(stderr, "kernel_launch: unexpected shapes (n_in %d, in0 %d, out %d, ws %zu, need %zu); nothing launched\n", n_in, n_in > 0 ? in_sizes[0] : -1, out_size, ws_size, (size_t)WS_END); grid = -1; return; }
        int dev = 0, cus = 0, per_cu = 0;
        if (hipGetDevice(&dev) != hipSuccess || hipDeviceGetAttribute(&cus, hipDeviceAttributeMultiprocessorCount, dev) != hipSuccess) { fprintf(stderr, "kernel_launch: device query failed\n"); grid = -1; return; }
        if (hipFuncSetAttribute((const void*)fwd_kernel, hipFuncAttributeMaxDynamicSharedMemorySize, LDS_BYTES) != hipSuccess) { fprintf(stderr, "kernel_launch: hipFuncSetAttribute failed\n"); grid = -1; return; }
        if (hipOccupancyMaxActiveBlocksPerMultiprocessor(&per_cu, (const void*)fwd_kernel, NWAVES * 64, LDS_BYTES) != hipSuccess || per_cu < 1)
            fprintf(stderr, "kernel_launch: note: occupancy query reports %d workgroups per CU\n", per_cu);
        (void)hipGetLastError();
        grid = cus < 256 ? cus : 256;
    }
    if (grid < 0) return;
    if (hipMemsetAsync((char*)d_ws + WS_CTL, 0, CTL_ZERO_BYTES, stream) != hipSuccess) { fprintf(stderr, "kernel_launch: memset failed\n"); return; }
    Args a{};
    for (int i = 0; i < 31; ++i) a.in[i] = (const float*)d_in[i];
    a.out = (float*)d_out; a.ws = (unsigned char*)d_ws;
#if MK_MULTI
    for (int p = 0; p < N_PHASES; ++p) {
        if (p == 1 + 8) continue;
        a.ph_lo = p; a.ph_hi = p + 1;
        hipLaunchKernelGGL(fwd_kernel, dim3(grid), dim3(NWAVES * 64), LDS_BYTES, stream, a);
    }
#else
    a.ph_lo = 0; a.ph_hi = N_PHASES;
    hipLaunchKernelGGL(fwd_kernel, dim3(grid), dim3(NWAVES * 64), LDS_BYTES, stream, a);
#endif
    const hipError_t le = hipPeekAtLastError();
    if (le != hipSuccess) fprintf(stderr, "kernel_launch: launch failed: %s\n", hipGetErrorName(le));
}
```

```cpp
#include <hip/hip_runtime.h>
#include <cstdio>
#include <cstdint>
namespace pg8 {
#define PG8_LAS __attribute__((address_space(3)))
typedef unsigned short bf16_t;
typedef short bf16x8 __attribute__((ext_vector_type(8)));
typedef float f32x4 __attribute__((ext_vector_type(4)));
typedef unsigned u32x4 __attribute__((ext_vector_type(4)));
typedef int v8i32 __attribute__((ext_vector_type(8)));
constexpr int BM = 256, BK = 64, HALF = 128, HTB = HALF * BK * 2  , STAGE_BYTES = 8 * HTB, NXCD = 8, WGM = 8;

__host__ __device__ __forceinline__ int lds_byte(int r, int c) { const int st = (r >> 4) * 2 + (c >> 5), rr = r & 15, cc = c & 31, ob = rr * 64 + cc * 2; return st * 1024 + (ob ^ (((ob >> 9) & 1) << 5)); }
__host__ __device__ __forceinline__ void stage_rc(int b, int& R, int& C) { const int st = b / 1024, sb = b % 1024, swz = sb ^ (((sb >> 9) & 1) << 5); R = (st >> 1) * 16 + swz / 64; C = (st & 1) * 32 + (swz % 64) / 2; }
__host__ __device__ __forceinline__ int perm32(int rho) { const int n = rho >> 4, i = rho & 15; return 8 * (i >> 2) + 4 * n + (i & 3); }

struct Unit { int pm, pn, ko = 0, aux = 0; };
struct Gemm { const bf16_t* A; const bf16_t* Bt; int M, N, K, lda, ldb; int ktA = 0, ktB = 0, rev = 0; };

struct StaticOrder {
    static constexpr bool NTB = false;
    int nM, nN, nwg, G, c, wgm;
    __host__ __device__ void init(int M, int N, int G_, int c_, int wgm_ = WGM) { nM = M / BM; nN = N / BM; nwg = nM * nN; G = G_; c = c_; wgm = wgm_; }
    __host__ __device__ bool next(int i, Unit& u) const {
        const long L = (long)i * G + c; if (L >= nwg) return false;
        int wgid = (int)L; { const int q = nwg / NXCD, r = nwg % NXCD, xcd = wgid % NXCD, off = wgid / NXCD; wgid = (xcd < r ? xcd * (q + 1) : r * (q + 1) + (xcd - r) * q) + off; }
        const int nig = wgm * nN, gid = wgid / nig, fm = gid * wgm, gsz = (nM - fm) < wgm ? (nM - fm) : wgm;
        u.pm = fm + ((wgid % nig) % gsz); u.pn = (wgid % nig) / gsz; return true;
    }
    __device__ __forceinline__ void a_ready(const Unit&) const {}
    __device__ __forceinline__ void done(const Unit&) const {}
};

__device__ __forceinline__ unsigned cvt_pk_bf16(float lo, float hi) { unsigned r; asm volatile("v_cvt_pk_bf16_f32 %0, %1, %2" : "=v"(r) : "v"(lo), "v"(hi)); return r; }
typedef float f32x2 __attribute__((ext_vector_type(2)));
__device__ __forceinline__ void mfma_e4m3(f32x4& acc, const v8i32& a, const v8i32& b, int one) {
    asm volatile("v_mfma_scale_f32_16x16x128_f8f6f4 %0, %1, %2, %0, %3, %3 op_sel_hi:[0,0,0]" : "+v"(acc) : "v"(a), "v"(b), "v"(one));
}
template <class Epi, class Sched, bool ALIGN_EPI = false, bool SP2 = false, bool FP8 = false>
__device__ __forceinline__ void gemm_phase(PG8_LAS unsigned char* lds, const Gemm g, const Sched& S, const Epi& E) {
    int tid_ = threadIdx.x; asm volatile("" : "+v"(tid_));
    const int tid = tid_, wid = __builtin_amdgcn_readfirstlane(tid >> 6), lane = tid & 63, wr = wid >> 2, wc = wid & 3, fr = lane & 15, fq = lane >> 4;
    constexpr int ES = FP8 ? 1 : 2, KE = FP8 ? 128 : 64;
    const int K = g.K, nt = K / KE;
    unsigned voffA[2], voffB[2];
#pragma unroll
    for (int i = 0; i < 2; ++i) { int R, C; stage_rc(tid * 16 + i * 8192, R, C); const int Rb = Epi::PERM ? ((R & ~31) + perm32(R & 31)) : R;
        voffA[i] = (unsigned)(R * (g.ktA ? 128 : g.lda * ES) + C * 2); voffB[i] = (unsigned)(Rb * (g.ktB ? 128 : g.ldb * ES) + C * 2); }
    const long kabsA = g.ktA ? 32768 : (BK * 2), kabsB = g.ktB ? 32768 : (BK * 2);
    const long kstepA = g.rev ? -kabsA : kabsA, kstepB = g.rev ? -kabsB : kabsB;
    const long kfirstA = g.rev ? (long)(nt - 1) * kabsA : 0, kfirstB = g.rev ? (long)(nt - 1) * kabsB : 0;
    const size_t hstepA = g.ktA ? (size_t)16384 : (size_t)HALF * g.lda * ES, hstepB = g.ktB ? (size_t)16384 : (size_t)HALF * g.ldb * ES;
    const size_t tstepA = (size_t)BM * g.lda * ES, tstepB = (size_t)BM * g.ldb * ES;
    const unsigned ldsw = (unsigned)wid * 1024u;
    const int fcol = FP8 ? ((fq >> 1) * 32 + (fq & 1) * 16) : fq * 8;
    const int aoff = lds_byte(wr * 64 + fr, fcol), boff = lds_byte(wc * 32 + fr, fcol);
#define PG8_SA(b, h) (((b) * 2 + (h)) * HTB)
#define PG8_SB(b, h) ((4 + (b) * 2 + (h)) * HTB)
#define PG8_STAGE(bufoff, gbase, voff) do { _Pragma("unroll") for (int _i = 0; _i < 2; ++_i) { \
        if constexpr (FP8) { unsigned vo_ = (voff)[_i]; asm volatile("" : "+v"(vo_));   \
            __builtin_amdgcn_global_load_lds((const unsigned*)((const char*)(gbase) + vo_), (PG8_LAS unsigned*)(lds + (bufoff) + ldsw + _i * 8192), 16, 0, 0); } else \
        if constexpr (Sched::NTB && (bufoff) >= 4 * HTB) __builtin_amdgcn_global_load_lds((const unsigned*)((const char*)(gbase) + (voff)[_i]), (PG8_LAS unsigned*)(lds + (bufoff) + ldsw + _i * 8192), 16, 0, 2); \
        else __builtin_amdgcn_global_load_lds((const unsigned*)((const char*)(gbase) + (voff)[_i]), (PG8_LAS unsigned*)(lds + (bufoff) + ldsw + _i * 8192), 16, 0, 0); } } while (0)
#define PG8_LDA(dst, b, h) do { if constexpr (FP8) { _Pragma("unroll") for (int m = 0; m < 4; ++m) { const PG8_LAS unsigned char* p_ = lds + PG8_SA(b, h) + aoff + m * 2048; \
        const u32x4 lo_ = *(const PG8_LAS u32x4*)p_, hi_ = *(const PG8_LAS u32x4*)(p_ + 16); dst##8[m] = (v8i32){(int)lo_.x, (int)lo_.y, (int)lo_.z, (int)lo_.w, (int)hi_.x, (int)hi_.y, (int)hi_.z, (int)hi_.w}; } } \
    else { _Pragma("unroll") for (int m = 0; m < 4; ++m) _Pragma("unroll") for (int k = 0; k < 2; ++k) dst[m][k] = *(const PG8_LAS bf16x8*)(lds + PG8_SA(b, h) + aoff + m * 2048 + k * 1024); } } while (0)
#define PG8_LDB(dst, b, h) do { if constexpr (FP8) { _Pragma("unroll") for (int n = 0; n < 2; ++n) { const PG8_LAS unsigned char* p_ = lds + PG8_SB(b, h) + boff + n * 2048; \
        const u32x4 lo_ = *(const PG8_LAS u32x4*)p_, hi_ = *(const PG8_LAS u32x4*)(p_ + 16); dst##8[n] = (v8i32){(int)lo_.x, (int)lo_.y, (int)lo_.z, (int)lo_.w, (int)hi_.x, (int)hi_.y, (int)hi_.z, (int)hi_.w}; } } \
    else { _Pragma("unroll") for (int n = 0; n < 2; ++n) _Pragma("unroll") for (int k = 0; k < 2; ++k) dst[n][k] = *(const PG8_LAS bf16x8*)(lds + PG8_SB(b, h) + boff + n * 2048 + k * 1024); } } while (0)
#define PG8_MMA(ai, bj, At, Bt) do { __builtin_amdgcn_s_setprio(1); if constexpr (FP8) { _Pragma("unroll") for (int m = 0; m < 4; ++m) _Pragma("unroll") for (int n = 0; n < 2; ++n) \
        mfma_e4m3(acc[ai][bj][m][n], Bt##8[n], At##8[m], one8); } \
    else { _Pragma("unroll") for (int m = 0; m < 4; ++m) _Pragma("unroll") for (int n = 0; n < 2; ++n) _Pragma("unroll") for (int k = 0; k < 2; ++k) \
        acc[ai][bj][m][n] = __builtin_amdgcn_mfma_f32_16x16x32_bf16(Bt[n][k], At[m][k], acc[ai][bj][m][n], 0, 0, 0); } __builtin_amdgcn_s_setprio(0); } while (0)
#define PG8_WAIT_V(n) asm volatile("s_waitcnt vmcnt(" #n ")" ::: "memory")
#define PG8_WAIT_L(n) asm volatile("s_waitcnt lgkmcnt(" #n ")" ::: "memory")
#define PG8_BAR __builtin_amdgcn_s_barrier()
#define PG8_SCHED __builtin_amdgcn_sched_barrier(0)
    Unit cur, nxt; int ui = 0;
    if (!S.next(0, cur)) return;
    f32x4 acc[2][2][4][2];
#pragma unroll
    for (int a = 0; a < 2; ++a)
#pragma unroll
        for (int b = 0; b < 2; ++b)
#pragma unroll
            for (int m = 0; m < 4; ++m)
#pragma unroll
                for (int n = 0; n < 2; ++n) acc[a][b][m][n] = (f32x4){0.f, 0.f, 0.f, 0.f};
    int one8 = 0x7F7F7F7F; asm volatile("" : "+v"(one8));
    bf16x8 At[4][2], B0[2][2], B1[2][2]; v8i32 At8[4], B08[2], B18[2];
    const char* cA = (const char*)g.A + (size_t)cur.pm * tstepA + (g.ktA ? (size_t)(cur.ko / KE) * 32768 : (size_t)cur.ko * ES) + kfirstA; const char* cB = (const char*)g.Bt + (size_t)cur.pn * tstepB + (g.ktB ? (size_t)(cur.ko / KE) * 32768 : (size_t)cur.ko * ES) + kfirstB;
    S.a_ready(cur);
    if constexpr (SP2) {
        PG8_STAGE(PG8_SB(0, 0), cB, voffB); PG8_STAGE(PG8_SB(0, 1), cB + hstepB, voffB); PG8_STAGE(PG8_SA(0, 0), cA, voffA); PG8_STAGE(PG8_SA(0, 1), cA + hstepA, voffA);
        if (wr == 1) PG8_BAR;
        PG8_WAIT_V(2); PG8_BAR;
        PG8_STAGE(PG8_SB(1, 0), cB + kstepB, voffB); PG8_STAGE(PG8_SA(1, 0), cA + kstepA, voffA); PG8_STAGE(PG8_SB(1, 1), cB + hstepB + kstepB, voffB);
        PG8_WAIT_V(6); PG8_BAR;
    } else {
        PG8_STAGE(PG8_SB(0, 0), cB, voffB); PG8_STAGE(PG8_SA(0, 0), cA, voffA); PG8_STAGE(PG8_SB(0, 1), cB + hstepB, voffB); PG8_STAGE(PG8_SA(0, 1), cA + hstepA, voffA);
        if (wr == 1) PG8_BAR;
        PG8_WAIT_V(4); PG8_BAR;
        PG8_STAGE(PG8_SB(1, 0), cB + kstepB, voffB); PG8_STAGE(PG8_SA(1, 0), cA + kstepA, voffA); PG8_STAGE(PG8_SB(1, 1), cB + hstepB + kstepB, voffB);
        PG8_WAIT_V(6); PG8_BAR;
    }
    for (;;) {
        const bool has_next = S.next(ui + 1, nxt);
        const char* nA = has_next ? (const char*)g.A + (size_t)nxt.pm * tstepA + (g.ktA ? (size_t)(nxt.ko / KE) * 32768 : (size_t)nxt.ko * ES) + kfirstA : cA; const char* nB = has_next ? (const char*)g.Bt + (size_t)nxt.pn * tstepB + (g.ktB ? (size_t)(nxt.ko / KE) * 32768 : (size_t)nxt.ko * ES) + kfirstB : cB;
        for (int t = 0; t < nt; t += 2) {
            const bool last = (t == nt - 2);
            const char* a1 = cA + (long)(t + 1) * kstepA;
            const char* a2 = last ? nA : cA + (long)(t + 2) * kstepA; const char* b2 = last ? nB : cB + (long)(t + 2) * kstepB;
            const char* a3 = a2 + kstepA; const char* b3 = b2 + kstepB;
            if (last && has_next) S.a_ready(nxt);
            if constexpr (SP2) {
            PG8_LDB(B0, 0, 0); PG8_LDB(B1, 0, 1); PG8_SCHED; PG8_LDA(At, 0, 0); PG8_STAGE(PG8_SA(1, 1), a1 + hstepA, voffA);
            PG8_WAIT_V(8); PG8_WAIT_L(0); PG8_BAR; PG8_MMA(0, 0, At, B0); PG8_MMA(0, 1, At, B1); PG8_BAR; PG8_SCHED;
            PG8_LDA(At, 0, 1); PG8_STAGE(PG8_SB(0, 0), b2, voffB); PG8_STAGE(PG8_SB(0, 1), b2 + hstepB, voffB); PG8_STAGE(PG8_SA(0, 0), a2, voffA);
            PG8_WAIT_V(8); PG8_WAIT_L(0); PG8_BAR; PG8_MMA(1, 0, At, B0); PG8_MMA(1, 1, At, B1); PG8_BAR; PG8_SCHED;
            PG8_LDB(B0, 1, 0); PG8_LDB(B1, 1, 1); PG8_SCHED; PG8_LDA(At, 1, 0); PG8_STAGE(PG8_SA(0, 1), a2 + hstepA, voffA);
            PG8_WAIT_V(8); PG8_WAIT_L(0); PG8_BAR; PG8_MMA(0, 0, At, B0); PG8_MMA(0, 1, At, B1); PG8_BAR; PG8_SCHED;
            PG8_LDA(At, 1, 1); PG8_STAGE(PG8_SB(1, 0), b3, voffB); PG8_STAGE(PG8_SB(1, 1), b3 + hstepB, voffB); PG8_STAGE(PG8_SA(1, 0), a3, voffA);
            PG8_WAIT_V(8); PG8_WAIT_L(0); PG8_BAR; PG8_MMA(1, 0, At, B0); PG8_MMA(1, 1, At, B1); PG8_BAR; PG8_SCHED;
            } else {
            PG8_LDB(B0, 0, 0); PG8_SCHED; PG8_LDA(At, 0, 0); PG8_STAGE(PG8_SA(1, 1), a1 + hstepA, voffA);
            PG8_WAIT_L(8); PG8_BAR; PG8_WAIT_L(0); PG8_MMA(0, 0, At, B0); PG8_BAR; PG8_SCHED;
            PG8_LDB(B1, 0, 1); PG8_STAGE(PG8_SB(0, 0), b2, voffB);
            PG8_BAR; PG8_WAIT_L(0); PG8_MMA(0, 1, At, B1); PG8_BAR;
            PG8_LDA(At, 0, 1); PG8_STAGE(PG8_SA(0, 0), a2, voffA);
            PG8_BAR; PG8_WAIT_L(0); PG8_MMA(1, 0, At, B0); PG8_BAR; PG8_SCHED;
            PG8_STAGE(PG8_SB(0, 1), b2 + hstepB, voffB);
            PG8_WAIT_V(6); PG8_BAR; PG8_MMA(1, 1, At, B1); PG8_BAR;
            PG8_LDB(B0, 1, 0); PG8_SCHED; PG8_LDA(At, 1, 0); PG8_STAGE(PG8_SA(0, 1), a2 + hstepA, voffA);
            PG8_WAIT_L(8); PG8_BAR; PG8_WAIT_L(0); PG8_MMA(0, 0, At, B0); PG8_BAR; PG8_SCHED;
            PG8_LDB(B1, 1, 1); PG8_STAGE(PG8_SB(1, 0), b3, voffB);
            PG8_BAR; PG8_WAIT_L(0); PG8_MMA(0, 1, At, B1); PG8_BAR;
            PG8_LDA(At, 1, 1); PG8_STAGE(PG8_SA(1, 0), a3, voffA);
            PG8_BAR; PG8_WAIT_L(0); PG8_MMA(1, 0, At, B0); PG8_BAR; PG8_SCHED;
            PG8_STAGE(PG8_SB(1, 1), b3 + hstepB, voffB);
            PG8_WAIT_V(6); PG8_BAR; PG8_MMA(1, 1, At, B1); PG8_BAR;
            }
        }
        if constexpr (FP8) {
#define PG8_ACC16(a) "+v"(acc[a][0][0][0]), "+v"(acc[a][0][0][1]), "+v"(acc[a][0][1][0]), "+v"(acc[a][0][1][1]), "+v"(acc[a][0][2][0]), "+v"(acc[a][0][2][1]), "+v"(acc[a][0][3][0]), "+v"(acc[a][0][3][1]), \
                     "+v"(acc[a][1][0][0]), "+v"(acc[a][1][0][1]), "+v"(acc[a][1][1][0]), "+v"(acc[a][1][1][1]), "+v"(acc[a][1][2][0]), "+v"(acc[a][1][2][1]), "+v"(acc[a][1][3][0]), "+v"(acc[a][1][3][1])
            asm volatile("s_nop 15\n\ts_nop 15" : PG8_ACC16(0));
            asm volatile("s_nop 0" : PG8_ACC16(1));
#undef PG8_ACC16
        }
        if constexpr (ALIGN_EPI) { if (wr == 0) PG8_BAR; }
        if constexpr (!Epi::AFTER_DRAIN) { E(acc, cur, wr, wc, fr, fq); S.done(cur); }
        if (!has_next) break;
#pragma unroll
        for (int a = 0; a < 2; ++a)
#pragma unroll
            for (int b = 0; b < 2; ++b)
#pragma unroll
                for (int m = 0; m < 4; ++m)
#pragma unroll
                    for (int n = 0; n < 2; ++n) acc[a][b][m][n] = (f32x4){0.f, 0.f, 0.f, 0.f};
        cur = nxt; cA = nA; cB = nB; ++ui;
        if constexpr (ALIGN_EPI) { if (wr == 1) PG8_BAR; }
    }
    PG8_WAIT_V(0);
    if constexpr (!ALIGN_EPI) { if (wr == 0) PG8_BAR; }
    PG8_BAR;
    if constexpr (Epi::AFTER_DRAIN) { E.fused(acc, cur, wr, wc, fr, fq, lds, wid, lane); S.done(cur); }
#undef PG8_SA
#undef PG8_SB
#undef PG8_STAGE
#undef PG8_LDA
#undef PG8_LDB
#undef PG8_MMA
#undef PG8_WAIT_V
#undef PG8_WAIT_L
#undef PG8_BAR
#undef PG8_SCHED
}
}

#define GAS __attribute__((address_space(1)))
#define LAS __attribute__((address_space(3)))
typedef unsigned short bf16;
typedef unsigned v4u __attribute__((ext_vector_type(4)));
typedef unsigned v2u __attribute__((ext_vector_type(2)));
typedef float f32x4 __attribute__((ext_vector_type(4)));
typedef __bf16 bf2_t __attribute__((ext_vector_type(2)));
typedef GAS unsigned gu32;
#define RLX_AGENT __ATOMIC_RELAXED, __HIP_MEMORY_SCOPE_AGENT
#define LDS_WAIT() asm volatile("s_waitcnt lgkmcnt(0)" ::: "memory")
#define VM_WAIT() asm volatile("s_waitcnt vmcnt(0)" ::: "memory")
__device__ __forceinline__ unsigned f2bf(float f) { unsigned u = __builtin_bit_cast(unsigned, f); return (u + 0x7fffu + ((u >> 16) & 1u)) >> 16; }
__device__ __forceinline__ unsigned pk2(float lo, float hi) { return f2bf(lo) | (f2bf(hi) << 16); }
__device__ __forceinline__ float bflo(unsigned u) { return __builtin_bit_cast(float, u << 16); }
__device__ __forceinline__ float bfhi(unsigned u) { return __builtin_bit_cast(float, u & 0xffff0000u); }
__device__ __forceinline__ float bf1(bf16 h) { return __builtin_bit_cast(float, ((unsigned)h) << 16); }
__device__ __forceinline__ float dot2bf(unsigned a, unsigned b, float c) { return __builtin_amdgcn_fdot2_f32_bf16(__builtin_bit_cast(bf2_t, a), __builtin_bit_cast(bf2_t, b), c, false); }
__device__ __forceinline__ float wave_sum(float v) {
#pragma unroll
    for (int o = 1; o < 64; o <<= 1) v += __shfl_xor(v, o);
    return v;
}

#define XB_TMO      128
#define XB_XCNT(j)  (256  + 64 * (j))
#define XB_XSUB(j)  (1280 + 64 * (j))
#define XB_XGEN(j)  (2304 + 64 * (j))
#define XB_TOP      3328
#define XB_TOPGEN   3392
#define XCD_BAR_WORDS 3456
#define XB_SPIN_CAP (1u << 18)

__device__ __forceinline__ unsigned xb_ld(unsigned* p)              { return __hip_atomic_load(p, __ATOMIC_RELAXED, __HIP_MEMORY_SCOPE_AGENT); }
__device__ __forceinline__ unsigned xb_add(unsigned* p, unsigned v) { return __hip_atomic_fetch_add(p, v, __ATOMIC_RELAXED, __HIP_MEMORY_SCOPE_AGENT); }
__device__ __forceinline__ unsigned xb_xcc_id() { return (unsigned)__builtin_amdgcn_s_getreg((3 << 11) | 20) & 0xFu; }
#define XB_SPIN(cond, bar) do { unsigned _sp = 0; while (cond) { __builtin_amdgcn_s_sleep(1); \
    if ((++_sp & 255u) == 0u) { if (xb_ld(&(bar)[XB_TMO])) break; if (_sp > XB_SPIN_CAP) { atomicAdd(&(bar)[XB_TMO], 1u); break; } } } } while (0)

struct XcdBarrier {
    unsigned* bar; unsigned x;
    volatile LAS unsigned* st;
};

__device__ __forceinline__ XcdBarrier xcd_barrier_post(unsigned* bar, volatile LAS unsigned* st) {
    XcdBarrier b; b.bar = bar; b.x = xb_xcc_id(); b.st = st;
    if (threadIdx.x == 0) (void)xb_add(&bar[XB_XCNT(b.x)], 1u);
    return b;
}
__device__ __forceinline__ void xcd_barrier_complete(unsigned* bar, unsigned x, unsigned& nloc, unsigned& nx) {
    const unsigned G = gridDim.x * gridDim.y * gridDim.z;
    unsigned sum, cnt, mine, sp = 0u;
    for (;;) {
        sum = 0u; cnt = 0u; mine = 0u;
#pragma unroll
        for (unsigned j = 0; j < 16; ++j) { const unsigned c = xb_ld(&bar[XB_XCNT(j)]); sum += c; cnt += (c > 0u) ? 1u : 0u; mine = (j == x) ? c : mine; }
        if (sum == G) break;
        __builtin_amdgcn_s_sleep(1);
        if ((++sp & 255u) == 0u) { if (xb_ld(&bar[XB_TMO])) break; if (sp > XB_SPIN_CAP) { atomicAdd(&bar[XB_TMO], 1u); break; } }
    }
    nloc = mine > 0u ? mine : 1u; nx = cnt > 0u ? cnt : 1u;
}

__device__ __forceinline__ void xcd_barrier(const XcdBarrier& b) {
    asm volatile("s_waitcnt vmcnt(0)" ::: "memory");
    __syncthreads();
    if (threadIdx.x == 0) {
        unsigned* bar = b.bar;
        __builtin_amdgcn_s_waitcnt(0);
        unsigned nloc = b.st[0], nx = b.st[1];
        if (nloc == 0u) { xcd_barrier_complete(bar, b.x, nloc, nx); b.st[0] = nloc; b.st[1] = nx; }
        const unsigned old = xb_add(&bar[XB_XSUB(b.x)], 1u);
        const unsigned gen = old / nloc;
        if (old + 1u == (gen + 1u) * nloc) {
            __builtin_amdgcn_fence(__ATOMIC_RELEASE, "agent");
            asm volatile("s_waitcnt vmcnt(0)" ::: "memory");
            const unsigned og = xb_add(&bar[XB_TOP], 1u);
            const unsigned tg = og / nx;
            if (og + 1u == (tg + 1u) * nx) xb_add(&bar[XB_TOPGEN], 1u);
            else XB_SPIN(xb_ld(&bar[XB_TOPGEN]) == tg, bar);
            __builtin_amdgcn_fence(__ATOMIC_ACQUIRE, "agent");
            xb_add(&bar[XB_XGEN(b.x)], 1u);
            asm volatile("s_waitcnt vmcnt(0)" ::: "memory");
        } else {
            XB_SPIN(xb_ld(&bar[XB_XGEN(b.x)]) == gen, bar);
            __builtin_amdgcn_fence(__ATOMIC_ACQUIRE, "agent");
            asm volatile("s_waitcnt vmcnt(0)" ::: "memory");
        }
    }
    __syncthreads();
}

constexpr int NWAVES = 8;
constexpr int DM = 2048, NBATCH = 8, SEQ = 2048, CTXL = 256, TPB = 2304  , MT = 18432, NPAN = 72;
constexpr int INC = 4672, INCP = 4864;
constexpr int C_NAQ = 0, C_NAK = 512, C_NAV = 1024, C_CQ = 1536, C_CKV = 1920, C_KPE = 2048, C_GQ = 2112, C_GK = 2624, C_GV = 2880, C_DQ = 3136, C_DK = 3648, C_DV = 4160;
constexpr int QMW = 768, KVW = 1280;
constexpr int DFF = 5632, DFE = 7168, NEXP = 8;
constexpr int MODW = 12288;
constexpr int MOE_ROWS = 34816, MOE_PAN = 136;
constexpr float EPSN = 1e-6f;
constexpr float SC_NA = 0.08838834764831845f, SC_MLA = 0.07216878364870322f, SC_DIFF = 0.125f;

constexpr size_t MiB = 1u << 20;
constexpr size_t WS_CTL = 0, CTL_ZERO_BYTES = 1 * MiB;
constexpr size_t WS_MOD = 1 * MiB;
constexpr size_t WS_ROPE = 1 * MiB + 900 * 1024;
constexpr size_t WS_ROUTE = 2 * MiB;
constexpr size_t WS_WIN = 3 * MiB;
constexpr size_t WS_WOUT = WS_WIN + 38 * MiB;
constexpr size_t WS_WQUP = WS_WOUT + 16 * MiB;
constexpr size_t WS_WKVUP = WS_WQUP + 2 * MiB;
constexpr size_t WS_WGU = WS_WKVUP + 2 * MiB;
constexpr size_t WS_WD = WS_WGU + 44 * MiB;
constexpr size_t WS_MGU = WS_WD + 22 * MiB;
constexpr size_t WS_MD = WS_MGU + 448 * MiB;
constexpr size_t WS_H = WS_MD + 224 * MiB;
constexpr size_t WS_U = WS_H + 144 * MiB;
constexpr size_t WS_R1 = WS_U + 72 * MiB;
constexpr size_t WS_QKV = WS_R1;
constexpr size_t WS_QM = WS_QKV + 171 * MiB;
constexpr size_t WS_KVM = WS_QM + 27 * MiB;
constexpr size_t WS_O = WS_KVM + 45 * MiB;
constexpr size_t WS_HM2 = WS_R1;
constexpr size_t WS_R2 = WS_R1 + 476 * MiB;
constexpr size_t WS_AS = WS_R2;
constexpr size_t WS_Y = WS_R2 + 136 * MiB;
constexpr size_t WS_HM = WS_R2;
constexpr size_t WS_END = WS_R2 + 272 * MiB;
static_assert(WS_O + 72 * MiB <= WS_R2, "region 1");
static_assert(WS_END <= (size_t)1792 * MiB, "workspace map must fit 4 x the largest input");
constexpr int RT_E = 0;
constexpr int RT_G = 16384;
constexpr int RT_RANK = 16384 * 3;
constexpr int RT_POS = 16384 * 5;
constexpr int RT_CNT = 16384 * 7;
static_assert((RT_CNT + 256 * 8) * 4 <= (int)MiB, "route info");
constexpr int CW_BAR = 4096;

constexpr int RING_OFF = 0, RING_BYTES = 131072;
constexpr int LDSCTL_OFF = RING_BYTES, MISC_OFF = LDSCTL_OFF + 320;
constexpr int LDS_BYTES = 147456;

namespace pg8 {
#define PG8_GAS __attribute__((address_space(1)))
struct LatentOrder : StaticOrder {
    __device__ bool next(int i, Unit& u) const { if (!StaticOrder::next(i, u)) return false; u.pm = u.pm + (u.pm >> 3) + 1; return true; }
};
#ifndef MOE_WGM
#define MOE_WGM 16
#endif
#ifndef MOE_NTB
#define MOE_NTB 0
#endif
struct MoeOrder : StaticOrder {
    static constexpr bool NTB = MOE_NTB;
    const PG8_LAS int* tab;
    __device__ bool next(int i, Unit& u) const {
        {
            const long L = (long)i * G + c; if (L >= nwg) return false;
            int wgid = (int)L; { const int q = nwg / NXCD, r = nwg % NXCD, xcd = wgid % NXCD, off = wgid / NXCD; wgid = (xcd < r ? xcd * (q + 1) : r * (q + 1) + (xcd - r) * q) + off; }
            const int nig = MOE_WGM * nN, gid = wgid / nig, fm = gid * MOE_WGM, gsz = (nM - fm) < MOE_WGM ? (nM - fm) : MOE_WGM;
            u.pm = fm + ((wgid % nig) % gsz); u.pn = (wgid % nig) / gsz;
        }
        int e = 0;
#pragma unroll
        for (int q = 0; q < 7; ++q) e += (u.pm >= __builtin_amdgcn_readfirstlane(tab[32 + q])) ? 1 : 0;
        u.pn += e * nN; return true;
    }
};
#ifndef MOED_WGM
#define MOED_WGM 4
#endif
struct MoeFullOrder : StaticOrder {
    const PG8_LAS int* tab;
    __device__ bool next(int i, Unit& u) const {
        {
            const long L = (long)i * G + c; if (L >= nwg) return false;
            int wgid = (int)L; { const int q = nwg / NXCD, r = nwg % NXCD, xcd = wgid % NXCD, off = wgid / NXCD; wgid = (xcd < r ? xcd * (q + 1) : r * (q + 1) + (xcd - r) * q) + off; }
            const int nig = MOED_WGM * nN, gid = wgid / nig, fm = gid * MOED_WGM, gsz = (nM - fm) < MOED_WGM ? (nM - fm) : MOED_WGM;
            u.pm = fm + ((wgid % nig) % gsz); u.pn = (wgid % nig) / gsz;
        }
        const int f = u.pm; int e = 0;
#pragma unroll
        for (int q = 0; q < 7; ++q) e += (f >= __builtin_amdgcn_readfirstlane(tab[40 + q])) ? 1 : 0;
        u.pm = f + __builtin_amdgcn_readfirstlane(tab[48 + e]); u.pn += e * nN; return true;
    }
    __device__ __forceinline__ void a_ready(const Unit&) const {}
    __device__ __forceinline__ void done(const Unit&) const {}
};
struct MoeRemOrder {
    static constexpr bool NTB = false;
    int nsub, G, c; const PG8_LAS int* tab;
    __device__ bool next(int i, Unit& u) const {
        const int L = i * G + c; if (L >= nsub) return false;
        const int r = L >> 5, pn = (L >> 2) & 7, ks = L & 3, e = tab[64 + r];
        u.pm = tab[32 + e] - 1; u.pn = e * 8 + pn; u.ko = ks * 1792; u.aux = r; return true;
    }
    __device__ __forceinline__ void a_ready(const Unit&) const {}
    __device__ __forceinline__ void done(const Unit&) const {}
};
struct CtxRemOrder {
    static constexpr bool NTB = false;
    int G, c;
    __device__ bool next(int i, Unit& u) const {
        const int L = i * G + c; if (L >= 256) return false;
        const int r = L >> 5, pn = (L >> 2) & 7, ks = L & 3;
        u.pm = 9 * r; u.pn = pn; u.ko = ks * 1408; u.aux = r; return true;
    }
    __device__ __forceinline__ void a_ready(const Unit&) const {}
    __device__ __forceinline__ void done(const Unit&) const {}
};
struct EpiSlab {
    static constexpr bool PERM = false, AFTER_DRAIN = false;
    float* S; float sc = 1.0f; int kdiv = 1792;
    __device__ __forceinline__ void operator()(const f32x4 (&acc)[2][2][4][2], const Unit& u, int wr, int wc, int fr_in, int fq_in) const {
        (void)fr_in; (void)fq_in; int t_ = threadIdx.x; asm volatile("" : "+v"(t_)); const int fr = t_ & 15, fq = (t_ >> 4) & 3;
        const int ks = u.ko / kdiv, pn = u.pn & 7;
        float* base = S + ((size_t)(ks * 8 + u.aux) * 256 + wr * 64 + fr) * 2048 + pn * BM + wc * 32 + 4 * fq;
#pragma unroll
        for (int ai = 0; ai < 2; ++ai)
#pragma unroll
            for (int m = 0; m < 4; ++m)
#pragma unroll
                for (int bj = 0; bj < 2; ++bj)
#pragma unroll
                    for (int n = 0; n < 2; ++n) *(PG8_GAS f32x4*)(base + (size_t)(ai * HALF + m * 16) * 2048 + bj * HALF + n * 16) = acc[ai][bj][m][n] * sc;
    }
};
struct EpiBf16P {
    static constexpr bool PERM = true, AFTER_DRAIN = false;
    bf16_t* O; int ldc; int pn_mod; float sc = 1.0f;
    __device__ __forceinline__ void operator()(const f32x4 (&acc)[2][2][4][2], const Unit& u, int wr, int wc, int fr_in, int fq_in) const {
        (void)fr_in; (void)fq_in; int t_ = threadIdx.x; asm volatile("" : "+v"(t_)); const int fr = t_ & 15, fq = (t_ >> 4) & 3;
        const int pn = pn_mod ? (u.pn % pn_mod) : u.pn;
        const int row0 = u.pm * BM + wr * 64 + fr, col0 = pn * BM + wc * 32 + 8 * fq;
#pragma unroll
        for (int ai = 0; ai < 2; ++ai)
#pragma unroll
            for (int m = 0; m < 4; ++m) { bf16_t* rowp = O + (size_t)(row0 + ai * HALF + m * 16) * ldc + col0;
#pragma unroll
                for (int bj = 0; bj < 2; ++bj) { const f32x4 v0 = acc[ai][bj][m][0] * sc, v1 = acc[ai][bj][m][1] * sc;
                    u32x4 w; w.x = cvt_pk_bf16(v0[0], v0[1]); w.y = cvt_pk_bf16(v0[2], v0[3]); w.z = cvt_pk_bf16(v1[0], v1[1]); w.w = cvt_pk_bf16(v1[2], v1[3]);
                    *(PG8_GAS u32x4*)(rowp + bj * HALF) = w; } }
    }
};
#ifndef KT_MOE
#define KT_MOE 1
#endif
#ifndef MOE_FP8
#define MOE_FP8 1
#endif
constexpr float MOE_WSCALE = 64.0f;
#ifndef EMU_FP8
#define EMU_FP8 0
#endif
#ifndef EMU_DGU
#define EMU_DGU 0
#endif
__device__ __forceinline__ unsigned pk4_fp8(float a, float b, float c, float d) { int p = __builtin_amdgcn_cvt_pk_fp8_f32(a, b, 0, false); p = __builtin_amdgcn_cvt_pk_fp8_f32(c, d, p, true); return (unsigned)p; }
__device__ __forceinline__ float fp8r(float x) { const int p = __builtin_amdgcn_cvt_pk_fp8_f32(x, x, 0, false); return __builtin_amdgcn_cvt_f32_fp8(p, 0); }
#ifndef NT_HM2
#define NT_HM2 1
#endif
__device__ __forceinline__ float silu_f(float x) { return x * __builtin_amdgcn_rcpf(1.0f + __expf(-x)); }
__device__ __forceinline__ float swiglu_f(float g, float u, float c1, float kk) { const float e = __builtin_amdgcn_exp2f(g * c1); return (g * u) * __builtin_amdgcn_rcpf(fmaf(e, kk, kk)); }
struct EpiSwiGLU {
    static constexpr bool PERM = true, AFTER_DRAIN = false;
    bf16_t* O; int ldc; int pn_mod; float isc = 1.0f;
    __device__ __forceinline__ void operator()(const f32x4 (&acc)[2][2][4][2], const Unit& u, int wr, int wc, int fr_in, int fq_in) const {
        (void)fr_in; (void)fq_in; int t_ = threadIdx.x; asm volatile("" : "+v"(t_)); const int fr = t_ & 15, fq = (t_ >> 4) & 3;
        const int pn = pn_mod ? (u.pn % pn_mod) : u.pn;
        const int row0 = u.pm * BM + wr * 64 + fr, col0 = pn * HALF + wc * 32 + 8 * fq;
        const float c1 = -1.4426950408889634f * isc, kk = 1.0f / (isc * isc);
#pragma unroll
        for (int ai = 0; ai < 2; ++ai)
#pragma unroll
            for (int m = 0; m < 4; ++m) { bf16_t* rowp = O + (size_t)(row0 + ai * HALF + m * 16) * ldc + col0;
                if (KT_MOE && pn_mod) rowp = O + ((size_t)(u.pm * (ldc >> 6) + (col0 >> 6)) * 256 + (wr * 64 + fr + ai * HALF + m * 16)) * 64 + (col0 & 63);
                f32x4 r0, r1;
#pragma unroll
                for (int j = 0; j < 4; ++j) { r0[j] = swiglu_f(acc[ai][0][m][0][j], acc[ai][1][m][0][j], c1, kk); r1[j] = swiglu_f(acc[ai][0][m][1][j], acc[ai][1][m][1][j], c1, kk); }
                if (MOE_FP8 && pn_mod) {
                    typedef unsigned u32x2 __attribute__((ext_vector_type(2)));
                    unsigned char* p8 = (unsigned char*)O + ((size_t)(u.pm * (ldc >> 7) + (col0 >> 7)) * 256 + (wr * 64 + fr + ai * HALF + m * 16)) * 128 + (col0 & 127);
                    u32x2 w8; w8.x = pk4_fp8(r0[0], r0[1], r0[2], r0[3]); w8.y = pk4_fp8(r1[0], r1[1], r1[2], r1[3]);
                    __builtin_nontemporal_store(w8, (PG8_GAS u32x2*)p8); continue; }
                if (EMU_FP8 && pn_mod) {
#pragma unroll
                    for (int j = 0; j < 4; ++j) { r0[j] = fp8r(r0[j]); r1[j] = fp8r(r1[j]); } }
                u32x4 w; w.x = cvt_pk_bf16(r0[0], r0[1]); w.y = cvt_pk_bf16(r0[2], r0[3]); w.z = cvt_pk_bf16(r1[0], r1[1]); w.w = cvt_pk_bf16(r1[2], r1[3]);
                if (NT_HM2 && pn_mod) __builtin_nontemporal_store(w, (PG8_GAS u32x4*)rowp); else *(PG8_GAS u32x4*)rowp = w; }
    }
};
struct EpiResGate {
    static constexpr bool PERM = false, AFTER_DRAIN = false;
    float* H; const float* gate;
    const float* xin; const float* cin;
    __device__ __forceinline__ void operator()(const f32x4 (&acc)[2][2][4][2], const Unit& u, int wr, int wc, int fr, int fq) const {
        const int b = u.pm / 9, j = u.pm - 9 * b, mr = (j == 0) ? 8 : b;
        const int rloc = wr * 64 + fr, col0 = u.pn * BM + wc * 32 + 4 * fq;
        const float* gp = gate + (size_t)mr * 12288 + col0;
        float* outp = H + (size_t)(u.pm * BM + rloc) * 2048 + col0;
        const float* inp = xin ? ((j == 0) ? cin + ((size_t)b * 256 + rloc) * 2048 + col0 : xin + ((size_t)b * 2048 + (size_t)(j - 1) * 256 + rloc) * 2048 + col0) : outp;
        f32x4 gv[2][2];
#pragma unroll
        for (int bj = 0; bj < 2; ++bj)
#pragma unroll
            for (int n = 0; n < 2; ++n) gv[bj][n] = *(const PG8_GAS f32x4*)(gp + bj * HALF + n * 16);
#pragma unroll
        for (int ai = 0; ai < 2; ++ai)
#pragma unroll
            for (int m = 0; m < 4; ++m) {
                const size_t ro = (size_t)(ai * HALF + m * 16) * 2048;
#pragma unroll
                for (int bj = 0; bj < 2; ++bj)
#pragma unroll
                    for (int n = 0; n < 2; ++n) { const f32x4 h = *(const PG8_GAS f32x4*)(inp + ro + bj * HALF + n * 16); *(PG8_GAS f32x4*)(outp + ro + bj * HALF + n * 16) = h + gv[bj][n] * acc[ai][bj][m][n]; }
                asm volatile("" ::: "memory"); }
    }
};
struct EpiQupRope {
    static constexpr bool PERM = false, AFTER_DRAIN = false;
    bf16_t* O; const float* tab;
    __device__ __forceinline__ void operator()(const f32x4 (&acc)[2][2][4][2], const Unit& u, int wr, int wc, int fr, int fq) const {
        const int b = u.pm / 9, j = u.pm - 9 * b; const bool lat = j != 0;
        const int rloc = wr * 64 + fr, col0 = u.pn * BM + wc * 32 + 4 * fq;
        typedef unsigned u32x2 __attribute__((ext_vector_type(2)));
#pragma unroll
        for (int bj = 0; bj < 2; ++bj) {
            const int dblk = (8 * u.pn + 4 * bj + wc) % 6; const bool rope = lat && dblk >= 4; const int axis = dblk - 4;
#pragma unroll
            for (int ai = 0; ai < 2; ++ai)
#pragma unroll
                for (int m = 0; m < 4; ++m) {
                    const int r = ai * HALF + m * 16 + rloc;
                    f32x4 x1 = acc[ai][bj][m][0], x2 = acc[ai][bj][m][1];
                    if (rope) { const int t = (j - 1) * 256 + r, pos = axis ? (t & 63) : (t >> 6);
                        const f32x4 c = *(const PG8_GAS f32x4*)(tab + pos * 16 + 4 * fq), sn = *(const PG8_GAS f32x4*)(tab + 1024 + pos * 16 + 4 * fq);
                        const f32x4 a = x1, bb = x2; x1 = a * c - bb * sn; x2 = bb * c + a * sn; }
                    bf16_t* rowp = O + (size_t)(u.pm * BM + r) * 768 + col0 + bj * HALF;
                    u32x2 w0, w1; w0.x = cvt_pk_bf16(x1[0], x1[1]); w0.y = cvt_pk_bf16(x1[2], x1[3]); w1.x = cvt_pk_bf16(x2[0], x2[1]); w1.y = cvt_pk_bf16(x2[2], x2[3]);
                    *(PG8_GAS u32x2*)rowp = w0; *(PG8_GAS u32x2*)(rowp + 16) = w1;
                    asm volatile("" ::: "memory");
                }
        }
    }
};
}
#define PG8_SP2 true
#define PG8_ALIGN true

struct Frame {
    LAS unsigned char* lds;
    volatile LAS unsigned* MISC;
    gu32* ctl;
    int wave, G, gw, NGW;
    float* out;
    unsigned char* ws;
};
__device__ __forceinline__ int opq_v(int v) { asm volatile("" : "+v"(v)); return v; }
#define TIDX opq_v((int)threadIdx.x)
typedef const float* cfptr;
__device__ __forceinline__ const float* inptr(int i) {
    const __attribute__((address_space(4))) cfptr* p = (const __attribute__((address_space(4))) cfptr*)__builtin_amdgcn_kernarg_segment_ptr();
    asm volatile("" : "+s"(p));
    return p[i];
}
enum { I_X = 0, I_C, I_CTX, I_CCTX, I_WMOD, I_BMOD, I_GMIX, I_WIN, I_NABIAS, I_MLAGQ, I_WQUP, I_MLAGKV, I_WKVUP, I_GQAGQ, I_GQAGK, I_LQ1, I_LK1, I_LQ2, I_LK2, I_GSUB, I_WOUT, I_GFFN,
       I_FG, I_FU, I_FD, I_MR, I_MB, I_MG, I_MU, I_MDN, I_GFIN };

struct TrJob { const float* W; bf16* WT; int N, ldk, k0, n0, drow0, tiled, emu; };
__device__ __forceinline__ void tr_load(const TrJob& j, f32x4 (&v)[16], int lane) {
#pragma unroll
    for (int i = 0; i < 16; ++i) { const int k = 4 * i + (lane >> 4), n4 = (lane & 15) * 4;
        v[i] = __builtin_nontemporal_load((const GAS f32x4*)(j.W + (size_t)(j.k0 + k) * j.N + j.n0 + n4)); }
}
__device__ __forceinline__ void tr_finish8(const TrJob& j, const f32x4 (&v)[16], LAS unsigned char* scr, int lane) {
    constexpr int ROWB = 68;
#pragma unroll
    for (int i = 0; i < 16; ++i) { const int k = 4 * i + (lane >> 4), n4 = (lane & 15) * 4; const f32x4 t = v[i] * pg8::MOE_WSCALE;
        *(LAS unsigned*)(scr + k * ROWB + n4) = pg8::pk4_fp8(t.x, t.y, t.z, t.w); }
    LDS_WAIT();
    const int c = lane & 3;
#pragma unroll 2
    for (int jj = 0; jj < 4; ++jj) {
        const int n = 16 * jj + (lane >> 2);
        const LAS unsigned char* s = scr + (16 * c) * ROWB + n;
        unsigned e[16];
#pragma unroll
        for (int i = 0; i < 16; ++i) e[i] = s[i * ROWB];
        v4u o; o.x = e[0] | (e[1] << 8) | (e[2] << 16) | (e[3] << 24); o.y = e[4] | (e[5] << 8) | (e[6] << 16) | (e[7] << 24);
        o.z = e[8] | (e[9] << 8) | (e[10] << 16) | (e[11] << 24); o.w = e[12] | (e[13] << 8) | (e[14] << 16) | (e[15] << 24);
        const int dr = j.drow0 + n;
        unsigned char* dst = (unsigned char*)j.WT + ((size_t)((dr >> 8) * (j.ldk >> 7) + (j.k0 >> 7)) * 256 + (dr & 255)) * 128 + (j.k0 & 127) + 16 * c;
        __builtin_nontemporal_store(o, (GAS v4u*)dst);
    }
    LDS_WAIT();
}
__device__ __forceinline__ void tr_finish(const TrJob& j, const f32x4 (&v)[16], LAS unsigned char* scr, int lane) {
    constexpr int ROWB = 136;
#pragma unroll
    for (int i = 0; i < 16; ++i) { const int k = 4 * i + (lane >> 4), n4 = (lane & 15) * 4;
        f32x4 t = v[i]; if ((EMU_FP8 && j.tiled) || (EMU_DGU && j.emu)) { t.x = pg8::fp8r(t.x * 64.f) * (1.f / 64.f); t.y = pg8::fp8r(t.y * 64.f) * (1.f / 64.f); t.z = pg8::fp8r(t.z * 64.f) * (1.f / 64.f); t.w = pg8::fp8r(t.w * 64.f) * (1.f / 64.f); }
        v2u w; w.x = pg8::cvt_pk_bf16(t.x, t.y); w.y = pg8::cvt_pk_bf16(t.z, t.w);
        *(LAS v2u*)(scr + k * ROWB + n4 * 2) = w; }
    LDS_WAIT();
    const int c = lane & 7;
#pragma unroll 2
    for (int jj = 0; jj < 8; ++jj) {
        const int n = 8 * jj + (lane >> 3);
        const LAS unsigned short* s = (const LAS unsigned short*)(scr + (8 * c) * ROWB + n * 2);
        unsigned e[8];
#pragma unroll
        for (int i = 0; i < 8; ++i) e[i] = s[i * (ROWB / 2)];
        v4u o; o.x = e[0] | (e[1] << 16); o.y = e[2] | (e[3] << 16); o.z = e[4] | (e[5] << 16); o.w = e[6] | (e[7] << 16);
        const int dr = j.drow0 + n;
        bf16* dst = j.tiled ? j.WT + ((size_t)((dr >> 8) * (j.ldk >> 6) + (j.k0 >> 6)) * 256 + (dr & 255)) * 64 + 8 * c : j.WT + (size_t)dr * j.ldk + j.k0 + 8 * c;
        __builtin_nontemporal_store(o, (GAS v4u*)dst);
    }
    LDS_WAIT();
}
constexpr int IT_WIN = 32 * 73, IT_WOUT = 32 * 32, IT_FGU = 32 * 88, IT_FD = 88 * 32, IT_MGU = 32 * 112, IT_MD = 112 * 32;
constexpr int CV_N0 = 2 * IT_WIN, CV_N1 = CV_N0 + 2 * IT_WOUT, CV_N2 = CV_N1 + 2 * IT_FGU, CV_N3 = CV_N2 + IT_FD, CV_N4 = CV_N3 + 16 * IT_MGU, CV_N5 = CV_N4 + 8 * IT_MD;
constexpr int CVQ_L1 = IT_WIN + IT_WOUT, CVQ_N = CVQ_L1 + (CV_N5 - CV_N1), CVQ_FFN_END = CVQ_L1 + (CV_N3 - CV_N1);
__device__ __forceinline__ int cvq_item(int q) { return q < IT_WIN ? IT_WIN + q : (q < CVQ_L1 ? CV_N0 + IT_WOUT + (q - IT_WIN) : CV_N1 + (q - CVQ_L1)); }
__device__ __forceinline__ TrJob conv_job(int it, unsigned char* ws) {
    const float* W; bf16* WT; int N, ldk, k0, n0, drow0, tiled = 0, emu = 0;
    if (it < CV_N0) { const int l = it / IT_WIN, r = it % IT_WIN, kb = r / 73, nb = r % 73;
        W = inptr(I_WIN) + (size_t)l * 2048 * INC; N = INC; WT = (bf16*)(ws + WS_WIN) + (size_t)l * INCP * 2048; ldk = 2048; k0 = kb * 64; n0 = nb * 64; drow0 = n0; }
    else if (it < CV_N1) { const int q = it - CV_N0, l = q / IT_WOUT, r = q % IT_WOUT, kb = r / 32, nb = r % 32;
        W = inptr(I_WOUT) + (size_t)l * 2048 * 2048; N = 2048; WT = (bf16*)(ws + WS_WOUT) + (size_t)l * 2048 * 2048; ldk = 2048; k0 = kb * 64; n0 = nb * 64; drow0 = n0; }
    else if (it < CV_N2) { const int q = it - CV_N1, which = q / IT_FGU, r = q % IT_FGU, kb = r / 88, nb = r % 88;
        W = which ? inptr(I_FU) : inptr(I_FG); N = DFF; WT = (bf16*)(ws + WS_WGU); ldk = 2048; k0 = kb * 64; n0 = nb * 64; drow0 = (n0 >> 7) * 256 + (n0 & 127) + which * 128; emu = 1; }
    else if (it < CV_N3) { const int r = it - CV_N2, kb = r / 32, nb = r % 32;
        W = inptr(I_FD); N = 2048; WT = (bf16*)(ws + WS_WD); ldk = DFF; k0 = kb * 64; n0 = nb * 64; drow0 = n0; }
    else if (it < CV_N4) { const int q = it - CV_N3, mat = q / IT_MGU, e = mat >> 1, which = mat & 1, r = q % IT_MGU, kb = r / 112, nb = r % 112;
        W = (which ? inptr(I_MU) : inptr(I_MG)) + (size_t)e * 2048 * DFE; N = DFE; WT = MOE_FP8 ? (bf16*)(ws + WS_MGU + (size_t)e * 14336 * 2048) : (bf16*)(ws + WS_MGU) + (size_t)e * 14336 * 2048; ldk = 2048; k0 = kb * 64; n0 = nb * 64; drow0 = (n0 >> 7) * 256 + (n0 & 127) + which * 128; tiled = MOE_FP8 ? 2 : KT_MOE; }
    else { const int q = it - CV_N4, e = q / IT_MD, r = q % IT_MD, kb = r / 32, nb = r % 32;
        W = inptr(I_MDN) + (size_t)e * DFE * 2048; N = 2048; WT = MOE_FP8 ? (bf16*)(ws + WS_MD + (size_t)e * 2048 * DFE) : (bf16*)(ws + WS_MD) + (size_t)e * 2048 * DFE; ldk = DFE; k0 = kb * 64; n0 = nb * 64; drow0 = n0; tiled = MOE_FP8 ? 2 : KT_MOE; }
    TrJob j; j.W = W; j.WT = WT; j.N = N; j.ldk = ldk; j.k0 = k0; j.n0 = n0; j.drow0 = drow0; j.tiled = tiled; j.emu = emu; return j;
}
template <bool QUEUE>
__device__ __forceinline__ void conv_pair(int it0, int it1, int nlim, unsigned char* ws, LAS unsigned char* scr, int lane) {
    if (it0 >= nlim) return;
    const bool two = it1 < nlim;
    const TrJob j0 = conv_job(QUEUE ? cvq_item(it0) : it0, ws), j1 = conv_job(QUEUE ? cvq_item(two ? it1 : it0) : (two ? it1 : it0), ws);
    f32x4 v0[16], v1[16];
#ifdef PROBE_CONV2
    if (QUEUE) { tr_load(j0, v0, lane); if (two) tr_load(j1, v1, lane); if (j0.tiled == 2) tr_finish8(j0, v0, scr, lane); else tr_finish(j0, v0, scr, lane); if (two) { if (j1.tiled == 2) tr_finish8(j1, v1, scr, lane); else tr_finish(j1, v1, scr, lane); } }
#endif
    tr_load(j0, v0, lane); if (two) tr_load(j1, v1, lane);
    if (j0.tiled == 2) tr_finish8(j0, v0, scr, lane); else tr_finish(j0, v0, scr, lane);
    if (two) { if (j1.tiled == 2) tr_finish8(j1, v1, scr, lane); else tr_finish(j1, v1, scr, lane); }
}
#ifndef CV_CHUNK_N
#define CV_CHUNK_N 16
#endif
constexpr int CW_QHEAD = 64, CW_DONE0 = 128, CV_CHUNK = CV_CHUNK_N;
#ifndef NO_TAIL_FILL
#define NO_TAIL_FILL 0
#endif
__device__ __forceinline__ void filler(Frame& F, int slot, int drain_to) {
    if (NO_TAIL_FILL && drain_to < 0) return;
    __syncthreads();
    LAS int* bc = (LAS int*)(F.lds + LDSCTL_OFF + 2048);
    LAS unsigned char* scr = F.lds + F.wave * 8704;
    gu32* qhead = F.ctl + CW_QHEAD; gu32* done = F.ctl + CW_DONE0 + 64 * slot;
    if (TIDX == 0 && drain_to < 0) __hip_atomic_fetch_add(done, 1u, RLX_AGENT);
    const int nq = CVQ_N, lim = drain_to < 0 ? nq : drain_to;
    for (;;) {
        if (TIDX == 0) {
            int h = -1; bool stop = false;
            if (drain_to < 0) stop = __hip_atomic_load(done, RLX_AGENT) >= (unsigned)F.G;
            else stop = __hip_atomic_load(qhead, RLX_AGENT) >= (unsigned)lim;
            if (!stop) { h = (int)__hip_atomic_fetch_add(qhead, (unsigned)CV_CHUNK, RLX_AGENT); if (h >= nq) h = -1; }
            *bc = h;
        }
        __syncthreads();
        const int h = *bc;
        __syncthreads();
        if (h < 0) break;
#pragma unroll 1
        for (int k = F.wave; k < CV_CHUNK; k += 2 * NWAVES) conv_pair<true>(h + k, h + k + NWAVES, CVQ_N, F.ws, scr, (TIDX & 63));
    }
    __syncthreads();
}

__device__ __forceinline__ void xcd_barrier_fill(const XcdBarrier& b, Frame& F) {
    asm volatile("s_waitcnt vmcnt(0)" ::: "memory");
    __syncthreads();
    LAS int* bc = (LAS int*)(F.lds + LDSCTL_OFF + 2048);
    if (threadIdx.x == 0) {
        unsigned* bar = b.bar;
        __builtin_amdgcn_s_waitcnt(0);
        unsigned nloc = b.st[0], nx = b.st[1];
        if (nloc == 0u) { xcd_barrier_complete(bar, b.x, nloc, nx); b.st[0] = nloc; b.st[1] = nx; }
        const unsigned old = xb_add(&bar[XB_XSUB(b.x)], 1u);
        const unsigned gen = old / nloc;
        if (old + 1u == (gen + 1u) * nloc) {
            __builtin_amdgcn_fence(__ATOMIC_RELEASE, "agent");
            asm volatile("s_waitcnt vmcnt(0)" ::: "memory");
            const unsigned og = xb_add(&bar[XB_TOP], 1u);
            const unsigned tg = og / nx;
            if (og + 1u == (tg + 1u) * nx) xb_add(&bar[XB_TOPGEN], 1u);
            else XB_SPIN(xb_ld(&bar[XB_TOPGEN]) == tg, bar);
            __builtin_amdgcn_fence(__ATOMIC_ACQUIRE, "agent");
            xb_add(&bar[XB_XGEN(b.x)], 1u);
            asm volatile("s_waitcnt vmcnt(0)" ::: "memory");
            bc[2] = 1;
        } else { bc[1] = (int)gen; bc[2] = 0; }
    }
    __syncthreads();
    if (bc[2] == 0) {
        LAS unsigned char* scr = F.lds + F.wave * 8704;
        gu32* qhead = F.ctl + CW_QHEAD;
        for (;;) {
            if (threadIdx.x == 0) {
                int h = -2;
                if (xb_ld(&b.bar[XB_XGEN(b.x)]) == (unsigned)bc[1]) { h = (int)__hip_atomic_fetch_add(qhead, 16u, RLX_AGENT); if (h >= CVQ_N) h = -1; }
                bc[0] = h;
            }
            __syncthreads();
            const int h = bc[0];
            __syncthreads();
            if (h < 0) { if (h == -1 && threadIdx.x == 0) XB_SPIN(xb_ld(&b.bar[XB_XGEN(b.x)]) == (unsigned)bc[1], b.bar); break; }
            conv_pair<true>(h + F.wave, h + F.wave + NWAVES, CVQ_N, F.ws, scr, (TIDX & 63));
        }
        if (threadIdx.x == 0) { __builtin_amdgcn_fence(__ATOMIC_ACQUIRE, "agent"); asm volatile("s_waitcnt vmcnt(0)" ::: "memory"); }
    }
    __syncthreads();
}

__device__ __forceinline__ void rope_cs(int pos, int i, float inv_nfreq, float& c, float& s) {
    const float freq = exp2f(-(float)i * inv_nfreq * 13.287712379549449f);
    const float ang = (float)pos * freq;
    c = __cosf(ang); s = __sinf(ang);
}

__device__ __forceinline__ void filler_quota(Frame& F, int nchunks) {
    __syncthreads();
    LAS int* bc = (LAS int*)(F.lds + LDSCTL_OFF + 2048);
    LAS unsigned char* scr = F.lds + F.wave * 8704;
    gu32* qhead = F.ctl + CW_QHEAD;
    const int nq = CVQ_N;
#pragma unroll 1
    for (int cidx = 0; cidx < nchunks; ++cidx) {
        if (TIDX == 0) { int h = -1;
            if (__hip_atomic_load(qhead, RLX_AGENT) < (unsigned)nq) { h = (int)__hip_atomic_fetch_add(qhead, (unsigned)CV_CHUNK, RLX_AGENT); if (h >= nq) h = -1; }
            *bc = h; }
        __syncthreads();
        const int h = *bc;
        __syncthreads();
        if (h < 0) break;
#pragma unroll 1
        for (int k = F.wave; k < CV_CHUNK; k += 2 * NWAVES) conv_pair<true>(h + k, h + k + NWAVES, CVQ_N, F.ws, scr, (TIDX & 63));
    }
    __syncthreads();
}

__device__ __forceinline__ float silu_g(float x) { return x / (1.0f + __expf(-x)); }

__device__ __forceinline__ void p0_prologue(Frame& F) {
    unsigned char* ws = F.ws;
    __syncthreads();
    {
        LAS float* sv = (LAS float*)(F.lds);
        LAS float* red = (LAS float*)(F.lds + 73728);
        for (int i = TIDX; i < 9 * 2048; i += 512) { const int r = i >> 11, d = i & 2047; const float v = (r < 8) ? inptr(I_C)[r * 2048 + d] : inptr(I_CCTX)[d]; sv[i] = silu_g(v); }
        __syncthreads();
        for (int cb = blockIdx.x; cb < 256; cb += F.G) {
            const int cg = cb * 96, layer = cg / MODW, col0 = cg - layer * MODW;
            const float* W = inptr(I_WMOD) + (size_t)layer * 2048 * MODW;
            if (TIDX < 384) {
                const int cq = TIDX % 24, ks = TIDX / 24;
                f32x4 acc[9];
#pragma unroll
                for (int r = 0; r < 9; ++r) acc[r] = (f32x4){0.f, 0.f, 0.f, 0.f};
                const float* wp = W + (size_t)(ks * 128) * MODW + col0 + cq * 4;
#pragma unroll 2
                for (int k = 0; k < 128; k += 4) {
                    f32x4 w[4];
#pragma unroll
                    for (int q = 0; q < 4; ++q) w[q] = __builtin_nontemporal_load((const GAS f32x4*)(wp + (size_t)(k + q) * MODW));
#pragma unroll
                    for (int r = 0; r < 9; ++r) { const f32x4 s4 = *(const LAS f32x4*)(sv + r * 2048 + ks * 128 + k);
                        acc[r] += w[0] * s4.x; acc[r] += w[1] * s4.y; acc[r] += w[2] * s4.z; acc[r] += w[3] * s4.w; }
                }
#pragma unroll
                for (int r = 0; r < 9; ++r) *(LAS f32x4*)(red + (ks * 9 + r) * 96 + cq * 4) = acc[r];
            }
            __syncthreads();
            for (int i = TIDX; i < 9 * 96; i += 512) {
                const int r = i / 96, c = i - r * 96; float s = inptr(I_BMOD)[layer * MODW + col0 + c];
#pragma unroll
                for (int ks = 0; ks < 16; ++ks) s += red[(ks * 9 + r) * 96 + c];
                ((float*)(ws + WS_MOD))[((size_t)layer * 9 + r) * MODW + col0 + c] = s;
            }
            __syncthreads();
        }
    }
    {
        const size_t gt = (size_t)blockIdx.x * 512 + TIDX, GT = (size_t)F.G * 512;
        for (size_t i = gt; i < (size_t)2 * 768 * 384; i += GT) { const int l = (int)(i / (768 * 384)), r = (int)(i % (768 * 384)), n = r / 384, k = r % 384;
            ((bf16*)(ws + WS_WQUP))[i] = (bf16)f2bf(inptr(I_WQUP)[((size_t)l * 384 + k) * 768 + n]); }
        for (size_t i = gt; i < (size_t)2 * 1280 * 256; i += GT) { const int l = (int)(i / (1280 * 256)), r = (int)(i % (1280 * 256)), row = r >> 8, k = r & 255, h = row / 320, j = row - 320 * h;
            float v = 0.f;
            if (j < 128) { if (k < 128) v = inptr(I_WKVUP)[((size_t)l * 128 + k) * 1024 + h * 256 + j]; }
            else if (j < 192) { if (k == j) v = 1.0f; }
            else { if (k < 128) v = inptr(I_WKVUP)[((size_t)l * 128 + k) * 1024 + h * 256 + 128 + (j - 192)]; }
            ((bf16*)(ws + WS_WKVUP))[i] = (bf16)f2bf(v); }
        for (size_t i = gt; i < 64 * 16 + 64 * 32; i += GT) { float* tb = (float*)(ws + WS_ROPE);
            if (i < 1024) { const int pos = (int)i >> 4, f = (int)i & 15; float c, sn; rope_cs(pos, f, 1.0f / 16.0f, c, sn); tb[i] = c; tb[1024 + i] = sn; }
            else { const int q = (int)i - 1024, pos = q >> 5, f = q & 31; float c, sn; rope_cs(pos, f, 1.0f / 32.0f, c, sn); tb[2048 + q] = c; tb[4096 + q] = sn; } }
        for (size_t i = gt; i < (size_t)2 * 192 * 2048 / 8; i += GT) { const int l = (int)(i / (192 * 256)), r = (int)(i % (192 * 256));
            *(GAS v4u*)((bf16*)(ws + WS_WIN) + ((size_t)l * INCP + INC) * 2048 + (size_t)r * 8) = (v4u){0u, 0u, 0u, 0u}; }
    }
    {
        LAS unsigned char* scr = F.lds + F.wave * 8704;
        for (int it = F.gw; it < IT_WIN + IT_WOUT; it += 2 * F.NGW) {
            const int i1 = it + F.NGW, a0 = it < IT_WIN ? it : CV_N0 + (it - IT_WIN), a1 = i1 < IT_WIN ? i1 : CV_N0 + (i1 - IT_WIN);
            conv_pair<false>(a0, i1 < IT_WIN + IT_WOUT ? a1 : CV_N5, CV_N5, ws, scr, (TIDX & 63)); }
    }
}

struct RowInfo { int b, w, t, mr; bool ctx; };
__device__ __forceinline__ RowInfo row_info(int r) { RowInfo q; q.b = r / TPB; q.w = r - q.b * TPB; q.ctx = q.w < CTXL; q.t = q.w - CTXL; q.mr = q.ctx ? 8 : q.b; return q; }

__device__ __forceinline__ void norm_pass(Frame& F, int layer, bool first  , bool from_input, bool split_ctx = false) {
    unsigned char* ws = F.ws;
    const float* modl = (const float*)(ws + WS_MOD) + (size_t)layer * 9 * MODW;
    const float* g = (first ? inptr(I_GMIX) : inptr(I_GFFN)) + layer * DM;
    const int sh_off = first ? 0 : 3 * DM, sc_off = first ? DM : 4 * DM;
    const float* H = (const float*)(ws + WS_H); bf16* U = (bf16*)(ws + WS_U);
    const int tid_ = TIDX, lane_ = tid_ & 63;
    LAS float* ca = (LAS float*)F.lds; LAS float* cb = ca + 4096;
    LAS float* cg = ca + 8192;
    for (int blk = blockIdx.x; blk < 256; blk += F.G) {
        const int r0 = blk * 72, bb = r0 / TPB;
        __syncthreads();
        for (int i = tid_; i < 2 * 2048; i += 512) { const int slot = i >> 11, col = i & 2047, mr = slot ? bb : 8;
            ca[i] = g[col] * (1.0f + modl[(size_t)mr * MODW + sc_off + col]); cb[i] = modl[(size_t)mr * MODW + sh_off + col]; }
        if (split_ctx) for (int i = tid_; i < 2048; i += 512) cg[i] = ((const float*)(ws + WS_MOD))[(size_t)8 * MODW + 5 * DM + i];
        __syncthreads();
#define NP_ROW(k_, q_) (split_ctx ? bb * TPB + ((3 * (k_) + (q_)) < 8 ? CTXL + 64 * (blk & 31) + 8 * F.wave + 3 * (k_) + (q_) : 8 * (blk & 31) + F.wave) : r0 + 9 * F.wave + 3 * (k_) + (q_))
#pragma unroll 1
        for (int k = 0; k < 3; ++k) {
            f32x4 v[3][8];
#pragma unroll
            for (int q = 0; q < 3; ++q) { const int r = NP_ROW(k, q), w = r - bb * TPB;
                const float* src = from_input ? ((w < CTXL) ? inptr(I_CTX) + ((size_t)bb * CTXL + w) * DM : inptr(I_X) + ((size_t)bb * SEQ + (w - CTXL)) * DM) : H + (size_t)r * DM;
                const GAS f32x4* xr = (const GAS f32x4*)src + lane_;
#pragma unroll
                for (int j = 0; j < 8; ++j) v[q][j] = xr[64 * j]; }
            if (split_ctx && k == 2) {
                const GAS f32x4* sl = (const GAS f32x4*)((const float*)(ws + WS_R1) + ((size_t)bb * 256 + 8 * (blk & 31) + F.wave) * 2048) + lane_;
                const LAS f32x4* gp = (const LAS f32x4*)cg + lane_;
#pragma unroll 1
                for (int s4 = 0; s4 < 4; ++s4) { f32x4 t[8];
#pragma unroll
                    for (int j = 0; j < 8; ++j) t[j] = sl[(size_t)s4 * (8 * 256 * 2048 / 4) + 64 * j];
#pragma unroll
                    for (int j = 0; j < 8; ++j) v[2][j] += gp[64 * j] * t[j]; }
            }
#pragma unroll
            for (int q = 0; q < 3; ++q) { const int r = NP_ROW(k, q), w = r - bb * TPB, slot = (w < CTXL) ? 0 : 1;
                float ss = 0.f;
#pragma unroll
                for (int j = 0; j < 8; ++j) ss += (v[q][j].x * v[q][j].x + v[q][j].y * v[q][j].y) + (v[q][j].z * v[q][j].z + v[q][j].w * v[q][j].w);
                const float rstd = 1.0f / sqrtf(wave_sum(ss) * (1.0f / DM) + EPSN);
                GAS v2u* o8 = (GAS v2u*)(U + (size_t)r * DM) + lane_;
                const LAS f32x4* ap = (const LAS f32x4*)(ca + slot * 2048) + lane_; const LAS f32x4* bp = (const LAS f32x4*)(cb + slot * 2048) + lane_;
#pragma unroll
                for (int j = 0; j < 8; ++j) { f32x4 y = v[q][j] * rstd * ap[64 * j] + bp[64 * j]; if (EMU_DGU && !first) { y.x = pg8::fp8r(y.x); y.y = pg8::fp8r(y.y); y.z = pg8::fp8r(y.z); y.w = pg8::fp8r(y.w); } v2u wv; wv.x = pg8::cvt_pk_bf16(y.x, y.y); wv.y = pg8::cvt_pk_bf16(y.z, y.w); o8[64 * j] = wv; } }
        }
#undef NP_ROW
    }
    __syncthreads();
}

struct PostRow { unsigned cq[3], ckv; float kpe[2], gq[6][2], df[8][2]; };
__device__ __forceinline__ void post_load(const bf16* q, bool lat, int lane, PostRow& R) {
    const GAS unsigned* pc = (const GAS unsigned*)(q + C_CQ);
#pragma unroll
    for (int j = 0; j < 3; ++j) R.cq[j] = pc[lane + 64 * j];
    R.ckv = ((const GAS unsigned*)(q + C_CKV))[lane];
    { const int axis = (lane >> 4) & 1, i = lane & 15; const GAS bf16* pk = (const GAS bf16*)(q + C_KPE + axis * 32); R.kpe[0] = bf1(pk[i]); R.kpe[1] = bf1(pk[16 + i]); }
#pragma unroll
    for (int hh = 0; hh < 6; ++hh) { const int base = (hh < 4) ? (C_GQ + 128 * hh) : (C_GK + 128 * (hh - 4)); const int axis = lane >> 5, i = lane & 31;
        const GAS bf16* pg = (const GAS bf16*)(q + base + axis * 64); R.gq[hh][0] = bf1(pg[i]); R.gq[hh][1] = bf1(pg[32 + i]); }
    if (lat) {
#pragma unroll
        for (int pp = 0; pp < 8; ++pp) { const int blk = 2 * pp + (lane >> 5), axis = (lane >> 4) & 1, i = lane & 15; const int base = (blk < 8) ? (C_DQ + 64 * blk) : (C_DK + 64 * (blk - 8));
            const GAS bf16* pd = (const GAS bf16*)(q + base + axis * 32); R.df[pp][0] = bf1(pd[i]); R.df[pp][1] = bf1(pd[16 + i]); }
    }
}
__device__ __forceinline__ void post_finish(bf16* q, bool lat, int prow, int pcol, int lane, const PostRow& R, const float* g_mq, const float* g_mkv, const float* g_gq, const float* g_gk, const float* rt) {
    { float ss = 0.f;
#pragma unroll
      for (int j = 0; j < 3; ++j) { const float a = bflo(R.cq[j]), b = bfhi(R.cq[j]); ss += a * a + b * b; }
      const float rs = 1.0f / sqrtf(wave_sum(ss) * (1.0f / 384.0f) + EPSN); GAS unsigned* pc = (GAS unsigned*)(q + C_CQ);
#pragma unroll
      for (int j = 0; j < 3; ++j) { const int c = 2 * (lane + 64 * j); pc[lane + 64 * j] = pk2(bflo(R.cq[j]) * rs * g_mq[c], bfhi(R.cq[j]) * rs * g_mq[c + 1]); } }
    { const float a = bflo(R.ckv), b = bfhi(R.ckv); const float rs = 1.0f / sqrtf(wave_sum(a * a + b * b) * (1.0f / 128.0f) + EPSN);
      ((GAS unsigned*)(q + C_CKV))[lane] = pk2(a * rs * g_mkv[2 * lane], b * rs * g_mkv[2 * lane + 1]); }
    if (lat && lane < 32) { const int axis = lane >> 4, i = lane & 15, pos = axis ? pcol : prow; const float c = rt[pos * 16 + i], s = rt[1024 + pos * 16 + i];
      GAS bf16* pk = (GAS bf16*)(q + C_KPE + axis * 32); pk[i] = (bf16)f2bf(R.kpe[0] * c - R.kpe[1] * s); pk[16 + i] = (bf16)f2bf(R.kpe[1] * c + R.kpe[0] * s); }
    { const int axis = lane >> 5, i = lane & 31, pos = axis ? pcol : prow; const float c = rt[2048 + pos * 32 + i], s = rt[4096 + pos * 32 + i];
#pragma unroll
      for (int hh = 0; hh < 6; ++hh) { const int base = (hh < 4) ? (C_GQ + 128 * hh) : (C_GK + 128 * (hh - 4)); const float* gg = (hh < 4) ? g_gq : g_gk;
        const float x1 = R.gq[hh][0], x2 = R.gq[hh][1];
        const float rs = 1.0f / sqrtf(wave_sum(x1 * x1 + x2 * x2) * (1.0f / 128.0f) + EPSN);
        float y1 = x1 * rs * gg[axis * 64 + i], y2 = x2 * rs * gg[axis * 64 + 32 + i];
        if (lat) { const float o1 = y1 * c - y2 * s, o2 = y2 * c + y1 * s; y1 = o1; y2 = o2; }
        GAS bf16* pg = (GAS bf16*)(q + base + axis * 64); pg[i] = (bf16)f2bf(y1); pg[32 + i] = (bf16)f2bf(y2); } }
    if (lat) { const int axis = (lane >> 4) & 1, i = lane & 15, pos = axis ? pcol : prow; const float c = rt[pos * 16 + i], s = rt[1024 + pos * 16 + i];
#pragma unroll
      for (int pp = 0; pp < 8; ++pp) { const int blk = 2 * pp + (lane >> 5); const int base = (blk < 8) ? (C_DQ + 64 * blk) : (C_DK + 64 * (blk - 8));
        GAS bf16* pd = (GAS bf16*)(q + base + axis * 32); pd[i] = (bf16)f2bf(R.df[pp][0] * c - R.df[pp][1] * s); pd[16 + i] = (bf16)f2bf(R.df[pp][1] * c + R.df[pp][0] * s); } }
}
__device__ __forceinline__ void post_pass(Frame& F, int layer) {
    bf16* QKV = (bf16*)(F.ws + WS_QKV); const float* rt = (const float*)(F.ws + WS_ROPE);
    const float* g_mq = inptr(I_MLAGQ) + layer * 384; const float* g_mkv = inptr(I_MLAGKV) + layer * 128;
    const float* g_gq = inptr(I_GQAGQ) + layer * 128; const float* g_gk = inptr(I_GQAGK) + layer * 128;
    const int lane = opq_v((TIDX & 63));
    for (int r = F.gw; r < MT; r += 2 * F.NGW) {
        const int r2 = r + F.NGW; const bool two = r2 < MT;
        const RowInfo ra = row_info(r), rb = row_info(two ? r2 : r);
        bf16* qa = QKV + (size_t)r * INCP; bf16* qb = QKV + (size_t)(two ? r2 : r) * INCP;
        PostRow A, B;
        post_load(qa, !ra.ctx, lane, A); if (two) post_load(qb, !rb.ctx, lane, B);
        post_finish(qa, !ra.ctx, ra.ctx ? 0 : (ra.t >> 6), ra.ctx ? 0 : (ra.t & 63), lane, A, g_mq, g_mkv, g_gq, g_gk, rt);
        if (two) post_finish(qb, !rb.ctx, rb.ctx ? 0 : (rb.t >> 6), rb.ctx ? 0 : (rb.t & 63), lane, B, g_mq, g_mkv, g_gq, g_gk, rt);
    }
}
__device__ __forceinline__ void qm_rope_pass(Frame& F) {
    bf16* QM = (bf16*)(F.ws + WS_QM); const int lane = opq_v((TIDX & 63));
    for (int r = F.gw; r < MT; r += F.NGW) {
        const RowInfo ri = row_info(r); if (ri.ctx) continue;
        const int prow = ri.t >> 6, pcol = ri.t & 63;
#pragma unroll
        for (int pp = 0; pp < 2; ++pp) {
            const int h = 2 * pp + (lane >> 5), axis = (lane >> 4) & 1, i = lane & 15;
            GAS bf16* p = (GAS bf16*)(QM + (size_t)r * QMW + 192 * h + 128 + axis * 32);
            const float x1 = bf1(p[i]), x2 = bf1(p[16 + i]); float c, s; rope_cs(axis ? pcol : prow, i, 1.0f / 16.0f, c, s);
            p[i] = (bf16)f2bf(x1 * c - x2 * s); p[16 + i] = (bf16)f2bf(x2 * c + x1 * s);
        }
    }
}

__device__ __forceinline__ void ffn_tables(Frame& F, int layer, int b, LAS float* ca, LAS float* cb) {
    const float* modl = (const float*)(F.ws + WS_MOD) + (size_t)layer * 9 * MODW + (size_t)b * MODW; const float* g = inptr(I_GFFN) + layer * DM;
    for (int i = TIDX; i < 2048; i += 512) { ca[i] = g[i] * (1.0f + modl[4 * DM + i]); cb[i] = modl[3 * DM + i]; }
}
__device__ __forceinline__ void ffn_u_pair(Frame& F, int r0, int r1, const LAS float* ca, const LAS float* cb, int lane_, f32x4 (&v0)[8], f32x4 (&v1)[8]) {
    const float* H = (const float*)(F.ws + WS_H);
    const GAS f32x4* x0 = (const GAS f32x4*)(H + (size_t)r0 * DM) + lane_; const GAS f32x4* x1 = (const GAS f32x4*)(H + (size_t)r1 * DM) + lane_;
#pragma unroll
    for (int j = 0; j < 8; ++j) { v0[j] = x0[64 * j]; v1[j] = x1[64 * j]; }
    float s0 = 0.f, s1 = 0.f;
#pragma unroll
    for (int j = 0; j < 8; ++j) { s0 += (v0[j].x * v0[j].x + v0[j].y * v0[j].y) + (v0[j].z * v0[j].z + v0[j].w * v0[j].w); s1 += (v1[j].x * v1[j].x + v1[j].y * v1[j].y) + (v1[j].z * v1[j].z + v1[j].w * v1[j].w); }
    const float q0 = 1.0f / sqrtf(wave_sum(s0) * (1.0f / DM) + EPSN), q1 = 1.0f / sqrtf(wave_sum(s1) * (1.0f / DM) + EPSN);
    const LAS f32x4* ap = (const LAS f32x4*)ca + lane_; const LAS f32x4* bp = (const LAS f32x4*)cb + lane_;
#pragma unroll
    for (int j = 0; j < 8; ++j) { const f32x4 a4 = ap[64 * j], b4 = bp[64 * j]; v0[j] = v0[j] * q0 * a4 + b4; v1[j] = v1[j] * q1 * a4 + b4; }
}
__device__ __forceinline__ int moe_tok(int blk, int tl) { return (blk >> 5) * 2048 + (blk & 31) + 32 * tl; }
__device__ __forceinline__ void route_one(const f32x4 (&v)[8], const LAS float* wl, const float* br, int lane_, int& e1o, int& e2o, float& g1o, float& g2o) {
    float lg[8];
#pragma unroll
    for (int e = 0; e < 8; ++e) lg[e] = 0.f;
#pragma unroll
    for (int j = 0; j < 8; ++j) {
        const LAS f32x4* wp = (const LAS f32x4*)(wl + (size_t)(4 * (lane_ + 64 * j)) * 8);
#pragma unroll
        for (int c = 0; c < 4; ++c) { const f32x4 w0 = wp[2 * c], w1 = wp[2 * c + 1]; const float x = v[j][c];
            lg[0] += x * w0.x; lg[1] += x * w0.y; lg[2] += x * w0.z; lg[3] += x * w0.w; lg[4] += x * w1.x; lg[5] += x * w1.y; lg[6] += x * w1.z; lg[7] += x * w1.w; }
    }
#pragma unroll
    for (int e = 0; e < 8; ++e) lg[e] = wave_sum(lg[e]) + br[e];
    int e1 = 0; float v1 = lg[0];
#pragma unroll
    for (int e = 1; e < 8; ++e) if (lg[e] > v1) { v1 = lg[e]; e1 = e; }
    int e2 = -1; float v2 = -3.0e38f;
#pragma unroll
    for (int e = 0; e < 8; ++e) if (e != e1 && lg[e] > v2) { v2 = lg[e]; e2 = e; }
    g2o = 1.0f / (1.0f + expf(v1 - v2)); g1o = 1.0f - g2o; e1o = e1; e2o = e2;
}
__device__ __forceinline__ void moe_route_pass(Frame& F, int layer) {
    const int lane_ = opq_v((TIDX & 63));
    int* rt = (int*)(F.ws + WS_ROUTE); float* rtf = (float*)(F.ws + WS_ROUTE);
    LAS float* ca = (LAS float*)F.lds; LAS float* cb = ca + 2048; LAS float* wl = ca + 4096;
    LAS int* le = (LAS int*)(F.lds + 16384 + 65536);
    const float* wr = inptr(I_MR); const float* br = inptr(I_MB);
    __syncthreads();
    for (int i = TIDX; i < 2048 * 8 / 4; i += 512) ((LAS f32x4*)wl)[i] = ((const GAS f32x4*)wr)[i];
    for (int blk = blockIdx.x; blk < 256; blk += F.G) {
        const int b = blk >> 5;
        __syncthreads();
        ffn_tables(F, layer, b, ca, cb);
        __syncthreads();
#pragma unroll 1
        for (int i = 0; i < 4; ++i) {
            const int tl = F.wave + 16 * i, tl1 = tl + 8, tok = moe_tok(blk, tl), tok1 = moe_tok(blk, tl1);
            f32x4 v0[8], v1[8]; ffn_u_pair(F, b * TPB + CTXL + (tok & 2047), b * TPB + CTXL + (tok1 & 2047), ca, cb, lane_, v0, v1);
            int e1, e2; float g1, g2;
            route_one(v0, wl, br, lane_, e1, e2, g1, g2);
            if (lane_ == 0) { le[tl] = e1 | (e2 << 8); rt[RT_E + tok] = e1 | (e2 << 8); rtf[RT_G + 2 * tok] = g1; rtf[RT_G + 2 * tok + 1] = g2; }
            route_one(v1, wl, br, lane_, e1, e2, g1, g2);
            if (lane_ == 0) { le[tl1] = e1 | (e2 << 8); rt[RT_E + tok1] = e1 | (e2 << 8); rtf[RT_G + 2 * tok1] = g1; rtf[RT_G + 2 * tok1 + 1] = g2; }
        }
        __syncthreads();
        if (TIDX < 8) { const int e = TIDX; int cnt = 0;
            for (int tl = 0; tl < 64; ++tl) { const int w = le[tl], a = w & 255, c = w >> 8;
                if (a == e) rt[RT_RANK + 2 * moe_tok(blk, tl)] = cnt++;
                if (c == e) rt[RT_RANK + 2 * moe_tok(blk, tl) + 1] = cnt++; }
            rt[RT_CNT + blk * 8 + e] = cnt; }
    }
    __syncthreads();
}
__device__ __forceinline__ void moe_tables(Frame& F, LAS int* tab, int blk) {
    const int* rt = (const int*)(F.ws + WS_ROUTE);
    __syncthreads();
    if (TIDX < 8) { const int e = TIDX; int tot = 0, before = 0;
        for (int k = 0; k < 256; ++k) { const int c = rt[RT_CNT + k * 8 + e]; tot += c; before += (k < blk) ? c : 0; }
        tab[e] = tot; tab[16 + e] = before; }
    __syncthreads();
    if (TIDX == 0) { int base = 0, pan = 0, nf = 0, nr = 0;
        for (int e = 0; e < 8; ++e) { tab[8 + e] = base; const int np = (tab[e] + 255) >> 8, fu = tab[e] >> 8; base += np * 256; pan += np; tab[32 + e] = pan;
            tab[48 + e] = nr; nf += fu; tab[40 + e] = nf; if (np != fu) { tab[64 + nr] = e; ++nr; } }
        tab[24] = pan; tab[56] = nf; tab[57] = nr; }
    __syncthreads();
}
__device__ __forceinline__ void moe_scatter_pass(Frame& F, int layer) {
    const int lane_ = opq_v((TIDX & 63));
    int* rt = (int*)(F.ws + WS_ROUTE); bf16* AS = (bf16*)(F.ws + WS_AS);
    LAS int* tab = (LAS int*)(F.lds + 16384); LAS float* ca = (LAS float*)F.lds; LAS float* cb = ca + 2048;
    for (int blk = blockIdx.x; blk < 256; blk += F.G) {
        const int b = blk >> 5;
        moe_tables(F, tab, blk);
        ffn_tables(F, layer, b, ca, cb);
        __syncthreads();
#pragma unroll 1
        for (int i = 0; i < 4; ++i) {
            const int tl = F.wave + 16 * i, tok = moe_tok(blk, tl), tok1 = moe_tok(blk, tl + 8);
            f32x4 v0[8], v1[8]; ffn_u_pair(F, b * TPB + CTXL + (tok & 2047), b * TPB + CTXL + (tok1 & 2047), ca, cb, lane_, v0, v1);
#pragma unroll
            for (int s = 0; s < 2; ++s) {
                const int tk = s ? tok1 : tok; const int w = rt[RT_E + tk], e1 = w & 255, e2 = w >> 8;
                const int p1 = tab[8 + e1] + tab[16 + e1] + rt[RT_RANK + 2 * tk], p2 = tab[8 + e2] + tab[16 + e2] + rt[RT_RANK + 2 * tk + 1];
                if (lane_ == 0) { rt[RT_POS + 2 * tk] = p1; rt[RT_POS + 2 * tk + 1] = p2; }
                if (MOE_FP8) {
                    GAS unsigned* q1 = (GAS unsigned*)((unsigned char*)AS + (size_t)p1 * DM) + lane_; GAS unsigned* q2 = (GAS unsigned*)((unsigned char*)AS + (size_t)p2 * DM) + lane_;
#pragma unroll
                    for (int j = 0; j < 8; ++j) { const f32x4 y = s ? v1[j] : v0[j]; const unsigned x = pg8::pk4_fp8(y.x, y.y, y.z, y.w); q1[64 * j] = x; q2[64 * j] = x; }
                    continue; }
                GAS v2u* o1 = (GAS v2u*)(AS + (size_t)p1 * DM) + lane_; GAS v2u* o2 = (GAS v2u*)(AS + (size_t)p2 * DM) + lane_;
#pragma unroll
                for (int j = 0; j < 8; ++j) { f32x4 y = s ? v1[j] : v0[j]; if (EMU_FP8) { y.x = pg8::fp8r(y.x); y.y = pg8::fp8r(y.y); y.z = pg8::fp8r(y.z); y.w = pg8::fp8r(y.w); } v2u x; x.x = pg8::cvt_pk_bf16(y.x, y.y); x.y = pg8::cvt_pk_bf16(y.z, y.w); o1[64 * j] = x; o2[64 * j] = x; }
            }
        }
        for (int e = 0; e < 8; ++e) { const int tot = tab[e], end = (tot + 255) & ~255;
            for (int pr = tot + blk * 8 + F.wave; pr < end; pr += 2048) {
                if (MOE_FP8) { GAS unsigned* o = (GAS unsigned*)((unsigned char*)AS + (size_t)(tab[8 + e] + pr) * DM) + lane_;
#pragma unroll
                    for (int j = 0; j < 8; ++j) o[64 * j] = 0u; continue; }
                GAS v2u* o = (GAS v2u*)(AS + (size_t)(tab[8 + e] + pr) * DM) + lane_;
#pragma unroll
                for (int j = 0; j < 8; ++j) o[64 * j] = (v2u){0u, 0u}; } }
    }
    __syncthreads();
}
__device__ __forceinline__ void final_pass(Frame& F, int layer) {
    const int lane_ = opq_v((TIDX & 63));
    const int* rt = (const int*)(F.ws + WS_ROUTE); const float* rtf = (const float*)(F.ws + WS_ROUTE);
    const bf16* Y = (const bf16*)(F.ws + WS_Y); const float* H = (const float*)(F.ws + WS_H); const float* SL = (const float*)(F.ws + WS_U);
    const float* modl = (const float*)(F.ws + WS_MOD) + (size_t)layer * 9 * MODW;
    LAS int* tab = (LAS int*)(F.lds);
    moe_tables(F, tab, 0);
    for (int tok = F.gw; tok < NBATCH * SEQ; tok += F.NGW) {
        const int b = tok >> 11, t = tok & 2047, r = b * TPB + CTXL + t;
        const int ee = rt[RT_E + tok]; const float g1 = rtf[RT_G + 2 * tok], g2 = rtf[RT_G + 2 * tok + 1];
        const GAS f32x4* xr = (const GAS f32x4*)(H + (size_t)r * DM) + lane_;
        const GAS f32x4* gt = (const GAS f32x4*)(modl + (size_t)b * MODW + 5 * DM) + lane_;
        f32x4 y[8], v[8];
#pragma unroll
        for (int j = 0; j < 8; ++j) { y[j] = (f32x4){0.f, 0.f, 0.f, 0.f}; v[j] = xr[64 * j]; }
#pragma unroll 1
        for (int s = 0; s < 2; ++s) {
            const int e = s ? (ee >> 8) : (ee & 255), p = rt[RT_POS + 2 * tok + s]; const float g = s ? g2 : g1;
            const int loc = p - tab[8 + e], fu = tab[e] >> 8;
            if (loc < 256 * fu) {
                const GAS v2u* yp = (const GAS v2u*)(Y + (size_t)p * DM) + lane_;
#pragma unroll
                for (int j = 0; j < 8; ++j) { const v2u a = yp[64 * j]; y[j] += (f32x4){bflo(a.x), bfhi(a.x), bflo(a.y), bfhi(a.y)} * g; }
            } else {
                const int rr = tab[48 + e], row = loc - 256 * fu;
#pragma unroll
                for (int ks = 0; ks < 4; ++ks) { const GAS f32x4* sp = (const GAS f32x4*)(SL + ((size_t)(ks * 8 + rr) * 256 + row) * DM) + lane_;
#pragma unroll
                    for (int j = 0; j < 8; ++j) y[j] += sp[64 * j] * g; }
            }
        }
        float ss = 0.f;
#pragma unroll
        for (int j = 0; j < 8; ++j) { v[j] = v[j] + gt[64 * j] * y[j]; ss += (v[j].x * v[j].x + v[j].y * v[j].y) + (v[j].z * v[j].z + v[j].w * v[j].w); }
        const float rstd = 1.0f / sqrtf(wave_sum(ss) * (1.0f / DM) + EPSN);
        const GAS f32x4* gf = (const GAS f32x4*)inptr(I_GFIN) + lane_;
        GAS f32x4* op = (GAS f32x4*)(F.out + (size_t)tok * DM) + lane_;
#pragma unroll
        for (int j = 0; j < 8; ++j) op[64 * j] = v[j] * rstd * gf[64 * j];
    }
}

namespace fa {
using bf16x8 = __attribute__((ext_vector_type(8))) short;
using s16x4  = __attribute__((ext_vector_type(4))) short;
using f32x16 = __attribute__((ext_vector_type(16))) float;
using u32x4  = __attribute__((ext_vector_type(4))) unsigned;
constexpr int SHM_V = 64 * 128 * 2;
constexpr float THRN = 8.f;
#define FA_SBAR() __builtin_amdgcn_sched_barrier(0)
__device__ __forceinline__ int kswz(int row, int colB, int pitch) { return row * pitch + (colB ^ ((row & 7) << 4)); }
__device__ __forceinline__ int crow(int r, int hi) { return (r & 3) + 8 * (r >> 2) + 4 * hi; }
__device__ __forceinline__ unsigned cvtpk(float lo, float hi) { unsigned r; asm volatile("v_cvt_pk_bf16_f32 %0, %1, %2" : "=v"(r) : "v"(lo), "v"(hi)); return r; }

__device__ __forceinline__ void partialSM(f32x16& p0, f32x16& p1, float& m_reg, float& mn, float& alpha, const float C, const float thr_raw) {
  float pmax = p0[0];
#pragma unroll
  for (int r = 1; r < 16; ++r) pmax = fmaxf(pmax, p0[r]);
#pragma unroll
  for (int r = 0; r < 16; ++r) pmax = fmaxf(pmax, p1[r]);
  { auto rr = __builtin_amdgcn_permlane32_swap(__float_as_uint(pmax), __float_as_uint(pmax), false, false);
    pmax = fmaxf(__uint_as_float(rr[0]), __uint_as_float(rr[1])); }
  if (__builtin_expect(__all(pmax - m_reg <= thr_raw), 1)) { mn = m_reg; alpha = 1.f; }
  else { mn = fmaxf(m_reg, pmax); alpha = __builtin_amdgcn_exp2f((m_reg - mn) * C); m_reg = mn; }
  const float mnC = -mn * C;
#pragma unroll
  for (int r = 0; r < 16; ++r) p0[r] = fmaf(p0[r], C, mnC);
#pragma unroll
  for (int r = 0; r < 16; ++r) p1[r] = fmaf(p1[r], C, mnC);
#pragma unroll
  for (int r = 0; r < 16; ++r) p0[r] = __builtin_amdgcn_exp2f(p0[r]);
}
__device__ __forceinline__ void finishSM(f32x16& p0, f32x16& p1, float alpha, float& l_reg, bf16x8& pa0, bf16x8& pa1, bf16x8& pa2, bf16x8& pa3) {
#pragma unroll
  for (int r = 0; r < 16; ++r) p1[r] = __builtin_amdgcn_exp2f(p1[r]);
  float ps = 0;
#pragma unroll
  for (int r = 0; r < 16; ++r) ps += p0[r];
#pragma unroll
  for (int r = 0; r < 16; ++r) ps += p1[r];
  { auto rr = __builtin_amdgcn_permlane32_swap(__float_as_uint(ps), __float_as_uint(ps), false, false);
    ps = __uint_as_float(rr[0]) + __uint_as_float(rr[1]); }
  l_reg = l_reg * alpha + ps;
#define FA_PK4(P, BASE, OUT) do { unsigned a0 = cvtpk(P[BASE + 0], P[BASE + 1]), a1 = cvtpk(P[BASE + 2], P[BASE + 3]);   \
    unsigned b0 = cvtpk(P[BASE + 4], P[BASE + 5]), b1 = cvtpk(P[BASE + 6], P[BASE + 7]);                              \
    auto r0 = __builtin_amdgcn_permlane32_swap(a0, b0, false, false); auto r1 = __builtin_amdgcn_permlane32_swap(a1, b1, false, false); \
    u32x4 w = {r0[0], r1[0], r0[1], r1[1]}; OUT = __builtin_bit_cast(bf16x8, w); } while (0)
  FA_PK4(p0, 0, pa0); FA_PK4(p0, 8, pa1); FA_PK4(p1, 0, pa2); FA_PK4(p1, 8, pa3);
#undef FA_PK4
}
template <int DK>
__device__ __forceinline__ void qkt(f32x16& p0, f32x16& p1, const LAS unsigned char* Ks, const bf16x8 (&qr)[DK / 16], int r32, int hi) {
  p0 = f32x16{}; p1 = f32x16{};
#pragma unroll
  for (int d0 = 0; d0 < DK / 16; ++d0) { const int cb = (d0 * 16 + hi * 8) * 2;
    const bf16x8 b0 = *(const LAS bf16x8*)(Ks + kswz(r32, cb, DK * 2));
    const bf16x8 b1 = *(const LAS bf16x8*)(Ks + kswz(32 + r32, cb, DK * 2));
    p0 = __builtin_amdgcn_mfma_f32_32x32x16_bf16(b0, qr[d0], p0, 0, 0, 0);
    p1 = __builtin_amdgcn_mfma_f32_32x32x16_bf16(b1, qr[d0], p1, 0, 0, 0); }
}
__device__ __forceinline__ int v_st(int k, int c) { const int kk = (k & ~0xC) | ((k & 4) << 1) | ((k & 8) >> 1); return ((kk >> 3) * 4 + (c >> 5)) * 512 + ((kk & 7) * 32 + (c & 31)) * 2; }
__device__ __forceinline__ int v_rd_base(int lane) { return ((lane & 3) << 3) | (((lane >> 2) & 3) << 6) | (((lane >> 4) & 1) << 5) | (((lane >> 5) & 1) << 8); }
constexpr int v_rd_off(int d0, int ks, int half) { return d0 * 512 + ks * 4096 + half * 2048; }
template <int OFF> __device__ __forceinline__ s16x4 tr_read(int vb) {
  s16x4 r; asm volatile("ds_read_b64_tr_b16 %0, %1 offset:%2" : "=&v"(r) : "v"(vb), "i"(OFF) : "memory"); return r;
}
template <int D0> __device__ __forceinline__ void pv_one(f32x16& od, int vb, bf16x8 pa0, bf16x8 pa1, bf16x8 pa2, bf16x8 pa3) {
  const s16x4 l0 = tr_read<v_rd_off(D0, 0, 0)>(vb), h0 = tr_read<v_rd_off(D0, 0, 1)>(vb), l1 = tr_read<v_rd_off(D0, 1, 0)>(vb), h1 = tr_read<v_rd_off(D0, 1, 1)>(vb);
  const s16x4 l2 = tr_read<v_rd_off(D0, 2, 0)>(vb), h2 = tr_read<v_rd_off(D0, 2, 1)>(vb), l3 = tr_read<v_rd_off(D0, 3, 0)>(vb), h3 = tr_read<v_rd_off(D0, 3, 1)>(vb);
  asm volatile("s_waitcnt lgkmcnt(0)" ::: "memory"); FA_SBAR();
#define FA_PK(L, H) (bf16x8){L[0], L[1], L[2], L[3], H[0], H[1], H[2], H[3]}
  od = __builtin_amdgcn_mfma_f32_32x32x16_bf16(pa0, FA_PK(l0, h0), od, 0, 0, 0);
  od = __builtin_amdgcn_mfma_f32_32x32x16_bf16(pa1, FA_PK(l1, h1), od, 0, 0, 0);
  od = __builtin_amdgcn_mfma_f32_32x32x16_bf16(pa2, FA_PK(l2, h2), od, 0, 0, 0);
  od = __builtin_amdgcn_mfma_f32_32x32x16_bf16(pa3, FA_PK(l3, h3), od, 0, 0, 0);
#undef FA_PK
}
__device__ __forceinline__ void pv_d0(f32x16 (&o)[4], int vb, bf16x8 pa0, bf16x8 pa1, bf16x8 pa2, bf16x8 pa3) {
  pv_one<0>(o[0], vb, pa0, pa1, pa2, pa3); pv_one<1>(o[1], vb, pa0, pa1, pa2, pa3); pv_one<2>(o[2], vb, pa0, pa1, pa2, pa3); pv_one<3>(o[3], vb, pa0, pa1, pa2, pa3);
}

struct TileMap { int k0, lat0, r_lo; bool na;
  __device__ __forceinline__ int row(int j) const { if (!na || j < 4) return k0 + 64 * j; const int g = min(r_lo + j - 4, 31); return lat0 + 64 * g; } };
struct NaLane { int qr, qc, rs, cs; const LAS float* btab; };

__device__ __forceinline__ void na_mask(f32x16& p0, f32x16& p1, int j, const TileMap& tm, const NaLane& nl, int hi) {
  if (j < 4) return;
  const int kr = tm.r_lo + j - 4; const bool rowok = (kr >= nl.rs) && (kr < nl.rs + 8);
  const int b0 = (kr - nl.qr + 7) * 31 + 15 - nl.qc;
#pragma unroll
  for (int r = 0; r < 16; ++r) {
    const int kc0 = crow(r, hi), kc1 = 32 + kc0;
    const bool ok0 = rowok && (kc0 >= nl.cs) && (kc0 < nl.cs + 16), ok1 = rowok && (kc1 >= nl.cs) && (kc1 < nl.cs + 16);
    float bv0 = 0.f, bv1 = 0.f; if (ok0) bv0 = nl.btab[b0 + kc0]; if (ok1) bv1 = nl.btab[b0 + kc1];
    p0[r] = ok0 ? p0[r] + bv0 : -1e30f; p1[r] = ok1 ? p1[r] + bv1 : -1e30f;
  }
}

template <int DK, int SDEPTH, bool NA>
__device__ __forceinline__ void body(const bf16* Qb, int ldq, const bf16* Kp, int ldk, const bf16* Vp, int ldv, const TileMap tm, const int NT, const float scale,
                                     const NaLane nl, LAS unsigned char* lds, f32x16 (&o)[4]) {
  constexpr int KP = DK / 64, SHM_K = 64 * DK * 2, KCH = DK / 8;
  int tid = threadIdx.x; asm volatile("" : "+v"(tid));
  const int wid = tid >> 6, lane = tid & 63, r32 = lane & 31, hi = lane >> 5;
  LAS unsigned char* V_lds = lds; LAS unsigned char* K_lds = lds + 2 * SHM_V;
  LAS float* wsl = (LAS float*)(lds + 2 * SHM_V + 2 * SHM_K) + wid * 64; LAS float* li_l = wsl; LAS float* al_l = wsl + 32;
  const float C = scale * 1.4426950408889634f, thr_raw = THRN / scale;
  float m_reg = -1e30f, l_reg = 0;
#pragma unroll
  for (int d = 0; d < 4; ++d) o[d] = f32x16{};
  bf16x8 qr[DK / 16];
  { const bf16* Qw = Qb + (long)(wid * 32 + r32) * ldq + hi * 8;
#pragma unroll
    for (int d0 = 0; d0 < DK / 16; ++d0) qr[d0] = *(const GAS bf16x8*)(Qw + d0 * 16); }
  const int sr = tid >> 4, sc = (tid & 15) * 8, vst0 = v_st(sr, sc), vst1 = v_st(32 + sr, sc);
  int krow[KP], kcol[KP], kst[KP];
#pragma unroll
  for (int i = 0; i < KP; ++i) { const int c = tid + 512 * i; krow[i] = c / KCH; kcol[i] = (c % KCH) * 8; kst[i] = kswz(krow[i], kcol[i] * 2, DK * 2); }
  const int vb0 = (int)(unsigned)(unsigned long)(V_lds) + v_rd_base(lane);
  struct Slot { bf16x8 vs0, vs1, ks[KP]; } sl[SDEPTH];
#define FA_SLOAD(i, j) do { const int r0_ = tm.row(j); sl[i].vs0 = *(const GAS bf16x8*)(Vp + (long)(r0_ + sr) * ldv + sc); sl[i].vs1 = *(const GAS bf16x8*)(Vp + (long)(r0_ + 32 + sr) * ldv + sc); \
    _Pragma("unroll") for (int q_ = 0; q_ < KP; ++q_) sl[i].ks[q_] = *(const GAS bf16x8*)(Kp + (long)(r0_ + krow[q_]) * ldk + kcol[q_]); } while (0)
#define FA_SWRITE(b, i) do { *(LAS bf16x8*)(V_lds + (b) * SHM_V + vst0) = sl[i].vs0; *(LAS bf16x8*)(V_lds + (b) * SHM_V + vst1) = sl[i].vs1; \
    _Pragma("unroll") for (int q_ = 0; q_ < KP; ++q_) *(LAS bf16x8*)(K_lds + (b) * SHM_K + kst[q_]) = sl[i].ks[q_]; } while (0)
#define FA_SWAIT() do { if constexpr (SDEPTH == 2) asm volatile("s_waitcnt vmcnt(%0)" :: "n"(2 + KP) : "memory"); else asm volatile("s_waitcnt vmcnt(0)" ::: "memory"); } while (0)
#define FA_RESC(a) do { if (__any((a) < 1.f)) { if (hi == 0) al_l[r32] = (a); asm volatile("s_waitcnt lgkmcnt(0)" ::: "memory"); \
    _Pragma("unroll") for (int d = 0; d < 4; ++d) _Pragma("unroll") for (int r = 0; r < 16; ++r) o[d][r] *= al_l[crow(r, hi)]; } } while (0)
#define FA_QKT(P0, P1, buf, j) do { qkt<DK>(P0, P1, K_lds + (buf) * SHM_K, qr, r32, hi); if constexpr (NA) na_mask(P0, P1, j, tm, nl, hi); } while (0)
  f32x16 pA0, pA1, pB0, pB1; float mnA, mnB, alA, alB; bf16x8 pa0, pa1, pa2, pa3;
  constexpr int SE = 0, SO = SDEPTH - 1;
  FA_SLOAD(SE, 0); asm volatile("s_waitcnt vmcnt(0)" ::: "memory"); FA_SWRITE(0, SE); __syncthreads();
  FA_QKT(pA0, pA1, 0, 0); partialSM(pA0, pA1, m_reg, mnA, alA, C, thr_raw);
  FA_SLOAD(SO, 1); if constexpr (SDEPTH == 2) { if (2 < NT) FA_SLOAD(SE, 2); }
  FA_SWAIT(); FA_SWRITE(1, SO); __syncthreads();
  for (int j = 1; j + 1 < NT; j += 2) {
    FA_SBAR(); FA_QKT(pB0, pB1, 1, j);
    finishSM(pA0, pA1, alA, l_reg, pa0, pa1, pa2, pa3); FA_SBAR();
    FA_SLOAD(SO, j + SDEPTH); FA_SBAR();
    pv_d0(o, vb0, pa0, pa1, pa2, pa3); partialSM(pB0, pB1, m_reg, mnB, alB, C, thr_raw);
    __syncthreads(); FA_SWAIT(); FA_SWRITE(0, SE);
    FA_RESC(alB); __syncthreads();
    FA_SBAR(); FA_QKT(pA0, pA1, 0, j + 1);
    finishSM(pB0, pB1, alB, l_reg, pa0, pa1, pa2, pa3); FA_SBAR();
    if (SDEPTH == 1 || j + 3 < NT) FA_SLOAD(SE, j + 1 + SDEPTH); FA_SBAR();
    pv_d0(o, vb0 + SHM_V, pa0, pa1, pa2, pa3); partialSM(pA0, pA1, m_reg, mnA, alA, C, thr_raw);
    __syncthreads(); FA_SWAIT(); FA_SWRITE(1, SO);
    FA_RESC(alA); __syncthreads();
  }
  FA_SBAR(); FA_QKT(pB0, pB1, 1, NT - 1);
  finishSM(pA0, pA1, alA, l_reg, pa0, pa1, pa2, pa3); FA_SBAR();
  pv_d0(o, vb0, pa0, pa1, pa2, pa3); partialSM(pB0, pB1, m_reg, mnB, alB, C, thr_raw);
  __syncthreads(); FA_RESC(alB);
  finishSM(pB0, pB1, alB, l_reg, pa0, pa1, pa2, pa3); FA_SBAR();
  pv_d0(o, vb0 + SHM_V, pa0, pa1, pa2, pa3);
  if (hi == 0) li_l[r32] = l_reg; asm volatile("s_waitcnt lgkmcnt(0)" ::: "memory");
#pragma unroll
  for (int r = 0; r < 16; ++r) { const float rl = __builtin_amdgcn_rcpf(li_l[crow(r, hi)]);
#pragma unroll
    for (int d0 = 0; d0 < 4; ++d0) o[d0][r] *= rl; }
#undef FA_SLOAD
#undef FA_SWRITE
#undef FA_SWAIT
#undef FA_RESC
#undef FA_QKT
}

template <int DK, bool NA>
__device__ __forceinline__ void body_seq(const bf16* Qb, int ldq, const bf16* Kp, int ldk, const bf16* Vp, int ldv, const TileMap tm, const int NT, const float scale,
                                         const NaLane nl, LAS unsigned char* lds, f32x16 (&o)[4]) {
  constexpr int KP = DK / 64, SHM_K = 64 * DK * 2, KCH = DK / 8;
  int tid = threadIdx.x; asm volatile("" : "+v"(tid));
  const int wid = tid >> 6, lane = tid & 63, r32 = lane & 31, hi = lane >> 5;
  LAS unsigned char* V_lds = lds; LAS unsigned char* K_lds = lds + 2 * SHM_V;
  LAS float* wsl = (LAS float*)(lds + 2 * SHM_V + 2 * SHM_K) + wid * 64; LAS float* li_l = wsl; LAS float* al_l = wsl + 32;
  const float C = scale * 1.4426950408889634f, thr_raw = THRN / scale;
  float m_reg = -1e30f, l_reg = 0;
#pragma unroll
  for (int d = 0; d < 4; ++d) o[d] = f32x16{};
  bf16x8 qr[DK / 16];
  { const bf16* Qw = Qb + (long)(wid * 32 + r32) * ldq + hi * 8;
#pragma unroll
    for (int d0 = 0; d0 < DK / 16; ++d0) qr[d0] = *(const GAS bf16x8*)(Qw + d0 * 16); }
  const int sr = tid >> 4, sc = (tid & 15) * 8, vst0 = v_st(sr, sc), vst1 = v_st(32 + sr, sc);
  int krow[KP], kcol[KP], kst[KP];
#pragma unroll
  for (int i = 0; i < KP; ++i) { const int c = tid + 512 * i; krow[i] = c / KCH; kcol[i] = (c % KCH) * 8; kst[i] = kswz(krow[i], kcol[i] * 2, DK * 2); }
  const int vb0 = (int)(unsigned)(unsigned long)(V_lds) + v_rd_base(lane);
  bf16x8 vs0, vs1, ks[KP];
#define FS_SLOAD(j) do { const int r0_ = tm.row(j); vs0 = *(const GAS bf16x8*)(Vp + (long)(r0_ + sr) * ldv + sc); vs1 = *(const GAS bf16x8*)(Vp + (long)(r0_ + 32 + sr) * ldv + sc); \
    _Pragma("unroll") for (int q_ = 0; q_ < KP; ++q_) ks[q_] = *(const GAS bf16x8*)(Kp + (long)(r0_ + krow[q_]) * ldk + kcol[q_]); } while (0)
#define FS_SWRITE(b) do { *(LAS bf16x8*)(V_lds + (b) * SHM_V + vst0) = vs0; *(LAS bf16x8*)(V_lds + (b) * SHM_V + vst1) = vs1; \
    _Pragma("unroll") for (int q_ = 0; q_ < KP; ++q_) *(LAS bf16x8*)(K_lds + (b) * SHM_K + kst[q_]) = ks[q_]; } while (0)
  FS_SLOAD(0); FS_SWRITE(0); __syncthreads();
#pragma unroll 1
  for (int j = 0; j < NT; ++j) {
    const int b = j & 1;
    if (j + 1 < NT) FS_SLOAD(j + 1);
    f32x16 p0, p1; float mn, al; bf16x8 pa0, pa1, pa2, pa3;
    qkt<DK>(p0, p1, K_lds + b * SHM_K, qr, r32, hi);
    if constexpr (NA) na_mask(p0, p1, j, tm, nl, hi);
    partialSM(p0, p1, m_reg, mn, al, C, thr_raw);
    finishSM(p0, p1, al, l_reg, pa0, pa1, pa2, pa3);
    if (__any(al < 1.f)) { if (hi == 0) al_l[r32] = al; asm volatile("s_waitcnt lgkmcnt(0)" ::: "memory");
#pragma unroll
      for (int d = 0; d < 4; ++d)
#pragma unroll
        for (int r = 0; r < 16; ++r) o[d][r] *= al_l[crow(r, hi)]; }
    FA_SBAR();
    pv_d0(o, vb0 + b * SHM_V, pa0, pa1, pa2, pa3);
    if (j + 1 < NT) FS_SWRITE(b ^ 1);
    __syncthreads();
  }
  if (hi == 0) li_l[r32] = l_reg; asm volatile("s_waitcnt lgkmcnt(0)" ::: "memory");
#pragma unroll
  for (int r = 0; r < 16; ++r) { const float rl = __builtin_amdgcn_rcpf(li_l[crow(r, hi)]);
#pragma unroll
    for (int d0 = 0; d0 < 4; ++d0) o[d0][r] *= rl; }
#undef FS_SLOAD
#undef FS_SWRITE
}
}

__device__ __forceinline__ void fa_store(const fa::f32x16 (&o)[4], LAS unsigned char* lds, bf16* Orow0  , bool do_norm, const float* gsub, float post) {
    int tid = threadIdx.x; asm volatile("" : "+v"(tid));
    const int wid = tid >> 6, lane = tid & 63, r32 = lane & 31, hi = lane >> 5;
    LAS float* slab = (LAS float*)(lds + wid * 16384);
    __syncthreads();
#pragma unroll
    for (int r = 0; r < 16; ++r) { const int row = fa::crow(r, hi);
#pragma unroll
        for (int d0 = 0; d0 < 4; ++d0) slab[row * 128 + d0 * 32 + r32] = o[d0][r]; }
    LDS_WAIT();
    const int row = lane >> 1, half = lane & 1;
    const LAS f32x4* src = (const LAS f32x4*)(slab + row * 128 + half * 64);
    f32x4 v[16]; float ss = 0.f;
#pragma unroll
    for (int c = 0; c < 16; ++c) { v[c] = src[c]; ss += (v[c].x * v[c].x + v[c].y * v[c].y) + (v[c].z * v[c].z + v[c].w * v[c].w); }
    float sc = 1.0f;
    if (do_norm) { ss += __shfl_xor(ss, 1); sc = post / sqrtf(ss * (1.0f / 128.0f) + EPSN);
#pragma unroll
        for (int c = 0; c < 16; ++c) v[c] = v[c] * *(const GAS f32x4*)(gsub + half * 64 + 4 * c); }
    GAS v4u* dst = (GAS v4u*)(Orow0 + (size_t)(wid * 32 + row) * DM + half * 64);
#pragma unroll
    for (int c = 0; c < 8; ++c) { const f32x4 a = v[2 * c] * sc, b = v[2 * c + 1] * sc; v4u w; w.x = pk2(a.x, a.y); w.y = pk2(a.z, a.w); w.z = pk2(b.x, b.y); w.w = pk2(b.z, b.w); dst[c] = w; }
    __syncthreads();
}

__device__ __forceinline__ void attn_unit_fa(Frame& F, int layer, int b, bool latent, int qb, int type, int h) {
    unsigned char* ws = F.ws;
    const bf16* QKV = (const bf16*)(ws + WS_QKV); const bf16* QM = (const bf16*)(ws + WS_QM); const bf16* KVM = (const bf16*)(ws + WS_KVM); bf16* O = (bf16*)(ws + WS_O);
    const int q0 = b * TPB + (latent ? CTXL + qb * 256 : 0);
    const int kall0 = b * TPB, ntall = latent ? TPB / 64 : CTXL / 64;
    bf16* orow0 = O + (size_t)q0 * DM + type * 512 + h * 128;
    fa::TileMap tm; tm.k0 = kall0; tm.lat0 = kall0 + CTXL; tm.r_lo = 0; tm.na = false;
    fa::NaLane nl; nl.qr = 0; nl.qc = 0; nl.rs = 0; nl.cs = 0; nl.btab = nullptr;
    fa::f32x16 o[4];
#ifdef FA_ONLY
    type = FA_ONLY; if (FA_ONLY != 4) latent = FA_ONLY != 0 ? latent : false; else { type = 0; latent = true; }
#endif
    if (type == 0 && latent) {
        const int r_lo = min(max(4 * qb - 4, 0), 24), r_hi = min(max(4 * qb + 3 - 4, 0), 24) + 8;
        tm.na = true; tm.r_lo = r_lo; int nt = 4 + (r_hi - r_lo); nt += nt & 1;
        LAS float* bt = (LAS float*)(F.lds + 100 * 1024);
        const float* bsrc = inptr(I_NABIAS) + ((size_t)layer * 4 + h) * 465;
        __syncthreads();
        for (int i = TIDX; i < 465; i += 512) bt[i] = bsrc[i] * (1.0f / SC_NA);
        __syncthreads();
        const int t = qb * 256 + (TIDX >> 6) * 32 + (TIDX & 31);
        nl.qr = t >> 6; nl.qc = t & 63; nl.rs = min(max(nl.qr - 4, 0), 24); nl.cs = min(max(nl.qc - 8, 0), 48); nl.btab = bt;
        fa::body_seq<128, true>(QKV + (size_t)q0 * INCP + C_NAQ + 128 * h, INCP, QKV + C_NAK + 128 * h, INCP, QKV + C_NAV + 128 * h, INCP, tm, nt, SC_NA, nl, F.lds, o);
        fa_store(o, F.lds, orow0, false, nullptr, 1.0f);
    } else if (type == 0 || type == 2) {
        const int qc = (type == 0) ? C_NAQ + 128 * h : C_GQ + 128 * h, kc = (type == 0) ? C_NAK + 128 * h : C_GK + 128 * (h >> 1), vc = (type == 0) ? C_NAV + 128 * h : C_GV + 128 * (h >> 1);
        fa::body<128, 2, false>(QKV + (size_t)q0 * INCP + qc, INCP, QKV + kc, INCP, QKV + vc, INCP, tm, ntall, SC_NA, nl, F.lds, o);
        fa_store(o, F.lds, orow0, false, nullptr, 1.0f);
    } else if (type == 1) {
        fa::body_seq<192, false>(QM + (size_t)q0 * QMW + 192 * h, QMW, KVM + 320 * h, KVW, KVM + 320 * h + 192, KVW, tm, ntall, SC_MLA, nl, F.lds, o);
        fa_store(o, F.lds, orow0, false, nullptr, 1.0f);
    } else {
        const float lam_init = layer == 0 ? 0.2f : 0.35550906759096926f;
        LAS float* lm = (LAS float*)(F.lds + 100 * 1024);
        __syncthreads();
        if (TIDX < 64) { const float a = wave_sum(inptr(I_LQ1)[layer * 64 + TIDX] * inptr(I_LK1)[layer * 64 + TIDX]), c = wave_sum(inptr(I_LQ2)[layer * 64 + TIDX] * inptr(I_LK2)[layer * 64 + TIDX]);
            if (TIDX == 0) lm[0] = expf(a) - expf(c) + lam_init; }
        __syncthreads();
        const float lam = lm[0];
        GAS f32x4* stash = (GAS f32x4*)((float*)(ws + WS_U) + ((size_t)blockIdx.x * 512 + TIDX) * 64);
#pragma unroll 1
        for (int pass = 0; pass < 2; ++pass) {
            fa::body<64, 2, false>(QKV + (size_t)q0 * INCP + C_DQ + 128 * h + 64 * pass, INCP, QKV + C_DK + 128 * h + 64 * pass, INCP, QKV + C_DV + 128 * h, INCP, tm, ntall, SC_DIFF, nl, F.lds, o);
            if (pass == 0) {
#pragma unroll
                for (int d0 = 0; d0 < 4; ++d0)
#pragma unroll
                    for (int r4 = 0; r4 < 4; ++r4) stash[d0 * 4 + r4] = (f32x4){o[d0][4 * r4], o[d0][4 * r4 + 1], o[d0][4 * r4 + 2], o[d0][4 * r4 + 3]};
                __syncthreads();
            }
        }
#pragma unroll
        for (int d0 = 0; d0 < 4; ++d0)
#pragma unroll
            for (int r4 = 0; r4 < 4; ++r4) { const f32x4 s1 = stash[d0 * 4 + r4];
#pragma unroll
                for (int q = 0; q < 4; ++q) o[d0][4 * r4 + q] = s1[q] - lam * o[d0][4 * r4 + q]; }
        fa_store(o, F.lds, orow0, true, inptr(I_GSUB) + layer * 128, 1.0f - lam_init);
    }
}
#ifndef ATTN_Q0
#define ATTN_Q0 0
#endif
#ifndef ATTN_Q1
#define ATTN_Q1 0
#endif
__device__ __forceinline__ void attn_phase_fa(Frame& F, int layer) {
    const int total = 1024 + ((layer == 0) ? 128 : 0);
#pragma unroll 1
    for (int n = blockIdx.x; n < total; n += F.G) {
        int type, h, qb, b; bool latent = n < 1024;
        if (latent) { const int i = n >> 8, k = n & 255, idx = i * 64 + (k >> 2); type = (k + i) & 3; h = idx & 3; qb = (idx >> 2) & 7; b = idx >> 5; }
        else { const int v = n - 1024, hh = v & 15; type = hh >> 2; h = hh & 3; qb = 0; b = v >> 4; }
        attn_unit_fa(F, layer, b, latent, qb, type, h);
        if (ATTN_Q0 + ATTN_Q1 > 0) filler_quota(F, layer == 0 ? ATTN_Q0 : ATTN_Q1);
    }
    __syncthreads();
}

#ifndef REP_GEMM
#define REP_GEMM 1
#endif
#ifndef REP_WIN
#define REP_WIN REP_GEMM
#endif
#ifndef REP_FGU
#define REP_FGU REP_GEMM
#endif
#ifndef REP_PASS
#define REP_PASS 1
#endif
#ifndef WO_WGM
#define WO_WGM 4
#endif
#ifndef REV_DOWN
#define REV_DOWN 1
#endif
#ifndef FD_WGM
#define FD_WGM 4
#endif
#ifndef PROBE_HOTB
#define PROBE_HOTB 0
#endif
#ifndef PROBE_LATE_DENSE
#define PROBE_LATE_DENSE 0
#endif
#ifndef REP_FDN
#define REP_FDN REP_GEMM
#endif
#ifndef REP_MGU
#define REP_MGU REP_GEMM
#endif
#ifndef REP_MDN
#define REP_MDN REP_GEMM
#endif
#ifndef REP_ATTN
#define REP_ATTN 1
#endif
#ifndef REP_P0
#define REP_P0 1
#endif
#ifndef MK_MULTI
#define MK_MULTI 0
#endif
constexpr int PH_PER_LAYER = 11, N_PHASES = 1 + 2 * PH_PER_LAYER + 1;
struct Args { const float* in[31]; float* out; unsigned char* ws; int ph_lo, ph_hi; };
static_assert(sizeof(Args) == 31 * 8 + 8 + 8 + 8, "Args has no padding");

#define IN(k) (lo <= (k) && (k) < hi)
#if MK_MULTI
#define SEAM(k) do { } while (0)
#else
#define SEAM(k) do { if (IN(k) && IN((k) + 1)) xcd_barrier(bar); } while (0)
#endif
#ifndef FILL_BAR
#define FILL_BAR 1
#endif
#if MK_MULTI || !FILL_BAR
#define SEAM_FILL(k) SEAM(k)
#define TAIL_FILL(slot) filler(F, slot, -1)
#else
#define SEAM_FILL(k) do { if (IN(k) && IN((k) + 1)) xcd_barrier_fill(bar, F); } while (0)
#define TAIL_FILL(slot) do { } while (0)
#endif
__device__ __forceinline__ int opq_s(int v) { asm volatile("" : "+s"(v)); return v; }
template <int layer>
__device__ __forceinline__ void layer_phases(Frame& F, const XcdBarrier& bar, const int lo, const int hi, LAS int* mtab) {
    unsigned char* ws = F.ws; asm volatile("" : "+s"(ws));
        const int pb = 1 + layer * PH_PER_LAYER;
        const float* modl = (const float*)(ws + WS_MOD) + (size_t)layer * 9 * MODW;
#ifndef SKIP_NORM
        if (IN(pb + 0)) for (int rp_ = 0; rp_ < REP_PASS; ++rp_) norm_pass(F, layer, true, layer == 0, layer == 1);
#endif
        SEAM_FILL(pb + 0);
        if (IN(pb + 1)) {
            pg8::Gemm g{(const bf16*)(ws + WS_U), (const bf16*)(ws + WS_WIN) + (size_t)layer * INCP * 2048, MT, INCP, 2048, 2048, 2048};
            pg8::StaticOrder S; S.init(MT, INCP, F.G, opq_s((int)blockIdx.x));
            pg8::EpiBf16P E{(bf16*)(ws + WS_QKV), INCP, 0};
            for (int rep_ = 0; rep_ < REP_WIN; ++rep_) { pg8::gemm_phase<pg8::EpiBf16P, pg8::StaticOrder, PG8_ALIGN, PG8_SP2>(F.lds + RING_OFF, g, S, E); if (rep_ + 1 < REP_WIN) __syncthreads(); }
            TAIL_FILL(layer * 8 + 0);
        }
        SEAM_FILL(pb + 1);
#ifndef SKIP_POST
        if (IN(pb + 2)) post_pass(F, layer);
#endif
        SEAM_FILL(pb + 2);
#ifndef SKIP_UP
        if (IN(pb + 3)) {
            { pg8::Gemm g{(const bf16*)(ws + WS_QKV) + C_CQ, (const bf16*)(ws + WS_WQUP) + (size_t)layer * QMW * 384, MT, QMW, opq_s(384), INCP, 384};
              pg8::StaticOrder S; S.init(MT, QMW, F.G, opq_s((int)blockIdx.x));
              pg8::EpiQupRope E{(bf16*)(ws + WS_QM), (const float*)(ws + WS_ROPE)};
              for (int rep_ = 0; rep_ < REP_GEMM; ++rep_) { pg8::gemm_phase<pg8::EpiQupRope, pg8::StaticOrder, PG8_ALIGN, PG8_SP2>(F.lds + RING_OFF, g, S, E); if (rep_ + 1 < REP_GEMM) __syncthreads(); } }
            __syncthreads();
            { pg8::Gemm g{(const bf16*)(ws + WS_QKV) + C_CKV, (const bf16*)(ws + WS_WKVUP) + (size_t)layer * KVW * 256, MT, KVW, opq_s(256), INCP, 256};
              pg8::StaticOrder S; S.init(MT, KVW, F.G, opq_s((int)blockIdx.x));
              pg8::EpiBf16P E{(bf16*)(ws + WS_KVM), KVW, 0};
              for (int rep_ = 0; rep_ < REP_GEMM; ++rep_) { pg8::gemm_phase<pg8::EpiBf16P, pg8::StaticOrder, PG8_ALIGN, PG8_SP2>(F.lds + RING_OFF, g, S, E); if (rep_ + 1 < REP_GEMM) __syncthreads(); } }
            TAIL_FILL(layer * 8 + 1);
        }
#endif
        SEAM_FILL(pb + 3);
        #ifndef SKIP_ATTN
        if (IN(pb + 5)) {
#pragma unroll
            for (int rep_ = 0; rep_ < REP_ATTN; ++rep_) attn_phase_fa(F, layer);
            TAIL_FILL(layer * 8 + 2); }
#endif
        SEAM_FILL(pb + 5);
#ifndef SKIP_WOUT
        if (IN(pb + 6)) {
            pg8::Gemm g{(const bf16*)(ws + WS_O), (const bf16*)(ws + WS_WOUT) + (size_t)layer * 2048 * 2048, MT, 2048, 2048, 2048, 2048};
            pg8::EpiResGate E{(float*)(ws + WS_H), modl + 2 * DM, layer == 0 ? inptr(I_X) : nullptr, layer == 0 ? inptr(I_CTX) : nullptr};
            pg8::EpiResGate Ed{(float*)(ws + WS_R2), modl + 2 * DM, nullptr, nullptr}; (void)Ed;
            if constexpr (layer == 0) { pg8::StaticOrder S; S.init(MT, 2048, F.G, opq_s((int)blockIdx.x), WO_WGM); for (int rep_ = 1; rep_ < REP_GEMM; ++rep_) { pg8::gemm_phase<pg8::EpiResGate, pg8::StaticOrder, PG8_ALIGN, PG8_SP2>(F.lds + RING_OFF, g, S, Ed); __syncthreads(); } pg8::gemm_phase<pg8::EpiResGate, pg8::StaticOrder, PG8_ALIGN, PG8_SP2>(F.lds + RING_OFF, g, S, E); }
            else { pg8::LatentOrder S; S.init(NBATCH * SEQ, 2048, F.G, opq_s((int)blockIdx.x), WO_WGM); for (int rep_ = 1; rep_ < REP_GEMM; ++rep_) { pg8::gemm_phase<pg8::EpiResGate, pg8::LatentOrder, PG8_ALIGN, PG8_SP2>(F.lds + RING_OFF, g, S, Ed); __syncthreads(); } pg8::gemm_phase<pg8::EpiResGate, pg8::LatentOrder, PG8_ALIGN, PG8_SP2>(F.lds + RING_OFF, g, S, E); }            TAIL_FILL(layer * 8 + 3);
        }
#endif
        SEAM_FILL(pb + 6);
        if constexpr (layer == 0) {
#ifndef SKIP_DENSE
            if (IN(pb + 7)) { for (int rp_ = 0; rp_ < REP_PASS; ++rp_) norm_pass(F, layer, false, false); filler(F, layer * 8 + 6, CVQ_FFN_END); }
            SEAM_FILL(pb + 7);
            if (IN(pb + 9)) {
                pg8::Gemm g{(const bf16*)(ws + WS_U), (const bf16*)(ws + WS_WGU), MT, 2 * DFF, 2048, 2048, 2048};
                pg8::StaticOrder S; S.init(MT, 2 * DFF, F.G, opq_s((int)blockIdx.x));
                pg8::EpiSwiGLU E{(bf16*)(ws + WS_HM), DFF, 0};
                for (int rep_ = 0; rep_ < REP_FGU; ++rep_) { pg8::gemm_phase<pg8::EpiSwiGLU, pg8::StaticOrder, PG8_ALIGN, PG8_SP2>(F.lds + RING_OFF, g, S, E); if (rep_ + 1 < REP_FGU) __syncthreads(); }                TAIL_FILL(layer * 8 + 4);
            }
            SEAM_FILL(pb + 9);
            if (IN(pb + 10)) {
                pg8::Gemm g{(const bf16*)(ws + WS_HM), (const bf16*)(ws + WS_WD), MT, 2048, DFF, DFF, DFF, 0, 0, REV_DOWN};
                pg8::LatentOrder S; S.init(NBATCH * SEQ, 2048, F.G, opq_s((int)blockIdx.x), FD_WGM);
                pg8::EpiResGate E{(float*)(ws + WS_H), modl + 5 * DM, nullptr, nullptr};
                pg8::gemm_phase<pg8::EpiResGate, pg8::LatentOrder, PG8_ALIGN, PG8_SP2>(F.lds + RING_OFF, g, S, E);
                __syncthreads();
                { pg8::Gemm g2{(const bf16*)(ws + WS_HM), (const bf16*)(ws + WS_WD), MT, 2048, opq_s(1408), DFF, DFF, 0, 0, REV_DOWN};
                  pg8::CtxRemOrder S2; S2.G = F.G; S2.c = opq_s((int)blockIdx.x);
                  pg8::EpiSlab E2{(float*)(ws + WS_R1), 1.0f, 1408};
                  pg8::gemm_phase<pg8::EpiSlab, pg8::CtxRemOrder, PG8_ALIGN, PG8_SP2>(F.lds + RING_OFF, g2, S2, E2); }
                TAIL_FILL(layer * 8 + 5);
            }
            SEAM_FILL(pb + 10);
#endif
        } else {
#ifndef SKIP_MOE
            if (IN(pb + 7)) for (int rp_ = 0; rp_ < REP_PASS; ++rp_) moe_route_pass(F, layer);
            SEAM_FILL(pb + 7);
            if (IN(pb + 8)) { for (int rp_ = 0; rp_ < REP_PASS; ++rp_) moe_scatter_pass(F, layer); filler(F, layer * 8 + 6, CVQ_N); }
            SEAM(pb + 8);
            if (IN(pb + 9)) {
#if PROBE_LATE_DENSE
                {
                    pg8::Gemm gd{(const bf16*)(ws + WS_U), (const bf16*)(ws + WS_WGU), MT, 2 * DFF, 2048, 2048, 2048};
                    pg8::StaticOrder Sd; Sd.init(MT, 2 * DFF, F.G, opq_s((int)blockIdx.x));
                    pg8::EpiSwiGLU Ed{(bf16*)(ws + WS_R1), DFF, 0};
                    pg8::gemm_phase<pg8::EpiSwiGLU, pg8::StaticOrder, PG8_ALIGN, PG8_SP2>(F.lds + RING_OFF, gd, Sd, Ed);
                    __syncthreads();
                }
#endif
                moe_tables(F, mtab, 0);
                pg8::Gemm g{(const bf16*)(ws + WS_AS), (const bf16*)(ws + WS_MGU), 0, 2 * DFE, 2048, 2048, 2048, 0, KT_MOE};
                pg8::MoeOrder S; S.init(__builtin_amdgcn_readfirstlane(mtab[24]) * 256, 2 * DFE, F.G, opq_s((int)blockIdx.x));
                S.tab = mtab;
                pg8::EpiSwiGLU E{(bf16*)(ws + WS_HM2), DFE, 2 * DFE / 256, MOE_FP8 ? 1.0f / pg8::MOE_WSCALE : 1.0f};
                for (int rep_ = 0; rep_ < REP_MGU; ++rep_) { pg8::gemm_phase<pg8::EpiSwiGLU, pg8::MoeOrder, PG8_ALIGN, PG8_SP2, (MOE_FP8 != 0)>(F.lds + RING_OFF, g, S, E); if (rep_ + 1 < REP_MGU) __syncthreads(); }
            }
            SEAM(pb + 9);
            if (IN(pb + 10)) {
                moe_tables(F, mtab, 0);
                pg8::Gemm g{(const bf16*)(ws + WS_HM2), (const bf16*)(ws + WS_MD), 0, 2048, DFE, DFE, DFE, KT_MOE, KT_MOE, REV_DOWN};
#define RFL(i) __builtin_amdgcn_readfirstlane(mtab[i])
                { pg8::MoeFullOrder S; S.init(RFL(56) * 256, 2048, F.G, opq_s((int)blockIdx.x));
                  S.tab = mtab;
                  pg8::EpiBf16P E{(bf16*)(ws + WS_Y), 2048, 8, MOE_FP8 ? 1.0f / pg8::MOE_WSCALE : 1.0f};
                  for (int rep_ = 0; rep_ < REP_MDN; ++rep_) { pg8::gemm_phase<pg8::EpiBf16P, pg8::MoeFullOrder, PG8_ALIGN, PG8_SP2, (MOE_FP8 != 0)>(F.lds + RING_OFF, g, S, E); if (rep_ + 1 < REP_MDN) __syncthreads(); } }
                __syncthreads();
                { pg8::Gemm g2{(const bf16*)(ws + WS_HM2), (const bf16*)(ws + WS_MD), 0, 2048, opq_s(1792), DFE, DFE, KT_MOE, KT_MOE, REV_DOWN};
                  pg8::MoeRemOrder S; S.nsub = RFL(57) * 32; S.G = F.G; S.c = opq_s((int)blockIdx.x); S.tab = mtab;
                  pg8::EpiSlab E{(float*)(ws + WS_U), MOE_FP8 ? 1.0f / pg8::MOE_WSCALE : 1.0f};
                  pg8::gemm_phase<pg8::EpiSlab, pg8::MoeRemOrder, PG8_ALIGN, PG8_SP2, (MOE_FP8 != 0)>(F.lds + RING_OFF, g2, S, E); }
#undef RFL
            }
            SEAM(pb + 10);
#endif
        }
}

__global__ void __launch_bounds__(NWAVES * 64, 2) fwd_kernel(Args args) {
    extern __shared__ __attribute__((aligned(16))) unsigned char lds[];
    Frame F;
    F.lds = (LAS unsigned char*)lds;
    F.MISC = (volatile LAS unsigned*)(F.lds + MISC_OFF);
    F.wave = __builtin_amdgcn_readfirstlane((int)threadIdx.x >> 6);
    F.G = gridDim.x; F.gw = blockIdx.x * NWAVES + F.wave; F.NGW = F.G * NWAVES;
    F.out = args.out; F.ws = args.ws; F.ctl = (gu32*)(args.ws + WS_CTL);
    unsigned char* ws = args.ws;
    for (int u = TIDX; u < (LDS_BYTES - LDSCTL_OFF) / 4; u += NWAVES * 64) ((LAS unsigned*)(F.lds + LDSCTL_OFF))[u] = 0u;
    __syncthreads();
    XcdBarrier bar; bar.bar = (unsigned*)(F.ctl + CW_BAR); bar.x = 0; bar.st = nullptr;
#if !MK_MULTI
    bar = xcd_barrier_post((unsigned*)(F.ctl + CW_BAR), F.MISC + 8);
#endif
    const int lo = args.ph_lo, hi = args.ph_hi;
    LAS int* mtab = (LAS int*)(F.lds + LDSCTL_OFF + 1024);

    #ifndef SKIP_P0
    if (IN(0)) {
#pragma unroll
        for (int rep_ = 0; rep_ < REP_P0; ++rep_) p0_prologue(F); }
#endif
    SEAM_FILL(0);

    layer_phases<0>(F, bar, lo, hi, mtab);
    layer_phases<1>(F, bar, lo, hi, mtab);
#ifndef SKIP_FINAL
    if (IN(N_PHASES - 1)) for (int rp_ = 0; rp_ < REP_PASS; ++rp_) final_pass(F, 1);
#endif
#undef IN
#undef SEAM
}

extern "C" void kernel_launch(void* const* d_in, const int* in_sizes, int n_in, void* d_out, int out_size, void* d_ws, size_t ws_size, hipStream_t stream) {
    static int grid = 0;
    if (grid == 0) {
        if (n_in != 31 || in_sizes[0] != NBATCH * SEQ * DM || out_size != NBATCH * SEQ * DM || ws_size < WS_END) {
            fprintf(stderr, "kernel_launch: unexpected shapes (n_in %d, in0 %d, out %d, ws %zu, need %zu); nothing launched\n", n_in, n_in > 0 ? in_sizes[0] : -1, out_size, ws_size, (size_t)WS_END); grid = -1; return; }
        int dev = 0, cus = 0, per_cu = 0;
        if (hipGetDevice(&dev) != hipSuccess || hipDeviceGetAttribute(&cus, hipDeviceAttributeMultiprocessorCount, dev) != hipSuccess) { fprintf(stderr, "kernel_launch: device query failed\n"); grid = -1; return; }
        if (hipFuncSetAttribute((const void*)fwd_kernel, hipFuncAttributeMaxDynamicSharedMemorySize, LDS_BYTES) != hipSuccess) { fprintf(stderr, "kernel_launch: hipFuncSetAttribute failed\n"); grid = -1; return; }
        if (hipOccupancyMaxActiveBlocksPerMultiprocessor(&per_cu, (const void*)fwd_kernel, NWAVES * 64, LDS_BYTES) != hipSuccess || per_cu < 1)
            fprintf(stderr, "kernel_launch: note: occupancy query reports %d workgroups per CU\n", per_cu);
        (void)hipGetLastError();
        grid = cus < 256 ? cus : 256;
    }
    if (grid < 0) return;
    if (hipMemsetAsync((char*)d_ws + WS_CTL, 0, CTL_ZERO_BYTES, stream) != hipSuccess) { fprintf(stderr, "kernel_launch: memset failed\n"); return; }
    Args a{};
    for (int i = 0; i < 31; ++i) a.in[i] = (const float*)d_in[i];
    a.out = (float*)d_out; a.ws = (unsigned char*)d_ws;
#if MK_MULTI
    for (int p = 0; p < N_PHASES; ++p) {
        if (p == 1 + 8) continue;
        a.ph_lo = p; a.ph_hi = p + 1;
        hipLaunchKernelGGL(fwd_kernel, dim3(grid), dim3(NWAVES * 64), LDS_BYTES, stream, a);
    }
#else
    a.ph_lo = 0; a.ph_hi = N_PHASES;
    hipLaunchKernelGGL(fwd_kernel, dim3(grid), dim3(NWAVES * 64), LDS_BYTES, stream, a);
#endif
    const hipError_t le = hipPeekAtLastError();
    if (le != hipSuccess) fprintf(stderr, "kernel_launch: launch failed: %s\n", hipGetErrorName(le));
}
```

```cpp
#include <hip/hip_runtime.h>
#include <cstdio>
#include <cstdint>
namespace pg8 {
#define PG8_LAS __attribute__((address_space(3)))
typedef unsigned short bf16_t;
typedef short bf16x8 __attribute__((ext_vector_type(8)));
typedef float f32x4 __attribute__((ext_vector_type(4)));
typedef unsigned u32x4 __attribute__((ext_vector_type(4)));
typedef int v8i32 __attribute__((ext_vector_type(8)));
constexpr int BM = 256, BK = 64, HALF = 128, HTB = HALF * BK * 2  , STAGE_BYTES = 8 * HTB, NXCD = 8, WGM = 8;

__host__ __device__ __forceinline__ int lds_byte(int r, int c) { const int st = (r >> 4) * 2 + (c >> 5), rr = r & 15, cc = c & 31, ob = rr * 64 + cc * 2; return st * 1024 + (ob ^ (((ob >> 9) & 1) << 5)); }
__host__ __device__ __forceinline__ void stage_rc(int b, int& R, int& C) { const int st = b / 1024, sb = b % 1024, swz = sb ^ (((sb >> 9) & 1) << 5); R = (st >> 1) * 16 + swz / 64; C = (st & 1) * 32 + (swz % 64) / 2; }
__host__ __device__ __forceinline__ int perm32(int rho) { const int n = rho >> 4, i = rho & 15; return 8 * (i >> 2) + 4 * n + (i & 3); }

struct Unit { int pm, pn, ko = 0, aux = 0; };
struct Gemm { const bf16_t* A; const bf16_t* Bt; int M, N, K, lda, ldb; int ktA = 0, ktB = 0, rev = 0; };

struct StaticOrder {
    static constexpr bool NTB = false;
    int nM, nN, nwg, G, c, wgm;
    __host__ __device__ void init(int M, int N, int G_, int c_, int wgm_ = WGM) { nM = M / BM; nN = N / BM; nwg = nM * nN; G = G_; c = c_; wgm = wgm_; }
    __host__ __device__ bool next(int i, Unit& u) const {
        const long L = (long)i * G + c; if (L >= nwg) return false;
        int wgid = (int)L; { const int q = nwg / NXCD, r = nwg % NXCD, xcd = wgid % NXCD, off = wgid / NXCD; wgid = (xcd < r ? xcd * (q + 1) : r * (q + 1) + (xcd - r) * q) + off; }
        const int nig = wgm * nN, gid = wgid / nig, fm = gid * wgm, gsz = (nM - fm) < wgm ? (nM - fm) : wgm;
        u.pm = fm + ((wgid % nig) % gsz); u.pn = (wgid % nig) / gsz; return true;
    }
    __device__ __forceinline__ void a_ready(const Unit&) const {}
    __device__ __forceinline__ void done(const Unit&) const {}
};

__device__ __forceinline__ unsigned cvt_pk_bf16(float lo, float hi) { unsigned r; asm volatile("v_cvt_pk_bf16_f32 %0, %1, %2" : "=v"(r) : "v"(lo), "v"(hi)); return r; }
typedef float f32x2 __attribute__((ext_vector_type(2)));
__device__ __forceinline__ void mfma_e4m3(f32x4& acc, const v8i32& a, const v8i32& b, int one) {
    asm volatile("v_mfma_scale_f32_16x16x128_f8f6f4 %0, %1, %2, %0, %3, %3 op_sel_hi:[0,0,0]" : "+v"(acc) : "v"(a), "v"(b), "v"(one));
}
template <class Epi, class Sched, bool ALIGN_EPI = false, bool SP2 = false, bool FP8 = false>
__device__ __forceinline__ void gemm_phase(PG8_LAS unsigned char* lds, const Gemm g, const Sched& S, const Epi& E) {
    int tid_ = threadIdx.x; asm volatile("" : "+v"(tid_));
    const int tid = tid_, wid = __builtin_amdgcn_readfirstlane(tid >> 6), lane = tid & 63, wr = wid >> 2, wc = wid & 3, fr = lane & 15, fq = lane >> 4;
    constexpr int ES = FP8 ? 1 : 2, KE = FP8 ? 128 : 64;
    const int K = g.K, nt = K / KE;
    unsigned voffA[2], voffB[2];
#pragma unroll
    for (int i = 0; i < 2; ++i) { int R, C; stage_rc(tid * 16 + i * 8192, R, C); const int Rb = Epi::PERM ? ((R & ~31) + perm32(R & 31)) : R;
        voffA[i] = (unsigned)(R * (g.ktA ? 128 : g.lda * ES) + C * 2); voffB[i] = (unsigned)(Rb * (g.ktB ? 128 : g.ldb * ES) + C * 2); }
    const long kabsA = g.ktA ? 32768 : (BK * 2), kabsB = g.ktB ? 32768 : (BK * 2);
    const long kstepA = g.rev ? -kabsA : kabsA, kstepB = g.rev ? -kabsB : kabsB;
    const long kfirstA = g.rev ? (long)(nt - 1) * kabsA : 0, kfirstB = g.rev ? (long)(nt - 1) * kabsB : 0;
    const size_t hstepA = g.ktA ? (size_t)16384 : (size_t)HALF * g.lda * ES, hstepB = g.ktB ? (size_t)16384 : (size_t)HALF * g.ldb * ES;
    const size_t tstepA = (size_t)BM * g.lda * ES, tstepB = (size_t)BM * g.ldb * ES;
    const unsigned ldsw = (unsigned)wid * 1024u;
    const int fcol = FP8 ? ((fq >> 1) * 32 + (fq & 1) * 16) : fq * 8;
    const int aoff = lds_byte(wr * 64 + fr, fcol), boff = lds_byte(wc * 32 + fr, fcol);
#define PG8_SA(b, h) (((b) * 2 + (h)) * HTB)
#define PG8_SB(b, h) ((4 + (b) * 2 + (h)) * HTB)
#define PG8_STAGE(bufoff, gbase, voff) do { _Pragma("unroll") for (int _i = 0; _i < 2; ++_i) { \
        if constexpr (FP8) { unsigned vo_ = (voff)[_i]; asm volatile("" : "+v"(vo_));   \
            __builtin_amdgcn_global_load_lds((const unsigned*)((const char*)(gbase) + vo_), (PG8_LAS unsigned*)(lds + (bufoff) + ldsw + _i * 8192), 16, 0, 0); } else \
        if constexpr (Sched::NTB && (bufoff) >= 4 * HTB) __builtin_amdgcn_global_load_lds((const unsigned*)((const char*)(gbase) + (voff)[_i]), (PG8_LAS unsigned*)(lds + (bufoff) + ldsw + _i * 8192), 16, 0, 2); \
        else __builtin_amdgcn_global_load_lds((const unsigned*)((const char*)(gbase) + (voff)[_i]), (PG8_LAS unsigned*)(lds + (bufoff) + ldsw + _i * 8192), 16, 0, 0); } } while (0)
#define PG8_LDA(dst, b, h) do { if constexpr (FP8) { _Pragma("unroll") for (int m = 0; m < 4; ++m) { const PG8_LAS unsigned char* p_ = lds + PG8_SA(b, h) + aoff + m * 2048; \
        const u32x4 lo_ = *(const PG8_LAS u32x4*)p_, hi_ = *(const PG8_LAS u32x4*)(p_ + 16); dst##8[m] = (v8i32){(int)lo_.x, (int)lo_.y, (int)lo_.z, (int)lo_.w, (int)hi_.x, (int)hi_.y, (int)hi_.z, (int)hi_.w}; } } \
    else { _Pragma("unroll") for (int m = 0; m < 4; ++m) _Pragma("unroll") for (int k = 0; k < 2; ++k) dst[m][k] = *(const PG8_LAS bf16x8*)(lds + PG8_SA(b, h) + aoff + m * 2048 + k * 1024); } } while (0)
#define PG8_LDB(dst, b, h) do { if constexpr (FP8) { _Pragma("unroll") for (int n = 0; n < 2; ++n) { const PG8_LAS unsigned char* p_ = lds + PG8_SB(b, h) + boff + n * 2048; \
        const u32x4 lo_ = *(const PG8_LAS u32x4*)p_, hi_ = *(const PG8_LAS u32x4*)(p_ + 16); dst##8[n] = (v8i32){(int)lo_.x, (int)lo_.y, (int)lo_.z, (int)lo_.w, (int)hi_.x, (int)hi_.y, (int)hi_.z, (int)hi_.w}; } } \
    else { _Pragma("unroll") for (int n = 0; n < 2; ++n) _Pragma("unroll") for (int k = 0; k < 2; ++k) dst[n][k] = *(const PG8_LAS bf16x8*)(lds + PG8_SB(b, h) + boff + n * 2048 + k * 1024); } } while (0)
#define PG8_MMA(ai, bj, At, Bt) do { __builtin_amdgcn_s_setprio(1); if constexpr (FP8) { _Pragma("unroll") for (int m = 0; m < 4; ++m) _Pragma("unroll") for (int n = 0; n < 2; ++n) \
        mfma_e4m3(acc[ai][bj][m][n], Bt##8[n], At##8[m], one8); } \
    else { _Pragma("unroll") for (int m = 0; m < 4; ++m) _Pragma("unroll") for (int n = 0; n < 2; ++n) _Pragma("unroll") for (int k = 0; k < 2; ++k) \
        acc[ai][bj][m][n] = __builtin_amdgcn_mfma_f32_16x16x32_bf16(Bt[n][k], At[m][k], acc[ai][bj][m][n], 0, 0, 0); } __builtin_amdgcn_s_setprio(0); } while (0)
#define PG8_WAIT_V(n) asm volatile("s_waitcnt vmcnt(" #n ")" ::: "memory")
#define PG8_WAIT_L(n) asm volatile("s_waitcnt lgkmcnt(" #n ")" ::: "memory")
#define PG8_BAR __builtin_amdgcn_s_barrier()
#define PG8_SCHED __builtin_amdgcn_sched_barrier(0)
    Unit cur, nxt; int ui = 0;
    if (!S.next(0, cur)) return;
    f32x4 acc[2][2][4][2];
#pragma unroll
    for (int a = 0; a < 2; ++a)
#pragma unroll
        for (int b = 0; b < 2; ++b)
#pragma unroll
            for (int m = 0; m < 4; ++m)
#pragma unroll
                for (int n = 0; n < 2; ++n) acc[a][b][m][n] = (f32x4){0.f, 0.f, 0.f, 0.f};
    int one8 = 0x7F7F7F7F; asm volatile("" : "+v"(one8));
    bf16x8 At[4][2], B0[2][2], B1[2][2]; v8i32 At8[4], B08[2], B18[2];
    const char* cA = (const char*)g.A + (size_t)cur.pm * tstepA + (g.ktA ? (size_t)(cur.ko / KE) * 32768 : (size_t)cur.ko * ES) + kfirstA; const char* cB = (const char*)g.Bt + (size_t)cur.pn * tstepB + (g.ktB ? (size_t)(cur.ko / KE) * 32768 : (size_t)cur.ko * ES) + kfirstB;
    S.a_ready(cur);
    if constexpr (SP2) {
        PG8_STAGE(PG8_SB(0, 0), cB, voffB); PG8_STAGE(PG8_SB(0, 1), cB + hstepB, voffB); PG8_STAGE(PG8_SA(0, 0), cA, voffA); PG8_STAGE(PG8_SA(0, 1), cA + hstepA, voffA);
        if (wr == 1) PG8_BAR;
        PG8_WAIT_V(2); PG8_BAR;
        PG8_STAGE(PG8_SB(1, 0), cB + kstepB, voffB); PG8_STAGE(PG8_SA(1, 0), cA + kstepA, voffA); PG8_STAGE(PG8_SB(1, 1), cB + hstepB + kstepB, voffB);
        PG8_WAIT_V(6); PG8_BAR;
    } else {
        PG8_STAGE(PG8_SB(0, 0), cB, voffB); PG8_STAGE(PG8_SA(0, 0), cA, voffA); PG8_STAGE(PG8_SB(0, 1), cB + hstepB, voffB); PG8_STAGE(PG8_SA(0, 1), cA + hstepA, voffA);
        if (wr == 1) PG8_BAR;
        PG8_WAIT_V(4); PG8_BAR;
        PG8_STAGE(PG8_SB(1, 0), cB + kstepB, voffB); PG8_STAGE(PG8_SA(1, 0), cA + kstepA, voffA); PG8_STAGE(PG8_SB(1, 1), cB + hstepB + kstepB, voffB);
        PG8_WAIT_V(6); PG8_BAR;
    }
    for (;;) {
        const bool has_next = S.next(ui + 1, nxt);
        const char* nA = has_next ? (const char*)g.A + (size_t)nxt.pm * tstepA + (g.ktA ? (size_t)(nxt.ko / KE) * 32768 : (size_t)nxt.ko * ES) + kfirstA : cA; const char* nB = has_next ? (const char*)g.Bt + (size_t)nxt.pn * tstepB + (g.ktB ? (size_t)(nxt.ko / KE) * 32768 : (size_t)nxt.ko * ES) + kfirstB : cB;
        for (int t = 0; t < nt; t += 2) {
            const bool last = (t == nt - 2);
            const char* a1 = cA + (long)(t + 1) * kstepA;
            const char* a2 = last ? nA : cA + (long)(t + 2) * kstepA; const char* b2 = last ? nB : cB + (long)(t + 2) * kstepB;
            const char* a3 = a2 + kstepA; const char* b3 = b2 + kstepB;
            if (last && has_next) S.a_ready(nxt);
            if constexpr (SP2) {
            PG8_LDB(B0, 0, 0); PG8_LDB(B1, 0, 1); PG8_SCHED; PG8_LDA(At, 0, 0); PG8_STAGE(PG8_SA(1, 1), a1 + hstepA, voffA);
            PG8_WAIT_V(8); PG8_WAIT_L(0); PG8_BAR; PG8_MMA(0, 0, At, B0); PG8_MMA(0, 1, At, B1); PG8_BAR; PG8_SCHED;
            PG8_LDA(At, 0, 1); PG8_STAGE(PG8_SB(0, 0), b2, voffB); PG8_STAGE(PG8_SB(0, 1), b2 + hstepB, voffB); PG8_STAGE(PG8_SA(0, 0), a2, voffA);
            PG8_WAIT_V(8); PG8_WAIT_L(0); PG8_BAR; PG8_MMA(1, 0, At, B0); PG8_MMA(1, 1, At, B1); PG8_BAR; PG8_SCHED;
            PG8_LDB(B0, 1, 0); PG8_LDB(B1, 1, 1); PG8_SCHED; PG8_LDA(At, 1, 0); PG8_STAGE(PG8_SA(0, 1), a2 + hstepA, voffA);
            PG8_WAIT_V(8); PG8_WAIT_L(0); PG8_BAR; PG8_MMA(0, 0, At, B0); PG8_MMA(0, 1, At, B1); PG8_BAR; PG8_SCHED;
            PG8_LDA(At, 1, 1); PG8_STAGE(PG8_SB(1, 0), b3, voffB); PG8_STAGE(PG8_SB(1, 1), b3 + hstepB, voffB); PG8_STAGE(PG8_SA(1, 0), a3, voffA);
            PG8_WAIT_V(8); PG8_WAIT_L(0); PG8_BAR; PG8_MMA(1, 0, At, B0); PG8_MMA(1, 1, At, B1); PG8_BAR; PG8_SCHED;
            } else {
            PG8_LDB(B0, 0, 0); PG8_SCHED; PG8_LDA(At, 0, 0); PG8_STAGE(PG8_SA(1, 1), a1 + hstepA, voffA);
            PG8_WAIT_L(8); PG8_BAR; PG8_WAIT_L(0); PG8_MMA(0, 0, At, B0); PG8_BAR; PG8_SCHED;
            PG8_LDB(B1, 0, 1); PG8_STAGE(PG8_SB(0, 0), b2, voffB);
            PG8_BAR; PG8_WAIT_L(0); PG8_MMA(0, 1, At, B1); PG8_BAR;
            PG8_LDA(At, 0, 1); PG8_STAGE(PG8_SA(0, 0), a2, voffA);
            PG8_BAR; PG8_WAIT_L(0); PG8_MMA(1, 0, At, B0); PG8_BAR; PG8_SCHED;
            PG8_STAGE(PG8_SB(0, 1), b2 + hstepB, voffB);
            PG8_WAIT_V(6); PG8_BAR; PG8_MMA(1, 1, At, B1); PG8_BAR;
            PG8_LDB(B0, 1, 0); PG8_SCHED; PG8_LDA(At, 1, 0); PG8_STAGE(PG8_SA(0, 1), a2 + hstepA, voffA);
            PG8_WAIT_L(8); PG8_BAR; PG8_WAIT_L(0); PG8_MMA(0, 0, At, B0); PG8_BAR; PG8_SCHED;
            PG8_LDB(B1, 1, 1); PG8_STAGE(PG8_SB(1, 0), b3, voffB);
            PG8_BAR; PG8_WAIT_L(0); PG8_MMA(0, 1, At, B1); PG8_BAR;
            PG8_LDA(At, 1, 1); PG8_STAGE(PG8_SA(1, 0), a3, voffA);
            PG8_BAR; PG8_WAIT_L(0); PG8_MMA(1, 0, At, B0); PG8_BAR; PG8_SCHED;
            PG8_STAGE(PG8_SB(1, 1), b3 + hstepB, voffB);
            PG8_WAIT_V(6); PG8_BAR; PG8_MMA(1, 1, At, B1); PG8_BAR;
            }
        }
        if constexpr (FP8) {
#define PG8_ACC16(a) "+v"(acc[a][0][0][0]), "+v"(acc[a][0][0][1]), "+v"(acc[a][0][1][0]), "+v"(acc[a][0][1][1]), "+v"(acc[a][0][2][0]), "+v"(acc[a][0][2][1]), "+v"(acc[a][0][3][0]), "+v"(acc[a][0][3][1]), \
                     "+v"(acc[a][1][0][0]), "+v"(acc[a][1][0][1]), "+v"(acc[a][1][1][0]), "+v"(acc[a][1][1][1]), "+v"(acc[a][1][2][0]), "+v"(acc[a][1][2][1]), "+v"(acc[a][1][3][0]), "+v"(acc[a][1][3][1])
            asm volatile("s_nop 15\n\ts_nop 15" : PG8_ACC16(0));
            asm volatile("s_nop 0" : PG8_ACC16(1));
#undef PG8_ACC16
        }
        if constexpr (ALIGN_EPI) { if (wr == 0) PG8_BAR; }
        if constexpr (!Epi::AFTER_DRAIN) { E(acc, cur, wr, wc, fr, fq); S.done(cur); }
        if (!has_next) break;
#pragma unroll
        for (int a = 0; a < 2; ++a)
#pragma unroll
            for (int b = 0; b < 2; ++b)
#pragma unroll
                for (int m = 0; m < 4; ++m)
#pragma unroll
                    for (int n = 0; n < 2; ++n) acc[a][b][m][n] = (f32x4){0.f, 0.f, 0.f, 0.f};
        cur = nxt; cA = nA; cB = nB; ++ui;
        if constexpr (ALIGN_EPI) { if (wr == 1) PG8_BAR; }
    }
    PG8_WAIT_V(0);
    if constexpr (!ALIGN_EPI) { if (wr == 0) PG8_BAR; }
    PG8_BAR;
    if constexpr (Epi::AFTER_DRAIN) { E.fused(acc, cur, wr, wc, fr, fq, lds, wid, lane); S.done(cur); }
#undef PG8_SA
#undef PG8_SB
#undef PG8_STAGE
#undef PG8_LDA
#undef PG8_LDB
#undef PG8_MMA
#undef PG8_WAIT_V
#undef PG8_WAIT_L
#undef PG8_BAR
#undef PG8_SCHED
}
}

#define GAS __attribute__((address_space(1)))
#define LAS __attribute__((address_space(3)))
typedef unsigned short bf16;
typedef unsigned v4u __attribute__((ext_vector_type(4)));
typedef unsigned v2u __attribute__((ext_vector_type(2)));
typedef float f32x4 __attribute__((ext_vector_type(4)));
typedef __bf16 bf2_t __attribute__((ext_vector_type(2)));
typedef GAS unsigned gu32;
#define RLX_AGENT __ATOMIC_RELAXED, __HIP_MEMORY_SCOPE_AGENT
#define LDS_WAIT() asm volatile("s_waitcnt lgkmcnt(0)" ::: "memory")
#define VM_WAIT() asm volatile("s_waitcnt vmcnt(0)" ::: "memory")
__device__ __forceinline__ unsigned f2bf(float f) { unsigned u = __builtin_bit_cast(unsigned, f); return (u + 0x7fffu + ((u >> 16) & 1u)) >> 16; }
__device__ __forceinline__ unsigned pk2(float lo, float hi) { return f2bf(lo) | (f2bf(hi) << 16); }
__device__ __forceinline__ float bflo(unsigned u) { return __builtin_bit_cast(float, u << 16); }
__device__ __forceinline__ float bfhi(unsigned u) { return __builtin_bit_cast(float, u & 0xffff0000u); }
__device__ __forceinline__ float bf1(bf16 h) { return __builtin_bit_cast(float, ((unsigned)h) << 16); }
__device__ __forceinline__ float dot2bf(unsigned a, unsigned b, float c) { return __builtin_amdgcn_fdot2_f32_bf16(__builtin_bit_cast(bf2_t, a), __builtin_bit_cast(bf2_t, b), c, false); }
__device__ __forceinline__ float wave_sum(float v) {
#pragma unroll
    for (int o = 1; o < 64; o <<= 1) v += __shfl_xor(v, o);
    return v;
}

#define XB_TMO      128
#define XB_XCNT(j)  (256  + 64 * (j))
#define XB_XSUB(j)  (1280 + 64 * (j))
#define XB_XGEN(j)  (2304 + 64 * (j))
#define XB_TOP      3328
#define XB_TOPGEN   3392
#define XCD_BAR_WORDS 3456
#define XB_SPIN_CAP (1u << 18)

__device__ __forceinline__ unsigned xb_ld(unsigned* p)              { return __hip_atomic_load(p, __ATOMIC_RELAXED, __HIP_MEMORY_SCOPE_AGENT); }
__device__ __forceinline__ unsigned xb_add(unsigned* p, unsigned v) { return __hip_atomic_fetch_add(p, v, __ATOMIC_RELAXED, __HIP_MEMORY_SCOPE_AGENT); }
__device__ __forceinline__ unsigned xb_xcc_id() { return (unsigned)__builtin_amdgcn_s_getreg((3 << 11) | 20) & 0xFu; }
#define XB_SPIN(cond, bar) do { unsigned _sp = 0; while (cond) { __builtin_amdgcn_s_sleep(1); \
    if ((++_sp & 255u) == 0u) { if (xb_ld(&(bar)[XB_TMO])) break; if (_sp > XB_SPIN_CAP) { atomicAdd(&(bar)[XB_TMO], 1u); break; } } } } while (0)

struct XcdBarrier {
    unsigned* bar; unsigned x;
    volatile LAS unsigned* st;
};

__device__ __forceinline__ XcdBarrier xcd_barrier_post(unsigned* bar, volatile LAS unsigned* st) {
    XcdBarrier b; b.bar = bar; b.x = xb_xcc_id(); b.st = st;
    if (threadIdx.x == 0) (void)xb_add(&bar[XB_XCNT(b.x)], 1u);
    return b;
}
__device__ __forceinline__ void xcd_barrier_complete(unsigned* bar, unsigned x, unsigned& nloc, unsigned& nx) {
    const unsigned G = gridDim.x * gridDim.y * gridDim.z;
    unsigned sum, cnt, mine, sp = 0u;
    for (;;) {
        sum = 0u; cnt = 0u; mine = 0u;
#pragma unroll
        for (unsigned j = 0; j < 16; ++j) { const unsigned c = xb_ld(&bar[XB_XCNT(j)]); sum += c; cnt += (c > 0u) ? 1u : 0u; mine = (j == x) ? c : mine; }
        if (sum == G) break;
        __builtin_amdgcn_s_sleep(1);
        if ((++sp & 255u) == 0u) { if (xb_ld(&bar[XB_TMO])) break; if (sp > XB_SPIN_CAP) { atomicAdd(&bar[XB_TMO], 1u); break; } }
    }
    nloc = mine > 0u ? mine : 1u; nx = cnt > 0u ? cnt : 1u;
}

__device__ __forceinline__ void xcd_barrier(const XcdBarrier& b) {
    asm volatile("s_waitcnt vmcnt(0)" ::: "memory");
    __syncthreads();
    if (threadIdx.x == 0) {
        unsigned* bar = b.bar;
        __builtin_amdgcn_s_waitcnt(0);
        unsigned nloc = b.st[0], nx = b.st[1];
        if (nloc == 0u) { xcd_barrier_complete(bar, b.x, nloc, nx); b.st[0] = nloc; b.st[1] = nx; }
        const unsigned old = xb_add(&bar[XB_XSUB(b.x)], 1u);
        const unsigned gen = old / nloc;
        if (old + 1u == (gen + 1u) * nloc) {
            __builtin_amdgcn_fence(__ATOMIC_RELEASE, "agent");
            asm volatile("s_waitcnt vmcnt(0)" ::: "memory");
            const unsigned og = xb_add(&bar[XB_TOP], 1u);
            const unsigned tg = og / nx;
            if (og + 1u == (tg + 1u) * nx) xb_add(&bar[XB_TOPGEN], 1u);
            else XB_SPIN(xb_ld(&bar[XB_TOPGEN]) == tg, bar);
            __builtin_amdgcn_fence(__ATOMIC_ACQUIRE, "agent");
            xb_add(&bar[XB_XGEN(b.x)], 1u);
            asm volatile("s_waitcnt vmcnt(0)" ::: "memory");
        } else {
            XB_SPIN(xb_ld(&bar[XB_XGEN(b.x)]) == gen, bar);
            __builtin_amdgcn_fence(__ATOMIC_ACQUIRE, "agent");
            asm volatile("s_waitcnt vmcnt(0)" ::: "memory");
        }
    }
    __syncthreads();
}

constexpr int NWAVES = 8;
constexpr int DM = 2048, NBATCH = 8, SEQ = 2048, CTXL = 256, TPB = 2304  , MT = 18432, NPAN = 72;
constexpr int INC = 4672, INCP = 4864;
constexpr int C_NAQ = 0, C_NAK = 512, C_NAV = 1024, C_CQ = 1536, C_CKV = 1920, C_KPE = 2048, C_GQ = 2112, C_GK = 2624, C_GV = 2880, C_DQ = 3136, C_DK = 3648, C_DV = 4160;
constexpr int QMW = 768, KVW = 1280;
constexpr int DFF = 5632, DFE = 7168, NEXP = 8;
constexpr int MODW = 12288;
constexpr int MOE_ROWS = 34816, MOE_PAN = 136;
constexpr float EPSN = 1e-6f;
constexpr float SC_NA = 0.08838834764831845f, SC_MLA = 0.07216878364870322f, SC_DIFF = 0.125f;

constexpr size_t MiB = 1u << 20;
constexpr size_t WS_CTL = 0, CTL_ZERO_BYTES = 1 * MiB;
constexpr size_t WS_MOD = 1 * MiB;
constexpr size_t WS_ROPE = 1 * MiB + 900 * 1024;
constexpr size_t WS_ROUTE = 2 * MiB;
constexpr size_t WS_WIN = 3 * MiB;
constexpr size_t WS_WOUT = WS_WIN + 38 * MiB;
constexpr size_t WS_WQUP = WS_WOUT + 16 * MiB;
constexpr size_t WS_WKVUP = WS_WQUP + 2 * MiB;
constexpr size_t WS_WGU = WS_WKVUP + 2 * MiB;
constexpr size_t WS_WD = WS_WGU + 44 * MiB;
constexpr size_t WS_MGU = WS_WD + 22 * MiB;
constexpr size_t WS_MD = WS_MGU + 448 * MiB;
constexpr size_t WS_H = WS_MD + 224 * MiB;
constexpr size_t WS_U = WS_H + 144 * MiB;
constexpr size_t WS_R1 = WS_U + 72 * MiB;
constexpr size_t WS_QKV = WS_R1;
constexpr size_t WS_QM = WS_QKV + 171 * MiB;
constexpr size_t WS_KVM = WS_QM + 27 * MiB;
constexpr size_t WS_O = WS_KVM + 45 * MiB;
constexpr size_t WS_HM2 = WS_R1;
constexpr size_t WS_R2 = WS_R1 + 476 * MiB;
constexpr size_t WS_AS = WS_R2;
constexpr size_t WS_Y = WS_R2 + 136 * MiB;
constexpr size_t WS_HM = WS_R2;
constexpr size_t WS_END = WS_R2 + 272 * MiB;
static_assert(WS_O + 72 * MiB <= WS_R2, "region 1");
static_assert(WS_END <= (size_t)1792 * MiB, "workspace map must fit 4 x the largest input");
constexpr int RT_E = 0;
constexpr int RT_G = 16384;
constexpr int RT_RANK = 16384 * 3;
constexpr int RT_POS = 16384 * 5;
constexpr int RT_CNT = 16384 * 7;
static_assert((RT_CNT + 256 * 8) * 4 <= (int)MiB, "route info");
constexpr int CW_BAR = 4096;

constexpr int RING_OFF = 0, RING_BYTES = 131072;
constexpr int LDSCTL_OFF = RING_BYTES, MISC_OFF = LDSCTL_OFF + 320;
constexpr int LDS_BYTES = 147456;

namespace pg8 {
#define PG8_GAS __attribute__((address_space(1)))
struct LatentOrder : StaticOrder {
    __device__ bool next(int i, Unit& u) const { if (!StaticOrder::next(i, u)) return false; u.pm = u.pm + (u.pm >> 3) + 1; return true; }
};
#ifndef MOE_WGM
#define MOE_WGM 16
#endif
#ifndef MOE_NTB
#define MOE_NTB 0
#endif
struct MoeOrder : StaticOrder {
    static constexpr bool NTB = MOE_NTB;
    const PG8_LAS int* tab;
    __device__ bool next(int i, Unit& u) const {
        {
            const long L = (long)i * G + c; if (L >= nwg) return false;
            int wgid = (int)L; { const int q = nwg / NXCD, r = nwg % NXCD, xcd = wgid % NXCD, off = wgid / NXCD; wgid = (xcd < r ? xcd * (q + 1) : r * (q + 1) + (xcd - r) * q) + off; }
            const int nig = MOE_WGM * nN, gid = wgid / nig, fm = gid * MOE_WGM, gsz = (nM - fm) < MOE_WGM ? (nM - fm) : MOE_WGM;
            u.pm = fm + ((wgid % nig) % gsz); u.pn = (wgid % nig) / gsz;
        }
        int e = 0;
#pragma unroll
        for (int q = 0; q < 7; ++q) e += (u.pm >= __builtin_amdgcn_readfirstlane(tab[32 + q])) ? 1 : 0;
        u.pn += e * nN; return true;
    }
};
#ifndef MOED_WGM
#define MOED_WGM 4
#endif
struct MoeFullOrder : StaticOrder {
    const PG8_LAS int* tab;
    __device__ bool next(int i, Unit& u) const {
        {
            const long L = (long)i * G + c; if (L >= nwg) return false;
            int wgid = (int)L; { const int q = nwg / NXCD, r = nwg % NXCD, xcd = wgid % NXCD, off = wgid / NXCD; wgid = (xcd < r ? xcd * (q + 1) : r * (q + 1) + (xcd - r) * q) + off; }
            const int nig = MOED_WGM * nN, gid = wgid / nig, fm = gid * MOED_WGM, gsz = (nM - fm) < MOED_WGM ? (nM - fm) : MOED_WGM;
            u.pm = fm + ((wgid % nig) % gsz); u.pn = (wgid % nig) / gsz;
        }
        const int f = u.pm; int e = 0;
#pragma unroll
        for (int q = 0; q < 7; ++q) e += (f >= __builtin_amdgcn_readfirstlane(tab[40 + q])) ? 1 : 0;
        u.pm = f + __builtin_amdgcn_readfirstlane(tab[48 + e]); u.pn += e * nN; return true;
    }
    __device__ __forceinline__ void a_ready(const Unit&) const {}
    __device__ __forceinline__ void done(const Unit&) const {}
};
struct MoeRemOrder {
    static constexpr bool NTB = false;
    int nsub, G, c; const PG8_LAS int* tab;
    __device__ bool next(int i, Unit& u) const {
        const int L = i * G + c; if (L >= nsub) return false;
        const int r = L >> 5, pn = (L >> 2) & 7, ks = L & 3, e = tab[64 + r];
        u.pm = tab[32 + e] - 1; u.pn = e * 8 + pn; u.ko = ks * 1792; u.aux = r; return true;
    }
    __device__ __forceinline__ void a_ready(const Unit&) const {}
    __device__ __forceinline__ void done(const Unit&) const {}
};
struct CtxRemOrder {
    static constexpr bool NTB = false;
    int G, c;
    __device__ bool next(int i, Unit& u) const {
        const int L = i * G + c; if (L >= 256) return false;
        const int r = L >> 5, pn = (L >> 2) & 7, ks = L & 3;
        u.pm = 9 * r; u.pn = pn; u.ko = ks * 1408; u.aux = r; return true;
    }
    __device__ __forceinline__ void a_ready(const Unit&) const {}
    __device__ __forceinline__ void done(const Unit&) const {}
};
struct EpiSlab {
    static constexpr bool PERM = false, AFTER_DRAIN = false;
    float* S; float sc = 1.0f; int kdiv = 1792;
    __device__ __forceinline__ void operator()(const f32x4 (&acc)[2][2][4][2], const Unit& u, int wr, int wc, int fr_in, int fq_in) const {
        (void)fr_in; (void)fq_in; int t_ = threadIdx.x; asm volatile("" : "+v"(t_)); const int fr = t_ & 15, fq = (t_ >> 4) & 3;
        const int ks = u.ko / kdiv, pn = u.pn & 7;
        float* base = S + ((size_t)(ks * 8 + u.aux) * 256 + wr * 64 + fr) * 2048 + pn * BM + wc * 32 + 4 * fq;
#pragma unroll
        for (int ai = 0; ai < 2; ++ai)
#pragma unroll
            for (int m = 0; m < 4; ++m)
#pragma unroll
                for (int bj = 0; bj < 2; ++bj)
#pragma unroll
                    for (int n = 0; n < 2; ++n) *(PG8_GAS f32x4*)(base + (size_t)(ai * HALF + m * 16) * 2048 + bj * HALF + n * 16) = acc[ai][bj][m][n] * sc;
    }
};
struct EpiBf16P {
    static constexpr bool PERM = true, AFTER_DRAIN = false;
    bf16_t* O; int ldc; int pn_mod; float sc = 1.0f;
    __device__ __forceinline__ void operator()(const f32x4 (&acc)[2][2][4][2], const Unit& u, int wr, int wc, int fr_in, int fq_in) const {
        (void)fr_in; (void)fq_in; int t_ = threadIdx.x; asm volatile("" : "+v"(t_)); const int fr = t_ & 15, fq = (t_ >> 4) & 3;
        const int pn = pn_mod ? (u.pn % pn_mod) : u.pn;
        const int row0 = u.pm * BM + wr * 64 + fr, col0 = pn * BM + wc * 32 + 8 * fq;
#pragma unroll
        for (int ai = 0; ai < 2; ++ai)
#pragma unroll
            for (int m = 0; m < 4; ++m) { bf16_t* rowp = O + (size_t)(row0 + ai * HALF + m * 16) * ldc + col0;
#pragma unroll
                for (int bj = 0; bj < 2; ++bj) { const f32x4 v0 = acc[ai][bj][m][0] * sc, v1 = acc[ai][bj][m][1] * sc;
                    u32x4 w; w.x = cvt_pk_bf16(v0[0], v0[1]); w.y = cvt_pk_bf16(v0[2], v0[3]); w.z = cvt_pk_bf16(v1[0], v1[1]); w.w = cvt_pk_bf16(v1[2], v1[3]);
                    *(PG8_GAS u32x4*)(rowp + bj * HALF) = w; } }
    }
};
#ifndef KT_MOE
#define KT_MOE 1
#endif
#ifndef MOE_FP8
#define MOE_FP8 1
#endif
constexpr float MOE_WSCALE = 64.0f;
#ifndef EMU_FP8
#define EMU_FP8 0
#endif
#ifndef EMU_DGU
#define EMU_DGU 0
#endif
__device__ __forceinline__ unsigned pk4_fp8(float a, float b, float c, float d) { int p = __builtin_amdgcn_cvt_pk_fp8_f32(a, b, 0, false); p = __builtin_amdgcn_cvt_pk_fp8_f32(c, d, p, true); return (unsigned)p; }
__device__ __forceinline__ float fp8r(float x) { const int p = __builtin_amdgcn_cvt_pk_fp8_f32(x, x, 0, false); return __builtin_amdgcn_cvt_f32_fp8(p, 0); }
#ifndef NT_HM2
#define NT_HM2 1
#endif
__device__ __forceinline__ float silu_f(float x) { return x * __builtin_amdgcn_rcpf(1.0f + __expf(-x)); }
__device__ __forceinline__ float swiglu_f(float g, float u, float c1, float kk) { const float e = __builtin_amdgcn_exp2f(g * c1); return (g * u) * __builtin_amdgcn_rcpf(fmaf(e, kk, kk)); }
struct EpiSwiGLU {
    static constexpr bool PERM = true, AFTER_DRAIN = false;
    bf16_t* O; int ldc; int pn_mod; float isc = 1.0f;
    __device__ __forceinline__ void operator()(const f32x4 (&acc)[2][2][4][2], const Unit& u, int wr, int wc, int fr_in, int fq_in) const {
        (void)fr_in; (void)fq_in; int t_ = threadIdx.x; asm volatile("" : "+v"(t_)); const int fr = t_ & 15, fq = (t_ >> 4) & 3;
        const int pn = pn_mod ? (u.pn % pn_mod) : u.pn;
        const int row0 = u.pm * BM + wr * 64 + fr, col0 = pn * HALF + wc * 32 + 8 * fq;
        const float c1 = -1.4426950408889634f * isc, kk = 1.0f / (isc * isc);
#pragma unroll
        for (int ai = 0; ai < 2; ++ai)
#pragma unroll
            for (int m = 0; m < 4; ++m) { bf16_t* rowp = O + (size_t)(row0 + ai * HALF + m * 16) * ldc + col0;
                if (KT_MOE && pn_mod) rowp = O + ((size_t)(u.pm * (ldc >> 6) + (col0 >> 6)) * 256 + (wr * 64 + fr + ai * HALF + m * 16)) * 64 + (col0 & 63);
                f32x4 r0, r1;
#pragma unroll
                for (int j = 0; j < 4; ++j) { r0[j] = swiglu_f(acc[ai][0][m][0][j], acc[ai][1][m][0][j], c1, kk); r1[j] = swiglu_f(acc[ai][0][m][1][j], acc[ai][1][m][1][j], c1, kk); }
                if (MOE_FP8 && pn_mod) {
                    typedef unsigned u32x2 __attribute__((ext_vector_type(2)));
                    unsigned char* p8 = (unsigned char*)O + ((size_t)(u.pm * (ldc >> 7) + (col0 >> 7)) * 256 + (wr * 64 + fr + ai * HALF + m * 16)) * 128 + (col0 & 127);
                    u32x2 w8; w8.x = pk4_fp8(r0[0], r0[1], r0[2], r0[3]); w8.y = pk4_fp8(r1[0], r1[1], r1[2], r1[3]);
                    __builtin_nontemporal_store(w8, (PG8_GAS u32x2*)p8); continue; }
                if (EMU_FP8 && pn_mod) {
#pragma unroll
                    for (int j = 0; j < 4; ++j) { r0[j] = fp8r(r0[j]); r1[j] = fp8r(r1[j]); } }
                u32x4 w; w.x = cvt_pk_bf16(r0[0], r0[1]); w.y = cvt_pk_bf16(r0[2], r0[3]); w.z = cvt_pk_bf16(r1[0], r1[1]); w.w = cvt_pk_bf16(r1[2], r1[3]);
                if (NT_HM2 && pn_mod) __builtin_nontemporal_store(w, (PG8_GAS u32x4*)rowp); else *(PG8_GAS u32x4*)rowp = w; }
    }
};
struct EpiResGate {
    static constexpr bool PERM = false, AFTER_DRAIN = false;
    float* H; const float* gate;
    const float* xin; const float* cin;
    __device__ __forceinline__ void operator()(const f32x4 (&acc)[2][2][4][2], const Unit& u, int wr, int wc, int fr, int fq) const {
        const int b = u.pm / 9, j = u.pm - 9 * b, mr = (j == 0) ? 8 : b;
        const int rloc = wr * 64 + fr, col0 = u.pn * BM + wc * 32 + 4 * fq;
        const float* gp = gate + (size_t)mr * 12288 + col0;
        float* outp = H + (size_t)(u.pm * BM + rloc) * 2048 + col0;
        const float* inp = xin ? ((j == 0) ? cin + ((size_t)b * 256 + rloc) * 2048 + col0 : xin + ((size_t)b * 2048 + (size_t)(j - 1) * 256 + rloc) * 2048 + col0) : outp;
        f32x4 gv[2][2];
#pragma unroll
        for (int bj = 0; bj < 2; ++bj)
#pragma unroll
            for (int n = 0; n < 2; ++n) gv[bj][n] = *(const PG8_GAS f32x4*)(gp + bj * HALF + n * 16);
#pragma unroll
        for (int ai = 0; ai < 2; ++ai)
#pragma unroll
            for (int m = 0; m < 4; ++m) {
                const size_t ro = (size_t)(ai * HALF + m * 16) * 2048;
#pragma unroll
                for (int bj = 0; bj < 2; ++bj)
#pragma unroll
                    for (int n = 0; n < 2; ++n) { const f32x4 h = *(const PG8_GAS f32x4*)(inp + ro + bj * HALF + n * 16); *(PG8_GAS f32x4*)(outp + ro + bj * HALF + n * 16) = h + gv[bj][n] * acc[ai][bj][m][n]; }
                asm volatile("" ::: "memory"); }
    }
};
struct EpiQupRope {
    static constexpr bool PERM = false, AFTER_DRAIN = false;
    bf16_t* O; const float* tab;
    __device__ __forceinline__ void operator()(const f32x4 (&acc)[2][2][4][2], const Unit& u, int wr, int wc, int fr, int fq) const {
        const int b = u.pm / 9, j = u.pm - 9 * b; const bool lat = j != 0;
        const int rloc = wr * 64 + fr, col0 = u.pn * BM + wc * 32 + 4 * fq;
        typedef unsigned u32x2 __attribute__((ext_vector_type(2)));
#pragma unroll
        for (int bj = 0; bj < 2; ++bj) {
            const int dblk = (8 * u.pn + 4 * bj + wc) % 6; const bool rope = lat && dblk >= 4; const int axis = dblk - 4;
#pragma unroll
            for (int ai = 0; ai < 2; ++ai)
#pragma unroll
                for (int m = 0; m < 4; ++m) {
                    const int r = ai * HALF + m * 16 + rloc;
                    f32x4 x1 = acc[ai][bj][m][0], x2 = acc[ai][bj][m][1];
                    if (rope) { const int t = (j - 1) * 256 + r, pos = axis ? (t & 63) : (t >> 6);
                        const f32x4 c = *(const PG8_GAS f32x4*)(tab + pos * 16 + 4 * fq), sn = *(const PG8_GAS f32x4*)(tab + 1024 + pos * 16 + 4 * fq);
                        const f32x4 a = x1, bb = x2; x1 = a * c - bb * sn; x2 = bb * c + a * sn; }
                    bf16_t* rowp = O + (size_t)(u.pm * BM + r) * 768 + col0 + bj * HALF;
                    u32x2 w0, w1; w0.x = cvt_pk_bf16(x1[0], x1[1]); w0.y = cvt_pk_bf16(x1[2], x1[3]); w1.x = cvt_pk_bf16(x2[0], x2[1]); w1.y = cvt_pk_bf16(x2[2], x2[3]);
                    *(PG8_GAS u32x2*)rowp = w0; *(PG8_GAS u32x2*)(rowp + 16) = w1;
                    asm volatile("" ::: "memory");
                }
        }
    }
};
}
#define PG8_SP2 true
#define PG8_ALIGN true

struct Frame {
    LAS unsigned char* lds;
    volatile LAS unsigned* MISC;
    gu32* ctl;
    int wave, G, gw, NGW;
    float* out;
    unsigned char* ws;
};
__device__ __forceinline__ int opq_v(int v) { asm volatile("" : "+v"(v)); return v; }
#define TIDX opq_v((int)threadIdx.x)
typedef const float* cfptr;
__device__ __forceinline__ const float* inptr(int i) {
    const __attribute__((address_space(4))) cfptr* p = (const __attribute__((address_space(4))) cfptr*)__builtin_amdgcn_kernarg_segment_ptr();
    asm volatile("" : "+s"(p));
    return p[i];
}
enum { I_X = 0, I_C, I_CTX, I_CCTX, I_WMOD, I_BMOD, I_GMIX, I_WIN, I_NABIAS, I_MLAGQ, I_WQUP, I_MLAGKV, I_WKVUP, I_GQAGQ, I_GQAGK, I_LQ1, I_LK1, I_LQ2, I_LK2, I_GSUB, I_WOUT, I_GFFN,
       I_FG, I_FU, I_FD, I_MR, I_MB, I_MG, I_MU, I_MDN, I_GFIN };

struct TrJob { const float* W; bf16* WT; int N, ldk, k0, n0, drow0, tiled, emu; };
__device__ __forceinline__ void tr_load(const TrJob& j, f32x4 (&v)[16], int lane) {
#pragma unroll
    for (int i = 0; i < 16; ++i) { const int k = 4 * i + (lane >> 4), n4 = (lane & 15) * 4;
        v[i] = __builtin_nontemporal_load((const GAS f32x4*)(j.W + (size_t)(j.k0 + k) * j.N + j.n0 + n4)); }
}
__device__ __forceinline__ void tr_finish8(const TrJob& j, const f32x4 (&v)[16], LAS unsigned char* scr, int lane) {
    constexpr int ROWB = 68;
#pragma unroll
    for (int i = 0; i < 16; ++i) { const int k = 4 * i + (lane >> 4), n4 = (lane & 15) * 4; const f32x4 t = v[i] * pg8::MOE_WSCALE;
        *(LAS unsigned*)(scr + k * ROWB + n4) = pg8::pk4_fp8(t.x, t.y, t.z, t.w); }
    LDS_WAIT();
    const int c = lane & 3;
#pragma unroll 2
    for (int jj = 0; jj < 4; ++jj) {
        const int n = 16 * jj + (lane >> 2);
        const LAS unsigned char* s = scr + (16 * c) * ROWB + n;
        unsigned e[16];
#pragma unroll
        for (int i = 0; i < 16; ++i) e[i] = s[i * ROWB];
        v4u o; o.x = e[0] | (e[1] << 8) | (e[2] << 16) | (e[3] << 24); o.y = e[4] | (e[5] << 8) | (e[6] << 16) | (e[7] << 24);
        o.z = e[8] | (e[9] << 8) | (e[10] << 16) | (e[11] << 24); o.w = e[12] | (e[13] << 8) | (e[14] << 16) | (e[15] << 24);
        const int dr = j.drow0 + n;
        unsigned char* dst = (unsigned char*)j.WT + ((size_t)((dr >> 8) * (j.ldk >> 7) + (j.k0 >> 7)) * 256 + (dr & 255)) * 128 + (j.k0 & 127) + 16 * c;
        __builtin_nontemporal_store(o, (GAS v4u*)dst);
    }
    LDS_WAIT();
}
__device__ __forceinline__ void tr_finish(const TrJob& j, const f32x4 (&v)[16], LAS unsigned char* scr, int lane) {
    constexpr int ROWB = 136;
#pragma unroll
    for (int i = 0; i < 16; ++i) { const int k = 4 * i + (lane >> 4), n4 = (lane & 15) * 4;
        f32x4 t = v[i]; if ((EMU_FP8 && j.tiled) || (EMU_DGU && j.emu)) { t.x = pg8::fp8r(t.x * 64.f) * (1.f / 64.f); t.y = pg8::fp8r(t.y * 64.f) * (1.f / 64.f); t.z = pg8::fp8r(t.z * 64.f) * (1.f / 64.f); t.w = pg8::fp8r(t.w * 64.f) * (1.f / 64.f); }
        v2u w; w.x = pg8::cvt_pk_bf16(t.x, t.y); w.y = pg8::cvt_pk_bf16(t.z, t.w);
        *(LAS v2u*)(scr + k * ROWB + n4 * 2) = w; }
    LDS_WAIT();
    const int c = lane & 7;
#pragma unroll 2
    for (int jj = 0; jj < 8; ++jj) {
        const int n = 8 * jj + (lane >> 3);
        const LAS unsigned short* s = (const LAS unsigned short*)(scr + (8 * c) * ROWB + n * 2);
        unsigned e[8];
#pragma unroll
        for (int i = 0; i < 8; ++i) e[i] = s[i * (ROWB / 2)];
        v4u o; o.x = e[0] | (e[1] << 16); o.y = e[2] | (e[3] << 16); o.z = e[4] | (e[5] << 16); o.w = e[6] | (e[7] << 16);
        const int dr = j.drow0 + n;
        bf16* dst = j.tiled ? j.WT + ((size_t)((dr >> 8) * (j.ldk >> 6) + (j.k0 >> 6)) * 256 + (dr & 255)) * 64 + 8 * c : j.WT + (size_t)dr * j.ldk + j.k0 + 8 * c;
        __builtin_nontemporal_store(o, (GAS v4u*)dst);
    }
    LDS_WAIT();
}
constexpr int IT_WIN = 32 * 73, IT_WOUT = 32 * 32, IT_FGU = 32 * 88, IT_FD = 88 * 32, IT_MGU = 32 * 112, IT_MD = 112 * 32;
constexpr int CV_N0 = 2 * IT_WIN, CV_N1 = CV_N0 + 2 * IT_WOUT, CV_N2 = CV_N1 + 2 * IT_FGU, CV_N3 = CV_N2 + IT_FD, CV_N4 = CV_N3 + 16 * IT_MGU, CV_N5 = CV_N4 + 8 * IT_MD;
constexpr int CVQ_L1 = IT_WIN + IT_WOUT, CVQ_N = CVQ_L1 + (CV_N5 - CV_N1), CVQ_FFN_END = CVQ_L1 + (CV_N3 - CV_N1);
__device__ __forceinline__ int cvq_item(int q) { return q < IT_WIN ? IT_WIN + q : (q < CVQ_L1 ? CV_N0 + IT_WOUT + (q - IT_WIN) : CV_N1 + (q - CVQ_L1)); }
__device__ __forceinline__ TrJob conv_job(int it, unsigned char* ws) {
    const float* W; bf16* WT; int N, ldk, k0, n0, drow0, tiled = 0, emu = 0;
    if (it < CV_N0) { const int l = it / IT_WIN, r = it % IT_WIN, kb = r / 73, nb = r % 73;
        W = inptr(I_WIN) + (size_t)l * 2048 * INC; N = INC; WT = (bf16*)(ws + WS_WIN) + (size_t)l * INCP * 2048; ldk = 2048; k0 = kb * 64; n0 = nb * 64; drow0 = n0; }
    else if (it < CV_N1) { const int q = it - CV_N0, l = q / IT_WOUT, r = q % IT_WOUT, kb = r / 32, nb = r % 32;
        W = inptr(I_WOUT) + (size_t)l * 2048 * 2048; N = 2048; WT = (bf16*)(ws + WS_WOUT) + (size_t)l * 2048 * 2048; ldk = 2048; k0 = kb * 64; n0 = nb * 64; drow0 = n0; }
    else if (it < CV_N2) { const int q = it - CV_N1, which = q / IT_FGU, r = q % IT_FGU, kb = r / 88, nb = r % 88;
        W = which ? inptr(I_FU) : inptr(I_FG); N = DFF; WT = (bf16*)(ws + WS_WGU); ldk = 2048; k0 = kb * 64; n0 = nb * 64; drow0 = (n0 >> 7) * 256 + (n0 & 127) + which * 128; emu = 1; }
    else if (it < CV_N3) { const int r = it - CV_N2, kb = r / 32, nb = r % 32;
        W = inptr(I_FD); N = 2048; WT = (bf16*)(ws + WS_WD); ldk = DFF; k0 = kb * 64; n0 = nb * 64; drow0 = n0; }
    else if (it < CV_N4) { const int q = it - CV_N3, mat = q / IT_MGU, e = mat >> 1, which = mat & 1, r = q % IT_MGU, kb = r / 112, nb = r % 112;
        W = (which ? inptr(I_MU) : inptr(I_MG)) + (size_t)e * 2048 * DFE; N = DFE; WT = MOE_FP8 ? (bf16*)(ws + WS_MGU + (size_t)e * 14336 * 2048) : (bf16*)(ws + WS_MGU) + (size_t)e * 14336 * 2048; ldk = 2048; k0 = kb * 64; n0 = nb * 64; drow0 = (n0 >> 7) * 256 + (n0 & 127) + which * 128; tiled = MOE_FP8 ? 2 : KT_MOE; }
    else { const int q = it - CV_N4, e = q / IT_MD, r = q % IT_MD, kb = r / 32, nb = r % 32;
        W = inptr(I_MDN) + (size_t)e * DFE * 2048; N = 2048; WT = MOE_FP8 ? (bf16*)(ws + WS_MD + (size_t)e * 2048 * DFE) : (bf16*)(ws + WS_MD) + (size_t)e * 2048 * DFE; ldk = DFE; k0 = kb * 64; n0 = nb * 64; drow0 = n0; tiled = MOE_FP8 ? 2 : KT_MOE; }
    TrJob j; j.W = W; j.WT = WT; j.N = N; j.ldk = ldk; j.k0 = k0; j.n0 = n0; j.drow0 = drow0; j.tiled = tiled; j.emu = emu; return j;
}
template <bool QUEUE>
__device__ __forceinline__ void conv_pair(int it0, int it1, int nlim, unsigned char* ws, LAS unsigned char* scr, int lane) {
    if (it0 >= nlim) return;
    const bool two = it1 < nlim;
    const TrJob j0 = conv_job(QUEUE ? cvq_item(it0) : it0, ws), j1 = conv_job(QUEUE ? cvq_item(two ? it1 : it0) : (two ? it1 : it0), ws);
    f32x4 v0[16], v1[16];
#ifdef PROBE_CONV2
    if (QUEUE) { tr_load(j0, v0, lane); if (two) tr_load(j1, v1, lane); if (j0.tiled == 2) tr_finish8(j0, v0, scr, lane); else tr_finish(j0, v0, scr, lane); if (two) { if (j1.tiled == 2) tr_finish8(j1, v1, scr, lane); else tr_finish(j1, v1, scr, lane); } }
#endif
    tr_load(j0, v0, lane); if (two) tr_load(j1, v1, lane);
    if (j0.tiled == 2) tr_finish8(j0, v0, scr, lane); else tr_finish(j0, v0, scr, lane);
    if (two) { if (j1.tiled == 2) tr_finish8(j1, v1, scr, lane); else tr_finish(j1, v1, scr, lane); }
}
#ifndef CV_CHUNK_N
#define CV_CHUNK_N 16
#endif
constexpr int CW_QHEAD = 64, CW_DONE0 = 128, CV_CHUNK = CV_CHUNK_N;
#ifndef NO_TAIL_FILL
#define NO_TAIL_FILL 0
#endif
__device__ __forceinline__ void filler(Frame& F, int slot, int drain_to) {
    if (NO_TAIL_FILL && drain_to < 0) return;
    __syncthreads();
    LAS int* bc = (LAS int*)(F.lds + LDSCTL_OFF + 2048);
    LAS unsigned char* scr = F.lds + F.wave * 8704;
    gu32* qhead = F.ctl + CW_QHEAD; gu32* done = F.ctl + CW_DONE0 + 64 * slot;
    if (TIDX == 0 && drain_to < 0) __hip_atomic_fetch_add(done, 1u, RLX_AGENT);
    const int nq = CVQ_N, lim = drain_to < 0 ? nq : drain_to;
    for (;;) {
        if (TIDX == 0) {
            int h = -1; bool stop = false;
            if (drain_to < 0) stop = __hip_atomic_load(done, RLX_AGENT) >= (unsigned)F.G;
            else stop = __hip_atomic_load(qhead, RLX_AGENT) >= (unsigned)lim;
            if (!stop) { h = (int)__hip_atomic_fetch_add(qhead, (unsigned)CV_CHUNK, RLX_AGENT); if (h >= nq) h = -1; }
            *bc = h;
        }
        __syncthreads();
        const int h = *bc;
        __syncthreads();
        if (h < 0) break;
#pragma unroll 1
        for (int k = F.wave; k < CV_CHUNK; k += 2 * NWAVES) conv_pair<true>(h + k, h + k + NWAVES, CVQ_N, F.ws, scr, (TIDX & 63));
    }
    __syncthreads();
}

__device__ __forceinline__ void xcd_barrier_fill(const XcdBarrier& b, Frame& F) {
    asm volatile("s_waitcnt vmcnt(0)" ::: "memory");
    __syncthreads();
    LAS int* bc = (LAS int*)(F.lds + LDSCTL_OFF + 2048);
    if (threadIdx.x == 0) {
        unsigned* bar = b.bar;
        __builtin_amdgcn_s_waitcnt(0);
        unsigned nloc = b.st[0], nx = b.st[1];
        if (nloc == 0u) { xcd_barrier_complete(bar, b.x, nloc, nx); b.st[0] = nloc; b.st[1] = nx; }
        const unsigned old = xb_add(&bar[XB_XSUB(b.x)], 1u);
        const unsigned gen = old / nloc;
        if (old + 1u == (gen + 1u) * nloc) {
            __builtin_amdgcn_fence(__ATOMIC_RELEASE, "agent");
            asm volatile("s_waitcnt vmcnt(0)" ::: "memory");
            const unsigned og = xb_add(&bar[XB_TOP], 1u);
            const unsigned tg = og / nx;
            if (og + 1u == (tg + 1u) * nx) xb_add(&bar[XB_TOPGEN], 1u);
            else XB_SPIN(xb_ld(&bar[XB_TOPGEN]) == tg, bar);
            __builtin_amdgcn_fence(__ATOMIC_ACQUIRE, "agent");
            xb_add(&bar[XB_XGEN(b.x)], 1u);
            asm volatile("s_waitcnt vmcnt(0)" ::: "memory");
            bc[2] = 1;
        } else { bc[1] = (int)gen; bc[2] = 0; }
    }
    __syncthreads();
    if (bc[2] == 0) {
        LAS unsigned char* scr = F.lds + F.wave * 8704;
        gu32* qhead = F.ctl + CW_QHEAD;
        for (;;) {
            if (threadIdx.x == 0) {
                int h = -2;
                if (xb_ld(&b.bar[XB_XGEN(b.x)]) == (unsigned)bc[1]) { h = (int)__hip_atomic_fetch_add(qhead, 8u, RLX_AGENT); if (h >= CVQ_N) h = -1; }
                bc[0] = h;
            }
            __syncthreads();
            const int h = bc[0];
            __syncthreads();
            if (h < 0) { if (h == -1 && threadIdx.x == 0) XB_SPIN(xb_ld(&b.bar[XB_XGEN(b.x)]) == (unsigned)bc[1], b.bar); break; }
            conv_pair<true>(h + F.wave, CVQ_N, CVQ_N, F.ws, scr, (TIDX & 63));
        }
        if (threadIdx.x == 0) { __builtin_amdgcn_fence(__ATOMIC_ACQUIRE, "agent"); asm volatile("s_waitcnt vmcnt(0)" ::: "memory"); }
    }
    __syncthreads();
}

__device__ __forceinline__ void rope_cs(int pos, int i, float inv_nfreq, float& c, float& s) {
    const float freq = exp2f(-(float)i * inv_nfreq * 13.287712379549449f);
    const float ang = (float)pos * freq;
    c = __cosf(ang); s = __sinf(ang);
}

__device__ __forceinline__ void filler_quota(Frame& F, int nchunks) {
    __syncthreads();
    LAS int* bc = (LAS int*)(F.lds + LDSCTL_OFF + 2048);
    LAS unsigned char* scr = F.lds + F.wave * 8704;
    gu32* qhead = F.ctl + CW_QHEAD;
    const int nq = CVQ_N;
#pragma unroll 1
    for (int cidx = 0; cidx < nchunks; ++cidx) {
        if (TIDX == 0) { int h = -1;
            if (__hip_atomic_load(qhead, RLX_AGENT) < (unsigned)nq) { h = (int)__hip_atomic_fetch_add(qhead, (unsigned)CV_CHUNK, RLX_AGENT); if (h >= nq) h = -1; }
            *bc = h; }
        __syncthreads();
        const int h = *bc;
        __syncthreads();
        if (h < 0) break;
#pragma unroll 1
        for (int k = F.wave; k < CV_CHUNK; k += 2 * NWAVES) conv_pair<true>(h + k, h + k + NWAVES, CVQ_N, F.ws, scr, (TIDX & 63));
    }
    __syncthreads();
}

__device__ __forceinline__ float silu_g(float x) { return x / (1.0f + __expf(-x)); }

__device__ __forceinline__ void p0_prologue(Frame& F) {
    unsigned char* ws = F.ws;
    __syncthreads();
    {
        LAS float* sv = (LAS float*)(F.lds);
        LAS float* red = (LAS float*)(F.lds + 73728);
        for (int i = TIDX; i < 9 * 2048; i += 512) { const int r = i >> 11, d = i & 2047; const float v = (r < 8) ? inptr(I_C)[r * 2048 + d] : inptr(I_CCTX)[d]; sv[i] = silu_g(v); }
        __syncthreads();
        for (int cb = blockIdx.x; cb < 256; cb += F.G) {
            const int cg = cb * 96, layer = cg / MODW, col0 = cg - layer * MODW;
            const float* W = inptr(I_WMOD) + (size_t)layer * 2048 * MODW;
            if (TIDX < 384) {
                const int cq = TIDX % 24, ks = TIDX / 24;
                f32x4 acc[9];
#pragma unroll
                for (int r = 0; r < 9; ++r) acc[r] = (f32x4){0.f, 0.f, 0.f, 0.f};
                const float* wp = W + (size_t)(ks * 128) * MODW + col0 + cq * 4;
#pragma unroll 1
                for (int k = 0; k < 128; k += 16) {
                    f32x4 w[16];
#pragma unroll
                    for (int q = 0; q < 16; ++q) w[q] = __builtin_nontemporal_load((const GAS f32x4*)(wp + (size_t)(k + q) * MODW));
#pragma unroll
                    for (int g4 = 0; g4 < 4; ++g4) {
#pragma unroll
                        for (int r = 0; r < 9; ++r) { const f32x4 s4 = *(const LAS f32x4*)(sv + r * 2048 + ks * 128 + k + 4 * g4);
                            acc[r] += w[4 * g4 + 0] * s4.x; acc[r] += w[4 * g4 + 1] * s4.y; acc[r] += w[4 * g4 + 2] * s4.z; acc[r] += w[4 * g4 + 3] * s4.w; }
                        __builtin_amdgcn_sched_barrier(0); }
                }
#pragma unroll
                for (int r = 0; r < 9; ++r) *(LAS f32x4*)(red + (ks * 9 + r) * 96 + cq * 4) = acc[r];
            }
            __syncthreads();
            for (int i = TIDX; i < 9 * 96; i += 512) {
                const int r = i / 96, c = i - r * 96; float s = inptr(I_BMOD)[layer * MODW + col0 + c];
#pragma unroll
                for (int ks = 0; ks < 16; ++ks) s += red[(ks * 9 + r) * 96 + c];
                ((float*)(ws + WS_MOD))[((size_t)layer * 9 + r) * MODW + col0 + c] = s;
            }
            __syncthreads();
        }
    }
    {
        const size_t gt = (size_t)blockIdx.x * 512 + TIDX, GT = (size_t)F.G * 512;
        for (size_t i = gt; i < (size_t)2 * 768 * 384; i += GT) { const int l = (int)(i / (768 * 384)), r = (int)(i % (768 * 384)), n = r / 384, k = r % 384;
            ((bf16*)(ws + WS_WQUP))[i] = (bf16)f2bf(inptr(I_WQUP)[((size_t)l * 384 + k) * 768 + n]); }
        for (size_t i = gt; i < (size_t)2 * 1280 * 256; i += GT) { const int l = (int)(i / (1280 * 256)), r = (int)(i % (1280 * 256)), row = r >> 8, k = r & 255, h = row / 320, j = row - 320 * h;
            float v = 0.f;
            if (j < 128) { if (k < 128) v = inptr(I_WKVUP)[((size_t)l * 128 + k) * 1024 + h * 256 + j]; }
            else if (j < 192) { if (k == j) v = 1.0f; }
            else { if (k < 128) v = inptr(I_WKVUP)[((size_t)l * 128 + k) * 1024 + h * 256 + 128 + (j - 192)]; }
            ((bf16*)(ws + WS_WKVUP))[i] = (bf16)f2bf(v); }
        for (size_t i = gt; i < 64 * 16 + 64 * 32; i += GT) { float* tb = (float*)(ws + WS_ROPE);
            if (i < 1024) { const int pos = (int)i >> 4, f = (int)i & 15; float c, sn; rope_cs(pos, f, 1.0f / 16.0f, c, sn); tb[i] = c; tb[1024 + i] = sn; }
            else { const int q = (int)i - 1024, pos = q >> 5, f = q & 31; float c, sn; rope_cs(pos, f, 1.0f / 32.0f, c, sn); tb[2048 + q] = c; tb[4096 + q] = sn; } }
        for (size_t i = gt; i < (size_t)2 * 192 * 2048 / 8; i += GT) { const int l = (int)(i / (192 * 256)), r = (int)(i % (192 * 256));
            *(GAS v4u*)((bf16*)(ws + WS_WIN) + ((size_t)l * INCP + INC) * 2048 + (size_t)r * 8) = (v4u){0u, 0u, 0u, 0u}; }
    }
    {
        LAS unsigned char* scr = F.lds + F.wave * 8704;
        for (int it = F.gw; it < IT_WIN + IT_WOUT; it += 2 * F.NGW) {
            const int i1 = it + F.NGW, a0 = it < IT_WIN ? it : CV_N0 + (it - IT_WIN), a1 = i1 < IT_WIN ? i1 : CV_N0 + (i1 - IT_WIN);
            conv_pair<false>(a0, i1 < IT_WIN + IT_WOUT ? a1 : CV_N5, CV_N5, ws, scr, (TIDX & 63)); }
    }
}

struct RowInfo { int b, w, t, mr; bool ctx; };
__device__ __forceinline__ RowInfo row_info(int r) { RowInfo q; q.b = r / TPB; q.w = r - q.b * TPB; q.ctx = q.w < CTXL; q.t = q.w - CTXL; q.mr = q.ctx ? 8 : q.b; return q; }

__device__ __forceinline__ void norm_pass(Frame& F, int layer, bool first  , bool from_input, bool split_ctx = false) {
    unsigned char* ws = F.ws;
    const float* modl = (const float*)(ws + WS_MOD) + (size_t)layer * 9 * MODW;
    const float* g = (first ? inptr(I_GMIX) : inptr(I_GFFN)) + layer * DM;
    const int sh_off = first ? 0 : 3 * DM, sc_off = first ? DM : 4 * DM;
    const float* H = (const float*)(ws + WS_H); bf16* U = (bf16*)(ws + WS_U);
    const int tid_ = TIDX, lane_ = tid_ & 63;
    LAS float* ca = (LAS float*)F.lds; LAS float* cb = ca + 4096;
    LAS float* cg = ca + 8192;
    for (int blk = blockIdx.x; blk < 256; blk += F.G) {
        const int r0 = blk * 72, bb = r0 / TPB;
        __syncthreads();
        for (int i = tid_; i < 2 * 2048; i += 512) { const int slot = i >> 11, col = i & 2047, mr = slot ? bb : 8;
            ca[i] = g[col] * (1.0f + modl[(size_t)mr * MODW + sc_off + col]); cb[i] = modl[(size_t)mr * MODW + sh_off + col]; }
        if (split_ctx) for (int i = tid_; i < 2048; i += 512) cg[i] = ((const float*)(ws + WS_MOD))[(size_t)8 * MODW + 5 * DM + i];
        __syncthreads();
#define NP_ROW(k_, q_) (split_ctx ? bb * TPB + ((3 * (k_) + (q_)) < 8 ? CTXL + 64 * (blk & 31) + 8 * F.wave + 3 * (k_) + (q_) : 8 * (blk & 31) + F.wave) : r0 + 9 * F.wave + 3 * (k_) + (q_))
#pragma unroll 1
        for (int k = 0; k < 3; ++k) {
            f32x4 v[3][8];
#pragma unroll
            for (int q = 0; q < 3; ++q) { const int r = NP_ROW(k, q), w = r - bb * TPB;
                const float* src = from_input ? ((w < CTXL) ? inptr(I_CTX) + ((size_t)bb * CTXL + w) * DM : inptr(I_X) + ((size_t)bb * SEQ + (w - CTXL)) * DM) : H + (size_t)r * DM;
                const GAS f32x4* xr = (const GAS f32x4*)src + lane_;
#pragma unroll
                for (int j = 0; j < 8; ++j) v[q][j] = xr[64 * j]; }
            if (split_ctx && k == 2) {
                const GAS f32x4* sl = (const GAS f32x4*)((const float*)(ws + WS_R1) + ((size_t)bb * 256 + 8 * (blk & 31) + F.wave) * 2048) + lane_;
                const LAS f32x4* gp = (const LAS f32x4*)cg + lane_;
#pragma unroll 1
                for (int s4 = 0; s4 < 4; ++s4) { f32x4 t[8];
#pragma unroll
                    for (int j = 0; j < 8; ++j) t[j] = sl[(size_t)s4 * (8 * 256 * 2048 / 4) + 64 * j];
#pragma unroll
                    for (int j = 0; j < 8; ++j) v[2][j] += gp[64 * j] * t[j]; }
            }
#pragma unroll
            for (int q = 0; q < 3; ++q) { const int r = NP_ROW(k, q), w = r - bb * TPB, slot = (w < CTXL) ? 0 : 1;
                float ss = 0.f;
#pragma unroll
                for (int j = 0; j < 8; ++j) ss += (v[q][j].x * v[q][j].x + v[q][j].y * v[q][j].y) + (v[q][j].z * v[q][j].z + v[q][j].w * v[q][j].w);
                const float rstd = 1.0f / sqrtf(wave_sum(ss) * (1.0f / DM) + EPSN);
                GAS v2u* o8 = (GAS v2u*)(U + (size_t)r * DM) + lane_;
                const LAS f32x4* ap = (const LAS f32x4*)(ca + slot * 2048) + lane_; const LAS f32x4* bp = (const LAS f32x4*)(cb + slot * 2048) + lane_;
#pragma unroll
                for (int j = 0; j < 8; ++j) { f32x4 y = v[q][j] * rstd * ap[64 * j] + bp[64 * j]; if (EMU_DGU && !first) { y.x = pg8::fp8r(y.x); y.y = pg8::fp8r(y.y); y.z = pg8::fp8r(y.z); y.w = pg8::fp8r(y.w); } v2u wv; wv.x = pg8::cvt_pk_bf16(y.x, y.y); wv.y = pg8::cvt_pk_bf16(y.z, y.w); o8[64 * j] = wv; } }
        }
#undef NP_ROW
    }
    __syncthreads();
}

struct PostRow { unsigned cq[3], ckv; float kpe[2], gq[6][2], df[8][2]; };
__device__ __forceinline__ void post_load(const bf16* q, bool lat, int lane, PostRow& R) {
    const GAS unsigned* pc = (const GAS unsigned*)(q + C_CQ);
#pragma unroll
    for (int j = 0; j < 3; ++j) R.cq[j] = pc[lane + 64 * j];
    R.ckv = ((const GAS unsigned*)(q + C_CKV))[lane];
    { const int axis = (lane >> 4) & 1, i = lane & 15; const GAS bf16* pk = (const GAS bf16*)(q + C_KPE + axis * 32); R.kpe[0] = bf1(pk[i]); R.kpe[1] = bf1(pk[16 + i]); }
#pragma unroll
    for (int hh = 0; hh < 6; ++hh) { const int base = (hh < 4) ? (C_GQ + 128 * hh) : (C_GK + 128 * (hh - 4)); const int axis = lane >> 5, i = lane & 31;
        const GAS bf16* pg = (const GAS bf16*)(q + base + axis * 64); R.gq[hh][0] = bf1(pg[i]); R.gq[hh][1] = bf1(pg[32 + i]); }
    if (lat) {
#pragma unroll
        for (int pp = 0; pp < 8; ++pp) { const int blk = 2 * pp + (lane >> 5), axis = (lane >> 4) & 1, i = lane & 15; const int base = (blk < 8) ? (C_DQ + 64 * blk) : (C_DK + 64 * (blk - 8));
            const GAS bf16* pd = (const GAS bf16*)(q + base + axis * 32); R.df[pp][0] = bf1(pd[i]); R.df[pp][1] = bf1(pd[16 + i]); }
    }
}
__device__ __forceinline__ void post_finish(bf16* q, bool lat, int prow, int pcol, int lane, const PostRow& R, const float* g_mq, const float* g_mkv, const float* g_gq, const float* g_gk, const float* rt) {
    { float ss = 0.f;
#pragma unroll
      for (int j = 0; j < 3; ++j) { const float a = bflo(R.cq[j]), b = bfhi(R.cq[j]); ss += a * a + b * b; }
      const float rs = 1.0f / sqrtf(wave_sum(ss) * (1.0f / 384.0f) + EPSN); GAS unsigned* pc = (GAS unsigned*)(q + C_CQ);
#pragma unroll
      for (int j = 0; j < 3; ++j) { const int c = 2 * (lane + 64 * j); pc[lane + 64 * j] = pk2(bflo(R.cq[j]) * rs * g_mq[c], bfhi(R.cq[j]) * rs * g_mq[c + 1]); } }
    { const float a = bflo(R.ckv), b = bfhi(R.ckv); const float rs = 1.0f / sqrtf(wave_sum(a * a + b * b) * (1.0f / 128.0f) + EPSN);
      ((GAS unsigned*)(q + C_CKV))[lane] = pk2(a * rs * g_mkv[2 * lane], b * rs * g_mkv[2 * lane + 1]); }
    if (lat && lane < 32) { const int axis = lane >> 4, i = lane & 15, pos = axis ? pcol : prow; const float c = rt[pos * 16 + i], s = rt[1024 + pos * 16 + i];
      GAS bf16* pk = (GAS bf16*)(q + C_KPE + axis * 32); pk[i] = (bf16)f2bf(R.kpe[0] * c - R.kpe[1] * s); pk[16 + i] = (bf16)f2bf(R.kpe[1] * c + R.kpe[0] * s); }
    { const int axis = lane >> 5, i = lane & 31, pos = axis ? pcol : prow; const float c = rt[2048 + pos * 32 + i], s = rt[4096 + pos * 32 + i];
#pragma unroll
      for (int hh = 0; hh < 6; ++hh) { const int base = (hh < 4) ? (C_GQ + 128 * hh) : (C_GK + 128 * (hh - 4)); const float* gg = (hh < 4) ? g_gq : g_gk;
        const float x1 = R.gq[hh][0], x2 = R.gq[hh][1];
        const float rs = 1.0f / sqrtf(wave_sum(x1 * x1 + x2 * x2) * (1.0f / 128.0f) + EPSN);
        float y1 = x1 * rs * gg[axis * 64 + i], y2 = x2 * rs * gg[axis * 64 + 32 + i];
        if (lat) { const float o1 = y1 * c - y2 * s, o2 = y2 * c + y1 * s; y1 = o1; y2 = o2; }
        GAS bf16* pg = (GAS bf16*)(q + base + axis * 64); pg[i] = (bf16)f2bf(y1); pg[32 + i] = (bf16)f2bf(y2); } }
    if (lat) { const int axis = (lane >> 4) & 1, i = lane & 15, pos = axis ? pcol : prow; const float c = rt[pos * 16 + i], s = rt[1024 + pos * 16 + i];
#pragma unroll
      for (int pp = 0; pp < 8; ++pp) { const int blk = 2 * pp + (lane >> 5); const int base = (blk < 8) ? (C_DQ + 64 * blk) : (C_DK + 64 * (blk - 8));
        GAS bf16* pd = (GAS bf16*)(q + base + axis * 32); pd[i] = (bf16)f2bf(R.df[pp][0] * c - R.df[pp][1] * s); pd[16 + i] = (bf16)f2bf(R.df[pp][1] * c + R.df[pp][0] * s); } }
}
__device__ __forceinline__ void post_pass(Frame& F, int layer) {
    bf16* QKV = (bf16*)(F.ws + WS_QKV); const float* rt = (const float*)(F.ws + WS_ROPE);
    const float* g_mq = inptr(I_MLAGQ) + layer * 384; const float* g_mkv = inptr(I_MLAGKV) + layer * 128;
    const float* g_gq = inptr(I_GQAGQ) + layer * 128; const float* g_gk = inptr(I_GQAGK) + layer * 128;
    const int lane = opq_v((TIDX & 63));
    for (int r = F.gw; r < MT; r += 2 * F.NGW) {
        const int r2 = r + F.NGW; const bool two = r2 < MT;
        const RowInfo ra = row_info(r), rb = row_info(two ? r2 : r);
        bf16* qa = QKV + (size_t)r * INCP; bf16* qb = QKV + (size_t)(two ? r2 : r) * INCP;
        PostRow A, B;
        post_load(qa, !ra.ctx, lane, A); if (two) post_load(qb, !rb.ctx, lane, B);
        post_finish(qa, !ra.ctx, ra.ctx ? 0 : (ra.t >> 6), ra.ctx ? 0 : (ra.t & 63), lane, A, g_mq, g_mkv, g_gq, g_gk, rt);
        if (two) post_finish(qb, !rb.ctx, rb.ctx ? 0 : (rb.t >> 6), rb.ctx ? 0 : (rb.t & 63), lane, B, g_mq, g_mkv, g_gq, g_gk, rt);
    }
}
__device__ __forceinline__ void qm_rope_pass(Frame& F) {
    bf16* QM = (bf16*)(F.ws + WS_QM); const int lane = opq_v((TIDX & 63));
    for (int r = F.gw; r < MT; r += F.NGW) {
        const RowInfo ri = row_info(r); if (ri.ctx) continue;
        const int prow = ri.t >> 6, pcol = ri.t & 63;
#pragma unroll
        for (int pp = 0; pp < 2; ++pp) {
            const int h = 2 * pp + (lane >> 5), axis = (lane >> 4) & 1, i = lane & 15;
            GAS bf16* p = (GAS bf16*)(QM + (size_t)r * QMW + 192 * h + 128 + axis * 32);
            const float x1 = bf1(p[i]), x2 = bf1(p[16 + i]); float c, s; rope_cs(axis ? pcol : prow, i, 1.0f / 16.0f, c, s);
            p[i] = (bf16)f2bf(x1 * c - x2 * s); p[16 + i] = (bf16)f2bf(x2 * c + x1 * s);
        }
    }
}

__device__ __forceinline__ void ffn_tables(Frame& F, int layer, int b, LAS float* ca, LAS float* cb) {
    const float* modl = (const float*)(F.ws + WS_MOD) + (size_t)layer * 9 * MODW + (size_t)b * MODW; const float* g = inptr(I_GFFN) + layer * DM;
    for (int i = TIDX; i < 2048; i += 512) { ca[i] = g[i] * (1.0f + modl[4 * DM + i]); cb[i] = modl[3 * DM + i]; }
}
__device__ __forceinline__ void ffn_u_pair(Frame& F, int r0, int r1, const LAS float* ca, const LAS float* cb, int lane_, f32x4 (&v0)[8], f32x4 (&v1)[8]) {
    const float* H = (const float*)(F.ws + WS_H);
    const GAS f32x4* x0 = (const GAS f32x4*)(H + (size_t)r0 * DM) + lane_; const GAS f32x4* x1 = (const GAS f32x4*)(H + (size_t)r1 * DM) + lane_;
#pragma unroll
    for (int j = 0; j < 8; ++j) { v0[j] = x0[64 * j]; v1[j] = x1[64 * j]; }
    float s0 = 0.f, s1 = 0.f;
#pragma unroll
    for (int j = 0; j < 8; ++j) { s0 += (v0[j].x * v0[j].x + v0[j].y * v0[j].y) + (v0[j].z * v0[j].z + v0[j].w * v0[j].w); s1 += (v1[j].x * v1[j].x + v1[j].y * v1[j].y) + (v1[j].z * v1[j].z + v1[j].w * v1[j].w); }
    const float q0 = 1.0f / sqrtf(wave_sum(s0) * (1.0f / DM) + EPSN), q1 = 1.0f / sqrtf(wave_sum(s1) * (1.0f / DM) + EPSN);
    const LAS f32x4* ap = (const LAS f32x4*)ca + lane_; const LAS f32x4* bp = (const LAS f32x4*)cb + lane_;
#pragma unroll
    for (int j = 0; j < 8; ++j) { const f32x4 a4 = ap[64 * j], b4 = bp[64 * j]; v0[j] = v0[j] * q0 * a4 + b4; v1[j] = v1[j] * q1 * a4 + b4; }
}
__device__ __forceinline__ int moe_tok(int blk, int tl) { return (blk >> 5) * 2048 + (blk & 31) + 32 * tl; }
__device__ __forceinline__ void route_one(const f32x4 (&v)[8], const LAS float* wl, const float* br, int lane_, int& e1o, int& e2o, float& g1o, float& g2o) {
    float lg[8];
#pragma unroll
    for (int e = 0; e < 8; ++e) lg[e] = 0.f;
#pragma unroll
    for (int j = 0; j < 8; ++j) {
        const LAS f32x4* wp = (const LAS f32x4*)(wl + (size_t)(4 * (lane_ + 64 * j)) * 8);
#pragma unroll
        for (int c = 0; c < 4; ++c) { const f32x4 w0 = wp[2 * c], w1 = wp[2 * c + 1]; const float x = v[j][c];
            lg[0] += x * w0.x; lg[1] += x * w0.y; lg[2] += x * w0.z; lg[3] += x * w0.w; lg[4] += x * w1.x; lg[5] += x * w1.y; lg[6] += x * w1.z; lg[7] += x * w1.w; }
    }
#pragma unroll
    for (int e = 0; e < 8; ++e) lg[e] = wave_sum(lg[e]) + br[e];
    int e1 = 0; float v1 = lg[0];
#pragma unroll
    for (int e = 1; e < 8; ++e) if (lg[e] > v1) { v1 = lg[e]; e1 = e; }
    int e2 = -1; float v2 = -3.0e38f;
#pragma unroll
    for (int e = 0; e < 8; ++e) if (e != e1 && lg[e] > v2) { v2 = lg[e]; e2 = e; }
    g2o = 1.0f / (1.0f + expf(v1 - v2)); g1o = 1.0f - g2o; e1o = e1; e2o = e2;
}
__device__ __forceinline__ void moe_route_pass(Frame& F, int layer) {
    const int lane_ = opq_v((TIDX & 63));
    int* rt = (int*)(F.ws + WS_ROUTE); float* rtf = (float*)(F.ws + WS_ROUTE);
    LAS float* ca = (LAS float*)F.lds; LAS float* cb = ca + 2048; LAS float* wl = ca + 4096;
    LAS int* le = (LAS int*)(F.lds + 16384 + 65536);
    const float* wr = inptr(I_MR); const float* br = inptr(I_MB);
    __syncthreads();
    for (int i = TIDX; i < 2048 * 8 / 4; i += 512) ((LAS f32x4*)wl)[i] = ((const GAS f32x4*)wr)[i];
    for (int blk = blockIdx.x; blk < 256; blk += F.G) {
        const int b = blk >> 5;
        __syncthreads();
        ffn_tables(F, layer, b, ca, cb);
        __syncthreads();
#pragma unroll 1
        for (int i = 0; i < 4; ++i) {
            const int tl = F.wave + 16 * i, tl1 = tl + 8, tok = moe_tok(blk, tl), tok1 = moe_tok(blk, tl1);
            f32x4 v0[8], v1[8]; ffn_u_pair(F, b * TPB + CTXL + (tok & 2047), b * TPB + CTXL + (tok1 & 2047), ca, cb, lane_, v0, v1);
            int e1, e2; float g1, g2;
            route_one(v0, wl, br, lane_, e1, e2, g1, g2);
            if (lane_ == 0) { le[tl] = e1 | (e2 << 8); rt[RT_E + tok] = e1 | (e2 << 8); rtf[RT_G + 2 * tok] = g1; rtf[RT_G + 2 * tok + 1] = g2; }
            route_one(v1, wl, br, lane_, e1, e2, g1, g2);
            if (lane_ == 0) { le[tl1] = e1 | (e2 << 8); rt[RT_E + tok1] = e1 | (e2 << 8); rtf[RT_G + 2 * tok1] = g1; rtf[RT_G + 2 * tok1 + 1] = g2; }
        }
        __syncthreads();
        if (TIDX < 8) { const int e = TIDX; int cnt = 0;
            for (int tl = 0; tl < 64; ++tl) { const int w = le[tl], a = w & 255, c = w >> 8;
                if (a == e) rt[RT_RANK + 2 * moe_tok(blk, tl)] = cnt++;
                if (c == e) rt[RT_RANK + 2 * moe_tok(blk, tl) + 1] = cnt++; }
            rt[RT_CNT + blk * 8 + e] = cnt; }
    }
    __syncthreads();
}
__device__ __forceinline__ void moe_tables(Frame& F, LAS int* tab, int blk) {
    const int* rt = (const int*)(F.ws + WS_ROUTE);
    __syncthreads();
    if (TIDX < 8) { const int e = TIDX; int tot = 0, before = 0;
        for (int k = 0; k < 256; ++k) { const int c = rt[RT_CNT + k * 8 + e]; tot += c; before += (k < blk) ? c : 0; }
        tab[e] = tot; tab[16 + e] = before; }
    __syncthreads();
    if (TIDX == 0) { int base = 0, pan = 0, nf = 0, nr = 0;
        for (int e = 0; e < 8; ++e) { tab[8 + e] = base; const int np = (tab[e] + 255) >> 8, fu = tab[e] >> 8; base += np * 256; pan += np; tab[32 + e] = pan;
            tab[48 + e] = nr; nf += fu; tab[40 + e] = nf; if (np != fu) { tab[64 + nr] = e; ++nr; } }
        tab[24] = pan; tab[56] = nf; tab[57] = nr; }
    __syncthreads();
}
__device__ __forceinline__ void moe_scatter_pass(Frame& F, int layer) {
    const int lane_ = opq_v((TIDX & 63));
    int* rt = (int*)(F.ws + WS_ROUTE); bf16* AS = (bf16*)(F.ws + WS_AS);
    LAS int* tab = (LAS int*)(F.lds + 16384); LAS float* ca = (LAS float*)F.lds; LAS float* cb = ca + 2048;
    for (int blk = blockIdx.x; blk < 256; blk += F.G) {
        const int b = blk >> 5;
        moe_tables(F, tab, blk);
        ffn_tables(F, layer, b, ca, cb);
        __syncthreads();
#pragma unroll 1
        for (int i = 0; i < 4; ++i) {
            const int tl = F.wave + 16 * i, tok = moe_tok(blk, tl), tok1 = moe_tok(blk, tl + 8);
            f32x4 v0[8], v1[8]; ffn_u_pair(F, b * TPB + CTXL + (tok & 2047), b * TPB + CTXL + (tok1 & 2047), ca, cb, lane_, v0, v1);
#pragma unroll
            for (int s = 0; s < 2; ++s) {
                const int tk = s ? tok1 : tok; const int w = rt[RT_E + tk], e1 = w & 255, e2 = w >> 8;
                const int p1 = tab[8 + e1] + tab[16 + e1] + rt[RT_RANK + 2 * tk], p2 = tab[8 + e2] + tab[16 + e2] + rt[RT_RANK + 2 * tk + 1];
                if (lane_ == 0) { rt[RT_POS + 2 * tk] = p1; rt[RT_POS + 2 * tk + 1] = p2; }
                if (MOE_FP8) {
                    GAS unsigned* q1 = (GAS unsigned*)((unsigned char*)AS + (size_t)p1 * DM) + lane_; GAS unsigned* q2 = (GAS unsigned*)((unsigned char*)AS + (size_t)p2 * DM) + lane_;
#pragma unroll
                    for (int j = 0; j < 8; ++j) { const f32x4 y = s ? v1[j] : v0[j]; const unsigned x = pg8::pk4_fp8(y.x, y.y, y.z, y.w); q1[64 * j] = x; q2[64 * j] = x; }
                    continue; }
                GAS v2u* o1 = (GAS v2u*)(AS + (size_t)p1 * DM) + lane_; GAS v2u* o2 = (GAS v2u*)(AS + (size_t)p2 * DM) + lane_;
#pragma unroll
                for (int j = 0; j < 8; ++j) { f32x4 y = s ? v1[j] : v0[j]; if (EMU_FP8) { y.x = pg8::fp8r(y.x); y.y = pg8::fp8r(y.y); y.z = pg8::fp8r(y.z); y.w = pg8::fp8r(y.w); } v2u x; x.x = pg8::cvt_pk_bf16(y.x, y.y); x.y = pg8::cvt_pk_bf16(y.z, y.w); o1[64 * j] = x; o2[64 * j] = x; }
            }
        }
        for (int e = 0; e < 8; ++e) { const int tot = tab[e], end = (tot + 255) & ~255;
            for (int pr = tot + blk * 8 + F.wave; pr < end; pr += 2048) {
                if (MOE_FP8) { GAS unsigned* o = (GAS unsigned*)((unsigned char*)AS + (size_t)(tab[8 + e] + pr) * DM) + lane_;
#pragma unroll
                    for (int j = 0; j < 8; ++j) o[64 * j] = 0u; continue; }
                GAS v2u* o = (GAS v2u*)(AS + (size_t)(tab[8 + e] + pr) * DM) + lane_;
#pragma unroll
                for (int j = 0; j < 8; ++j) o[64 * j] = (v2u){0u, 0u}; } }
    }
    __syncthreads();
}
__device__ __forceinline__ void final_pass(Frame& F, int layer) {
    const int lane_ = opq_v((TIDX & 63));
    const int* rt = (const int*)(F.ws + WS_ROUTE); const float* rtf = (const float*)(F.ws + WS_ROUTE);
    const bf16* Y = (const bf16*)(F.ws + WS_Y); const float* H = (const float*)(F.ws + WS_H); const float* SL = (const float*)(F.ws + WS_U);
    const float* modl = (const float*)(F.ws + WS_MOD) + (size_t)layer * 9 * MODW;
    LAS int* tab = (LAS int*)(F.lds);
    moe_tables(F, tab, 0);
    for (int tok = F.gw; tok < NBATCH * SEQ; tok += F.NGW) {
        const int b = tok >> 11, t = tok & 2047, r = b * TPB + CTXL + t;
        const int ee = rt[RT_E + tok]; const float g1 = rtf[RT_G + 2 * tok], g2 = rtf[RT_G + 2 * tok + 1];
        const GAS f32x4* xr = (const GAS f32x4*)(H + (size_t)r * DM) + lane_;
        const GAS f32x4* gt = (const GAS f32x4*)(modl + (size_t)b * MODW + 5 * DM) + lane_;
        f32x4 y[8], v[8];
#pragma unroll
        for (int j = 0; j < 8; ++j) { y[j] = (f32x4){0.f, 0.f, 0.f, 0.f}; v[j] = xr[64 * j]; }
#pragma unroll 1
        for (int s = 0; s < 2; ++s) {
            const int e = s ? (ee >> 8) : (ee & 255), p = rt[RT_POS + 2 * tok + s]; const float g = s ? g2 : g1;
            const int loc = p - tab[8 + e], fu = tab[e] >> 8;
            if (loc < 256 * fu) {
                const GAS v2u* yp = (const GAS v2u*)(Y + (size_t)p * DM) + lane_;
#pragma unroll
                for (int j = 0; j < 8; ++j) { const v2u a = yp[64 * j]; y[j] += (f32x4){bflo(a.x), bfhi(a.x), bflo(a.y), bfhi(a.y)} * g; }
            } else {
                const int rr = tab[48 + e], row = loc - 256 * fu;
#pragma unroll
                for (int ks = 0; ks < 4; ++ks) { const GAS f32x4* sp = (const GAS f32x4*)(SL + ((size_t)(ks * 8 + rr) * 256 + row) * DM) + lane_;
#pragma unroll
                    for (int j = 0; j < 8; ++j) y[j] += sp[64 * j] * g; }
            }
        }
        float ss = 0.f;
#pragma unroll
        for (int j = 0; j < 8; ++j) { v[j] = v[j] + gt[64 * j] * y[j]; ss += (v[j].x * v[j].x + v[j].y * v[j].y) + (v[j].z * v[j].z + v[j].w * v[j].w); }
        const float rstd = 1.0f / sqrtf(wave_sum(ss) * (1.0f / DM) + EPSN);
        const GAS f32x4* gf = (const GAS f32x4*)inptr(I_GFIN) + lane_;
        GAS f32x4* op = (GAS f32x4*)(F.out + (size_t)tok * DM) + lane_;
#pragma unroll
        for (int j = 0; j < 8; ++j) op[64 * j] = v[j] * rstd * gf[64 * j];
    }
}

namespace fa {
using bf16x8 = __attribute__((ext_vector_type(8))) short;
using s16x4  = __attribute__((ext_vector_type(4))) short;
using f32x16 = __attribute__((ext_vector_type(16))) float;
using u32x4  = __attribute__((ext_vector_type(4))) unsigned;
constexpr int SHM_V = 64 * 128 * 2;
constexpr float THRN = 8.f;
#define FA_SBAR() __builtin_amdgcn_sched_barrier(0)
__device__ __forceinline__ int kswz(int row, int colB, int pitch) { return row * pitch + (colB ^ ((row & 7) << 4)); }
__device__ __forceinline__ int crow(int r, int hi) { return (r & 3) + 8 * (r >> 2) + 4 * hi; }
__device__ __forceinline__ unsigned cvtpk(float lo, float hi) { unsigned r; asm volatile("v_cvt_pk_bf16_f32 %0, %1, %2" : "=v"(r) : "v"(lo), "v"(hi)); return r; }

__device__ __forceinline__ void partialSM(f32x16& p0, f32x16& p1, float& m_reg, float& mn, float& alpha, const float C, const float thr_raw) {
  float pmax = p0[0];
#pragma unroll
  for (int r = 1; r < 16; ++r) pmax = fmaxf(pmax, p0[r]);
#pragma unroll
  for (int r = 0; r < 16; ++r) pmax = fmaxf(pmax, p1[r]);
  { auto rr = __builtin_amdgcn_permlane32_swap(__float_as_uint(pmax), __float_as_uint(pmax), false, false);
    pmax = fmaxf(__uint_as_float(rr[0]), __uint_as_float(rr[1])); }
  if (__builtin_expect(__all(pmax - m_reg <= thr_raw), 1)) { mn = m_reg; alpha = 1.f; }
  else { mn = fmaxf(m_reg, pmax); alpha = __builtin_amdgcn_exp2f((m_reg - mn) * C); m_reg = mn; }
  const float mnC = -mn * C;
#pragma unroll
  for (int r = 0; r < 16; ++r) p0[r] = fmaf(p0[r], C, mnC);
#pragma unroll
  for (int r = 0; r < 16; ++r) p1[r] = fmaf(p1[r], C, mnC);
#pragma unroll
  for (int r = 0; r < 16; ++r) p0[r] = __builtin_amdgcn_exp2f(p0[r]);
}
__device__ __forceinline__ void finishSM(f32x16& p0, f32x16& p1, float alpha, float& l_reg, bf16x8& pa0, bf16x8& pa1, bf16x8& pa2, bf16x8& pa3) {
#pragma unroll
  for (int r = 0; r < 16; ++r) p1[r] = __builtin_amdgcn_exp2f(p1[r]);
  float ps = 0;
#pragma unroll
  for (int r = 0; r < 16; ++r) ps += p0[r];
#pragma unroll
  for (int r = 0; r < 16; ++r) ps += p1[r];
  { auto rr = __builtin_amdgcn_permlane32_swap(__float_as_uint(ps), __float_as_uint(ps), false, false);
    ps = __uint_as_float(rr[0]) + __uint_as_float(rr[1]); }
  l_reg = l_reg * alpha + ps;
#define FA_PK4(P, BASE, OUT) do { unsigned a0 = cvtpk(P[BASE + 0], P[BASE + 1]), a1 = cvtpk(P[BASE + 2], P[BASE + 3]);   \
    unsigned b0 = cvtpk(P[BASE + 4], P[BASE + 5]), b1 = cvtpk(P[BASE + 6], P[BASE + 7]);                              \
    auto r0 = __builtin_amdgcn_permlane32_swap(a0, b0, false, false); auto r1 = __builtin_amdgcn_permlane32_swap(a1, b1, false, false); \
    u32x4 w = {r0[0], r1[0], r0[1], r1[1]}; OUT = __builtin_bit_cast(bf16x8, w); } while (0)
  FA_PK4(p0, 0, pa0); FA_PK4(p0, 8, pa1); FA_PK4(p1, 0, pa2); FA_PK4(p1, 8, pa3);
#undef FA_PK4
}
template <int DK>
__device__ __forceinline__ void qkt(f32x16& p0, f32x16& p1, const LAS unsigned char* Ks, const bf16x8 (&qr)[DK / 16], int r32, int hi) {
  p0 = f32x16{}; p1 = f32x16{};
#pragma unroll
  for (int d0 = 0; d0 < DK / 16; ++d0) { const int cb = (d0 * 16 + hi * 8) * 2;
    const bf16x8 b0 = *(const LAS bf16x8*)(Ks + kswz(r32, cb, DK * 2));
    const bf16x8 b1 = *(const LAS bf16x8*)(Ks + kswz(32 + r32, cb, DK * 2));
    p0 = __builtin_amdgcn_mfma_f32_32x32x16_bf16(b0, qr[d0], p0, 0, 0, 0);
    p1 = __builtin_amdgcn_mfma_f32_32x32x16_bf16(b1, qr[d0], p1, 0, 0, 0); }
}
__device__ __forceinline__ int v_st(int k, int c) { const int kk = (k & ~0xC) | ((k & 4) << 1) | ((k & 8) >> 1); return ((kk >> 3) * 4 + (c >> 5)) * 512 + ((kk & 7) * 32 + (c & 31)) * 2; }
__device__ __forceinline__ int v_rd_base(int lane) { return ((lane & 3) << 3) | (((lane >> 2) & 3) << 6) | (((lane >> 4) & 1) << 5) | (((lane >> 5) & 1) << 8); }
constexpr int v_rd_off(int d0, int ks, int half) { return d0 * 512 + ks * 4096 + half * 2048; }
template <int OFF> __device__ __forceinline__ s16x4 tr_read(int vb) {
  s16x4 r; asm volatile("ds_read_b64_tr_b16 %0, %1 offset:%2" : "=&v"(r) : "v"(vb), "i"(OFF) : "memory"); return r;
}
template <int D0> __device__ __forceinline__ void pv_one(f32x16& od, int vb, bf16x8 pa0, bf16x8 pa1, bf16x8 pa2, bf16x8 pa3) {
  const s16x4 l0 = tr_read<v_rd_off(D0, 0, 0)>(vb), h0 = tr_read<v_rd_off(D0, 0, 1)>(vb), l1 = tr_read<v_rd_off(D0, 1, 0)>(vb), h1 = tr_read<v_rd_off(D0, 1, 1)>(vb);
  const s16x4 l2 = tr_read<v_rd_off(D0, 2, 0)>(vb), h2 = tr_read<v_rd_off(D0, 2, 1)>(vb), l3 = tr_read<v_rd_off(D0, 3, 0)>(vb), h3 = tr_read<v_rd_off(D0, 3, 1)>(vb);
  asm volatile("s_waitcnt lgkmcnt(0)" ::: "memory"); FA_SBAR();
#define FA_PK(L, H) (bf16x8){L[0], L[1], L[2], L[3], H[0], H[1], H[2], H[3]}
  od = __builtin_amdgcn_mfma_f32_32x32x16_bf16(pa0, FA_PK(l0, h0), od, 0, 0, 0);
  od = __builtin_amdgcn_mfma_f32_32x32x16_bf16(pa1, FA_PK(l1, h1), od, 0, 0, 0);
  od = __builtin_amdgcn_mfma_f32_32x32x16_bf16(pa2, FA_PK(l2, h2), od, 0, 0, 0);
  od = __builtin_amdgcn_mfma_f32_32x32x16_bf16(pa3, FA_PK(l3, h3), od, 0, 0, 0);
#undef FA_PK
}
__device__ __forceinline__ void pv_d0(f32x16 (&o)[4], int vb, bf16x8 pa0, bf16x8 pa1, bf16x8 pa2, bf16x8 pa3) {
  pv_one<0>(o[0], vb, pa0, pa1, pa2, pa3); pv_one<1>(o[1], vb, pa0, pa1, pa2, pa3); pv_one<2>(o[2], vb, pa0, pa1, pa2, pa3); pv_one<3>(o[3], vb, pa0, pa1, pa2, pa3);
}

struct TileMap { int k0, lat0, r_lo; bool na;
  __device__ __forceinline__ int row(int j) const { if (!na || j < 4) return k0 + 64 * j; const int g = min(r_lo + j - 4, 31); return lat0 + 64 * g; } };
struct NaLane { int qr, qc, rs, cs; const LAS float* btab; };

__device__ __forceinline__ void na_mask(f32x16& p0, f32x16& p1, int j, const TileMap& tm, const NaLane& nl, int hi) {
  if (j < 4) return;
  const int kr = tm.r_lo + j - 4; const bool rowok = (kr >= nl.rs) && (kr < nl.rs + 8);
  const int b0 = (kr - nl.qr + 7) * 31 + 15 - nl.qc;
#pragma unroll
  for (int r = 0; r < 16; ++r) {
    const int kc0 = crow(r, hi), kc1 = 32 + kc0;
    const bool ok0 = rowok && (kc0 >= nl.cs) && (kc0 < nl.cs + 16), ok1 = rowok && (kc1 >= nl.cs) && (kc1 < nl.cs + 16);
    float bv0 = 0.f, bv1 = 0.f; if (ok0) bv0 = nl.btab[b0 + kc0]; if (ok1) bv1 = nl.btab[b0 + kc1];
    p0[r] = ok0 ? p0[r] + bv0 : -1e30f; p1[r] = ok1 ? p1[r] + bv1 : -1e30f;
  }
}

template <int DK, int SDEPTH, bool NA>
__device__ __forceinline__ void body(const bf16* Qb, int ldq, const bf16* Kp, int ldk, const bf16* Vp, int ldv, const TileMap tm, const int NT, const float scale,
                                     const NaLane nl, LAS unsigned char* lds, f32x16 (&o)[4]) {
  constexpr int KP = DK / 64, SHM_K = 64 * DK * 2, KCH = DK / 8;
  int tid = threadIdx.x; asm volatile("" : "+v"(tid));
  const int wid = tid >> 6, lane = tid & 63, r32 = lane & 31, hi = lane >> 5;
  LAS unsigned char* V_lds = lds; LAS unsigned char* K_lds = lds + 2 * SHM_V;
  LAS float* wsl = (LAS float*)(lds + 2 * SHM_V + 2 * SHM_K) + wid * 64; LAS float* li_l = wsl; LAS float* al_l = wsl + 32;
  const float C = scale * 1.4426950408889634f, thr_raw = THRN / scale;
  float m_reg = -1e30f, l_reg = 0;
#pragma unroll
  for (int d = 0; d < 4; ++d) o[d] = f32x16{};
  bf16x8 qr[DK / 16];
  { const bf16* Qw = Qb + (long)(wid * 32 + r32) * ldq + hi * 8;
#pragma unroll
    for (int d0 = 0; d0 < DK / 16; ++d0) qr[d0] = *(const GAS bf16x8*)(Qw + d0 * 16); }
  const int sr = tid >> 4, sc = (tid & 15) * 8, vst0 = v_st(sr, sc), vst1 = v_st(32 + sr, sc);
  int krow[KP], kcol[KP], kst[KP];
#pragma unroll
  for (int i = 0; i < KP; ++i) { const int c = tid + 512 * i; krow[i] = c / KCH; kcol[i] = (c % KCH) * 8; kst[i] = kswz(krow[i], kcol[i] * 2, DK * 2); }
  const int vb0 = (int)(unsigned)(unsigned long)(V_lds) + v_rd_base(lane);
  struct Slot { bf16x8 vs0, vs1, ks[KP]; } sl[SDEPTH];
#define FA_SLOAD(i, j) do { const int r0_ = tm.row(j); sl[i].vs0 = *(const GAS bf16x8*)(Vp + (long)(r0_ + sr) * ldv + sc); sl[i].vs1 = *(const GAS bf16x8*)(Vp + (long)(r0_ + 32 + sr) * ldv + sc); \
    _Pragma("unroll") for (int q_ = 0; q_ < KP; ++q_) sl[i].ks[q_] = *(const GAS bf16x8*)(Kp + (long)(r0_ + krow[q_]) * ldk + kcol[q_]); } while (0)
#define FA_SWRITE(b, i) do { *(LAS bf16x8*)(V_lds + (b) * SHM_V + vst0) = sl[i].vs0; *(LAS bf16x8*)(V_lds + (b) * SHM_V + vst1) = sl[i].vs1; \
    _Pragma("unroll") for (int q_ = 0; q_ < KP; ++q_) *(LAS bf16x8*)(K_lds + (b) * SHM_K + kst[q_]) = sl[i].ks[q_]; } while (0)
#define FA_SWAIT() do { if constexpr (SDEPTH == 2) asm volatile("s_waitcnt vmcnt(%0)" :: "n"(2 + KP) : "memory"); else asm volatile("s_waitcnt vmcnt(0)" ::: "memory"); } while (0)
#define FA_RESC(a) do { if (__any((a) < 1.f)) { if (hi == 0) al_l[r32] = (a); asm volatile("s_waitcnt lgkmcnt(0)" ::: "memory"); \
    _Pragma("unroll") for (int d = 0; d < 4; ++d) _Pragma("unroll") for (int r = 0; r < 16; ++r) o[d][r] *= al_l[crow(r, hi)]; } } while (0)
#define FA_QKT(P0, P1, buf, j) do { qkt<DK>(P0, P1, K_lds + (buf) * SHM_K, qr, r32, hi); if constexpr (NA) na_mask(P0, P1, j, tm, nl, hi); } while (0)
  f32x16 pA0, pA1, pB0, pB1; float mnA, mnB, alA, alB; bf16x8 pa0, pa1, pa2, pa3;
  constexpr int SE = 0, SO = SDEPTH - 1;
  FA_SLOAD(SE, 0); asm volatile("s_waitcnt vmcnt(0)" ::: "memory"); FA_SWRITE(0, SE); __syncthreads();
  FA_QKT(pA0, pA1, 0, 0); partialSM(pA0, pA1, m_reg, mnA, alA, C, thr_raw);
  FA_SLOAD(SO, 1); if constexpr (SDEPTH == 2) { if (2 < NT) FA_SLOAD(SE, 2); }
  FA_SWAIT(); FA_SWRITE(1, SO); __syncthreads();
  for (int j = 1; j + 1 < NT; j += 2) {
    FA_SBAR(); FA_QKT(pB0, pB1, 1, j);
    finishSM(pA0, pA1, alA, l_reg, pa0, pa1, pa2, pa3); FA_SBAR();
    FA_SLOAD(SO, j + SDEPTH); FA_SBAR();
    pv_d0(o, vb0, pa0, pa1, pa2, pa3); partialSM(pB0, pB1, m_reg, mnB, alB, C, thr_raw);
    __syncthreads(); FA_SWAIT(); FA_SWRITE(0, SE);
    FA_RESC(alB); __syncthreads();
    FA_SBAR(); FA_QKT(pA0, pA1, 0, j + 1);
    finishSM(pB0, pB1, alB, l_reg, pa0, pa1, pa2, pa3); FA_SBAR();
    if (SDEPTH == 1 || j + 3 < NT) FA_SLOAD(SE, j + 1 + SDEPTH); FA_SBAR();
    pv_d0(o, vb0 + SHM_V, pa0, pa1, pa2, pa3); partialSM(pA0, pA1, m_reg, mnA, alA, C, thr_raw);
    __syncthreads(); FA_SWAIT(); FA_SWRITE(1, SO);
    FA_RESC(alA); __syncthreads();
  }
  FA_SBAR(); FA_QKT(pB0, pB1, 1, NT - 1);
  finishSM(pA0, pA1, alA, l_reg, pa0, pa1, pa2, pa3); FA_SBAR();
  pv_d0(o, vb0, pa0, pa1, pa2, pa3); partialSM(pB0, pB1, m_reg, mnB, alB, C, thr_raw);
  __syncthreads(); FA_RESC(alB);
  finishSM(pB0, pB1, alB, l_reg, pa0, pa1, pa2, pa3); FA_SBAR();
  pv_d0(o, vb0 + SHM_V, pa0, pa1, pa2, pa3);
  if (hi == 0) li_l[r32] = l_reg; asm volatile("s_waitcnt lgkmcnt(0)" ::: "memory");
#pragma unroll
  for (int r = 0; r < 16; ++r) { const float rl = __builtin_amdgcn_rcpf(li_l[crow(r, hi)]);
#pragma unroll
    for (int d0 = 0; d0 < 4; ++d0) o[d0][r] *= rl; }
#undef FA_SLOAD
#undef FA_SWRITE
#undef FA_SWAIT
#undef FA_RESC
#undef FA_QKT
}

template <int DK, bool NA>
__device__ __forceinline__ void body_seq(const bf16* Qb, int ldq, const bf16* Kp, int ldk, const bf16* Vp, int ldv, const TileMap tm, const int NT, const float scale,
                                         const NaLane nl, LAS unsigned char* lds, f32x16 (&o)[4]) {
  constexpr int KP = DK / 64, SHM_K = 64 * DK * 2, KCH = DK / 8;
  int tid = threadIdx.x; asm volatile("" : "+v"(tid));
  const int wid = tid >> 6, lane = tid & 63, r32 = lane & 31, hi = lane >> 5;
  LAS unsigned char* V_lds = lds; LAS unsigned char* K_lds = lds + 2 * SHM_V;
  LAS float* wsl = (LAS float*)(lds + 2 * SHM_V + 2 * SHM_K) + wid * 64; LAS float* li_l = wsl; LAS float* al_l = wsl + 32;
  const float C = scale * 1.4426950408889634f, thr_raw = THRN / scale;
  float m_reg = -1e30f, l_reg = 0;
#pragma unroll
  for (int d = 0; d < 4; ++d) o[d] = f32x16{};
  bf16x8 qr[DK / 16];
  { const bf16* Qw = Qb + (long)(wid * 32 + r32) * ldq + hi * 8;
#pragma unroll
    for (int d0 = 0; d0 < DK / 16; ++d0) qr[d0] = *(const GAS bf16x8*)(Qw + d0 * 16); }
  const int sr = tid >> 4, sc = (tid & 15) * 8, vst0 = v_st(sr, sc), vst1 = v_st(32 + sr, sc);
  int krow[KP], kcol[KP], kst[KP];
#pragma unroll
  for (int i = 0; i < KP; ++i) { const int c = tid + 512 * i; krow[i] = c / KCH; kcol[i] = (c % KCH) * 8; kst[i] = kswz(krow[i], kcol[i] * 2, DK * 2); }
  const int vb0 = (int)(unsigned)(unsigned long)(V_lds) + v_rd_base(lane);
  bf16x8 vs0, vs1, ks[KP];
#define FS_SLOAD(j) do { const int r0_ = tm.row(j); vs0 = *(const GAS bf16x8*)(Vp + (long)(r0_ + sr) * ldv + sc); vs1 = *(const GAS bf16x8*)(Vp + (long)(r0_ + 32 + sr) * ldv + sc); \
    _Pragma("unroll") for (int q_ = 0; q_ < KP; ++q_) ks[q_] = *(const GAS bf16x8*)(Kp + (long)(r0_ + krow[q_]) * ldk + kcol[q_]); } while (0)
#define FS_SWRITE(b) do { *(LAS bf16x8*)(V_lds + (b) * SHM_V + vst0) = vs0; *(LAS bf16x8*)(V_lds + (b) * SHM_V + vst1) = vs1; \
    _Pragma("unroll") for (int q_ = 0; q_ < KP; ++q_) *(LAS bf16x8*)(K_lds + (b) * SHM_K + kst[q_]) = ks[q_]; } while (0)
  FS_SLOAD(0); FS_SWRITE(0); __syncthreads();
#pragma unroll 1
  for (int j = 0; j < NT; ++j) {
    const int b = j & 1;
    if (j + 1 < NT) FS_SLOAD(j + 1);
    f32x16 p0, p1; float mn, al; bf16x8 pa0, pa1, pa2, pa3;
    qkt<DK>(p0, p1, K_lds + b * SHM_K, qr, r32, hi);
    if constexpr (NA) na_mask(p0, p1, j, tm, nl, hi);
    partialSM(p0, p1, m_reg, mn, al, C, thr_raw);
    finishSM(p0, p1, al, l_reg, pa0, pa1, pa2, pa3);
    if (__any(al < 1.f)) { if (hi == 0) al_l[r32] = al; asm volatile("s_waitcnt lgkmcnt(0)" ::: "memory");
#pragma unroll
      for (int d = 0; d < 4; ++d)
#pragma unroll
        for (int r = 0; r < 16; ++r) o[d][r] *= al_l[crow(r, hi)]; }
    FA_SBAR();
    pv_d0(o, vb0 + b * SHM_V, pa0, pa1, pa2, pa3);
    if (j + 1 < NT) FS_SWRITE(b ^ 1);
    __syncthreads();
  }
  if (hi == 0) li_l[r32] = l_reg; asm volatile("s_waitcnt lgkmcnt(0)" ::: "memory");
#pragma unroll
  for (int r = 0; r < 16; ++r) { const float rl = __builtin_amdgcn_rcpf(li_l[crow(r, hi)]);
#pragma unroll
    for (int d0 = 0; d0 < 4; ++d0) o[d0][r] *= rl; }
#undef FS_SLOAD
#undef FS_SWRITE
}
}

__device__ __forceinline__ void fa_store(const fa::f32x16 (&o)[4], LAS unsigned char* lds, bf16* Orow0  , bool do_norm, const float* gsub, float post) {
    int tid = threadIdx.x; asm volatile("" : "+v"(tid));
    const int wid = tid >> 6, lane = tid & 63, r32 = lane & 31, hi = lane >> 5;
    LAS float* slab = (LAS float*)(lds + wid * 16384);
    __syncthreads();
#pragma unroll
    for (int r = 0; r < 16; ++r) { const int row = fa::crow(r, hi);
#pragma unroll
        for (int d0 = 0; d0 < 4; ++d0) slab[row * 128 + d0 * 32 + r32] = o[d0][r]; }
    LDS_WAIT();
    const int row = lane >> 1, half = lane & 1;
    const LAS f32x4* src = (const LAS f32x4*)(slab + row * 128 + half * 64);
    f32x4 v[16]; float ss = 0.f;
#pragma unroll
    for (int c = 0; c < 16; ++c) { v[c] = src[c]; ss += (v[c].x * v[c].x + v[c].y * v[c].y) + (v[c].z * v[c].z + v[c].w * v[c].w); }
    float sc = 1.0f;
    if (do_norm) { ss += __shfl_xor(ss, 1); sc = post / sqrtf(ss * (1.0f / 128.0f) + EPSN);
#pragma unroll
        for (int c = 0; c < 16; ++c) v[c] = v[c] * *(const GAS f32x4*)(gsub + half * 64 + 4 * c); }
    GAS v4u* dst = (GAS v4u*)(Orow0 + (size_t)(wid * 32 + row) * DM + half * 64);
#pragma unroll
    for (int c = 0; c < 8; ++c) { const f32x4 a = v[2 * c] * sc, b = v[2 * c + 1] * sc; v4u w; w.x = pk2(a.x, a.y); w.y = pk2(a.z, a.w); w.z = pk2(b.x, b.y); w.w = pk2(b.z, b.w); dst[c] = w; }
    __syncthreads();
}

__device__ __forceinline__ void attn_unit_fa(Frame& F, int layer, int b, bool latent, int qb, int type, int h) {
    unsigned char* ws = F.ws;
    const bf16* QKV = (const bf16*)(ws + WS_QKV); const bf16* QM = (const bf16*)(ws + WS_QM); const bf16* KVM = (const bf16*)(ws + WS_KVM); bf16* O = (bf16*)(ws + WS_O);
    const int q0 = b * TPB + (latent ? CTXL + qb * 256 : 0);
    const int kall0 = b * TPB, ntall = latent ? TPB / 64 : CTXL / 64;
    bf16* orow0 = O + (size_t)q0 * DM + type * 512 + h * 128;
    fa::TileMap tm; tm.k0 = kall0; tm.lat0 = kall0 + CTXL; tm.r_lo = 0; tm.na = false;
    fa::NaLane nl; nl.qr = 0; nl.qc = 0; nl.rs = 0; nl.cs = 0; nl.btab = nullptr;
    fa::f32x16 o[4];
#ifdef FA_ONLY
    type = FA_ONLY; if (FA_ONLY != 4) latent = FA_ONLY != 0 ? latent : false; else { type = 0; latent = true; }
#endif
    if (type == 0 && latent) {
        const int r_lo = min(max(4 * qb - 4, 0), 24), r_hi = min(max(4 * qb + 3 - 4, 0), 24) + 8;
        tm.na = true; tm.r_lo = r_lo; int nt = 4 + (r_hi - r_lo); nt += nt & 1;
        LAS float* bt = (LAS float*)(F.lds + 100 * 1024);
        const float* bsrc = inptr(I_NABIAS) + ((size_t)layer * 4 + h) * 465;
        __syncthreads();
        for (int i = TIDX; i < 465; i += 512) bt[i] = bsrc[i] * (1.0f / SC_NA);
        __syncthreads();
        const int t = qb * 256 + (TIDX >> 6) * 32 + (TIDX & 31);
        nl.qr = t >> 6; nl.qc = t & 63; nl.rs = min(max(nl.qr - 4, 0), 24); nl.cs = min(max(nl.qc - 8, 0), 48); nl.btab = bt;
        fa::body_seq<128, true>(QKV + (size_t)q0 * INCP + C_NAQ + 128 * h, INCP, QKV + C_NAK + 128 * h, INCP, QKV + C_NAV + 128 * h, INCP, tm, nt, SC_NA, nl, F.lds, o);
        fa_store(o, F.lds, orow0, false, nullptr, 1.0f);
    } else if (type == 0 || type == 2) {
        const int qc = (type == 0) ? C_NAQ + 128 * h : C_GQ + 128 * h, kc = (type == 0) ? C_NAK + 128 * h : C_GK + 128 * (h >> 1), vc = (type == 0) ? C_NAV + 128 * h : C_GV + 128 * (h >> 1);
        fa::body<128, 2, false>(QKV + (size_t)q0 * INCP + qc, INCP, QKV + kc, INCP, QKV + vc, INCP, tm, ntall, SC_NA, nl, F.lds, o);
        fa_store(o, F.lds, orow0, false, nullptr, 1.0f);
    } else if (type == 1) {
        fa::body_seq<192, false>(QM + (size_t)q0 * QMW + 192 * h, QMW, KVM + 320 * h, KVW, KVM + 320 * h + 192, KVW, tm, ntall, SC_MLA, nl, F.lds, o);
        fa_store(o, F.lds, orow0, false, nullptr, 1.0f);
    } else {
        const float lam_init = layer == 0 ? 0.2f : 0.35550906759096926f;
        LAS float* lm = (LAS float*)(F.lds + 100 * 1024);
        __syncthreads();
        if (TIDX < 64) { const float a = wave_sum(inptr(I_LQ1)[layer * 64 + TIDX] * inptr(I_LK1)[layer * 64 + TIDX]), c = wave_sum(inptr(I_LQ2)[layer * 64 + TIDX] * inptr(I_LK2)[layer * 64 + TIDX]);
            if (TIDX == 0) lm[0] = expf(a) - expf(c) + lam_init; }
        __syncthreads();
        const float lam = lm[0];
        GAS f32x4* stash = (GAS f32x4*)((float*)(ws + WS_U) + ((size_t)blockIdx.x * 512 + TIDX) * 64);
#pragma unroll 1
        for (int pass = 0; pass < 2; ++pass) {
            fa::body<64, 2, false>(QKV + (size_t)q0 * INCP + C_DQ + 128 * h + 64 * pass, INCP, QKV + C_DK + 128 * h + 64 * pass, INCP, QKV + C_DV + 128 * h, INCP, tm, ntall, SC_DIFF, nl, F.lds, o);
            if (pass == 0) {
#pragma unroll
                for (int d0 = 0; d0 < 4; ++d0)
#pragma unroll
                    for (int r4 = 0; r4 < 4; ++r4) stash[d0 * 4 + r4] = (f32x4){o[d0][4 * r4], o[d0][4 * r4 + 1], o[d0][4 * r4 + 2], o[d0][4 * r4 + 3]};
                __syncthreads();
            }
        }
#pragma unroll
        for (int d0 = 0; d0 < 4; ++d0)
#pragma unroll
            for (int r4 = 0; r4 < 4; ++r4) { const f32x4 s1 = stash[d0 * 4 + r4];
#pragma unroll
                for (int q = 0; q < 4; ++q) o[d0][4 * r4 + q] = s1[q] - lam * o[d0][4 * r4 + q]; }
        fa_store(o, F.lds, orow0, true, inptr(I_GSUB) + layer * 128, 1.0f - lam_init);
    }
}
#ifndef ATTN_Q0
#define ATTN_Q0 0
#endif
#ifndef ATTN_Q1
#define ATTN_Q1 0
#endif
__device__ __forceinline__ void attn_phase_fa(Frame& F, int layer) {
    const int total = 1024 + ((layer == 0) ? 128 : 0);
#pragma unroll 1
    for (int n = blockIdx.x; n < total; n += F.G) {
        int type, h, qb, b; bool latent = n < 1024;
        if (latent) { const int i = n >> 8, k = n & 255, idx = i * 64 + (k >> 2); type = (k + i) & 3; h = idx & 3; qb = (idx >> 2) & 7; b = idx >> 5; }
        else { const int v = n - 1024, hh = v & 15; type = hh >> 2; h = hh & 3; qb = 0; b = v >> 4; }
        attn_unit_fa(F, layer, b, latent, qb, type, h);
        if (ATTN_Q0 + ATTN_Q1 > 0) filler_quota(F, layer == 0 ? ATTN_Q0 : ATTN_Q1);
    }
    __syncthreads();
}

#ifndef REP_GEMM
#define REP_GEMM 1
#endif
#ifndef REP_WIN
#define REP_WIN REP_GEMM
#endif
#ifndef REP_FGU
#define REP_FGU REP_GEMM
#endif
#ifndef REP_PASS
#define REP_PASS 1
#endif
#ifndef WO_WGM
#define WO_WGM 4
#endif
#ifndef REV_DOWN
#define REV_DOWN 1
#endif
#ifndef FD_WGM
#define FD_WGM 4
#endif
#ifndef PROBE_HOTB
#define PROBE_HOTB 0
#endif
#ifndef PROBE_LATE_DENSE
#define PROBE_LATE_DENSE 0
#endif
#ifndef REP_FDN
#define REP_FDN REP_GEMM
#endif
#ifndef REP_MGU
#define REP_MGU REP_GEMM
#endif
#ifndef REP_MDN
#define REP_MDN REP_GEMM
#endif
#ifndef REP_ATTN
#define REP_ATTN 1
#endif
#ifndef REP_P0
#define REP_P0 1
#endif
#ifndef MK_MULTI
#define MK_MULTI 0
#endif
constexpr int PH_PER_LAYER = 11, N_PHASES = 1 + 2 * PH_PER_LAYER + 1;
struct Args { const float* in[31]; float* out; unsigned char* ws; int ph_lo, ph_hi; };
static_assert(sizeof(Args) == 31 * 8 + 8 + 8 + 8, "Args has no padding");

#define IN(k) (lo <= (k) && (k) < hi)
#if MK_MULTI
#define SEAM(k) do { } while (0)
#else
#define SEAM(k) do { if (IN(k) && IN((k) + 1)) xcd_barrier(bar); } while (0)
#endif
#ifndef FILL_BAR
#define FILL_BAR 1
#endif
#if MK_MULTI || !FILL_BAR
#define SEAM_FILL(k) SEAM(k)
#define TAIL_FILL(slot) filler(F, slot, -1)
#else
#define SEAM_FILL(k) do { if (IN(k) && IN((k) + 1)) xcd_barrier_fill(bar, F); } while (0)
#define TAIL_FILL(slot) do { } while (0)
#endif
__device__ __forceinline__ int opq_s(int v) { asm volatile("" : "+s"(v)); return v; }
template <int layer>
__device__ __forceinline__ void layer_phases(Frame& F, const XcdBarrier& bar, const int lo, const int hi, LAS int* mtab) {
    unsigned char* ws = F.ws; asm volatile("" : "+s"(ws));
        const int pb = 1 + layer * PH_PER_LAYER;
        const float* modl = (const float*)(ws + WS_MOD) + (size_t)layer * 9 * MODW;
#ifndef SKIP_NORM
        if (IN(pb + 0)) for (int rp_ = 0; rp_ < REP_PASS; ++rp_) norm_pass(F, layer, true, layer == 0, layer == 1);
#endif
        SEAM_FILL(pb + 0);
        if (IN(pb + 1)) {
            pg8::Gemm g{(const bf16*)(ws + WS_U), (const bf16*)(ws + WS_WIN) + (size_t)layer * INCP * 2048, MT, INCP, 2048, 2048, 2048};
            pg8::StaticOrder S; S.init(MT, INCP, F.G, opq_s((int)blockIdx.x));
            pg8::EpiBf16P E{(bf16*)(ws + WS_QKV), INCP, 0};
            for (int rep_ = 0; rep_ < REP_WIN; ++rep_) { pg8::gemm_phase<pg8::EpiBf16P, pg8::StaticOrder, PG8_ALIGN, PG8_SP2>(F.lds + RING_OFF, g, S, E); if (rep_ + 1 < REP_WIN) __syncthreads(); }
            TAIL_FILL(layer * 8 + 0);
        }
        SEAM_FILL(pb + 1);
#ifndef SKIP_POST
        if (IN(pb + 2)) post_pass(F, layer);
#endif
        SEAM_FILL(pb + 2);
#ifndef SKIP_UP
        if (IN(pb + 3)) {
            { pg8::Gemm g{(const bf16*)(ws + WS_QKV) + C_CQ, (const bf16*)(ws + WS_WQUP) + (size_t)layer * QMW * 384, MT, QMW, opq_s(384), INCP, 384};
              pg8::StaticOrder S; S.init(MT, QMW, F.G, opq_s((int)blockIdx.x));
              pg8::EpiQupRope E{(bf16*)(ws + WS_QM), (const float*)(ws + WS_ROPE)};
              for (int rep_ = 0; rep_ < REP_GEMM; ++rep_) { pg8::gemm_phase<pg8::EpiQupRope, pg8::StaticOrder, PG8_ALIGN, PG8_SP2>(F.lds + RING_OFF, g, S, E); if (rep_ + 1 < REP_GEMM) __syncthreads(); } }
            __syncthreads();
            { pg8::Gemm g{(const bf16*)(ws + WS_QKV) + C_CKV, (const bf16*)(ws + WS_WKVUP) + (size_t)layer * KVW * 256, MT, KVW, opq_s(256), INCP, 256};
              pg8::StaticOrder S; S.init(MT, KVW, F.G, opq_s((int)blockIdx.x));
              pg8::EpiBf16P E{(bf16*)(ws + WS_KVM), KVW, 0};
              for (int rep_ = 0; rep_ < REP_GEMM; ++rep_) { pg8::gemm_phase<pg8::EpiBf16P, pg8::StaticOrder, PG8_ALIGN, PG8_SP2>(F.lds + RING_OFF, g, S, E); if (rep_ + 1 < REP_GEMM) __syncthreads(); } }
            TAIL_FILL(layer * 8 + 1);
        }
#endif
        SEAM_FILL(pb + 3);
        #ifndef SKIP_ATTN
        if (IN(pb + 5)) {
#pragma unroll
            for (int rep_ = 0; rep_ < REP_ATTN; ++rep_) attn_phase_fa(F, layer);
            TAIL_FILL(layer * 8 + 2); }
#endif
        SEAM_FILL(pb + 5);
#ifndef SKIP_WOUT
        if (IN(pb + 6)) {
            pg8::Gemm g{(const bf16*)(ws + WS_O), (const bf16*)(ws + WS_WOUT) + (size_t)layer * 2048 * 2048, MT, 2048, 2048, 2048, 2048};
            pg8::EpiResGate E{(float*)(ws + WS_H), modl + 2 * DM, layer == 0 ? inptr(I_X) : nullptr, layer == 0 ? inptr(I_CTX) : nullptr};
            pg8::EpiResGate Ed{(float*)(ws + WS_R2), modl + 2 * DM, nullptr, nullptr}; (void)Ed;
            if constexpr (layer == 0) { pg8::StaticOrder S; S.init(MT, 2048, F.G, opq_s((int)blockIdx.x), WO_WGM); for (int rep_ = 1; rep_ < REP_GEMM; ++rep_) { pg8::gemm_phase<pg8::EpiResGate, pg8::StaticOrder, PG8_ALIGN, PG8_SP2>(F.lds + RING_OFF, g, S, Ed); __syncthreads(); } pg8::gemm_phase<pg8::EpiResGate, pg8::StaticOrder, PG8_ALIGN, PG8_SP2>(F.lds + RING_OFF, g, S, E); }
            else { pg8::LatentOrder S; S.init(NBATCH * SEQ, 2048, F.G, opq_s((int)blockIdx.x), WO_WGM); for (int rep_ = 1; rep_ < REP_GEMM; ++rep_) { pg8::gemm_phase<pg8::EpiResGate, pg8::LatentOrder, PG8_ALIGN, PG8_SP2>(F.lds + RING_OFF, g, S, Ed); __syncthreads(); } pg8::gemm_phase<pg8::EpiResGate, pg8::LatentOrder, PG8_ALIGN, PG8_SP2>(F.lds + RING_OFF, g, S, E); }            TAIL_FILL(layer * 8 + 3);
        }
#endif
        SEAM_FILL(pb + 6);
        if constexpr (layer == 0) {
#ifndef SKIP_DENSE
            if (IN(pb + 7)) { for (int rp_ = 0; rp_ < REP_PASS; ++rp_) norm_pass(F, layer, false, false); filler(F, layer * 8 + 6, CVQ_FFN_END); }
            SEAM_FILL(pb + 7);
            if (IN(pb + 9)) {
                pg8::Gemm g{(const bf16*)(ws + WS_U), (const bf16*)(ws + WS_WGU), MT, 2 * DFF, 2048, 2048, 2048};
                pg8::StaticOrder S; S.init(MT, 2 * DFF, F.G, opq_s((int)blockIdx.x));
                pg8::EpiSwiGLU E{(bf16*)(ws + WS_HM), DFF, 0};
                for (int rep_ = 0; rep_ < REP_FGU; ++rep_) { pg8::gemm_phase<pg8::EpiSwiGLU, pg8::StaticOrder, PG8_ALIGN, PG8_SP2>(F.lds + RING_OFF, g, S, E); if (rep_ + 1 < REP_FGU) __syncthreads(); }                TAIL_FILL(layer * 8 + 4);
            }
            SEAM_FILL(pb + 9);
            if (IN(pb + 10)) {
                pg8::Gemm g{(const bf16*)(ws + WS_HM), (const bf16*)(ws + WS_WD), MT, 2048, DFF, DFF, DFF, 0, 0, REV_DOWN};
                pg8::LatentOrder S; S.init(NBATCH * SEQ, 2048, F.G, opq_s((int)blockIdx.x), FD_WGM);
                pg8::EpiResGate E{(float*)(ws + WS_H), modl + 5 * DM, nullptr, nullptr};
                pg8::gemm_phase<pg8::EpiResGate, pg8::LatentOrder, PG8_ALIGN, PG8_SP2>(F.lds + RING_OFF, g, S, E);
                __syncthreads();
                { pg8::Gemm g2{(const bf16*)(ws + WS_HM), (const bf16*)(ws + WS_WD), MT, 2048, opq_s(1408), DFF, DFF, 0, 0, REV_DOWN};
                  pg8::CtxRemOrder S2; S2.G = F.G; S2.c = opq_s((int)blockIdx.x);
                  pg8::EpiSlab E2{(float*)(ws + WS_R1), 1.0f, 1408};
                  pg8::gemm_phase<pg8::EpiSlab, pg8::CtxRemOrder, PG8_ALIGN, PG8_SP2>(F.lds + RING_OFF, g2, S2, E2); }
                TAIL_FILL(layer * 8 + 5);
            }
            SEAM_FILL(pb + 10);
#endif
        } else {
#ifndef SKIP_MOE
            if (IN(pb + 7)) for (int rp_ = 0; rp_ < REP_PASS; ++rp_) moe_route_pass(F, layer);
            SEAM_FILL(pb + 7);
            if (IN(pb + 8)) { for (int rp_ = 0; rp_ < REP_PASS; ++rp_) moe_scatter_pass(F, layer); filler(F, layer * 8 + 6, CVQ_N); }
            SEAM(pb + 8);
            if (IN(pb + 9)) {
#if PROBE_LATE_DENSE
                {
                    pg8::Gemm gd{(const bf16*)(ws + WS_U), (const bf16*)(ws + WS_WGU), MT, 2 * DFF, 2048, 2048, 2048};
                    pg8::StaticOrder Sd; Sd.init(MT, 2 * DFF, F.G, opq_s((int)blockIdx.x));
                    pg8::EpiSwiGLU Ed{(bf16*)(ws + WS_R1), DFF, 0};
                    pg8::gemm_phase<pg8::EpiSwiGLU, pg8::StaticOrder, PG8_ALIGN, PG8_SP2>(F.lds + RING_OFF, gd, Sd, Ed);
                    __syncthreads();
                }
#endif
                moe_tables(F, mtab, 0);
                pg8::Gemm g{(const bf16*)(ws + WS_AS), (const bf16*)(ws + WS_MGU), 0, 2 * DFE, 2048, 2048, 2048, 0, KT_MOE};
                pg8::MoeOrder S; S.init(__builtin_amdgcn_readfirstlane(mtab[24]) * 256, 2 * DFE, F.G, opq_s((int)blockIdx.x));
                S.tab = mtab;
                pg8::EpiSwiGLU E{(bf16*)(ws + WS_HM2), DFE, 2 * DFE / 256, MOE_FP8 ? 1.0f / pg8::MOE_WSCALE : 1.0f};
                for (int rep_ = 0; rep_ < REP_MGU; ++rep_) { pg8::gemm_phase<pg8::EpiSwiGLU, pg8::MoeOrder, PG8_ALIGN, PG8_SP2, (MOE_FP8 != 0)>(F.lds + RING_OFF, g, S, E); if (rep_ + 1 < REP_MGU) __syncthreads(); }
            }
            SEAM(pb + 9);
            if (IN(pb + 10)) {
                moe_tables(F, mtab, 0);
                pg8::Gemm g{(const bf16*)(ws + WS_HM2), (const bf16*)(ws + WS_MD), 0, 2048, DFE, DFE, DFE, KT_MOE, KT_MOE, REV_DOWN};
#define RFL(i) __builtin_amdgcn_readfirstlane(mtab[i])
                { pg8::MoeFullOrder S; S.init(RFL(56) * 256, 2048, F.G, opq_s((int)blockIdx.x));
                  S.tab = mtab;
                  pg8::EpiBf16P E{(bf16*)(ws + WS_Y), 2048, 8, MOE_FP8 ? 1.0f / pg8::MOE_WSCALE : 1.0f};
                  for (int rep_ = 0; rep_ < REP_MDN; ++rep_) { pg8::gemm_phase<pg8::EpiBf16P, pg8::MoeFullOrder, PG8_ALIGN, PG8_SP2, (MOE_FP8 != 0)>(F.lds + RING_OFF, g, S, E); if (rep_ + 1 < REP_MDN) __syncthreads(); } }
                __syncthreads();
                { pg8::Gemm g2{(const bf16*)(ws + WS_HM2), (const bf16*)(ws + WS_MD), 0, 2048, opq_s(1792), DFE, DFE, KT_MOE, KT_MOE, REV_DOWN};
                  pg8::MoeRemOrder S; S.nsub = RFL(57) * 32; S.G = F.G; S.c = opq_s((int)blockIdx.x); S.tab = mtab;
                  pg8::EpiSlab E{(float*)(ws + WS_U), MOE_FP8 ? 1.0f / pg8::MOE_WSCALE : 1.0f};
                  pg8::gemm_phase<pg8::EpiSlab, pg8::MoeRemOrder, PG8_ALIGN, PG8_SP2, (MOE_FP8 != 0)>(F.lds + RING_OFF, g2, S, E); }
#undef RFL
            }
            SEAM(pb + 10);
#endif
        }
}

__global__ void __launch_bounds__(NWAVES * 64, 2) fwd_kernel(Args args) {
    extern __shared__ __attribute__((aligned(16))) unsigned char lds[];
    Frame F;
    F.lds = (LAS unsigned char*)lds;
    F.MISC = (volatile LAS unsigned*)(F.lds + MISC_OFF);
    F.wave = __builtin_amdgcn_readfirstlane((int)threadIdx.x >> 6);
    F.G = gridDim.x; F.gw = blockIdx.x * NWAVES + F.wave; F.NGW = F.G * NWAVES;
    F.out = args.out; F.ws = args.ws; F.ctl = (gu32*)(args.ws + WS_CTL);
    unsigned char* ws = args.ws;
    for (int u = TIDX; u < (LDS_BYTES - LDSCTL_OFF) / 4; u += NWAVES * 64) ((LAS unsigned*)(F.lds + LDSCTL_OFF))[u] = 0u;
    __syncthreads();
    XcdBarrier bar; bar.bar = (unsigned*)(F.ctl + CW_BAR); bar.x = 0; bar.st = nullptr;
#if !MK_MULTI
    bar = xcd_barrier_post((unsigned*)(F.ctl + CW_BAR), F.MISC + 8);
#endif
    const int lo = args.ph_lo, hi = args.ph_hi;
    LAS int* mtab = (LAS int*)(F.lds + LDSCTL_OFF + 1024);

    #ifndef SKIP_P0
    if (IN(0)) {
#pragma unroll
        for (int rep_ = 0; rep_ < REP_P0; ++rep_) p0_prologue(F); }
#endif
    SEAM_FILL(0);

    layer_phases<0>(F, bar, lo, hi, mtab);
    layer_phases<1>(F, bar, lo, hi, mtab);
#ifndef SKIP_FINAL
    if (IN(N_PHASES - 1)) for (int rp_ = 0; rp_ < REP_PASS; ++rp_) final_pass(F, 1);
#endif
#undef IN
#undef SEAM
}

extern "C" void kernel_launch(void* const* d_in, const int* in_sizes, int n_in, void* d_out, int out_size, void* d_ws, size_t ws_size, hipStream_t stream) {
    static int grid = 0;
    if (grid == 0) {
        if (n_in != 31 || in_sizes[0] != NBATCH * SEQ * DM || out_size != NBATCH * SEQ * DM || ws_size < WS_END) {
            fprintf(stderr, "kernel_launch: unexpected shapes (n_in %d, in0 %d, out %d, ws %zu, need %zu); nothing launched\n", n_in, n_in > 0 ? in_sizes[0] : -1, out_size, ws_size, (size_t)WS_END); grid = -1; return; }
        int dev = 0, cus = 0, per_cu = 0;
        if (hipGetDevice(&dev) != hipSuccess || hipDeviceGetAttribute(&cus, hipDeviceAttributeMultiprocessorCount, dev) != hipSuccess) { fprintf(stderr, "kernel_launch: device query failed\n"); grid = -1; return; }
        if (hipFuncSetAttribute((const void*)fwd_kernel, hipFuncAttributeMaxDynamicSharedMemorySize, LDS_BYTES) != hipSuccess) { fprintf(stderr, "kernel_launch: hipFuncSetAttribute failed\n"); grid = -1; return; }
        if (hipOccupancyMaxActiveBlocksPerMultiprocessor(&per_cu, (const void*)fwd_kernel, NWAVES * 64, LDS_BYTES) != hipSuccess || per_cu < 1)
            fprintf(stderr, "kernel_launch: note: occupancy query reports %d workgroups per CU\n", per_cu);
        (void)hipGetLastError();
        grid = cus < 256 ? cus : 256;
    }
    if (grid < 0) return;
    if (hipMemsetAsync((char*)d_ws + WS_CTL, 0, CTL_ZERO_BYTES, stream) != hipSuccess) { fprintf(stderr, "kernel_launch: memset failed\n"); return; }
    Args a{};
    for (int i = 0; i < 31; ++i) a.in[i] = (const float*)d_in[i];
    a.out = (float*)d_out; a.ws = (unsigned char*)d_ws;
#if MK_MULTI
    for (int p = 0; p < N_PHASES; ++p) {
        if (p == 1 + 8) continue;
        a.ph_lo = p; a.ph_hi = p + 1;
        hipLaunchKernelGGL(fwd_kernel, dim3(grid), dim3(NWAVES * 64), LDS_BYTES, stream, a);
    }
#else
    a.ph_lo = 0; a.ph_hi = N_PHASES;
    hipLaunchKernelGGL(fwd_kernel, dim3(grid), dim3(NWAVES * 64), LDS_BYTES, stream, a);
#endif
    const hipError_t le = hipPeekAtLastError();
    if (le != hipSuccess) fprintf(stderr, "kernel_launch: launch failed: %s\n", hipGetErrorName(le));
}
```
